# Optimizing an MI355X kernel written in HIP

```python
import jax, jax.numpy as jnp
from jax import lax
import numpy as np

D_MODEL = 1024
BATCH = 16
SEQ = 2048
DEPTH = 2

GRID_W = 64
CTX_LEN = 256
D_MIX = D_MODEL
RG_WIDTH = 3 * D_MIX // 8
RG_HEADS = 6
RG_HEAD_DIM = RG_WIDTH // RG_HEADS
RG_CONV = 4
RG_C = 8.0
M_WIDTH = 3 * D_MIX // 8
M_HEADS = 4
M_HEAD_DIM = M_WIDTH // M_HEADS
M_CHUNK = 128
CM_WIDTH = D_MIX - RG_WIDTH - M_WIDTH
CM_GROUPS = 4
CM_GROUP_DIM = CM_WIDTH // CM_GROUPS
CM_CHUNK = 128
D_IN = 2 * RG_WIDTH + 4 * M_WIDTH + 4 * M_HEADS + 2 * CM_WIDTH
N_EXPERTS = 256
TOP_K = 8
N_GROUPS = 8
TOPK_GROUPS = 4
MOE_FF = (2048 * D_MODEL // 7168) // 32 * 32
ROUTED_SCALE = 2.5
EXPERT_BLOCK = 128
EPS = 1e-6

kernel_name = "hybrid_rglru_mlstm_gmlp_moe_prefix_dit"

F32 = jnp.float32


def rms_norm(x, g):
    xf = x.astype(F32)
    y = xf * lax.rsqrt(jnp.mean(xf * xf, axis=-1, keepdims=True) + EPS)
    return (y * g.astype(F32)).astype(x.dtype)


def pos_embed_2d(rows, dim):
    quarter = dim // 4
    omega = 1.0 / (10000.0 ** (jnp.arange(quarter, dtype=F32) / quarter))
    row = jnp.repeat(jnp.arange(rows, dtype=F32), GRID_W)
    col = jnp.tile(jnp.arange(GRID_W, dtype=F32), rows)

    def axis_embed(p):
        ang = p[:, None] * omega[None, :]
        return jnp.concatenate([jnp.sin(ang), jnp.cos(ang)], axis=-1)

    return jnp.concatenate([axis_embed(row), axis_embed(col)], axis=-1)


def adaln_params(cond, w_mod, b_mod):
    m = jax.nn.silu(cond) @ w_mod + b_mod
    m = m.reshape(cond.shape[0], 6, cond.shape[-1])
    return jnp.moveaxis(m, 1, 0)[:, :, None, :]


def modulate(z, shift, scale):
    return z * (1.0 + scale) + shift


def split_columns(p):
    sizes = (RG_WIDTH, RG_WIDTH, M_WIDTH, M_WIDTH, M_WIDTH, M_WIDTH, 4 * M_HEADS, 2 * CM_WIDTH)
    return jnp.split(p, np.cumsum(sizes)[:-1].tolist(), axis=-1)


def short_conv(z, w, b):
    C = z.shape[-1]
    y = lax.conv_general_dilated(z, w[:, None, :].astype(z.dtype), window_strides=(1,),
                                 padding=[(2, 1)], dimension_numbers=('NWC', 'WIO', 'NWC'),
                                 feature_group_count=C)
    return y + b


def rglru_gates(z, w, b, lam):
    B, T, W = z.shape
    zb = z.reshape(B, T, RG_HEADS, RG_HEAD_DIM)
    pre = jnp.einsum('bthi,ghij->gbthj', zb, w.astype(F32)).reshape(2, B, T, W) + b.astype(F32)[:, None, None, :]
    r = jax.nn.sigmoid(pre[0])
    i = jax.nn.sigmoid(pre[1])
    log_a = -RG_C * r * jax.nn.softplus(-lam.astype(F32))
    return jnp.exp(log_a), jnp.sqrt(-jnp.expm1(2.0 * log_a)) * (i * z)


def linear_recurrence(a, u, h0):
    def combine(left, right):
        a_l, u_l = left
        a_r, u_r = right
        return a_l * a_r, a_r * u_l + u_r
    a_cum, u_cum = lax.associative_scan(combine, (a, u), axis=1)
    return a_cum * h0[:, None, :] + u_cum


def rglru_bidir(z_lat, z_ctx, gate_w, gate_b, lam, need_ctx):
    z_lat = z_lat.astype(F32)
    z_ctx = z_ctx.astype(F32)
    y_lat, y_ctx = 0.0, 0.0
    for d in range(2):
        flip = (lambda t: jnp.flip(t, axis=1)) if d else (lambda t: t)
        a_c, u_c = rglru_gates(flip(z_ctx), gate_w[d], gate_b[d], lam[d])
        h_c = linear_recurrence(a_c, u_c, jnp.zeros_like(u_c[:, 0]))
        a_x, u_x = rglru_gates(flip(z_lat), gate_w[d], gate_b[d], lam[d])
        h_x = linear_recurrence(a_x, u_x, h_c[:, -1])
        y_lat = y_lat + flip(h_x)
        if need_ctx:
            y_ctx = y_ctx + flip(h_c)
    return y_lat, (y_ctx if need_ctx else None)


def mlstm_prepare(q, k, v, gt, gate_b):
    B, T, _ = q.shape
    heads = lambda t: t.astype(F32).reshape(B, T, M_HEADS, M_HEAD_DIM).transpose(0, 2, 1, 3)
    pre = gt.astype(F32).reshape(B, T, 2, 2, M_HEADS) + gate_b.astype(F32)
    pre = pre.transpose(2, 3, 0, 4, 1)
    return heads(q), heads(k) * (M_HEAD_DIM ** -0.5), heads(v), pre[:, 0], jax.nn.log_sigmoid(pre[:, 1])


def mlstm_chunkwise(q, k, v, li, lf, state0, with_out):
    B, H, T, dk = k.shape
    dv = v.shape[-1]
    L = M_CHUNK
    NC = T // L
    kc = k.reshape(B, H, NC, L, dk)
    vc = v.reshape(B, H, NC, L, dv)
    lic = li.reshape(B, H, NC, L)
    bc = jnp.cumsum(lf.reshape(B, H, NC, L), axis=-1)
    g = bc[..., -1]
    w_end = g[..., None] - bc + lic

    def step(carry, inp):
        C, n, m = carry
        kk, vv, ww, gg = inp
        m_new = jnp.maximum(gg + m, ww.max(-1))
        decay = jnp.exp(gg + m - m_new)
        ws = jnp.exp(ww - m_new[..., None])
        C_new = decay[..., None, None] * C + jnp.einsum('bhl,bhlk,bhlv->bhkv', ws, kk, vv)
        n_new = decay[..., None] * n + jnp.einsum('bhl,bhlk->bhk', ws, kk)
        return (C_new, n_new, m_new), (C, n, m)

    xs = (jnp.moveaxis(kc, 2, 0), jnp.moveaxis(vc, 2, 0), jnp.moveaxis(w_end, 2, 0), jnp.moveaxis(g, 2, 0))
    final, (C_st, n_st, m_st) = lax.scan(step, state0, xs)
    if not with_out:
        return None, final
    C_st = jnp.moveaxis(C_st, 0, 2)
    n_st = jnp.moveaxis(n_st, 0, 2)
    m_st = jnp.moveaxis(m_st, 0, 2)
    qc = q.reshape(B, H, NC, L, dk)
    mask = jnp.tril(jnp.ones((L, L), dtype=bool))
    D = jnp.where(mask, bc[..., :, None] - bc[..., None, :] + lic[..., None, :], -jnp.inf)
    inter = bc + m_st[..., None]
    m = jnp.maximum(D.max(-1), inter)
    S = jnp.einsum('bhntk,bhnsk->bhnts', qc, kc) * jnp.exp(D - m[..., None])
    e_inter = jnp.exp(inter - m)
    num = jnp.einsum('bhnts,bhnsv->bhntv', S, vc) + e_inter[..., None] * jnp.einsum('bhntk,bhnkv->bhntv', qc, C_st)
    den = S.sum(-1) + e_inter * jnp.einsum('bhntk,bhnk->bhnt', qc, n_st)
    h = num / jnp.maximum(jnp.abs(den), jnp.exp(-m))[..., None]
    return h.reshape(B, H, T, dv), final


def mlstm_readout(hsum, o, norm_g):
    B, H, T, dv = hsum.shape
    hs = hsum.transpose(0, 2, 1, 3)
    hs = hs * lax.rsqrt(jnp.mean(hs * hs, axis=-1, keepdims=True) + EPS)
    hs = hs.reshape(B, T, H * dv) * norm_g.astype(F32)
    return (jax.nn.sigmoid(o.astype(F32)) * hs).astype(o.dtype)


def mlstm_bidir(lat_cols, ctx_cols, gate_b, norm_g, need_ctx):
    q, k, v, li, lf = mlstm_prepare(lat_cols[0], lat_cols[1], lat_cols[2], lat_cols[4], gate_b)
    qc, kc, vc, lic, lfc = mlstm_prepare(ctx_cols[0], ctx_cols[1], ctx_cols[2], ctx_cols[4], gate_b)
    B = q.shape[0]
    zero = (jnp.zeros((B, M_HEADS, M_HEAD_DIM, M_HEAD_DIM), F32),
            jnp.zeros((B, M_HEADS, M_HEAD_DIM), F32),
            jnp.zeros((B, M_HEADS), F32))
    lat_sum, ctx_sum = 0.0, 0.0
    for d in range(2):
        fl = (lambda t: jnp.flip(t, axis=2)) if d else (lambda t: t)
        h_c, state = mlstm_chunkwise(fl(qc), fl(kc), fl(vc), fl(lic[d]), fl(lfc[d]), zero, need_ctx)
        h_x, _ = mlstm_chunkwise(fl(q), fl(k), fl(v), fl(li[d]), fl(lf[d]), state, True)
        lat_sum = lat_sum + fl(h_x)
        if need_ctx:
            ctx_sum = ctx_sum + fl(h_c)
    y_lat = mlstm_readout(lat_sum, lat_cols[3], norm_g)
    y_ctx = mlstm_readout(ctx_sum, ctx_cols[3], norm_g) if need_ctx else None
    return y_lat, y_ctx


def chunk_mlp(p, norm_g, w_s, b_s):
    u, v = jnp.split(p, 2, axis=-1)
    v = rms_norm(v, norm_g)
    B, T, _ = v.shape
    vb = v.reshape(B, T // CM_CHUNK, CM_CHUNK, CM_GROUPS, CM_GROUP_DIM)
    mixed = jnp.einsum('gts,bnsgc->bntgc', w_s, vb) + b_s.T[None, None, :, :, None]
    return (u * mixed.reshape(B, T, CM_WIDTH)).astype(p.dtype)


def swiglu(x, w_g, w_u, w_d):
    return (jax.nn.silu(x @ w_g) * (x @ w_u)) @ w_d


def routed_experts(xt, eidx, w, e_gate, e_up, e_down):
    T, D = xt.shape
    K = eidx.shape[1]
    E = e_gate.shape[0]
    A = T * K
    flat_e = eidx.reshape(A)
    order = jnp.argsort(flat_e)
    e_sorted = flat_e[order]
    tok_sorted = order // K
    w_sorted = w.reshape(A)[order]
    counts = jnp.bincount(flat_e, length=E)
    padded = (counts + EXPERT_BLOCK - 1) // EXPERT_BLOCK * EXPERT_BLOCK
    pad_end = jnp.cumsum(padded)
    pad_start = pad_end - padded
    start = jnp.cumsum(counts) - counts
    dest = pad_start[e_sorted] + jnp.arange(A) - start[e_sorted]
    n_blocks = -(-(A + E * (EXPERT_BLOCK - 1)) // EXPERT_BLOCK)
    n_rows = n_blocks * EXPERT_BLOCK
    row_tok = jnp.zeros((n_rows,), jnp.int32).at[dest].set(tok_sorted)
    row_w = jnp.zeros((n_rows,), w.dtype).at[dest].set(w_sorted)
    block_e = jnp.minimum(jnp.searchsorted(pad_end, jnp.arange(n_blocks) * EXPERT_BLOCK, side='right'), E - 1)

    def block_ffn(args):
        tok_b, w_b, e = args
        xb = xt[tok_b]
        hb = jax.nn.silu(xb @ e_gate[e]) * (xb @ e_up[e])
        return ((hb @ e_down[e]) * w_b[:, None]).astype(xt.dtype)

    yb = lax.map(block_ffn, (row_tok.reshape(n_blocks, EXPERT_BLOCK),
                             row_w.reshape(n_blocks, EXPERT_BLOCK), block_e))
    return jnp.zeros_like(xt).at[row_tok].add(yb.reshape(n_rows, D))


def moe(xt, router_w, router_b, e_gate, e_up, e_down, s_gate, s_up, s_down):
    T = xt.shape[0]
    scores = jax.nn.sigmoid((xt @ router_w).astype(F32))
    sel = scores + router_b.astype(F32)
    per_group = N_EXPERTS // N_GROUPS
    group_score = lax.top_k(sel.reshape(T, N_GROUPS, per_group), 2)[0].sum(-1)
    _, gidx = lax.top_k(group_score, TOPK_GROUPS)
    gmask = (gidx[:, :, None] == jnp.arange(N_GROUPS)[None, None, :]).any(axis=1)
    sel = jnp.where(jnp.repeat(gmask, per_group, axis=1), sel, -jnp.inf)
    _, eidx = lax.top_k(sel, TOP_K)
    w = jnp.take_along_axis(scores, eidx, axis=1)
    w = w / w.sum(-1, keepdims=True) * ROUTED_SCALE
    return routed_experts(xt, eidx, w, e_gate, e_up, e_down) + swiglu(xt, s_gate, s_up, s_down)


def hybrid_layer(x, h, c, c_ctx, norm1_g, norm2_g, w_mod, b_mod, w_in, rg_conv_w, rg_conv_b,
                 rg_gate_w, rg_gate_b, rg_lambda, mlstm_gate_b, mlstm_norm_g, cm_norm_g, cm_w, cm_b,
                 w_out, router_w, router_b, exp_gate, exp_up, exp_down, sh_gate, sh_up, sh_down, last):
    need_ctx = not last
    mod_x = adaln_params(c, w_mod, b_mod)
    mod_h = adaln_params(c_ctx[None], w_mod, b_mod)
    xa = modulate(rms_norm(x, norm1_g), mod_x[0], mod_x[1])
    ha = modulate(rms_norm(h, norm1_g), mod_h[0], mod_h[1])
    rx, rgx, qx, kx, vx, ox, gx, cmx = split_columns(xa @ w_in)
    rh, rgh, qh, kh, vh, oh, gh, cmh = split_columns(ha @ w_in)

    r_lat, r_ctx = rglru_bidir(short_conv(rx, rg_conv_w, rg_conv_b), short_conv(rh, rg_conv_w, rg_conv_b),
                               rg_gate_w, rg_gate_b, rg_lambda, need_ctx)
    m_lat, m_ctx = mlstm_bidir((qx, kx, vx, ox, gx), (qh, kh, vh, oh, gh), mlstm_gate_b, mlstm_norm_g, need_ctx)
    mix_lat = jnp.concatenate([(jax.nn.gelu(rgx) * r_lat).astype(x.dtype), m_lat,
                               chunk_mlp(jax.nn.gelu(cmx), cm_norm_g, cm_w, cm_b)], axis=-1)
    x = x + mod_x[2] * (mix_lat @ w_out)
    if need_ctx:
        mix_ctx = jnp.concatenate([(jax.nn.gelu(rgh) * r_ctx).astype(h.dtype), m_ctx,
                                   chunk_mlp(jax.nn.gelu(cmh), cm_norm_g, cm_w, cm_b)], axis=-1)
        h = h + mod_h[2] * (mix_ctx @ w_out)

    moe_w = (router_w, router_b, exp_gate, exp_up, exp_down, sh_gate, sh_up, sh_down)
    xb = modulate(rms_norm(x, norm2_g), mod_x[3], mod_x[4])
    D = x.shape[-1]
    if last:
        x = x + mod_x[5] * moe(xb.reshape(-1, D), *moe_w).reshape(x.shape)
        return x, None
    hb = modulate(rms_norm(h, norm2_g), mod_h[3], mod_h[4])
    nx = x.shape[0] * x.shape[1]
    y = moe(jnp.concatenate([xb.reshape(-1, D), hb.reshape(-1, D)], axis=0), *moe_w)
    x = x + mod_x[5] * y[:nx].reshape(x.shape)
    h = h + mod_h[5] * y[nx:].reshape(h.shape)
    return x, h


def setup_inputs(seed: int = 0) -> dict:
    key = jax.random.key(seed)
    ks_arr = jax.random.split(key, 32)
    ks = iter([ks_arr[i] for i in range(32)])

    def normal(shape, std):
        return jax.random.normal(next(ks), shape, F32) * std

    def uniform(shape, lo, hi):
        return jax.random.uniform(next(ks), shape, F32, lo, hi)

    L = DEPTH
    x = normal((BATCH, SEQ, D_MODEL), 1.0)
    c = normal((BATCH, D_MODEL), 1.0)
    ctx = normal((BATCH, CTX_LEN, D_MODEL), 1.0)
    c_ctx = normal((D_MODEL,), 1.0)
    norm1_g = 1.0 + normal((L, D_MODEL), 0.02)
    norm2_g = 1.0 + normal((L, D_MODEL), 0.02)
    w_mod = normal((L, D_MODEL, 6 * D_MODEL), 0.5 * D_MODEL ** -0.5)
    b_mod = normal((L, 6 * D_MODEL), 0.02)
    w_in = normal((L, D_MODEL, D_IN), D_MODEL ** -0.5)
    rg_conv_w = normal((L, RG_CONV, RG_WIDTH), RG_CONV ** -0.5)
    rg_conv_b = normal((L, RG_WIDTH), 0.02)
    rg_gate_w = normal((L, 2, 2, RG_HEADS, RG_HEAD_DIM, RG_HEAD_DIM), RG_HEAD_DIM ** -0.5)
    rg_gate_b = normal((L, 2, 2, RG_WIDTH), 0.02)
    a0 = uniform((L, 2, RG_WIDTH), 0.9, 0.999)
    s = a0 ** (1.0 / RG_C)
    rg_lambda = jnp.log(s) - jnp.log1p(-s)
    mlstm_gate_b = jnp.stack([normal((L, 2, M_HEADS), 0.1), uniform((L, 2, M_HEADS), 3.0, 6.0)], axis=2)
    mlstm_norm_g = 1.0 + normal((L, M_WIDTH), 0.02)
    cm_norm_g = 1.0 + normal((L, CM_WIDTH), 0.02)
    cm_w = normal((L, CM_GROUPS, CM_CHUNK, CM_CHUNK), CM_CHUNK ** -0.5)
    cm_b = 1.0 + normal((L, CM_GROUPS, CM_CHUNK), 0.02)
    w_out = normal((L, D_MIX, D_MODEL), D_MIX ** -0.5)
    router_w = normal((L, D_MODEL, N_EXPERTS), D_MODEL ** -0.5)
    router_b = normal((L, N_EXPERTS), 0.01)
    exp_gate = normal((L, N_EXPERTS, D_MODEL, MOE_FF), D_MODEL ** -0.5)
    exp_up = normal((L, N_EXPERTS, D_MODEL, MOE_FF), D_MODEL ** -0.5)
    exp_down = normal((L, N_EXPERTS, MOE_FF, D_MODEL), MOE_FF ** -0.5)
    sh_gate = normal((L, D_MODEL, MOE_FF), D_MODEL ** -0.5)
    sh_up = normal((L, D_MODEL, MOE_FF), D_MODEL ** -0.5)
    sh_down = normal((L, MOE_FF, D_MODEL), MOE_FF ** -0.5)
    final_norm_g = 1.0 + normal((D_MODEL,), 0.02)
    return {"x": x, "c": c, "ctx": ctx, "c_ctx": c_ctx, "norm1_g": norm1_g, "norm2_g": norm2_g,
            "w_mod": w_mod, "b_mod": b_mod, "w_in": w_in, "rg_conv_w": rg_conv_w, "rg_conv_b": rg_conv_b,
            "rg_gate_w": rg_gate_w, "rg_gate_b": rg_gate_b, "rg_lambda": rg_lambda,
            "mlstm_gate_b": mlstm_gate_b, "mlstm_norm_g": mlstm_norm_g, "cm_norm_g": cm_norm_g,
            "cm_w": cm_w, "cm_b": cm_b, "w_out": w_out, "router_w": router_w, "router_b": router_b,
            "exp_gate": exp_gate, "exp_up": exp_up, "exp_down": exp_down, "sh_gate": sh_gate,
            "sh_up": sh_up, "sh_down": sh_down, "final_norm_g": final_norm_g}


def reference(x, c, ctx, c_ctx, norm1_g, norm2_g, w_mod, b_mod, w_in, rg_conv_w, rg_conv_b,
              rg_gate_w, rg_gate_b, rg_lambda, mlstm_gate_b, mlstm_norm_g, cm_norm_g, cm_w, cm_b,
              w_out, router_w, router_b, exp_gate, exp_up, exp_down, sh_gate, sh_up, sh_down,
              final_norm_g):
    rows = x.shape[1] // GRID_W
    x = x + pos_embed_2d(rows, x.shape[-1]).astype(x.dtype)[None]
    h = ctx
    for l in range(DEPTH):
        x, h = hybrid_layer(x, h, c, c_ctx, norm1_g[l], norm2_g[l], w_mod[l], b_mod[l], w_in[l],
                            rg_conv_w[l], rg_conv_b[l], rg_gate_w[l], rg_gate_b[l], rg_lambda[l],
                            mlstm_gate_b[l], mlstm_norm_g[l], cm_norm_g[l], cm_w[l], cm_b[l], w_out[l],
                            router_w[l], router_b[l], exp_gate[l], exp_up[l], exp_down[l],
                            sh_gate[l], sh_up[l], sh_down[l], l == DEPTH - 1)
    return rms_norm(x, final_norm_g)
```

```cpp
#include <hip/hip_runtime.h>
#include <cstdio>
#include <cstdint>

#ifndef MK_PER_PHASE
#define MK_PER_PHASE 1
#endif

#define LAS __attribute__((address_space(3)))
typedef unsigned short bf16_t;
typedef short bf16x8 __attribute__((ext_vector_type(8)));
typedef float f32x4 __attribute__((ext_vector_type(4)));
typedef float f32x2 __attribute__((ext_vector_type(2)));
typedef unsigned u32x4 __attribute__((ext_vector_type(4)));
typedef unsigned u32x2 __attribute__((ext_vector_type(2)));

constexpr int D = 1024, NBATCH = 16, SEQ = 2048, CTXL = 256;
constexpr int NLAT = NBATCH * SEQ, NCTX = NBATCH * CTXL, TOK = NLAT + NCTX;
constexpr int DIN = 2832, PW = 2816, NIN = 3072;
constexpr int NE = 256, FF = 288, NSLOT = 9, LCAP = TOK;
constexpr int NTHREADS = 512;
constexpr int LDS_BYTES = 147456;
constexpr int LDS_TAB = 131072;
constexpr int LDS_BARW = LDS_BYTES - 16;
constexpr float EPS = 1e-6f;

constexpr int PC_RX = 0, PC_RG = 384, PC_Q = 768, PC_K = 1152, PC_V = 1536, PC_O = 1920, PC_CU = 2304, PC_CV = 2560;

constexpr size_t WS_CTL = 0, CTL_BYTES = 65536;
constexpr size_t CTL_CNT = 16384, CTL_QUEUE = 20480;
constexpr size_t WS_MOD = 65536;
constexpr size_t WS_X = WS_MOD + 1048576;
constexpr size_t WS_XA = WS_X + (size_t)TOK * D * 4;
constexpr size_t WS_R1 = WS_XA + (size_t)TOK * D * 2;
constexpr size_t R1_BYTES = (size_t)TOK * NSLOT * D * 2;
constexpr size_t WS_P = WS_R1;
constexpr size_t WS_MIX = WS_P + (size_t)TOK * PW * 2;
constexpr size_t WS_MHS = WS_MIX + (size_t)TOK * D * 2;
constexpr size_t WS_RGY = WS_MHS + (size_t)2 * TOK * 384 * 4;
static_assert(WS_RGY + (size_t)2 * TOK * 384 * 4 <= WS_R1 + R1_BYTES, "aliases");
constexpr int HB_ROWS = (TOK * 8 / 256 + 256 + TOK / 256) * 256;
constexpr size_t WS_HB = WS_R1 + R1_BYTES;
constexpr size_t WS_GATES = WS_HB + (size_t)HB_ROWS * FF * 2 + 256;
constexpr size_t WS_LOGITS = WS_GATES + (size_t)TOK * 16 * 4;
constexpr size_t WS_LSLOT = WS_LOGITS + (size_t)TOK * 256 * 4;
constexpr size_t WS_LW = WS_LSLOT + (size_t)NE * LCAP * 4;
constexpr size_t WS_WIN = WS_LW + (size_t)NE * LCAP * 4;
constexpr size_t WS_WOUT = WS_WIN + (size_t)2 * NIN * D * 2;
constexpr size_t WS_ROUT = WS_WOUT + (size_t)2 * D * D * 2;
constexpr size_t WS_E1 = WS_ROUT + (size_t)2 * NE * D * 2;
constexpr size_t WS_E2 = WS_E1 + (size_t)2 * 257 * 576 * D * 2 + 256;
constexpr size_t WS_END = WS_E2 + (size_t)2 * 257 * D * FF * 2 + 256;

__device__ __forceinline__ float bf2f(bf16_t b) { return __uint_as_float(((unsigned)b) << 16); }
__device__ __forceinline__ unsigned cvt_pk_bf16(float lo, float hi) { unsigned r; asm volatile("v_cvt_pk_bf16_f32 %0, %1, %2" : "=v"(r) : "v"(lo), "v"(hi)); return r; }
__device__ __forceinline__ bf16_t f2bf(float f) { return (bf16_t)(cvt_pk_bf16(f, 0.f) & 0xffffu); }
__device__ __forceinline__ float sigmoidf_(float x) { return 1.0f / (1.0f + __expf(-x)); }
__device__ __forceinline__ float siluf_(float x) { return x / (1.0f + __expf(-x)); }
__device__ __forceinline__ float gelu_tanh(float x) { const float u = 1.5957691216057308f * (x + 0.044715f * x * x * x); return x / (1.0f + __expf(-u)); }
__device__ __forceinline__ float wave_sum(float v) {
#pragma unroll
    for (int o = 32; o >= 1; o >>= 1) v += __shfl_xor(v, o);
    return v;
}
__device__ __forceinline__ int opaque_tid() { int t = threadIdx.x; asm volatile("" : "+v"(t)); return t; }
#define WAIT_VM0() asm volatile("s_waitcnt vmcnt(0)" ::: "memory")

#define XB_TMO      128
#define XB_XCNT(j)  (256  + 64 * (j))
#define XB_XSUB(j)  (1280 + 64 * (j))
#define XB_XGEN(j)  (2304 + 64 * (j))
#define XB_TOP      3328
#define XB_TOPGEN   3392
#define XCD_BAR_WORDS 3456
#define XB_SPIN_CAP (1u << 18)

__device__ __forceinline__ unsigned xb_ld(unsigned* p)              { return __hip_atomic_load(p, __ATOMIC_RELAXED, __HIP_MEMORY_SCOPE_AGENT); }
__device__ __forceinline__ unsigned xb_add(unsigned* p, unsigned v) { return __hip_atomic_fetch_add(p, v, __ATOMIC_RELAXED, __HIP_MEMORY_SCOPE_AGENT); }
__device__ __forceinline__ unsigned xb_xcc_id() { return (unsigned)__builtin_amdgcn_s_getreg((3 << 11) | 20) & 0xFu; }
#define XB_SPIN(cond, bar) do { unsigned _sp = 0; while (cond) { __builtin_amdgcn_s_sleep(1); \
    if ((++_sp & 255u) == 0u) { if (xb_ld(&(bar)[XB_TMO])) break; if (_sp > XB_SPIN_CAP) { atomicAdd(&(bar)[XB_TMO], 1u); break; } } } } while (0)

struct XcdBarrier { unsigned* bar; unsigned x; volatile LAS unsigned* st; };

__device__ __forceinline__ XcdBarrier xcd_barrier_post(unsigned* bar, volatile LAS unsigned* st) {
    XcdBarrier b; b.bar = bar; b.x = xb_xcc_id(); b.st = st;
    if (threadIdx.x == 0) (void)xb_add(&bar[XB_XCNT(b.x)], 1u);
    return b;
}
__device__ __forceinline__ void xcd_barrier_complete(unsigned* bar, unsigned x, unsigned& nloc, unsigned& nx) {
    const unsigned G = gridDim.x * gridDim.y * gridDim.z;
    unsigned sum, cnt, mine, sp = 0u;
    for (;;) {
        sum = 0u; cnt = 0u; mine = 0u;
#pragma unroll
        for (unsigned j = 0; j < 16; ++j) { const unsigned c = xb_ld(&bar[XB_XCNT(j)]); sum += c; cnt += (c > 0u) ? 1u : 0u; mine = (j == x) ? c : mine; }
        if (sum == G) break;
        __builtin_amdgcn_s_sleep(1);
        if ((++sp & 255u) == 0u) { if (xb_ld(&bar[XB_TMO])) break; if (sp > XB_SPIN_CAP) { atomicAdd(&bar[XB_TMO], 1u); break; } }
    }
    nloc = mine > 0u ? mine : 1u; nx = cnt > 0u ? cnt : 1u;
}
__device__ __forceinline__ void xcd_barrier(const XcdBarrier& b) {
    asm volatile("s_waitcnt vmcnt(0)" ::: "memory");
    __syncthreads();
    if (threadIdx.x == 0) {
        unsigned* bar = b.bar;
        __builtin_amdgcn_s_waitcnt(0);
        unsigned nloc = b.st[0], nx = b.st[1];
        if (nloc == 0u) { xcd_barrier_complete(bar, b.x, nloc, nx); b.st[0] = nloc; b.st[1] = nx; }
        const unsigned old = xb_add(&bar[XB_XSUB(b.x)], 1u);
        const unsigned gen = old / nloc;
        if (old + 1u == (gen + 1u) * nloc) {
            __builtin_amdgcn_fence(__ATOMIC_RELEASE, "agent");
            asm volatile("s_waitcnt vmcnt(0)" ::: "memory");
            const unsigned og = xb_add(&bar[XB_TOP], 1u);
            const unsigned tg = og / nx;
            if (og + 1u == (tg + 1u) * nx) xb_add(&bar[XB_TOPGEN], 1u);
            else XB_SPIN(xb_ld(&bar[XB_TOPGEN]) == tg, bar);
            __builtin_amdgcn_fence(__ATOMIC_ACQUIRE, "agent");
            xb_add(&bar[XB_XGEN(b.x)], 1u);
            asm volatile("s_waitcnt vmcnt(0)" ::: "memory");
        } else {
            XB_SPIN(xb_ld(&bar[XB_XGEN(b.x)]) == gen, bar);
            __builtin_amdgcn_fence(__ATOMIC_ACQUIRE, "agent");
            asm volatile("s_waitcnt vmcnt(0)" ::: "memory");
        }
    }
    __syncthreads();
}

struct Args { const float* in[29]; float* out; unsigned char* ws; int ph_lo, ph_hi; };
enum { I_X = 0, I_C, I_CTX, I_CCTX, I_N1G, I_N2G, I_WMOD, I_BMOD, I_WIN, I_RGCW, I_RGCB, I_RGGW, I_RGGB, I_RGLAM, I_MGB, I_MNG, I_CMNG, I_CMW, I_CMB,
       I_WOUT, I_RW, I_RB, I_EG, I_EU, I_ED, I_SG, I_SU, I_SD, I_FNG };

__device__ __forceinline__ int lds_byte(int r, int c) { const int st = (r >> 4) * 2 + (c >> 5), ob = (r & 15) * 64 + (c & 31) * 2; return st * 1024 + (ob ^ (((ob >> 9) & 1) << 5)); }
__device__ __forceinline__ void stage_rc(int b, int& R, int& C) { const int st = b >> 10, sb = b & 1023, swz = sb ^ (((sb >> 9) & 1) << 5); R = (st >> 1) * 16 + (swz >> 6); C = (st & 1) * 32 + ((swz & 63) >> 1); }

template <int BN, int WC> struct GT { static constexpr int WR = 8 / WC, MF = 256 / WR / 16, NF = BN / WC / 16, BP = BN / 64; };

template <int BN, int WC>
__device__ __forceinline__ void gemm_run(LAS unsigned char* lds, f32x4 (&acc)[GT<BN, WC>::MF][GT<BN, WC>::NF], const unsigned char* Ab, const unsigned (&aoff)[4],
                                         const unsigned char* Bb, const unsigned (&boff)[GT<BN, WC>::BP], const int nt, const bool tail) {
    constexpr int MF = GT<BN, WC>::MF, NF = GT<BN, WC>::NF, BP = GT<BN, WC>::BP;
    const int tid = opaque_tid(), wid = __builtin_amdgcn_readfirstlane(tid >> 6), lane = tid & 63, fr = lane & 15, fq = lane >> 4;
    const int wr = wid / WC, wc = wid % WC;
    const int aro = lds_byte(wr * (MF * 16) + fr, fq * 8), bro = 32768 + lds_byte(wc * (NF * 16) + fr, fq * 8);
#pragma unroll
    for (int m = 0; m < MF; ++m)
#pragma unroll
        for (int n = 0; n < NF; ++n) acc[m][n] = (f32x4){0.f, 0.f, 0.f, 0.f};
#define GE_STAGE(buf, kt) do { \
        _Pragma("unroll") for (int _i = 0; _i < 4; ++_i) __builtin_amdgcn_global_load_lds((const unsigned*)(Ab + aoff[_i] + (size_t)(kt) * 128), (LAS unsigned*)(lds + (buf) * 65536 + wid * 1024 + _i * 8192), 16, 0, 0); \
        _Pragma("unroll") for (int _i = 0; _i < BP; ++_i) __builtin_amdgcn_global_load_lds((const unsigned*)(Bb + boff[_i] + (size_t)(kt) * 128), (LAS unsigned*)(lds + (buf) * 65536 + 32768 + wid * 1024 + _i * 8192), 16, 0, 0); } while (0)
#define GE_KSTEP(buf, ks) do { bf16x8 At[MF], Bf[NF]; \
        _Pragma("unroll") for (int m = 0; m < MF; ++m) At[m] = *(const LAS bf16x8*)(lds + (buf) * 65536 + aro + m * 2048 + (ks) * 1024); \
        _Pragma("unroll") for (int n = 0; n < NF; ++n) Bf[n] = *(const LAS bf16x8*)(lds + (buf) * 65536 + bro + n * 2048 + (ks) * 1024); \
        _Pragma("unroll") for (int m = 0; m < MF; ++m) _Pragma("unroll") for (int n = 0; n < NF; ++n) acc[m][n] = __builtin_amdgcn_mfma_f32_16x16x32_bf16(Bf[n], At[m], acc[m][n], 0, 0, 0); __builtin_amdgcn_sched_barrier(0); } while (0)
    GE_STAGE(0, 0); WAIT_VM0(); __syncthreads();
#pragma unroll 1
    for (int t = 0; t < nt; ++t) {
        const int cur = t & 1;
        if (t + 1 < nt) GE_STAGE(cur ^ 1, t + 1);
        GE_KSTEP(cur, 0);
        if (!(tail && t == nt - 1)) GE_KSTEP(cur, 1);
        WAIT_VM0(); __syncthreads();
    }
#undef GE_STAGE
#undef GE_KSTEP
}

__device__ __forceinline__ bf16x8 ldfrag(const LAS bf16_t* img, int pitch, int row0, int k0, int fr, int fq) { return *(const LAS bf16x8*)(img + (row0 + fr) * pitch + k0 + fq * 8); }
#define MFMA(a, b, c) __builtin_amdgcn_mfma_f32_16x16x32_bf16(a, b, c, 0, 0, 0)

__device__ __forceinline__ void p0_mod(const Args& a, LAS unsigned char* lds) {
    LAS float* sc = (LAS float*)lds;
    LAS float* red = (LAS float*)(lds + 69632);
    const int tid = opaque_tid();
    for (int i = tid; i < 17 * 1024; i += NTHREADS) { const int s = i >> 10, k = i & 1023; const float v = s < 16 ? a.in[I_C][s * 1024 + k] : a.in[I_CCTX][k]; sc[i] = siluf_(v); }
    __syncthreads();
    float* MOD = (float*)(a.ws + WS_MOD);
    for (int u = blockIdx.x; u < 192; u += gridDim.x) {
        const int l = u / 96, cb = (u % 96) * 64, col = tid & 63, ks = tid >> 6;
        const float* w = a.in[I_WMOD] + (size_t)l * 1024 * 6144 + cb + col;
        float acc[17];
#pragma unroll
        for (int s = 0; s < 17; ++s) acc[s] = 0.f;
#pragma unroll 4
        for (int k = ks * 128; k < ks * 128 + 128; ++k) {
            const float wv = w[(size_t)k * 6144];
#pragma unroll
            for (int s = 0; s < 17; ++s) acc[s] += sc[s * 1024 + k] * wv;
        }
#pragma unroll
        for (int s = 0; s < 17; ++s) red[(ks * 17 + s) * 64 + col] = acc[s];
        __syncthreads();
        for (int i = tid; i < 17 * 64; i += NTHREADS) {
            const int s = i >> 6, c = i & 63; float v = 0.f;
#pragma unroll
            for (int k2 = 0; k2 < 8; ++k2) v += red[(k2 * 17 + s) * 64 + c];
            MOD[((size_t)l * 17 + s) * 6144 + cb + c] = v + a.in[I_BMOD][l * 6144 + cb + c];
        }
        __syncthreads();
    }
}

template <int KT>
__device__ __forceinline__ void conv_tile(LAS float* tile, const float* p0, const float* p1, const float* p2, const float* p3, int ldn, int k0, bf16_t* dst, int K) {
    const int tid = opaque_tid(), r = tid >> 4, c4 = tid & 15, grp = c4 >> 2, within = (c4 & 3) * 4;
    const float* p = grp == 0 ? p0 : grp == 1 ? p1 : grp == 2 ? p2 : p3;
#pragma unroll
    for (int i = 0; i < KT / 32; ++i) {
        const int k = r + 32 * i; f32x4 v = (f32x4){0.f, 0.f, 0.f, 0.f};
        if (p) v = *(const f32x4*)(p + (size_t)(k0 + k) * ldn + within);
        tile[k * 65 + c4 * 4 + 0] = v[0]; tile[k * 65 + c4 * 4 + 1] = v[1]; tile[k * 65 + c4 * 4 + 2] = v[2]; tile[k * 65 + c4 * 4 + 3] = v[3];
    }
    __syncthreads();
    constexpr int CPR = KT / 16;
    const int row = tid / CPR, ch = tid % CPR;
    if (row < 64) {
        float v[16];
#pragma unroll
        for (int j = 0; j < 16; ++j) v[j] = tile[(ch * 16 + j) * 65 + row];
        u32x4 w0, w1;
        w0.x = cvt_pk_bf16(v[0], v[1]); w0.y = cvt_pk_bf16(v[2], v[3]); w0.z = cvt_pk_bf16(v[4], v[5]); w0.w = cvt_pk_bf16(v[6], v[7]);
        w1.x = cvt_pk_bf16(v[8], v[9]); w1.y = cvt_pk_bf16(v[10], v[11]); w1.z = cvt_pk_bf16(v[12], v[13]); w1.w = cvt_pk_bf16(v[14], v[15]);
        bf16_t* dp = dst + (size_t)row * K + k0 + ch * 16;
        *(u32x4*)dp = w0; *(u32x4*)(dp + 8) = w1;
    }
    __syncthreads();
}

constexpr int CV_WIN = 384, CV_WOUT = 128, CV_ROUT = 32, CV_E1 = 257 * 72, CV_E2 = 257 * 48, CV_LAYER = CV_WIN + CV_WOUT + CV_ROUT + CV_E1 + CV_E2;
__device__ __forceinline__ void p0_conv(const Args& a, LAS unsigned char* lds) {
    LAS float* tile = (LAS float*)lds;
    for (int u = blockIdx.x; u < 2 * CV_LAYER; u += gridDim.x) {
        const int l = u / CV_LAYER; int j = u % CV_LAYER;
        if (j < CV_WIN) {
            const int rho0 = (j >> 3) * 64, kt = j & 7; const float* src = a.in[I_WIN] + (size_t)l * 1024 * DIN; const float* p[4];
#pragma unroll
            for (int g = 0; g < 4; ++g) { const int rho = rho0 + 16 * g; const int col = rho < 2304 ? rho : rho < 2816 ? rho + 16 : rho < 2832 ? rho - 512 : -1; p[g] = col >= 0 ? src + col : nullptr; }
            conv_tile<128>(tile, p[0], p[1], p[2], p[3], DIN, kt * 128, (bf16_t*)(a.ws + WS_WIN) + ((size_t)l * NIN + rho0) * 1024, 1024);
            continue;
        }
        j -= CV_WIN;
        if (j < CV_WOUT) {
            const int rho0 = (j >> 3) * 64, kt = j & 7; const float* src = a.in[I_WOUT] + (size_t)l * 1024 * 1024 + rho0;
            conv_tile<128>(tile, src, src + 16, src + 32, src + 48, 1024, kt * 128, (bf16_t*)(a.ws + WS_WOUT) + ((size_t)l * 1024 + rho0) * 1024, 1024);
            continue;
        }
        j -= CV_WOUT;
        if (j < CV_ROUT) {
            const int rho0 = (j >> 3) * 64, kt = j & 7; const float* src = a.in[I_RW] + (size_t)l * 1024 * 256 + rho0;
            conv_tile<128>(tile, src, src + 16, src + 32, src + 48, 256, kt * 128, (bf16_t*)(a.ws + WS_ROUT) + ((size_t)l * 256 + rho0) * 1024, 1024);
            continue;
        }
        j -= CV_ROUT;
        if (j < CV_E1) {
            const int e = j / 72, jj = j % 72, rho0 = (jj >> 3) * 64, kt = jj & 7;
            const float* sg = e < 256 ? a.in[I_EG] + ((size_t)l * 256 + e) * 1024 * FF : a.in[I_SG] + (size_t)l * 1024 * FF;
            const float* su = e < 256 ? a.in[I_EU] + ((size_t)l * 256 + e) * 1024 * FF : a.in[I_SU] + (size_t)l * 1024 * FF;
            const float* p[4];
#pragma unroll
            for (int g = 0; g < 4; ++g) { const int rho = rho0 + 16 * g, nt = rho / 192, tc = rho % 192, wc = tc / 96, n = (tc % 96) / 16; p[g] = (n < 3 ? sg : su) + nt * 96 + wc * 48 + 16 * (n % 3); }
            conv_tile<128>(tile, p[0], p[1], p[2], p[3], FF, kt * 128, (bf16_t*)(a.ws + WS_E1) + (((size_t)l * 257 + e) * 576 + rho0) * 1024, 1024);
            continue;
        }
        j -= CV_E1;
        {
            const int e = j / 48, jj = j % 48, rho0 = (jj / 3) * 64, kt = jj % 3;
            const float* sd = (e < 256 ? a.in[I_ED] + ((size_t)l * 256 + e) * FF * 1024 : a.in[I_SD] + (size_t)l * FF * 1024) + rho0;
            conv_tile<96>(tile, sd, sd + 16, sd + 32, sd + 48, 1024, kt * 96, (bf16_t*)(a.ws + WS_E2) + (((size_t)l * 257 + e) * 1024 + rho0) * FF, FF);
        }
    }
}

__device__ __forceinline__ int sample_of(int row) { return row < NLAT ? (row >> 11) : 16; }

__device__ __forceinline__ void slot_sum(const bf16_t* Y, int row, int lane, f32x4 (&s)[4]) {
#pragma unroll
    for (int ii = 0; ii < 4; ++ii) s[ii] = (f32x4){0.f, 0.f, 0.f, 0.f};
#pragma unroll
    for (int k = 0; k < NSLOT; ++k) {
        const bf16_t* yp = Y + ((size_t)row * NSLOT + k) * 1024 + lane * 4;
#pragma unroll
        for (int ii = 0; ii < 4; ++ii) { const u32x2 w = *(const u32x2*)(yp + ii * 256); s[ii][0] += __uint_as_float(w.x << 16); s[ii][1] += __uint_as_float(w.x & 0xffff0000u); s[ii][2] += __uint_as_float(w.y << 16); s[ii][3] += __uint_as_float(w.y & 0xffff0000u); }
    }
}
__device__ __forceinline__ void norm_mod_store(const f32x4 (&v)[4], const float* g, const float* shift, const float* scale, bf16_t* dst, int lane) {
    float ss = 0.f;
#pragma unroll
    for (int ii = 0; ii < 4; ++ii) ss += v[ii][0] * v[ii][0] + v[ii][1] * v[ii][1] + v[ii][2] * v[ii][2] + v[ii][3] * v[ii][3];
    ss = wave_sum(ss);
    const float rstd = rsqrtf(ss * (1.0f / 1024.0f) + EPS);
#pragma unroll
    for (int ii = 0; ii < 4; ++ii) {
        const int c = ii * 256 + lane * 4;
        const f32x4 gg = *(const f32x4*)(g + c), sh = *(const f32x4*)(shift + c), sc = *(const f32x4*)(scale + c);
        f32x4 y;
#pragma unroll
        for (int j = 0; j < 4; ++j) y[j] = v[ii][j] * rstd * gg[j] * (1.0f + sc[j]) + sh[j];
        u32x2 w; w.x = cvt_pk_bf16(y[0], y[1]); w.y = cvt_pk_bf16(y[2], y[3]);
        *(u32x2*)(dst + c) = w;
    }
}

__device__ __forceinline__ void phase_n1(const Args& a, int l) {
    const int tid = opaque_tid(), wid = tid >> 6, lane = tid & 63;
    float* X = (float*)(a.ws + WS_X); bf16_t* XA = (bf16_t*)(a.ws + WS_XA); const float* MOD = (const float*)(a.ws + WS_MOD); const bf16_t* Y = (const bf16_t*)(a.ws + WS_R1);
    for (int row = blockIdx.x * 8 + wid; row < TOK; row += gridDim.x * 8) {
        const int s = sample_of(row);
        f32x4 v[4];
        if (l == 0) {
            if (row < NLAT) {
                const float* xp = a.in[I_X] + (size_t)row * 1024 + lane * 4;
                const int tp = row & 2047; const float pr = (float)(tp >> 6), pc = (float)(tp & 63);
#pragma unroll
                for (int ii = 0; ii < 4; ++ii) v[ii] = *(const f32x4*)(xp + ii * 256);
#pragma unroll
                for (int j = 0; j < 4; ++j) {
                    const float om = exp2f(-13.287712379549449f * (float)(lane * 4 + j) * (1.0f / 256.0f));
                    const float ar = pr * om, ac = pc * om;
                    v[0][j] += sinf(ar); v[1][j] += cosf(ar); v[2][j] += sinf(ac); v[3][j] += cosf(ac);
                }
            } else {
                const float* xp = a.in[I_CTX] + (size_t)(row - NLAT) * 1024 + lane * 4;
#pragma unroll
                for (int ii = 0; ii < 4; ++ii) v[ii] = *(const f32x4*)(xp + ii * 256);
            }
        } else {
            f32x4 ys[4]; slot_sum(Y, row, lane, ys);
            const float* gate = MOD + ((size_t)(l - 1) * 17 + s) * 6144 + 5 * 1024 + lane * 4;
#pragma unroll
            for (int ii = 0; ii < 4; ++ii) { const f32x4 xv = *(const f32x4*)(X + (size_t)row * 1024 + ii * 256 + lane * 4), gv = *(const f32x4*)(gate + ii * 256); v[ii] = xv + gv * ys[ii]; }
        }
#pragma unroll
        for (int ii = 0; ii < 4; ++ii) *(f32x4*)(X + (size_t)row * 1024 + ii * 256 + lane * 4) = v[ii];
        const float* m = MOD + ((size_t)l * 17 + s) * 6144;
        norm_mod_store(v, a.in[I_N1G] + l * 1024, m, m + 1024, XA + (size_t)row * 1024, lane);
    }
}
__device__ __forceinline__ void phase_n2(const Args& a, int l, int T) {
    const int tid = opaque_tid(), wid = tid >> 6, lane = tid & 63;
    const float* X = (const float*)(a.ws + WS_X); bf16_t* XA = (bf16_t*)(a.ws + WS_XA); const float* MOD = (const float*)(a.ws + WS_MOD);
    for (int row = blockIdx.x * 8 + wid; row < T; row += gridDim.x * 8) {
        const int s = sample_of(row);
        f32x4 v[4];
#pragma unroll
        for (int ii = 0; ii < 4; ++ii) v[ii] = *(const f32x4*)(X + (size_t)row * 1024 + ii * 256 + lane * 4);
        const float* m = MOD + ((size_t)l * 17 + s) * 6144;
        norm_mod_store(v, a.in[I_N2G] + l * 1024, m + 3 * 1024, m + 4 * 1024, XA + (size_t)row * 1024, lane);
    }
}
__device__ __forceinline__ void phase_fin(const Args& a) {
    const int tid = opaque_tid(), wid = tid >> 6, lane = tid & 63;
    const float* X = (const float*)(a.ws + WS_X); const float* MOD = (const float*)(a.ws + WS_MOD); const bf16_t* Y = (const bf16_t*)(a.ws + WS_R1);
    for (int row = blockIdx.x * 8 + wid; row < NLAT; row += gridDim.x * 8) {
        const int s = sample_of(row);
        f32x4 ys[4], v[4]; slot_sum(Y, row, lane, ys);
        const float* gate = MOD + ((size_t)17 + s) * 6144 + 5 * 1024 + lane * 4;
        float ss = 0.f;
#pragma unroll
        for (int ii = 0; ii < 4; ++ii) { const f32x4 xv = *(const f32x4*)(X + (size_t)row * 1024 + ii * 256 + lane * 4), gv = *(const f32x4*)(gate + ii * 256); v[ii] = xv + gv * ys[ii];
            ss += v[ii][0] * v[ii][0] + v[ii][1] * v[ii][1] + v[ii][2] * v[ii][2] + v[ii][3] * v[ii][3]; }
        ss = wave_sum(ss);
        const float rstd = rsqrtf(ss * (1.0f / 1024.0f) + EPS);
#pragma unroll
        for (int ii = 0; ii < 4; ++ii) { const f32x4 g = *(const f32x4*)(a.in[I_FNG] + ii * 256 + lane * 4); *(f32x4*)(a.out + (size_t)row * 1024 + ii * 256 + lane * 4) = v[ii] * rstd * g; }
    }
}

template <int NP> __device__ __forceinline__ void lin_offsets(unsigned (&off)[NP], int pitch_bytes, int wid, int lane) {
#pragma unroll
    for (int i = 0; i < NP; ++i) { int R, C; stage_rc(wid * 1024 + i * 8192 + lane * 16, R, C); off[i] = (unsigned)(R * pitch_bytes + C * 2); }
}

__device__ __forceinline__ void phase_g1(const Args& a, LAS unsigned char* lds, int l) {
    const int tid = opaque_tid(), wid = __builtin_amdgcn_readfirstlane(tid >> 6), lane = tid & 63, fr = lane & 15, fq = lane >> 4, wr = wid >> 2, wc = wid & 3;
    unsigned aoff[4], boff[4]; lin_offsets<4>(aoff, 2048, wid, lane); lin_offsets<4>(boff, 2048, wid, lane);
    const bf16_t* XA = (const bf16_t*)(a.ws + WS_XA); const bf16_t* W = (const bf16_t*)(a.ws + WS_WIN) + (size_t)l * NIN * 1024;
    bf16_t* P = (bf16_t*)(a.ws + WS_P); float* GATES = (float*)(a.ws + WS_GATES);
    for (int u = blockIdx.x; u < (TOK / 256) * 12; u += gridDim.x) {
        const int pm = u / 12, pn = u % 12;
        f32x4 acc[8][4];
        gemm_run<256, 4>(lds, acc, (const unsigned char*)(XA + (size_t)pm * 256 * 1024), aoff, (const unsigned char*)(W + (size_t)pn * 256 * 1024), boff, 16, false);
        const int row0 = pm * 256 + wr * 128 + fr;
#pragma unroll
        for (int n = 0; n < 4; ++n) {
            const int cb = pn * 256 + wc * 64 + n * 16;
            if (cb >= DIN) continue;
            if (cb >= PW) {
#pragma unroll
                for (int m = 0; m < 8; ++m) *(f32x4*)(GATES + (size_t)(row0 + m * 16) * 16 + fq * 4) = acc[m][n];
            } else {
                const bool g = (cb >= PC_RG && cb < PC_Q) || cb >= PC_CU;
                const float sc = (cb >= PC_K && cb < PC_V) ? 0.10206207261596575f : 1.0f;
#pragma unroll
                for (int m = 0; m < 8; ++m) {
                    f32x4 v = acc[m][n];
                    if (g) { v[0] = gelu_tanh(v[0]); v[1] = gelu_tanh(v[1]); v[2] = gelu_tanh(v[2]); v[3] = gelu_tanh(v[3]); } else v = v * sc;
                    u32x2 w; w.x = cvt_pk_bf16(v[0], v[1]); w.y = cvt_pk_bf16(v[2], v[3]);
                    *(u32x2*)(P + (size_t)(row0 + m * 16) * PW + cb + fq * 4) = w;
                }
            }
        }
    }
}

__device__ __forceinline__ void phase_g2(const Args& a, LAS unsigned char* lds, int l, int T) {
    const int tid = opaque_tid(), wid = __builtin_amdgcn_readfirstlane(tid >> 6), lane = tid & 63, fr = lane & 15, fq = lane >> 4, wr = wid >> 2, wc = wid & 3;
    unsigned aoff[4], boff[4]; lin_offsets<4>(aoff, 2048, wid, lane); lin_offsets<4>(boff, 2048, wid, lane);
    const bf16_t* MIX = (const bf16_t*)(a.ws + WS_MIX); const bf16_t* W = (const bf16_t*)(a.ws + WS_WOUT) + (size_t)l * 1024 * 1024;
    float* X = (float*)(a.ws + WS_X); const float* MOD = (const float*)(a.ws + WS_MOD);
    for (int u = blockIdx.x; u < (T / 256) * 4; u += gridDim.x) {
        const int pm = u >> 2, pn = u & 3;
        f32x4 acc[8][4];
        gemm_run<256, 4>(lds, acc, (const unsigned char*)(MIX + (size_t)pm * 256 * 1024), aoff, (const unsigned char*)(W + (size_t)pn * 256 * 1024), boff, 16, false);
        const int row0 = pm * 256 + wr * 128 + fr, s = sample_of(pm * 256);
        const float* gate = MOD + ((size_t)l * 17 + s) * 6144 + 2 * 1024;
#pragma unroll
        for (int n = 0; n < 4; ++n) {
            const int col = pn * 256 + wc * 64 + n * 16 + fq * 4;
            const f32x4 gv = *(const f32x4*)(gate + col);
#pragma unroll
            for (int m = 0; m < 8; ++m) { float* xp = X + (size_t)(row0 + m * 16) * 1024 + col; *(f32x4*)xp = *(const f32x4*)xp + gv * acc[m][n]; }
        }
    }
}

__device__ __forceinline__ void phase_rt(const Args& a, LAS unsigned char* lds, int l, int T) {
    const int tid = opaque_tid(), wid = __builtin_amdgcn_readfirstlane(tid >> 6), lane = tid & 63, fr = lane & 15, fq = lane >> 4, wr = wid >> 2, wc = wid & 3;
    unsigned aoff[4], boff[4]; lin_offsets<4>(aoff, 2048, wid, lane); lin_offsets<4>(boff, 2048, wid, lane);
    const bf16_t* XA = (const bf16_t*)(a.ws + WS_XA); const bf16_t* W = (const bf16_t*)(a.ws + WS_ROUT) + (size_t)l * 256 * 1024;
    float* LG = (float*)(a.ws + WS_LOGITS);
    for (int u = blockIdx.x; u < T / 256; u += gridDim.x) {
        f32x4 acc[8][4];
        gemm_run<256, 4>(lds, acc, (const unsigned char*)(XA + (size_t)u * 256 * 1024), aoff, (const unsigned char*)W, boff, 16, false);
        const int row0 = u * 256 + wr * 128 + fr;
#pragma unroll
        for (int n = 0; n < 4; ++n)
#pragma unroll
            for (int m = 0; m < 8; ++m) *(f32x4*)(LG + (size_t)(row0 + m * 16) * 256 + wc * 64 + n * 16 + fq * 4) = acc[m][n];
    }
}

__device__ __forceinline__ void phase_tk(const Args& a, int l, int T) {
    const int tid = opaque_tid(), wid = tid >> 6, lane = tid & 63;
    const float* LG = (const float*)(a.ws + WS_LOGITS); const float* rb = a.in[I_RB] + l * 256;
    unsigned* CNT = (unsigned*)(a.ws + WS_CTL + CTL_CNT) + l * 256; int* LS = (int*)(a.ws + WS_LSLOT); float* LWt = (float*)(a.ws + WS_LW);
    const f32x4 bias = *(const f32x4*)(rb + lane * 4);
    const float NEG = -__builtin_huge_valf();
    for (int t = blockIdx.x * 8 + wid; t < T; t += gridDim.x * 8) {
        const f32x4 lg = *(const f32x4*)(LG + (size_t)t * 256 + lane * 4);
        float sc[4], sel[4];
#pragma unroll
        for (int j = 0; j < 4; ++j) { sc[j] = 1.0f / (1.0f + expf(-lg[j])); sel[j] = sc[j] + bias[j]; }
        float a1 = fmaxf(sel[0], sel[1]), a2 = fminf(sel[0], sel[1]);
#pragma unroll
        for (int j = 2; j < 4; ++j) { const float v = sel[j]; a2 = fmaxf(a2, fminf(a1, v)); a1 = fmaxf(a1, v); }
#pragma unroll
        for (int o = 1; o <= 4; o <<= 1) { const float b1 = __shfl_xor(a1, o), b2 = __shfl_xor(a2, o); const float n1 = fmaxf(a1, b1), n2 = fmaxf(fminf(a1, b1), fmaxf(a2, b2)); a1 = n1; a2 = n2; }
        const float gs = a1 + a2; const int g = lane >> 3; int rank = 0;
#pragma unroll
        for (int g2 = 0; g2 < 8; ++g2) { const float s2 = __shfl(gs, g2 * 8); rank += (s2 > gs || (s2 == gs && g2 < g)) ? 1 : 0; }
        float ms[4];
#pragma unroll
        for (int j = 0; j < 4; ++j) ms[j] = rank < 4 ? sel[j] : NEG;
        int my_e = 0; float my_s = 0.f, ssum = 0.f;
#pragma unroll
        for (int k = 0; k < 8; ++k) {
            float bv = ms[0]; int bi = lane * 4;
#pragma unroll
            for (int j = 1; j < 4; ++j) if (ms[j] > bv) { bv = ms[j]; bi = lane * 4 + j; }
#pragma unroll
            for (int o = 32; o >= 1; o >>= 1) { const float ov = __shfl_xor(bv, o); const int oi = __shfl_xor(bi, o); if (ov > bv || (ov == bv && oi < bi)) { bv = ov; bi = oi; } }
            const int jj = bi & 3; const float mysc = jj == 0 ? sc[0] : jj == 1 ? sc[1] : jj == 2 ? sc[2] : sc[3];
            const float sk = __shfl(mysc, bi >> 2);
#pragma unroll
            for (int j = 0; j < 4; ++j) if (lane * 4 + j == bi) ms[j] = NEG;
            if (lane == k) { my_e = bi; my_s = sk; }
            ssum += sk;
        }
        if (lane < 8) {
            const float w = my_s / ssum * 2.5f;
            const unsigned pos = atomicAdd(&CNT[my_e], 1u);
            LS[(size_t)my_e * LCAP + pos] = t * NSLOT + lane; LWt[(size_t)my_e * LCAP + pos] = w;
        }
    }
}

__device__ __forceinline__ void moe_tables(const Args& a, LAS unsigned char* lds, int l, int T) {
    LAS int* cntE = (LAS int*)(lds + LDS_TAB); LAS int* blkoff = cntE + 264;
    const int tid = opaque_tid(); const unsigned* CNT = (const unsigned*)(a.ws + WS_CTL + CTL_CNT) + l * 256;
    if (tid < 256) cntE[tid] = (int)CNT[tid]; else if (tid == 256) cntE[256] = T;
    __syncthreads();
    if (tid < 258) { int s = 0; for (int e = 0; e < tid && e < 257; ++e) s += (cntE[e] + 255) >> 8; blkoff[tid] = s; }
    __syncthreads();
}
__device__ __forceinline__ int moe_find(const LAS int* blkoff, int mbg) { int lo = 0, hi = 257; while (hi - lo > 1) { const int mid = (lo + hi) >> 1; if (blkoff[mid] <= mbg) lo = mid; else hi = mid; } return lo; }

__device__ __forceinline__ void phase_e1(const Args& a, LAS unsigned char* lds, int l, int T) {
    const int tid = opaque_tid(), wid = __builtin_amdgcn_readfirstlane(tid >> 6), lane = tid & 63, fr = lane & 15, fq = lane >> 4, wr = wid >> 1, wc = wid & 1;
    LAS int* cntE = (LAS int*)(lds + LDS_TAB); LAS int* blkoff = cntE + 264; LAS int* tokrow = blkoff + 264;
    moe_tables(a, lds, l, T);
    const int nblk = blkoff[257];
    const bf16_t* XA = (const bf16_t*)(a.ws + WS_XA); const bf16_t* W = (const bf16_t*)(a.ws + WS_E1) + (size_t)l * 257 * 576 * 1024;
    bf16_t* HB = (bf16_t*)(a.ws + WS_HB); const int* LS = (const int*)(a.ws + WS_LSLOT);
    unsigned boff[3]; lin_offsets<3>(boff, 2048, wid, lane);
    int Rr[4], Cc[4];
#pragma unroll
    for (int i = 0; i < 4; ++i) stage_rc(wid * 1024 + i * 8192 + lane * 16, Rr[i], Cc[i]);
    for (int u = blockIdx.x; u < nblk * 3; u += gridDim.x) {
        const int mbg = u / 3, nt = u % 3, e = moe_find(blkoff, mbg), mb = mbg - blkoff[e], cnt = cntE[e];
        __syncthreads();
        if (tid < 256) { const int pos = mb * 256 + tid; int tok = 0; if (pos < cnt) tok = e < 256 ? LS[(size_t)e * LCAP + pos] / NSLOT : pos; tokrow[tid] = tok; }
        __syncthreads();
        unsigned aoff[4];
#pragma unroll
        for (int i = 0; i < 4; ++i) aoff[i] = (unsigned)tokrow[Rr[i]] * 2048u + (unsigned)Cc[i] * 2u;
        f32x4 acc[4][6];
        gemm_run<192, 2>(lds, acc, (const unsigned char*)XA, aoff, (const unsigned char*)(W + ((size_t)e * 576 + nt * 192) * 1024), boff, 16, false);
#pragma unroll
        for (int m = 0; m < 4; ++m) {
            bf16_t* hp = HB + (size_t)(mbg * 256 + wr * 64 + m * 16 + fr) * FF + nt * 96 + wc * 48 + fq * 4;
#pragma unroll
            for (int n = 0; n < 3; ++n) {
                const f32x4 g = acc[m][n], uu = acc[m][n + 3];
                u32x2 w; w.x = cvt_pk_bf16(siluf_(g[0]) * uu[0], siluf_(g[1]) * uu[1]); w.y = cvt_pk_bf16(siluf_(g[2]) * uu[2], siluf_(g[3]) * uu[3]);
                *(u32x2*)(hp + n * 16) = w;
            }
        }
    }
}

__device__ __forceinline__ void phase_e2(const Args& a, LAS unsigned char* lds, int l, int T) {
    const int tid = opaque_tid(), wid = __builtin_amdgcn_readfirstlane(tid >> 6), lane = tid & 63, fr = lane & 15, fq = lane >> 4, wr = wid >> 2, wc = wid & 3;
    LAS int* cntE = (LAS int*)(lds + LDS_TAB); LAS int* blkoff = cntE + 264; LAS int* slotrow = blkoff + 264; LAS float* wrow = (LAS float*)(slotrow + 256);
    moe_tables(a, lds, l, T);
    const int nblk = blkoff[257];
    const bf16_t* HB = (const bf16_t*)(a.ws + WS_HB); const bf16_t* W = (const bf16_t*)(a.ws + WS_E2) + (size_t)l * 257 * 1024 * FF;
    bf16_t* Y = (bf16_t*)(a.ws + WS_R1); const int* LS = (const int*)(a.ws + WS_LSLOT); const float* LWt = (const float*)(a.ws + WS_LW);
    unsigned aoff[4], boff[4]; lin_offsets<4>(aoff, FF * 2, wid, lane); lin_offsets<4>(boff, FF * 2, wid, lane);
    for (int u = blockIdx.x; u < nblk * 4; u += gridDim.x) {
        const int mbg = u >> 2, pn = u & 3, e = moe_find(blkoff, mbg), mb = mbg - blkoff[e], cnt = cntE[e];
        __syncthreads();
        if (tid < 256) { const int pos = mb * 256 + tid; int slot = -1; float w = 0.f;
            if (pos < cnt) { if (e < 256) { slot = LS[(size_t)e * LCAP + pos]; w = LWt[(size_t)e * LCAP + pos]; } else { slot = pos * NSLOT + 8; w = 1.0f; } }
            slotrow[tid] = slot; wrow[tid] = w; }
        f32x4 acc[8][4];
        gemm_run<256, 4>(lds, acc, (const unsigned char*)(HB + (size_t)mbg * 256 * FF), aoff, (const unsigned char*)(W + ((size_t)e * 1024 + pn * 256) * FF), boff, 5, true);
#pragma unroll
        for (int m = 0; m < 8; ++m) {
            const int r = wr * 128 + m * 16 + fr, slot = slotrow[r];
            if (slot >= 0) {
                const float w = wrow[r]; bf16_t* yp = Y + (size_t)slot * 1024 + pn * 256 + wc * 64 + fq * 4;
#pragma unroll
                for (int n = 0; n < 4; ++n) { const f32x4 v = acc[m][n] * w; u32x2 o; o.x = cvt_pk_bf16(v[0], v[1]); o.y = cvt_pk_bf16(v[2], v[3]); *(u32x2*)(yp + n * 16) = o; }
            }
        }
    }
}

__device__ __forceinline__ float logsigmoidf_(float x) { return fminf(x, 0.f) - log1pf(expf(-fabsf(x))); }

__device__ __forceinline__ void mlstm_unit(const Args& a, LAS unsigned char* lds, int l, int b, int h, int d) {
    const int tid = opaque_tid(), wid = __builtin_amdgcn_readfirstlane(tid >> 6), lane = tid & 63, fr = lane & 15, fq = lane >> 4;
    LAS bf16_t* Qi = (LAS bf16_t*)(lds);
    LAS bf16_t* Ki = (LAS bf16_t*)(lds + 26624);
    LAS bf16_t* Si = (LAS bf16_t*)(lds);
    LAS bf16_t* KT = (LAS bf16_t*)(lds + 53248);
    LAS bf16_t* VT = (LAS bf16_t*)(lds + 79360);
    LAS bf16_t* CT = (LAS bf16_t*)(lds + 109824);
    LAS float* colterm = (LAS float*)(lds + 133120);
    LAS float* Marr = colterm + 128;
    LAS float* bcarr = Marr + 128;
    const bf16_t* P = (const bf16_t*)(a.ws + WS_P); const float* GATES = (const float*)(a.ws + WS_GATES);
    float* MHS = (float*)(a.ws + WS_MHS) + (size_t)d * TOK * 384;
    const float bi = a.in[I_MGB][((l * 2 + d) * 2 + 0) * 4 + h], bfg = a.in[I_MGB][((l * 2 + d) * 2 + 1) * 4 + h];
    __syncthreads();
    for (int i = tid; i < 112 * 104; i += NTHREADS) CT[i] = 0;
    for (int i = tid; i < 16 * 136; i += NTHREADS) VT[96 * 136 + i] = (i < 136) ? (bf16_t)0x3F80 : (bf16_t)0;
    f32x4 Cst[7];
#pragma unroll
    for (int cb = 0; cb < 7; ++cb) Cst[cb] = (f32x4){0.f, 0.f, 0.f, 0.f};
    float m = 0.f;
    for (int step = 0; step < 18; ++step) {
        const bool isctx = step < 2; const int n = isctx ? step : step - 2, Tseg = isctx ? CTXL : SEQ, rowbase = isctx ? NLAT + b * CTXL : b * SEQ;
        const bool do_out = !isctx || l == 0;
        if (wid == 0) {
            const int p0 = 2 * lane, t0 = d ? Tseg - 1 - (n * 128 + p0) : n * 128 + p0, t1 = d ? t0 - 1 : t0 + 1;
            const float* g0 = GATES + (size_t)(rowbase + t0) * 16 + d * 8 + h; const float* g1 = GATES + (size_t)(rowbase + t1) * 16 + d * 8 + h;
            const float gi0 = g0[0] + bi, gi1 = g1[0] + bi, lf0 = logsigmoidf_(g0[4] + bfg), lf1 = logsigmoidf_(g1[4] + bfg);
            float s = lf0 + lf1;
#pragma unroll
            for (int o = 1; o < 64; o <<= 1) { const float t = __shfl_up(s, o); if (lane >= o) s += t; }
            const float bc1 = s, bc0 = s - lf1, ct0 = gi0 - bc0, ct1 = gi1 - bc1;
            float pm = fmaxf(ct0, ct1);
#pragma unroll
            for (int o = 1; o < 64; o <<= 1) { const float t = __shfl_up(pm, o); if (lane >= o) pm = fmaxf(pm, t); }
            float prev = __shfl_up(pm, 1); if (lane == 0) prev = -__builtin_huge_valf();
            const float pm0 = fmaxf(prev, ct0);
            colterm[p0] = ct0; colterm[p0 + 1] = ct1; bcarr[p0] = bc0; bcarr[p0 + 1] = bc1; Marr[p0] = fmaxf(m, pm0); Marr[p0 + 1] = fmaxf(m, pm);
        }
        __syncthreads();
        const float Mend = Marr[127], gsum = bcarr[127];
#pragma unroll
        for (int i = 0; i < 9; ++i) {
            const int rem = tid + 512 * (i % 3), p = rem / 12, ch = rem - p * 12;
            const int tok = d ? Tseg - 1 - (n * 128 + p) : n * 128 + p;
            const u32x4 v = *(const u32x4*)(P + (size_t)(rowbase + tok) * PW + PC_Q + (i / 3) * 384 + h * 96 + ch * 8);
            if (i < 3) *(LAS u32x4*)(Qi + p * 104 + ch * 8) = v;
            else if (i < 6) {
                *(LAS u32x4*)(Ki + p * 104 + ch * 8) = v;
                const float w = expf(colterm[p] - Mend);
                const unsigned vv[4] = {v.x, v.y, v.z, v.w};
#pragma unroll
                for (int j = 0; j < 4; ++j) { KT[(ch * 8 + 2 * j) * 136 + p] = f2bf(__uint_as_float(vv[j] << 16) * w); KT[(ch * 8 + 2 * j + 1) * 136 + p] = f2bf(__uint_as_float(vv[j] & 0xffff0000u) * w); }
            } else {
                const unsigned vv[4] = {v.x, v.y, v.z, v.w};
#pragma unroll
                for (int j = 0; j < 4; ++j) { VT[(ch * 8 + 2 * j) * 136 + p] = (bf16_t)(vv[j] & 0xffffu); VT[(ch * 8 + 2 * j + 1) * 136 + p] = (bf16_t)(vv[j] >> 16); }
            }
        }
        __syncthreads();
        f32x4 num[7], sacc[8];
        const int t = wid * 16 + fr; const float Mt = Marr[t];
        if (do_out) {
#pragma unroll
            for (int cb = 0; cb < 7; ++cb) num[cb] = (f32x4){0.f, 0.f, 0.f, 0.f};
#pragma unroll
            for (int ks = 0; ks < 3; ++ks) {
                const bf16x8 bq = ldfrag(Qi, 104, wid * 16, ks * 32, fr, fq);
#pragma unroll
                for (int cb = 0; cb < 7; ++cb) num[cb] = MFMA(ldfrag(CT, 104, cb * 16, ks * 32, fr, fq), bq, num[cb]);
#pragma unroll
                for (int sb = 0; sb < 8; ++sb) if (sb <= wid) { if (ks == 0) sacc[sb] = (f32x4){0.f, 0.f, 0.f, 0.f}; sacc[sb] = MFMA(ldfrag(Ki, 104, sb * 16, ks * 32, fr, fq), bq, sacc[sb]); }
            }
            const float ei = expf(m - Mt);
#pragma unroll
            for (int cb = 0; cb < 7; ++cb) num[cb] = num[cb] * ei;
        }
        __syncthreads();
        if (do_out) {
#pragma unroll
            for (int sb = 0; sb < 8; ++sb) {
                u32x2 w; w.x = 0u; w.y = 0u;
                if (sb <= wid) {
                    const f32x4 ct = *(const LAS f32x4*)(colterm + sb * 16 + fq * 4); float e[4];
#pragma unroll
                    for (int j = 0; j < 4; ++j) { const int s = sb * 16 + fq * 4 + j; e[j] = (s <= t) ? sacc[sb][j] * expf(ct[j] - Mt) : 0.f; }
                    w.x = cvt_pk_bf16(e[0], e[1]); w.y = cvt_pk_bf16(e[2], e[3]);
                }
                *(LAS u32x2*)(Si + t * 136 + sb * 16 + fq * 4) = w;
            }
        }
        __syncthreads();
        if (do_out) {
#pragma unroll
            for (int ks = 0; ks < 4; ++ks) {
                const bf16x8 bs = ldfrag(Si, 136, wid * 16, ks * 32, fr, fq);
#pragma unroll
                for (int cb = 0; cb < 7; ++cb) num[cb] = MFMA(ldfrag(VT, 136, cb * 16, ks * 32, fr, fq), bs, num[cb]);
            }
            const float den = __shfl(num[6][0], fr);
            const float inv = 1.0f / fmaxf(fabsf(den), expf(-(bcarr[t] + Mt)));
            const int tok = d ? Tseg - 1 - (n * 128 + t) : n * 128 + t;
            float* op = MHS + (size_t)(rowbase + tok) * 384 + h * 96 + fq * 4;
#pragma unroll
            for (int cb = 0; cb < 6; ++cb) *(f32x4*)(op + cb * 16) = num[cb] * inv;
        }
        const float decay = expf(m - Mend);
        if (wid < 6) {
#pragma unroll
            for (int cb = 0; cb < 7; ++cb) Cst[cb] = Cst[cb] * decay;
#pragma unroll
            for (int ks = 0; ks < 4; ++ks) {
                const bf16x8 bk = ldfrag(KT, 136, wid * 16, ks * 32, fr, fq);
#pragma unroll
                for (int cb = 0; cb < 7; ++cb) Cst[cb] = MFMA(ldfrag(VT, 136, cb * 16, ks * 32, fr, fq), bk, Cst[cb]);
            }
#pragma unroll
            for (int cb = 0; cb < 7; ++cb)
#pragma unroll
                for (int j = 0; j < 4; ++j) CT[(cb * 16 + fq * 4 + j) * 104 + wid * 16 + fr] = f2bf(Cst[cb][j]);
        }
        m = gsum + Mend;
        __syncthreads();
    }
}

__device__ __forceinline__ void rglru_unit(const Args& a, LAS unsigned char* lds, int l, int b, int hd, int d) {
    const int tid = opaque_tid(), wid = __builtin_amdgcn_readfirstlane(tid >> 6), lane = tid & 63, fr = lane & 15, fq = lane >> 4;
    LAS float* zf = (LAS float*)lds;
    LAS bf16_t* zi = (LAS bf16_t*)(lds + 32768);
    LAS bf16_t* Wi = (LAS bf16_t*)(lds + 51200);
    LAS float* aa = (LAS float*)(lds + 69632);
    LAS float* uu = (LAS float*)(lds + 102400);
    LAS float* segA = (LAS float*)(lds + 135168);
    LAS float* segU = segA + 512;
    LAS float* hc = segU + 512;
    LAS float* cst = hc + 128;
    const bf16_t* P = (const bf16_t*)(a.ws + WS_P); float* RGY = (float*)(a.ws + WS_RGY) + (size_t)d * TOK * 384;
    __syncthreads();
    { const float* gw = a.in[I_RGGW] + (size_t)(l * 2 + d) * 2 * 6 * 4096;
      for (int idx = tid; idx < 8192; idx += NTHREADS) { const int g = idx >> 12, i = (idx >> 6) & 63, j = idx & 63; Wi[(g * 64 + j) * 72 + i] = f2bf(gw[((size_t)(g * 6 + hd) * 64 + i) * 64 + j]); } }
    if (tid < 64) { cst[tid] = a.in[I_RGGB][((l * 2 + d) * 2 + 0) * 384 + hd * 64 + tid]; cst[64 + tid] = a.in[I_RGGB][((l * 2 + d) * 2 + 1) * 384 + hd * 64 + tid];
                    cst[128 + tid] = log1pf(expf(-a.in[I_RGLAM][(l * 2 + d) * 384 + hd * 64 + tid])); hc[tid] = 0.f; }
    const int c = lane, ch = hd * 64 + c;
    const float cw0 = a.in[I_RGCW][(l * 4 + 0) * 384 + ch], cw1 = a.in[I_RGCW][(l * 4 + 1) * 384 + ch], cw2 = a.in[I_RGCW][(l * 4 + 2) * 384 + ch], cw3 = a.in[I_RGCW][(l * 4 + 3) * 384 + ch], cbias = a.in[I_RGCB][l * 384 + ch];
    __syncthreads();
    for (int step = 0; step < 18; ++step) {
        const bool isctx = step < 2; const int n = isctx ? step : step - 2, Tseg = isctx ? CTXL : SEQ, rowbase = isctx ? NLAT + b * CTXL : b * SEQ;
        const int base = d ? Tseg - 128 * (n + 1) : 128 * n;
        const bool do_out = !isctx || l == 0;
        {
            const int tl0 = wid * 16; float xm2, xm1, x0, xp1;
            const bf16_t* pp = P + (size_t)rowbase * PW + PC_RX + ch;
#define RG_LD(pos) (((pos) >= 0 && (pos) < Tseg) ? bf2f(pp[(size_t)(pos) * PW]) : 0.f)
            xm2 = RG_LD(base + tl0 - 2); xm1 = RG_LD(base + tl0 - 1); x0 = RG_LD(base + tl0);
#pragma unroll
            for (int i = 0; i < 16; ++i) {
                xp1 = RG_LD(base + tl0 + i + 1);
                const float z = cw0 * xm2 + cw1 * xm1 + cw2 * x0 + cw3 * xp1 + cbias;
                zf[(tl0 + i) * 64 + c] = z; zi[(tl0 + i) * 72 + c] = f2bf(z);
                xm2 = xm1; xm1 = x0; x0 = xp1;
            }
        }
        __syncthreads();
        {
            f32x4 acc[8];
#pragma unroll
            for (int nb = 0; nb < 8; ++nb) acc[nb] = (f32x4){0.f, 0.f, 0.f, 0.f};
#pragma unroll
            for (int ks = 0; ks < 2; ++ks) {
                const bf16x8 bz = ldfrag(zi, 72, wid * 16, ks * 32, fr, fq);
#pragma unroll
                for (int nb = 0; nb < 8; ++nb) acc[nb] = MFMA(ldfrag(Wi, 72, nb * 16, ks * 32, fr, fq), bz, acc[nb]);
            }
            const int tl = wid * 16 + fr, p = d ? 127 - tl : tl;
#pragma unroll
            for (int nb = 0; nb < 4; ++nb) {
                const int j0 = nb * 16 + fq * 4;
                const f32x4 z4 = *(const LAS f32x4*)(zf + tl * 64 + j0), br = *(const LAS f32x4*)(cst + j0), bi4 = *(const LAS f32x4*)(cst + 64 + j0), sp = *(const LAS f32x4*)(cst + 128 + j0);
                f32x4 av, uv;
#pragma unroll
                for (int j = 0; j < 4; ++j) {
                    const float rg = sigmoidf_(acc[nb][j] + br[j]), ig = sigmoidf_(acc[nb + 4][j] + bi4[j]);
                    const float la = -8.0f * rg * sp[j];
                    av[j] = expf(la); uv[j] = sqrtf(fmaxf(-expm1f(2.0f * la), 0.f)) * ig * z4[j];
                }
                *(LAS f32x4*)(aa + p * 64 + j0) = av; *(LAS f32x4*)(uu + p * 64 + j0) = uv;
            }
        }
        __syncthreads();
        {
            float A = 1.f, U = 0.f;
#pragma unroll
            for (int i = 0; i < 16; ++i) { const float av = aa[(wid * 16 + i) * 64 + c], uv = uu[(wid * 16 + i) * 64 + c]; U = av * U + uv; A *= av; }
            segA[wid * 64 + c] = A; segU[wid * 64 + c] = U;
        }
        __syncthreads();
        {
            float hv = hc[(step & 1) * 64 + c];
            for (int s2 = 0; s2 < wid; ++s2) hv = segA[s2 * 64 + c] * hv + segU[s2 * 64 + c];
#pragma unroll
            for (int i = 0; i < 16; ++i) {
                const int p = wid * 16 + i; hv = aa[p * 64 + c] * hv + uu[p * 64 + c];
                if (do_out) { const int tl = d ? 127 - p : p; RGY[(size_t)(rowbase + base + tl) * 384 + ch] = hv; }
            }
            if (wid == 7) hc[((step + 1) & 1) * 64 + c] = hv;
        }
    }
    __syncthreads();
}

__device__ __forceinline__ void gmlp_unit(const Args& a, LAS unsigned char* lds, int l, int chunk) {
    const int tid = opaque_tid(), wid = __builtin_amdgcn_readfirstlane(tid >> 6), lane = tid & 63, fr = lane & 15, fq = lane >> 4;
    LAS bf16_t* vT = (LAS bf16_t*)lds;
    const bf16_t* P = (const bf16_t*)(a.ws + WS_P); bf16_t* MIX = (bf16_t*)(a.ws + WS_MIX);
    const int row0 = chunk * 128;
    __syncthreads();
    {
        const f32x4 g = *(const f32x4*)(a.in[I_CMNG] + l * 256 + lane * 4);
        for (int i = 0; i < 16; ++i) {
            const int s = wid * 16 + i;
            const u32x2 w = *(const u32x2*)(P + (size_t)(row0 + s) * PW + PC_CV + lane * 4);
            const float v0 = __uint_as_float(w.x << 16), v1 = __uint_as_float(w.x & 0xffff0000u), v2 = __uint_as_float(w.y << 16), v3 = __uint_as_float(w.y & 0xffff0000u);
            const float ss = wave_sum(v0 * v0 + v1 * v1 + v2 * v2 + v3 * v3);
            const float rstd = rsqrtf(ss * (1.0f / 256.0f) + EPS);
            vT[(lane * 4 + 0) * 136 + s] = f2bf(v0 * rstd * g[0]); vT[(lane * 4 + 1) * 136 + s] = f2bf(v1 * rstd * g[1]);
            vT[(lane * 4 + 2) * 136 + s] = f2bf(v2 * rstd * g[2]); vT[(lane * 4 + 3) * 136 + s] = f2bf(v3 * rstd * g[3]);
        }
    }
    __syncthreads();
    const int g = wid >> 1, th = wid & 1;
    const float* ws = a.in[I_CMW] + ((size_t)(l * 4 + g) * 128) * 128;
    f32x4 acc[4][4];
#pragma unroll
    for (int m = 0; m < 4; ++m)
#pragma unroll
        for (int n = 0; n < 4; ++n) acc[m][n] = (f32x4){0.f, 0.f, 0.f, 0.f};
#pragma unroll
    for (int ks = 0; ks < 4; ++ks) {
        bf16x8 bw[4];
#pragma unroll
        for (int m = 0; m < 4; ++m) {
            const float* wp = ws + (size_t)(th * 64 + m * 16 + fr) * 128 + ks * 32 + fq * 8;
            const f32x4 w0 = *(const f32x4*)wp, w1 = *(const f32x4*)(wp + 4);
            u32x4 pk; pk.x = cvt_pk_bf16(w0[0], w0[1]); pk.y = cvt_pk_bf16(w0[2], w0[3]); pk.z = cvt_pk_bf16(w1[0], w1[1]); pk.w = cvt_pk_bf16(w1[2], w1[3]);
            bw[m] = __builtin_bit_cast(bf16x8, pk);
        }
#pragma unroll
        for (int n = 0; n < 4; ++n) {
            const bf16x8 av = ldfrag(vT, 136, g * 64 + n * 16, ks * 32, fr, fq);
#pragma unroll
            for (int m = 0; m < 4; ++m) acc[m][n] = MFMA(av, bw[m], acc[m][n]);
        }
    }
#pragma unroll
    for (int m = 0; m < 4; ++m) {
        const int t = th * 64 + m * 16 + fr; const float bsv = a.in[I_CMB][(l * 4 + g) * 128 + t];
#pragma unroll
        for (int n = 0; n < 4; ++n) {
            const int cc = g * 64 + n * 16 + fq * 4;
            const u32x2 uw = *(const u32x2*)(P + (size_t)(row0 + t) * PW + PC_CU + cc);
            const float u0 = __uint_as_float(uw.x << 16), u1 = __uint_as_float(uw.x & 0xffff0000u), u2 = __uint_as_float(uw.y << 16), u3 = __uint_as_float(uw.y & 0xffff0000u);
            u32x2 o; o.x = cvt_pk_bf16(u0 * (acc[m][n][0] + bsv), u1 * (acc[m][n][1] + bsv)); o.y = cvt_pk_bf16(u2 * (acc[m][n][2] + bsv), u3 * (acc[m][n][3] + bsv));
            *(u32x2*)(MIX + (size_t)(row0 + t) * 1024 + 768 + cc) = o;
        }
    }
}

__device__ __forceinline__ void phase_mx(const Args& a, LAS unsigned char* lds, int l) {
    unsigned* q = (unsigned*)(a.ws + WS_CTL + CTL_QUEUE) + l * 256;
    LAS int* qv = (LAS int*)(lds + LDS_BARW - 16);
    const int tid = opaque_tid();
#define MX_NEXT(head) ({ __syncthreads(); if (tid == 0) *qv = (int)atomicAdd(q + (head) * 64, 1u); __syncthreads(); *qv; })
#ifndef MXSEL
#define MXSEL 7
#endif
    if (MXSEL & 1) for (;;) { const int u = MX_NEXT(0); if (u >= 128) break; mlstm_unit(a, lds, l, u >> 3, (u >> 1) & 3, u & 1); }
    if (MXSEL & 2) for (;;) { const int u = MX_NEXT(1); if (u >= 192) break; rglru_unit(a, lds, l, u / 12, (u >> 1) % 6, u & 1); }
    const int ngm = (l == 0 ? TOK : NLAT) / 128;
    if (MXSEL & 4) for (;;) { const int u = MX_NEXT(2); if (u >= ngm) break; gmlp_unit(a, lds, l, u); }
#undef MX_NEXT
}

__device__ __forceinline__ void phase_mr(const Args& a, int l, int T) {
    const int tid = opaque_tid(), wid = tid >> 6, lane = tid & 63;
    const bf16_t* P = (const bf16_t*)(a.ws + WS_P); bf16_t* MIX = (bf16_t*)(a.ws + WS_MIX);
    const float* MH0 = (const float*)(a.ws + WS_MHS); const float* MH1 = MH0 + (size_t)TOK * 384;
    const float* RG0 = (const float*)(a.ws + WS_RGY); const float* RG1 = RG0 + (size_t)TOK * 384;
    const int c0 = lane * 6;
    float ng[6];
#pragma unroll
    for (int j = 0; j < 6; ++j) ng[j] = a.in[I_MNG][l * 384 + c0 + j];
    for (int row = blockIdx.x * 8 + wid; row < T; row += gridDim.x * 8) {
        const size_t o = (size_t)row * 384 + c0; const bf16_t* pr = P + (size_t)row * PW;
        float hs[6], y[6], ss = 0.f;
#pragma unroll
        for (int j = 0; j < 6; j += 2) { const f32x2 x0 = *(const f32x2*)(MH0 + o + j), x1 = *(const f32x2*)(MH1 + o + j), r0 = *(const f32x2*)(RG0 + o + j), r1 = *(const f32x2*)(RG1 + o + j);
            hs[j] = x0[0] + x1[0]; hs[j + 1] = x0[1] + x1[1]; y[j] = r0[0] + r1[0]; y[j + 1] = r0[1] + r1[1]; }
#pragma unroll
        for (int j = 0; j < 6; ++j) ss += hs[j] * hs[j];
        ss += __shfl_xor(ss, 1); ss += __shfl_xor(ss, 2); ss += __shfl_xor(ss, 4); ss += __shfl_xor(ss, 8);
        const float rstd = rsqrtf(ss * (1.0f / 96.0f) + EPS);
        unsigned om[3], og[3];
#pragma unroll
        for (int j = 0; j < 6; j += 2) {
            const unsigned ow = *(const unsigned*)(pr + PC_O + c0 + j), gw = *(const unsigned*)(pr + PC_RG + c0 + j);
            const float o0 = __uint_as_float(ow << 16), o1 = __uint_as_float(ow & 0xffff0000u), g0 = __uint_as_float(gw << 16), g1 = __uint_as_float(gw & 0xffff0000u);
            om[j >> 1] = cvt_pk_bf16(sigmoidf_(o0) * hs[j] * rstd * ng[j], sigmoidf_(o1) * hs[j + 1] * rstd * ng[j + 1]);
            og[j >> 1] = cvt_pk_bf16(g0 * y[j], g1 * y[j + 1]);
        }
        unsigned* mo = (unsigned*)(MIX + (size_t)row * 1024 + 384 + c0); unsigned* go = (unsigned*)(MIX + (size_t)row * 1024 + c0);
        mo[0] = om[0]; mo[1] = om[1]; mo[2] = om[2]; go[0] = og[0]; go[1] = og[1]; go[2] = og[2];
    }
}

constexpr int N_PHASES = 22;
__global__ void __launch_bounds__(NTHREADS, 2) fwd_kernel(Args a) {
    extern __shared__ __attribute__((aligned(16))) unsigned char lds_raw[];
    LAS unsigned char* lds = (LAS unsigned char*)lds_raw;
    const int lo = a.ph_lo, hi = a.ph_hi;
    XcdBarrier bar; bar.bar = (unsigned*)(a.ws + WS_CTL); bar.x = 0; bar.st = (volatile LAS unsigned*)(lds + LDS_BARW);
    if (hi - lo > 1) {
        if (threadIdx.x == 0) { *(LAS u32x4*)(lds + LDS_BARW) = (u32x4){0u, 0u, 0u, 0u}; }
        __syncthreads();
        bar = xcd_barrier_post((unsigned*)(a.ws + WS_CTL), (volatile LAS unsigned*)(lds + LDS_BARW));
    }
#ifndef PHSEL
#define PHSEL 0xFFF
#endif
#define SELJ(j) (((PHSEL) >> (j)) & 1)
#define IN(k) (lo <= (k) && (k) < hi)
#define SEAM(k) do { if (IN(k) && IN((k) + 1)) xcd_barrier(bar); } while (0)
    if (SELJ(10) && IN(0)) { p0_mod(a, lds); p0_conv(a, lds); }
    SEAM(0);
    for (int l = 0; l < 2; ++l) {
        const int pb = 1 + 10 * l, T = (l == 0) ? TOK : NLAT;
        if (SELJ(0) && IN(pb + 0)) phase_n1(a, l);
        SEAM(pb + 0);
        if (SELJ(1) && IN(pb + 1)) phase_g1(a, lds, l);
        SEAM(pb + 1);
        if (SELJ(2) && IN(pb + 2)) phase_mx(a, lds, l);
        SEAM(pb + 2);
        if (SELJ(3) && IN(pb + 3)) phase_mr(a, l, T);
        SEAM(pb + 3);
        if (SELJ(4) && IN(pb + 4)) phase_g2(a, lds, l, T);
        SEAM(pb + 4);
        if (SELJ(5) && IN(pb + 5)) phase_n2(a, l, T);
        SEAM(pb + 5);
        if (SELJ(6) && IN(pb + 6)) phase_rt(a, lds, l, T);
        SEAM(pb + 6);
        if (SELJ(7) && IN(pb + 7)) phase_tk(a, l, T);
        SEAM(pb + 7);
        if (SELJ(8) && IN(pb + 8)) phase_e1(a, lds, l, T);
        SEAM(pb + 8);
        if (SELJ(9) && IN(pb + 9)) phase_e2(a, lds, l, T);
        SEAM(pb + 9);
    }
    if (SELJ(11) && IN(21)) phase_fin(a);
#undef IN
#undef SEAM
}

extern "C" void kernel_launch(void* const* d_in, const int* in_sizes, int n_in, void* d_out, int out_size, void* d_ws, size_t ws_size, hipStream_t stream) {
    static int grid = 0;
    if (grid == 0) {
        if (n_in != 29 || out_size != NLAT * D || ws_size < WS_END) { fprintf(stderr, "kernel_launch: unexpected shapes (n_in %d, out %d, ws %zu, need %zu)\n", n_in, out_size, ws_size, (size_t)WS_END); grid = -1; return; }
        int dev = 0, cus = 0, per_cu = 0;
        if (hipGetDevice(&dev) != hipSuccess || hipDeviceGetAttribute(&cus, hipDeviceAttributeMultiprocessorCount, dev) != hipSuccess) { grid = -1; return; }
        if (hipFuncSetAttribute((const void*)fwd_kernel, hipFuncAttributeMaxDynamicSharedMemorySize, LDS_BYTES) != hipSuccess) { fprintf(stderr, "kernel_launch: hipFuncSetAttribute failed\n"); grid = -1; return; }
        if (hipOccupancyMaxActiveBlocksPerMultiprocessor(&per_cu, (const void*)fwd_kernel, NTHREADS, LDS_BYTES) != hipSuccess || per_cu < 1) { fprintf(stderr, "kernel_launch: occupancy query says %d\n", per_cu); (void)hipGetLastError(); grid = -1; return; }
        grid = cus;
    }
    if (grid < 0) return;
    (void)hipMemsetAsync((char*)d_ws + WS_CTL, 0, CTL_BYTES, stream);
    Args a{};
    for (int i = 0; i < 29; ++i) a.in[i] = (const float*)d_in[i];
    a.out = (float*)d_out; a.ws = (unsigned char*)d_ws;
#if MK_PER_PHASE
    for (int p = 0; p < N_PHASES; ++p) { a.ph_lo = p; a.ph_hi = p + 1; hipLaunchKernelGGL(fwd_kernel, dim3(grid), dim3(NTHREADS), LDS_BYTES, stream, a); }
#else
    a.ph_lo = 0; a.ph_hi = N_PHASES;
    hipLaunchKernelGGL(fwd_kernel, dim3(grid), dim3(NTHREADS), LDS_BYTES, stream, a);
#endif
}
```

```cpp
#include <hip/hip_runtime.h>
#include <cstdio>
#include <cstdint>

#ifndef MK_PER_PHASE
#define MK_PER_PHASE 0
#endif

#define LAS __attribute__((address_space(3)))
typedef unsigned short bf16_t;
typedef short bf16x8 __attribute__((ext_vector_type(8)));
typedef float f32x4 __attribute__((ext_vector_type(4)));
typedef float f32x2 __attribute__((ext_vector_type(2)));
typedef unsigned u32x4 __attribute__((ext_vector_type(4)));
typedef unsigned u32x2 __attribute__((ext_vector_type(2)));

constexpr int D = 1024, NBATCH = 16, SEQ = 2048, CTXL = 256;
constexpr int NLAT = NBATCH * SEQ, NCTX = NBATCH * CTXL, TOK = NLAT + NCTX;
constexpr int DIN = 2832, PW = 2816, NIN = 3072;
constexpr int NE = 256, FF = 288, NSLOT = 9, LCAP = TOK;
constexpr int NTHREADS = 512;
constexpr int LDS_BYTES = 147456;
constexpr int LDS_TAB = 131072;
constexpr int LDS_BARW = LDS_BYTES - 16;
constexpr float EPS = 1e-6f;

constexpr int PC_RX = 0, PC_RG = 384, PC_Q = 768, PC_K = 1152, PC_V = 1536, PC_O = 1920, PC_CU = 2304, PC_CV = 2560;

constexpr size_t WS_CTL = 0, CTL_BYTES = 65536;
constexpr size_t CTL_CNT = 16384, CTL_QUEUE = 20480;
constexpr size_t WS_MOD = 65536;
constexpr size_t WS_X = WS_MOD + 1048576;
constexpr size_t WS_XA = WS_X + (size_t)TOK * D * 4;
constexpr size_t WS_R1 = WS_XA + (size_t)TOK * D * 2;
constexpr size_t R1_BYTES = (size_t)TOK * NSLOT * D * 2;
constexpr size_t WS_P = WS_R1;
constexpr size_t WS_MIX = WS_P + (size_t)TOK * PW * 2;
constexpr size_t WS_MHS = WS_MIX + (size_t)TOK * D * 2;
constexpr size_t WS_RGY = WS_MHS + (size_t)2 * TOK * 384 * 4;
static_assert(WS_RGY + (size_t)2 * TOK * 384 * 4 <= WS_R1 + R1_BYTES, "aliases");
constexpr int HB_ROWS = (TOK * 8 / 256 + 256 + TOK / 256) * 256;
constexpr size_t WS_HB = WS_R1 + R1_BYTES;
constexpr size_t WS_GATES = WS_HB + (size_t)HB_ROWS * FF * 2 + 256;
constexpr size_t WS_LOGITS = WS_GATES + (size_t)TOK * 16 * 4;
constexpr size_t WS_LSLOT = WS_LOGITS + (size_t)TOK * 256 * 4;
constexpr size_t WS_LW = WS_LSLOT + (size_t)NE * LCAP * 4;
constexpr size_t WS_WIN = WS_LW + (size_t)NE * LCAP * 4;
constexpr size_t WS_WOUT = WS_WIN + (size_t)2 * NIN * D * 2;
constexpr size_t WS_ROUT = WS_WOUT + (size_t)2 * D * D * 2;
constexpr size_t WS_E1 = WS_ROUT + (size_t)2 * NE * D * 2;
constexpr size_t WS_E2 = WS_E1 + (size_t)2 * 257 * 576 * D * 2 + 256;
constexpr size_t WS_END = WS_E2 + (size_t)2 * 257 * D * FF * 2 + 256;

__device__ __forceinline__ float bf2f(bf16_t b) { return __uint_as_float(((unsigned)b) << 16); }
__device__ __forceinline__ unsigned cvt_pk_bf16(float lo, float hi) { unsigned r; asm volatile("v_cvt_pk_bf16_f32 %0, %1, %2" : "=v"(r) : "v"(lo), "v"(hi)); return r; }
__device__ __forceinline__ bf16_t f2bf(float f) { return (bf16_t)(cvt_pk_bf16(f, 0.f) & 0xffffu); }
__device__ __forceinline__ float sigmoidf_(float x) { return 1.0f / (1.0f + __expf(-x)); }
__device__ __forceinline__ float siluf_(float x) { return x / (1.0f + __expf(-x)); }
__device__ __forceinline__ float gelu_tanh(float x) { const float u = 1.5957691216057308f * (x + 0.044715f * x * x * x); return x / (1.0f + __expf(-u)); }
__device__ __forceinline__ float wave_sum(float v) {
#pragma unroll
    for (int o = 32; o >= 1; o >>= 1) v += __shfl_xor(v, o);
    return v;
}
__device__ __forceinline__ int opaque_tid() { int t = threadIdx.x; asm volatile("" : "+v"(t)); return t; }
#define WAIT_VM0() asm volatile("s_waitcnt vmcnt(0)" ::: "memory")

#define XB_TMO      128
#define XB_XCNT(j)  (256  + 64 * (j))
#define XB_XSUB(j)  (1280 + 64 * (j))
#define XB_XGEN(j)  (2304 + 64 * (j))
#define XB_TOP      3328
#define XB_TOPGEN   3392
#define XCD_BAR_WORDS 3456
#define XB_SPIN_CAP (1u << 18)

__device__ __forceinline__ unsigned xb_ld(unsigned* p)              { return __hip_atomic_load(p, __ATOMIC_RELAXED, __HIP_MEMORY_SCOPE_AGENT); }
__device__ __forceinline__ unsigned xb_add(unsigned* p, unsigned v) { return __hip_atomic_fetch_add(p, v, __ATOMIC_RELAXED, __HIP_MEMORY_SCOPE_AGENT); }
__device__ __forceinline__ unsigned xb_xcc_id() { return (unsigned)__builtin_amdgcn_s_getreg((3 << 11) | 20) & 0xFu; }
#define XB_SPIN(cond, bar) do { unsigned _sp = 0; while (cond) { __builtin_amdgcn_s_sleep(1); \
    if ((++_sp & 255u) == 0u) { if (xb_ld(&(bar)[XB_TMO])) break; if (_sp > XB_SPIN_CAP) { atomicAdd(&(bar)[XB_TMO], 1u); break; } } } } while (0)

struct XcdBarrier { unsigned* bar; unsigned x; volatile LAS unsigned* st; };

__device__ __forceinline__ XcdBarrier xcd_barrier_post(unsigned* bar, volatile LAS unsigned* st) {
    XcdBarrier b; b.bar = bar; b.x = xb_xcc_id(); b.st = st;
    if (threadIdx.x == 0) (void)xb_add(&bar[XB_XCNT(b.x)], 1u);
    return b;
}
__device__ __forceinline__ void xcd_barrier_complete(unsigned* bar, unsigned x, unsigned& nloc, unsigned& nx) {
    const unsigned G = gridDim.x * gridDim.y * gridDim.z;
    unsigned sum, cnt, mine, sp = 0u;
    for (;;) {
        sum = 0u; cnt = 0u; mine = 0u;
#pragma unroll
        for (unsigned j = 0; j < 16; ++j) { const unsigned c = xb_ld(&bar[XB_XCNT(j)]); sum += c; cnt += (c > 0u) ? 1u : 0u; mine = (j == x) ? c : mine; }
        if (sum == G) break;
        __builtin_amdgcn_s_sleep(1);
        if ((++sp & 255u) == 0u) { if (xb_ld(&bar[XB_TMO])) break; if (sp > XB_SPIN_CAP) { atomicAdd(&bar[XB_TMO], 1u); break; } }
    }
    nloc = mine > 0u ? mine : 1u; nx = cnt > 0u ? cnt : 1u;
}
__device__ __forceinline__ void xcd_barrier(const XcdBarrier& b) {
    asm volatile("s_waitcnt vmcnt(0)" ::: "memory");
    __syncthreads();
    if (threadIdx.x == 0) {
        unsigned* bar = b.bar;
        __builtin_amdgcn_s_waitcnt(0);
        unsigned nloc = b.st[0], nx = b.st[1];
        if (nloc == 0u) { xcd_barrier_complete(bar, b.x, nloc, nx); b.st[0] = nloc; b.st[1] = nx; }
        const unsigned old = xb_add(&bar[XB_XSUB(b.x)], 1u);
        const unsigned gen = old / nloc;
        if (old + 1u == (gen + 1u) * nloc) {
            __builtin_amdgcn_fence(__ATOMIC_RELEASE, "agent");
            asm volatile("s_waitcnt vmcnt(0)" ::: "memory");
            const unsigned og = xb_add(&bar[XB_TOP], 1u);
            const unsigned tg = og / nx;
            if (og + 1u == (tg + 1u) * nx) xb_add(&bar[XB_TOPGEN], 1u);
            else XB_SPIN(xb_ld(&bar[XB_TOPGEN]) == tg, bar);
            __builtin_amdgcn_fence(__ATOMIC_ACQUIRE, "agent");
            xb_add(&bar[XB_XGEN(b.x)], 1u);
            asm volatile("s_waitcnt vmcnt(0)" ::: "memory");
        } else {
            XB_SPIN(xb_ld(&bar[XB_XGEN(b.x)]) == gen, bar);
            __builtin_amdgcn_fence(__ATOMIC_ACQUIRE, "agent");
            asm volatile("s_waitcnt vmcnt(0)" ::: "memory");
        }
    }
    __syncthreads();
}

struct Args { const float* in[29]; float* out; unsigned char* ws; int ph_lo, ph_hi; };
enum { I_X = 0, I_C, I_CTX, I_CCTX, I_N1G, I_N2G, I_WMOD, I_BMOD, I_WIN, I_RGCW, I_RGCB, I_RGGW, I_RGGB, I_RGLAM, I_MGB, I_MNG, I_CMNG, I_CMW, I_CMB,
       I_WOUT, I_RW, I_RB, I_EG, I_EU, I_ED, I_SG, I_SU, I_SD, I_FNG };

__device__ __forceinline__ int lds_byte(int r, int c) { const int st = (r >> 4) * 2 + (c >> 5), ob = (r & 15) * 64 + (c & 31) * 2; return st * 1024 + (ob ^ (((ob >> 9) & 1) << 5)); }
__device__ __forceinline__ void stage_rc(int b, int& R, int& C) { const int st = b >> 10, sb = b & 1023, swz = sb ^ (((sb >> 9) & 1) << 5); R = (st >> 1) * 16 + (swz >> 6); C = (st & 1) * 32 + ((swz & 63) >> 1); }

template <int BN, int WC> struct GT { static constexpr int WR = 8 / WC, MF = 256 / WR / 16, NF = BN / WC / 16, BP = BN / 64; };

template <int BN, int WC>
__device__ __forceinline__ void gemm_run(LAS unsigned char* lds, f32x4 (&acc)[GT<BN, WC>::MF][GT<BN, WC>::NF], const unsigned char* Ab, const unsigned (&aoff)[4],
                                         const unsigned char* Bb, const unsigned (&boff)[GT<BN, WC>::BP], const int nt, const bool tail) {
    constexpr int MF = GT<BN, WC>::MF, NF = GT<BN, WC>::NF, BP = GT<BN, WC>::BP;
    const int tid = opaque_tid(), wid = __builtin_amdgcn_readfirstlane(tid >> 6), lane = tid & 63, fr = lane & 15, fq = lane >> 4;
    const int wr = wid / WC, wc = wid % WC;
    const int aro = lds_byte(wr * (MF * 16) + fr, fq * 8), bro = 32768 + lds_byte(wc * (NF * 16) + fr, fq * 8);
#pragma unroll
    for (int m = 0; m < MF; ++m)
#pragma unroll
        for (int n = 0; n < NF; ++n) acc[m][n] = (f32x4){0.f, 0.f, 0.f, 0.f};
#define GE_STAGE(buf, kt) do { \
        _Pragma("unroll") for (int _i = 0; _i < 4; ++_i) __builtin_amdgcn_global_load_lds((const unsigned*)(Ab + aoff[_i] + (size_t)(kt) * 128), (LAS unsigned*)(lds + (buf) * 65536 + wid * 1024 + _i * 8192), 16, 0, 0); \
        _Pragma("unroll") for (int _i = 0; _i < BP; ++_i) __builtin_amdgcn_global_load_lds((const unsigned*)(Bb + boff[_i] + (size_t)(kt) * 128), (LAS unsigned*)(lds + (buf) * 65536 + 32768 + wid * 1024 + _i * 8192), 16, 0, 0); } while (0)
#define GE_KSTEP(buf, ks) do { bf16x8 At[MF], Bf[NF]; \
        _Pragma("unroll") for (int m = 0; m < MF; ++m) At[m] = *(const LAS bf16x8*)(lds + (buf) * 65536 + aro + m * 2048 + (ks) * 1024); \
        _Pragma("unroll") for (int n = 0; n < NF; ++n) Bf[n] = *(const LAS bf16x8*)(lds + (buf) * 65536 + bro + n * 2048 + (ks) * 1024); \
        _Pragma("unroll") for (int m = 0; m < MF; ++m) _Pragma("unroll") for (int n = 0; n < NF; ++n) acc[m][n] = __builtin_amdgcn_mfma_f32_16x16x32_bf16(Bf[n], At[m], acc[m][n], 0, 0, 0); __builtin_amdgcn_sched_barrier(0); } while (0)
    GE_STAGE(0, 0); WAIT_VM0(); __syncthreads();
#pragma unroll 1
    for (int t = 0; t < nt; ++t) {
        const int cur = t & 1;
        if (t + 1 < nt) GE_STAGE(cur ^ 1, t + 1);
        GE_KSTEP(cur, 0);
        if (!(tail && t == nt - 1)) GE_KSTEP(cur, 1);
        WAIT_VM0(); __syncthreads();
    }
#undef GE_STAGE
#undef GE_KSTEP
}

__device__ __forceinline__ bf16x8 ldfrag(const LAS bf16_t* img, int pitch, int row0, int k0, int fr, int fq) { return *(const LAS bf16x8*)(img + (row0 + fr) * pitch + k0 + fq * 8); }
#define MFMA(a, b, c) __builtin_amdgcn_mfma_f32_16x16x32_bf16(a, b, c, 0, 0, 0)

__device__ __forceinline__ void p0_mod(const Args& a, LAS unsigned char* lds) {
    LAS float* sc = (LAS float*)lds;
    LAS float* red = (LAS float*)(lds + 69632);
    const int tid = opaque_tid();
    for (int i = tid; i < 17 * 1024; i += NTHREADS) { const int s = i >> 10, k = i & 1023; const float v = s < 16 ? a.in[I_C][s * 1024 + k] : a.in[I_CCTX][k]; sc[i] = siluf_(v); }
    __syncthreads();
    float* MOD = (float*)(a.ws + WS_MOD);
    for (int u = blockIdx.x; u < 192; u += gridDim.x) {
        const int l = u / 96, cb = (u % 96) * 64, col = tid & 63, ks = tid >> 6;
        const float* w = a.in[I_WMOD] + (size_t)l * 1024 * 6144 + cb + col;
        float acc[17];
#pragma unroll
        for (int s = 0; s < 17; ++s) acc[s] = 0.f;
#pragma unroll 4
        for (int k = ks * 128; k < ks * 128 + 128; ++k) {
            const float wv = w[(size_t)k * 6144];
#pragma unroll
            for (int s = 0; s < 17; ++s) acc[s] += sc[s * 1024 + k] * wv;
        }
#pragma unroll
        for (int s = 0; s < 17; ++s) red[(ks * 17 + s) * 64 + col] = acc[s];
        __syncthreads();
        for (int i = tid; i < 17 * 64; i += NTHREADS) {
            const int s = i >> 6, c = i & 63; float v = 0.f;
#pragma unroll
            for (int k2 = 0; k2 < 8; ++k2) v += red[(k2 * 17 + s) * 64 + c];
            MOD[((size_t)l * 17 + s) * 6144 + cb + c] = v + a.in[I_BMOD][l * 6144 + cb + c];
        }
        __syncthreads();
    }
}

template <int KT>
__device__ __forceinline__ void conv_tile(LAS float* tile, const float* p0, const float* p1, const float* p2, const float* p3, int ldn, int k0, bf16_t* dst, int K) {
    const int tid = opaque_tid(), r = tid >> 4, c4 = tid & 15, grp = c4 >> 2, within = (c4 & 3) * 4;
    const float* p = grp == 0 ? p0 : grp == 1 ? p1 : grp == 2 ? p2 : p3;
#pragma unroll
    for (int i = 0; i < KT / 32; ++i) {
        const int k = r + 32 * i; f32x4 v = (f32x4){0.f, 0.f, 0.f, 0.f};
        if (p) v = *(const f32x4*)(p + (size_t)(k0 + k) * ldn + within);
        tile[k * 65 + c4 * 4 + 0] = v[0]; tile[k * 65 + c4 * 4 + 1] = v[1]; tile[k * 65 + c4 * 4 + 2] = v[2]; tile[k * 65 + c4 * 4 + 3] = v[3];
    }
    __syncthreads();
    constexpr int CPR = KT / 16;
    const int row = tid / CPR, ch = tid % CPR;
    if (row < 64) {
        float v[16];
#pragma unroll
        for (int j = 0; j < 16; ++j) v[j] = tile[(ch * 16 + j) * 65 + row];
        u32x4 w0, w1;
        w0.x = cvt_pk_bf16(v[0], v[1]); w0.y = cvt_pk_bf16(v[2], v[3]); w0.z = cvt_pk_bf16(v[4], v[5]); w0.w = cvt_pk_bf16(v[6], v[7]);
        w1.x = cvt_pk_bf16(v[8], v[9]); w1.y = cvt_pk_bf16(v[10], v[11]); w1.z = cvt_pk_bf16(v[12], v[13]); w1.w = cvt_pk_bf16(v[14], v[15]);
        bf16_t* dp = dst + (size_t)row * K + k0 + ch * 16;
        *(u32x4*)dp = w0; *(u32x4*)(dp + 8) = w1;
    }
    __syncthreads();
}

constexpr int CV_WIN = 384, CV_WOUT = 128, CV_ROUT = 32, CV_E1 = 257 * 72, CV_E2 = 257 * 48, CV_LAYER = CV_WIN + CV_WOUT + CV_ROUT + CV_E1 + CV_E2;
__device__ __forceinline__ void p0_conv(const Args& a, LAS unsigned char* lds) {
    LAS float* tile = (LAS float*)lds;
    for (int u = blockIdx.x; u < 2 * CV_LAYER; u += gridDim.x) {
        const int l = u / CV_LAYER; int j = u % CV_LAYER;
        if (j < CV_WIN) {
            const int rho0 = (j >> 3) * 64, kt = j & 7; const float* src = a.in[I_WIN] + (size_t)l * 1024 * DIN; const float* p[4];
#pragma unroll
            for (int g = 0; g < 4; ++g) { const int rho = rho0 + 16 * g; const int col = rho < 2304 ? rho : rho < 2816 ? rho + 16 : rho < 2832 ? rho - 512 : -1; p[g] = col >= 0 ? src + col : nullptr; }
            conv_tile<128>(tile, p[0], p[1], p[2], p[3], DIN, kt * 128, (bf16_t*)(a.ws + WS_WIN) + ((size_t)l * NIN + rho0) * 1024, 1024);
            continue;
        }
        j -= CV_WIN;
        if (j < CV_WOUT) {
            const int rho0 = (j >> 3) * 64, kt = j & 7; const float* src = a.in[I_WOUT] + (size_t)l * 1024 * 1024 + rho0;
            conv_tile<128>(tile, src, src + 16, src + 32, src + 48, 1024, kt * 128, (bf16_t*)(a.ws + WS_WOUT) + ((size_t)l * 1024 + rho0) * 1024, 1024);
            continue;
        }
        j -= CV_WOUT;
        if (j < CV_ROUT) {
            const int rho0 = (j >> 3) * 64, kt = j & 7; const float* src = a.in[I_RW] + (size_t)l * 1024 * 256 + rho0;
            conv_tile<128>(tile, src, src + 16, src + 32, src + 48, 256, kt * 128, (bf16_t*)(a.ws + WS_ROUT) + ((size_t)l * 256 + rho0) * 1024, 1024);
            continue;
        }
        j -= CV_ROUT;
        if (j < CV_E1) {
            const int e = j / 72, jj = j % 72, rho0 = (jj >> 3) * 64, kt = jj & 7;
            const float* sg = e < 256 ? a.in[I_EG] + ((size_t)l * 256 + e) * 1024 * FF : a.in[I_SG] + (size_t)l * 1024 * FF;
            const float* su = e < 256 ? a.in[I_EU] + ((size_t)l * 256 + e) * 1024 * FF : a.in[I_SU] + (size_t)l * 1024 * FF;
            const float* p[4];
#pragma unroll
            for (int g = 0; g < 4; ++g) { const int rho = rho0 + 16 * g, nt = rho / 192, tc = rho % 192, wc = tc / 96, n = (tc % 96) / 16; p[g] = (n < 3 ? sg : su) + nt * 96 + wc * 48 + 16 * (n % 3); }
            conv_tile<128>(tile, p[0], p[1], p[2], p[3], FF, kt * 128, (bf16_t*)(a.ws + WS_E1) + (((size_t)l * 257 + e) * 576 + rho0) * 1024, 1024);
            continue;
        }
        j -= CV_E1;
        {
            const int e = j / 48, jj = j % 48, rho0 = (jj / 3) * 64, kt = jj % 3;
            const float* sd = (e < 256 ? a.in[I_ED] + ((size_t)l * 256 + e) * FF * 1024 : a.in[I_SD] + (size_t)l * FF * 1024) + rho0;
            conv_tile<96>(tile, sd, sd + 16, sd + 32, sd + 48, 1024, kt * 96, (bf16_t*)(a.ws + WS_E2) + (((size_t)l * 257 + e) * 1024 + rho0) * FF, FF);
        }
    }
}

__device__ __forceinline__ int sample_of(int row) { return row < NLAT ? (row >> 11) : 16; }

__device__ __forceinline__ void slot_sum(const bf16_t* Y, int row, int lane, f32x4 (&s)[4]) {
#pragma unroll
    for (int ii = 0; ii < 4; ++ii) s[ii] = (f32x4){0.f, 0.f, 0.f, 0.f};
#pragma unroll
    for (int k = 0; k < NSLOT; ++k) {
        const bf16_t* yp = Y + ((size_t)row * NSLOT + k) * 1024 + lane * 4;
#pragma unroll
        for (int ii = 0; ii < 4; ++ii) { const u32x2 w = *(const u32x2*)(yp + ii * 256); s[ii][0] += __uint_as_float(w.x << 16); s[ii][1] += __uint_as_float(w.x & 0xffff0000u); s[ii][2] += __uint_as_float(w.y << 16); s[ii][3] += __uint_as_float(w.y & 0xffff0000u); }
    }
}
__device__ __forceinline__ void norm_mod_store(const f32x4 (&v)[4], const float* g, const float* shift, const float* scale, bf16_t* dst, int lane) {
    float ss = 0.f;
#pragma unroll
    for (int ii = 0; ii < 4; ++ii) ss += v[ii][0] * v[ii][0] + v[ii][1] * v[ii][1] + v[ii][2] * v[ii][2] + v[ii][3] * v[ii][3];
    ss = wave_sum(ss);
    const float rstd = rsqrtf(ss * (1.0f / 1024.0f) + EPS);
#pragma unroll
    for (int ii = 0; ii < 4; ++ii) {
        const int c = ii * 256 + lane * 4;
        const f32x4 gg = *(const f32x4*)(g + c), sh = *(const f32x4*)(shift + c), sc = *(const f32x4*)(scale + c);
        f32x4 y;
#pragma unroll
        for (int j = 0; j < 4; ++j) y[j] = v[ii][j] * rstd * gg[j] * (1.0f + sc[j]) + sh[j];
        u32x2 w; w.x = cvt_pk_bf16(y[0], y[1]); w.y = cvt_pk_bf16(y[2], y[3]);
        *(u32x2*)(dst + c) = w;
    }
}

__device__ __forceinline__ void phase_n1(const Args& a, int l) {
    const int tid = opaque_tid(), wid = tid >> 6, lane = tid & 63;
    float* X = (float*)(a.ws + WS_X); bf16_t* XA = (bf16_t*)(a.ws + WS_XA); const float* MOD = (const float*)(a.ws + WS_MOD); const bf16_t* Y = (const bf16_t*)(a.ws + WS_R1);
    for (int row = blockIdx.x * 8 + wid; row < TOK; row += gridDim.x * 8) {
        const int s = sample_of(row);
        f32x4 v[4];
        if (l == 0) {
            if (row < NLAT) {
                const float* xp = a.in[I_X] + (size_t)row * 1024 + lane * 4;
                const int tp = row & 2047; const float pr = (float)(tp >> 6), pc = (float)(tp & 63);
#pragma unroll
                for (int ii = 0; ii < 4; ++ii) v[ii] = *(const f32x4*)(xp + ii * 256);
#pragma unroll
                for (int j = 0; j < 4; ++j) {
                    const float om = exp2f(-13.287712379549449f * (float)(lane * 4 + j) * (1.0f / 256.0f));
                    const float ar = pr * om, ac = pc * om;
                    v[0][j] += sinf(ar); v[1][j] += cosf(ar); v[2][j] += sinf(ac); v[3][j] += cosf(ac);
                }
            } else {
                const float* xp = a.in[I_CTX] + (size_t)(row - NLAT) * 1024 + lane * 4;
#pragma unroll
                for (int ii = 0; ii < 4; ++ii) v[ii] = *(const f32x4*)(xp + ii * 256);
            }
        } else {
            f32x4 ys[4]; slot_sum(Y, row, lane, ys);
            const float* gate = MOD + ((size_t)(l - 1) * 17 + s) * 6144 + 5 * 1024 + lane * 4;
#pragma unroll
            for (int ii = 0; ii < 4; ++ii) { const f32x4 xv = *(const f32x4*)(X + (size_t)row * 1024 + ii * 256 + lane * 4), gv = *(const f32x4*)(gate + ii * 256); v[ii] = xv + gv * ys[ii]; }
        }
#pragma unroll
        for (int ii = 0; ii < 4; ++ii) *(f32x4*)(X + (size_t)row * 1024 + ii * 256 + lane * 4) = v[ii];
        const float* m = MOD + ((size_t)l * 17 + s) * 6144;
        norm_mod_store(v, a.in[I_N1G] + l * 1024, m, m + 1024, XA + (size_t)row * 1024, lane);
    }
}
__device__ __forceinline__ void phase_n2(const Args& a, int l, int T) {
    const int tid = opaque_tid(), wid = tid >> 6, lane = tid & 63;
    const float* X = (const float*)(a.ws + WS_X); bf16_t* XA = (bf16_t*)(a.ws + WS_XA); const float* MOD = (const float*)(a.ws + WS_MOD);
    for (int row = blockIdx.x * 8 + wid; row < T; row += gridDim.x * 8) {
        const int s = sample_of(row);
        f32x4 v[4];
#pragma unroll
        for (int ii = 0; ii < 4; ++ii) v[ii] = *(const f32x4*)(X + (size_t)row * 1024 + ii * 256 + lane * 4);
        const float* m = MOD + ((size_t)l * 17 + s) * 6144;
        norm_mod_store(v, a.in[I_N2G] + l * 1024, m + 3 * 1024, m + 4 * 1024, XA + (size_t)row * 1024, lane);
    }
}
__device__ __forceinline__ void phase_fin(const Args& a) {
    const int tid = opaque_tid(), wid = tid >> 6, lane = tid & 63;
    const float* X = (const float*)(a.ws + WS_X); const float* MOD = (const float*)(a.ws + WS_MOD); const bf16_t* Y = (const bf16_t*)(a.ws + WS_R1);
    for (int row = blockIdx.x * 8 + wid; row < NLAT; row += gridDim.x * 8) {
        const int s = sample_of(row);
        f32x4 ys[4], v[4]; slot_sum(Y, row, lane, ys);
        const float* gate = MOD + ((size_t)17 + s) * 6144 + 5 * 1024 + lane * 4;
        float ss = 0.f;
#pragma unroll
        for (int ii = 0; ii < 4; ++ii) { const f32x4 xv = *(const f32x4*)(X + (size_t)row * 1024 + ii * 256 + lane * 4), gv = *(const f32x4*)(gate + ii * 256); v[ii] = xv + gv * ys[ii];
            ss += v[ii][0] * v[ii][0] + v[ii][1] * v[ii][1] + v[ii][2] * v[ii][2] + v[ii][3] * v[ii][3]; }
        ss = wave_sum(ss);
        const float rstd = rsqrtf(ss * (1.0f / 1024.0f) + EPS);
#pragma unroll
        for (int ii = 0; ii < 4; ++ii) { const f32x4 g = *(const f32x4*)(a.in[I_FNG] + ii * 256 + lane * 4); *(f32x4*)(a.out + (size_t)row * 1024 + ii * 256 + lane * 4) = v[ii] * rstd * g; }
    }
}

template <int NP> __device__ __forceinline__ void lin_offsets(unsigned (&off)[NP], int pitch_bytes, int wid, int lane) {
#pragma unroll
    for (int i = 0; i < NP; ++i) { int R, C; stage_rc(wid * 1024 + i * 8192 + lane * 16, R, C); off[i] = (unsigned)(R * pitch_bytes + C * 2); }
}

__device__ __forceinline__ void phase_g1(const Args& a, LAS unsigned char* lds, int l) {
    const int tid = opaque_tid(), wid = __builtin_amdgcn_readfirstlane(tid >> 6), lane = tid & 63, fr = lane & 15, fq = lane >> 4, wr = wid >> 2, wc = wid & 3;
    unsigned aoff[4], boff[4]; lin_offsets<4>(aoff, 2048, wid, lane); lin_offsets<4>(boff, 2048, wid, lane);
    const bf16_t* XA = (const bf16_t*)(a.ws + WS_XA); const bf16_t* W = (const bf16_t*)(a.ws + WS_WIN) + (size_t)l * NIN * 1024;
    bf16_t* P = (bf16_t*)(a.ws + WS_P); float* GATES = (float*)(a.ws + WS_GATES);
    for (int u = blockIdx.x; u < (TOK / 256) * 12; u += gridDim.x) {
        const int pm = u / 12, pn = u % 12;
        f32x4 acc[8][4];
        gemm_run<256, 4>(lds, acc, (const unsigned char*)(XA + (size_t)pm * 256 * 1024), aoff, (const unsigned char*)(W + (size_t)pn * 256 * 1024), boff, 16, false);
        const int row0 = pm * 256 + wr * 128 + fr;
#pragma unroll
        for (int n = 0; n < 4; ++n) {
            const int cb = pn * 256 + wc * 64 + n * 16;
            if (cb >= DIN) continue;
            if (cb >= PW) {
#pragma unroll
                for (int m = 0; m < 8; ++m) *(f32x4*)(GATES + (size_t)(row0 + m * 16) * 16 + fq * 4) = acc[m][n];
            } else {
                const bool g = (cb >= PC_RG && cb < PC_Q) || cb >= PC_CU;
                const float sc = (cb >= PC_K && cb < PC_V) ? 0.10206207261596575f : 1.0f;
#pragma unroll
                for (int m = 0; m < 8; ++m) {
                    f32x4 v = acc[m][n];
                    if (g) { v[0] = gelu_tanh(v[0]); v[1] = gelu_tanh(v[1]); v[2] = gelu_tanh(v[2]); v[3] = gelu_tanh(v[3]); } else v = v * sc;
                    u32x2 w; w.x = cvt_pk_bf16(v[0], v[1]); w.y = cvt_pk_bf16(v[2], v[3]);
                    *(u32x2*)(P + (size_t)(row0 + m * 16) * PW + cb + fq * 4) = w;
                }
            }
        }
    }
}

__device__ __forceinline__ void phase_g2(const Args& a, LAS unsigned char* lds, int l, int T) {
    const int tid = opaque_tid(), wid = __builtin_amdgcn_readfirstlane(tid >> 6), lane = tid & 63, fr = lane & 15, fq = lane >> 4, wr = wid >> 2, wc = wid & 3;
    unsigned aoff[4], boff[4]; lin_offsets<4>(aoff, 2048, wid, lane); lin_offsets<4>(boff, 2048, wid, lane);
    const bf16_t* MIX = (const bf16_t*)(a.ws + WS_MIX); const bf16_t* W = (const bf16_t*)(a.ws + WS_WOUT) + (size_t)l * 1024 * 1024;
    float* X = (float*)(a.ws + WS_X); const float* MOD = (const float*)(a.ws + WS_MOD);
    for (int u = blockIdx.x; u < (T / 256) * 4; u += gridDim.x) {
        const int pm = u >> 2, pn = u & 3;
        f32x4 acc[8][4];
        gemm_run<256, 4>(lds, acc, (const unsigned char*)(MIX + (size_t)pm * 256 * 1024), aoff, (const unsigned char*)(W + (size_t)pn * 256 * 1024), boff, 16, false);
        const int row0 = pm * 256 + wr * 128 + fr, s = sample_of(pm * 256);
        const float* gate = MOD + ((size_t)l * 17 + s) * 6144 + 2 * 1024;
#pragma unroll
        for (int n = 0; n < 4; ++n) {
            const int col = pn * 256 + wc * 64 + n * 16 + fq * 4;
            const f32x4 gv = *(const f32x4*)(gate + col);
#pragma unroll
            for (int m = 0; m < 8; ++m) { float* xp = X + (size_t)(row0 + m * 16) * 1024 + col; *(f32x4*)xp = *(const f32x4*)xp + gv * acc[m][n]; }
        }
    }
}

__device__ __forceinline__ void phase_rt(const Args& a, LAS unsigned char* lds, int l, int T) {
    const int tid = opaque_tid(), wid = __builtin_amdgcn_readfirstlane(tid >> 6), lane = tid & 63, fr = lane & 15, fq = lane >> 4, wr = wid >> 2, wc = wid & 3;
    unsigned aoff[4], boff[4]; lin_offsets<4>(aoff, 2048, wid, lane); lin_offsets<4>(boff, 2048, wid, lane);
    const bf16_t* XA = (const bf16_t*)(a.ws + WS_XA); const bf16_t* W = (const bf16_t*)(a.ws + WS_ROUT) + (size_t)l * 256 * 1024;
    float* LG = (float*)(a.ws + WS_LOGITS);
    for (int u = blockIdx.x; u < T / 256; u += gridDim.x) {
        f32x4 acc[8][4];
        gemm_run<256, 4>(lds, acc, (const unsigned char*)(XA + (size_t)u * 256 * 1024), aoff, (const unsigned char*)W, boff, 16, false);
        const int row0 = u * 256 + wr * 128 + fr;
#pragma unroll
        for (int n = 0; n < 4; ++n)
#pragma unroll
            for (int m = 0; m < 8; ++m) *(f32x4*)(LG + (size_t)(row0 + m * 16) * 256 + wc * 64 + n * 16 + fq * 4) = acc[m][n];
    }
}

__device__ __forceinline__ void phase_tk(const Args& a, int l, int T) {
    const int tid = opaque_tid(), wid = tid >> 6, lane = tid & 63;
    const float* LG = (const float*)(a.ws + WS_LOGITS); const float* rb = a.in[I_RB] + l * 256;
    unsigned* CNT = (unsigned*)(a.ws + WS_CTL + CTL_CNT) + l * 256; int* LS = (int*)(a.ws + WS_LSLOT); float* LWt = (float*)(a.ws + WS_LW);
    const f32x4 bias = *(const f32x4*)(rb + lane * 4);
    const float NEG = -__builtin_huge_valf();
    for (int t = blockIdx.x * 8 + wid; t < T; t += gridDim.x * 8) {
        const f32x4 lg = *(const f32x4*)(LG + (size_t)t * 256 + lane * 4);
        float sc[4], sel[4];
#pragma unroll
        for (int j = 0; j < 4; ++j) { sc[j] = 1.0f / (1.0f + expf(-lg[j])); sel[j] = sc[j] + bias[j]; }
        float a1 = fmaxf(sel[0], sel[1]), a2 = fminf(sel[0], sel[1]);
#pragma unroll
        for (int j = 2; j < 4; ++j) { const float v = sel[j]; a2 = fmaxf(a2, fminf(a1, v)); a1 = fmaxf(a1, v); }
#pragma unroll
        for (int o = 1; o <= 4; o <<= 1) { const float b1 = __shfl_xor(a1, o), b2 = __shfl_xor(a2, o); const float n1 = fmaxf(a1, b1), n2 = fmaxf(fminf(a1, b1), fmaxf(a2, b2)); a1 = n1; a2 = n2; }
        const float gs = a1 + a2; const int g = lane >> 3; int rank = 0;
#pragma unroll
        for (int g2 = 0; g2 < 8; ++g2) { const float s2 = __shfl(gs, g2 * 8); rank += (s2 > gs || (s2 == gs && g2 < g)) ? 1 : 0; }
        float ms[4];
#pragma unroll
        for (int j = 0; j < 4; ++j) ms[j] = rank < 4 ? sel[j] : NEG;
        int my_e = 0; float my_s = 0.f, ssum = 0.f;
#pragma unroll
        for (int k = 0; k < 8; ++k) {
            float bv = ms[0]; int bi = lane * 4;
#pragma unroll
            for (int j = 1; j < 4; ++j) if (ms[j] > bv) { bv = ms[j]; bi = lane * 4 + j; }
#pragma unroll
            for (int o = 32; o >= 1; o >>= 1) { const float ov = __shfl_xor(bv, o); const int oi = __shfl_xor(bi, o); if (ov > bv || (ov == bv && oi < bi)) { bv = ov; bi = oi; } }
            const int jj = bi & 3; const float mysc = jj == 0 ? sc[0] : jj == 1 ? sc[1] : jj == 2 ? sc[2] : sc[3];
            const float sk = __shfl(mysc, bi >> 2);
#pragma unroll
            for (int j = 0; j < 4; ++j) if (lane * 4 + j == bi) ms[j] = NEG;
            if (lane == k) { my_e = bi; my_s = sk; }
            ssum += sk;
        }
        if (lane < 8) {
            const float w = my_s / ssum * 2.5f;
            const unsigned pos = atomicAdd(&CNT[my_e], 1u);
            LS[(size_t)my_e * LCAP + pos] = t * NSLOT + lane; LWt[(size_t)my_e * LCAP + pos] = w;
        }
    }
}

__device__ __forceinline__ void moe_tables(const Args& a, LAS unsigned char* lds, int l, int T) {
    LAS int* cntE = (LAS int*)(lds + LDS_TAB); LAS int* blkoff = cntE + 264;
    const int tid = opaque_tid(); const unsigned* CNT = (const unsigned*)(a.ws + WS_CTL + CTL_CNT) + l * 256;
    if (tid < 256) cntE[tid] = (int)CNT[tid]; else if (tid == 256) cntE[256] = T;
    __syncthreads();
    if (tid < 258) { int s = 0; for (int e = 0; e < tid && e < 257; ++e) s += (cntE[e] + 255) >> 8; blkoff[tid] = s; }
    __syncthreads();
}
__device__ __forceinline__ int moe_find(const LAS int* blkoff, int mbg) { int lo = 0, hi = 257; while (hi - lo > 1) { const int mid = (lo + hi) >> 1; if (blkoff[mid] <= mbg) lo = mid; else hi = mid; } return lo; }

__device__ __forceinline__ void phase_e1(const Args& a, LAS unsigned char* lds, int l, int T) {
    const int tid = opaque_tid(), wid = __builtin_amdgcn_readfirstlane(tid >> 6), lane = tid & 63, fr = lane & 15, fq = lane >> 4, wr = wid >> 1, wc = wid & 1;
    LAS int* cntE = (LAS int*)(lds + LDS_TAB); LAS int* blkoff = cntE + 264; LAS int* tokrow = blkoff + 264;
    moe_tables(a, lds, l, T);
    const int nblk = blkoff[257];
    const bf16_t* XA = (const bf16_t*)(a.ws + WS_XA); const bf16_t* W = (const bf16_t*)(a.ws + WS_E1) + (size_t)l * 257 * 576 * 1024;
    bf16_t* HB = (bf16_t*)(a.ws + WS_HB); const int* LS = (const int*)(a.ws + WS_LSLOT);
    unsigned boff[3]; lin_offsets<3>(boff, 2048, wid, lane);
    int Rr[4], Cc[4];
#pragma unroll
    for (int i = 0; i < 4; ++i) stage_rc(wid * 1024 + i * 8192 + lane * 16, Rr[i], Cc[i]);
    for (int u = blockIdx.x; u < nblk * 3; u += gridDim.x) {
        const int mbg = u / 3, nt = u % 3, e = moe_find(blkoff, mbg), mb = mbg - blkoff[e], cnt = cntE[e];
        __syncthreads();
        if (tid < 256) { const int pos = mb * 256 + tid; int tok = 0; if (pos < cnt) tok = e < 256 ? LS[(size_t)e * LCAP + pos] / NSLOT : pos; tokrow[tid] = tok; }
        __syncthreads();
        unsigned aoff[4];
#pragma unroll
        for (int i = 0; i < 4; ++i) aoff[i] = (unsigned)tokrow[Rr[i]] * 2048u + (unsigned)Cc[i] * 2u;
        f32x4 acc[4][6];
        gemm_run<192, 2>(lds, acc, (const unsigned char*)XA, aoff, (const unsigned char*)(W + ((size_t)e * 576 + nt * 192) * 1024), boff, 16, false);
#pragma unroll
        for (int m = 0; m < 4; ++m) {
            bf16_t* hp = HB + (size_t)(mbg * 256 + wr * 64 + m * 16 + fr) * FF + nt * 96 + wc * 48 + fq * 4;
#pragma unroll
            for (int n = 0; n < 3; ++n) {
                const f32x4 g = acc[m][n], uu = acc[m][n + 3];
                u32x2 w; w.x = cvt_pk_bf16(siluf_(g[0]) * uu[0], siluf_(g[1]) * uu[1]); w.y = cvt_pk_bf16(siluf_(g[2]) * uu[2], siluf_(g[3]) * uu[3]);
                *(u32x2*)(hp + n * 16) = w;
            }
        }
    }
}

__device__ __forceinline__ void phase_e2(const Args& a, LAS unsigned char* lds, int l, int T) {
    const int tid = opaque_tid(), wid = __builtin_amdgcn_readfirstlane(tid >> 6), lane = tid & 63, fr = lane & 15, fq = lane >> 4, wr = wid >> 2, wc = wid & 3;
    LAS int* cntE = (LAS int*)(lds + LDS_TAB); LAS int* blkoff = cntE + 264; LAS int* slotrow = blkoff + 264; LAS float* wrow = (LAS float*)(slotrow + 256);
    moe_tables(a, lds, l, T);
    const int nblk = blkoff[257];
    const bf16_t* HB = (const bf16_t*)(a.ws + WS_HB); const bf16_t* W = (const bf16_t*)(a.ws + WS_E2) + (size_t)l * 257 * 1024 * FF;
    bf16_t* Y = (bf16_t*)(a.ws + WS_R1); const int* LS = (const int*)(a.ws + WS_LSLOT); const float* LWt = (const float*)(a.ws + WS_LW);
    unsigned aoff[4], boff[4]; lin_offsets<4>(aoff, FF * 2, wid, lane); lin_offsets<4>(boff, FF * 2, wid, lane);
    for (int u = blockIdx.x; u < nblk * 4; u += gridDim.x) {
        const int mbg = u >> 2, pn = u & 3, e = moe_find(blkoff, mbg), mb = mbg - blkoff[e], cnt = cntE[e];
        __syncthreads();
        if (tid < 256) { const int pos = mb * 256 + tid; int slot = -1; float w = 0.f;
            if (pos < cnt) { if (e < 256) { slot = LS[(size_t)e * LCAP + pos]; w = LWt[(size_t)e * LCAP + pos]; } else { slot = pos * NSLOT + 8; w = 1.0f; } }
            slotrow[tid] = slot; wrow[tid] = w; }
        f32x4 acc[8][4];
        gemm_run<256, 4>(lds, acc, (const unsigned char*)(HB + (size_t)mbg * 256 * FF), aoff, (const unsigned char*)(W + ((size_t)e * 1024 + pn * 256) * FF), boff, 5, true);
#pragma unroll
        for (int m = 0; m < 8; ++m) {
            const int r = wr * 128 + m * 16 + fr, slot = slotrow[r];
            if (slot >= 0) {
                const float w = wrow[r]; bf16_t* yp = Y + (size_t)slot * 1024 + pn * 256 + wc * 64 + fq * 4;
#pragma unroll
                for (int n = 0; n < 4; ++n) { const f32x4 v = acc[m][n] * w; u32x2 o; o.x = cvt_pk_bf16(v[0], v[1]); o.y = cvt_pk_bf16(v[2], v[3]); *(u32x2*)(yp + n * 16) = o; }
            }
        }
    }
}

__device__ __forceinline__ float logsigmoidf_(float x) { return fminf(x, 0.f) - log1pf(expf(-fabsf(x))); }

__device__ __forceinline__ void mlstm_unit(const Args& a, LAS unsigned char* lds, int l, int b, int h, int d) {
    const int tid = opaque_tid(), wid = __builtin_amdgcn_readfirstlane(tid >> 6), lane = tid & 63, fr = lane & 15, fq = lane >> 4;
    LAS bf16_t* Qi = (LAS bf16_t*)(lds);
    LAS bf16_t* Ki = (LAS bf16_t*)(lds + 26624);
    LAS bf16_t* Si = (LAS bf16_t*)(lds);
    LAS bf16_t* KT = (LAS bf16_t*)(lds + 53248);
    LAS bf16_t* VT = (LAS bf16_t*)(lds + 79360);
    LAS bf16_t* CT = (LAS bf16_t*)(lds + 109824);
    LAS float* colterm = (LAS float*)(lds + 133120);
    LAS float* Marr = colterm + 128;
    LAS float* bcarr = Marr + 128;
    const bf16_t* P = (const bf16_t*)(a.ws + WS_P); const float* GATES = (const float*)(a.ws + WS_GATES);
    float* MHS = (float*)(a.ws + WS_MHS) + (size_t)d * TOK * 384;
    const float bi = a.in[I_MGB][((l * 2 + d) * 2 + 0) * 4 + h], bfg = a.in[I_MGB][((l * 2 + d) * 2 + 1) * 4 + h];
    __syncthreads();
    for (int i = tid; i < 112 * 104; i += NTHREADS) CT[i] = 0;
    for (int i = tid; i < 16 * 136; i += NTHREADS) VT[96 * 136 + i] = (i < 136) ? (bf16_t)0x3F80 : (bf16_t)0;
    f32x4 Cst[7];
#pragma unroll
    for (int cb = 0; cb < 7; ++cb) Cst[cb] = (f32x4){0.f, 0.f, 0.f, 0.f};
    float m = 0.f;
    for (int step = 0; step < 18; ++step) {
        const bool isctx = step < 2; const int n = isctx ? step : step - 2, Tseg = isctx ? CTXL : SEQ, rowbase = isctx ? NLAT + b * CTXL : b * SEQ;
        const bool do_out = !isctx || l == 0;
        if (wid == 0) {
            const int p0 = 2 * lane, t0 = d ? Tseg - 1 - (n * 128 + p0) : n * 128 + p0, t1 = d ? t0 - 1 : t0 + 1;
            const float* g0 = GATES + (size_t)(rowbase + t0) * 16 + d * 8 + h; const float* g1 = GATES + (size_t)(rowbase + t1) * 16 + d * 8 + h;
            const float gi0 = g0[0] + bi, gi1 = g1[0] + bi, lf0 = logsigmoidf_(g0[4] + bfg), lf1 = logsigmoidf_(g1[4] + bfg);
            float s = lf0 + lf1;
#pragma unroll
            for (int o = 1; o < 64; o <<= 1) { const float t = __shfl_up(s, o); if (lane >= o) s += t; }
            const float bc1 = s, bc0 = s - lf1, ct0 = gi0 - bc0, ct1 = gi1 - bc1;
            float pm = fmaxf(ct0, ct1);
#pragma unroll
            for (int o = 1; o < 64; o <<= 1) { const float t = __shfl_up(pm, o); if (lane >= o) pm = fmaxf(pm, t); }
            float prev = __shfl_up(pm, 1); if (lane == 0) prev = -__builtin_huge_valf();
            const float pm0 = fmaxf(prev, ct0);
            colterm[p0] = ct0; colterm[p0 + 1] = ct1; bcarr[p0] = bc0; bcarr[p0 + 1] = bc1; Marr[p0] = fmaxf(m, pm0); Marr[p0 + 1] = fmaxf(m, pm);
        }
        __syncthreads();
        const float Mend = Marr[127], gsum = bcarr[127];
#pragma unroll
        for (int i = 0; i < 9; ++i) {
            const int rem = tid + 512 * (i % 3), p = rem / 12, ch = rem - p * 12;
            const int tok = d ? Tseg - 1 - (n * 128 + p) : n * 128 + p;
            const u32x4 v = *(const u32x4*)(P + (size_t)(rowbase + tok) * PW + PC_Q + (i / 3) * 384 + h * 96 + ch * 8);
            if (i < 3) *(LAS u32x4*)(Qi + p * 104 + ch * 8) = v;
            else if (i < 6) {
                *(LAS u32x4*)(Ki + p * 104 + ch * 8) = v;
                const float w = expf(colterm[p] - Mend);
                const unsigned vv[4] = {v.x, v.y, v.z, v.w};
#pragma unroll
                for (int j = 0; j < 4; ++j) { KT[(ch * 8 + 2 * j) * 136 + p] = f2bf(__uint_as_float(vv[j] << 16) * w); KT[(ch * 8 + 2 * j + 1) * 136 + p] = f2bf(__uint_as_float(vv[j] & 0xffff0000u) * w); }
            } else {
                const unsigned vv[4] = {v.x, v.y, v.z, v.w};
#pragma unroll
                for (int j = 0; j < 4; ++j) { VT[(ch * 8 + 2 * j) * 136 + p] = (bf16_t)(vv[j] & 0xffffu); VT[(ch * 8 + 2 * j + 1) * 136 + p] = (bf16_t)(vv[j] >> 16); }
            }
        }
        __syncthreads();
        f32x4 num[7], sacc[8];
        const int t = wid * 16 + fr; const float Mt = Marr[t];
        if (do_out) {
#pragma unroll
            for (int cb = 0; cb < 7; ++cb) num[cb] = (f32x4){0.f, 0.f, 0.f, 0.f};
#pragma unroll
            for (int ks = 0; ks < 3; ++ks) {
                const bf16x8 bq = ldfrag(Qi, 104, wid * 16, ks * 32, fr, fq);
#pragma unroll
                for (int cb = 0; cb < 7; ++cb) num[cb] = MFMA(ldfrag(CT, 104, cb * 16, ks * 32, fr, fq), bq, num[cb]);
#pragma unroll
                for (int sb = 0; sb < 8; ++sb) if (sb <= wid) { if (ks == 0) sacc[sb] = (f32x4){0.f, 0.f, 0.f, 0.f}; sacc[sb] = MFMA(ldfrag(Ki, 104, sb * 16, ks * 32, fr, fq), bq, sacc[sb]); }
            }
            const float ei = expf(m - Mt);
#pragma unroll
            for (int cb = 0; cb < 7; ++cb) num[cb] = num[cb] * ei;
        }
        __syncthreads();
        if (do_out) {
#pragma unroll
            for (int sb = 0; sb < 8; ++sb) {
                u32x2 w; w.x = 0u; w.y = 0u;
                if (sb <= wid) {
                    const f32x4 ct = *(const LAS f32x4*)(colterm + sb * 16 + fq * 4); float e[4];
#pragma unroll
                    for (int j = 0; j < 4; ++j) { const int s = sb * 16 + fq * 4 + j; e[j] = (s <= t) ? sacc[sb][j] * expf(ct[j] - Mt) : 0.f; }
                    w.x = cvt_pk_bf16(e[0], e[1]); w.y = cvt_pk_bf16(e[2], e[3]);
                }
                *(LAS u32x2*)(Si + t * 136 + sb * 16 + fq * 4) = w;
            }
        }
        __syncthreads();
        if (do_out) {
#pragma unroll
            for (int ks = 0; ks < 4; ++ks) {
                const bf16x8 bs = ldfrag(Si, 136, wid * 16, ks * 32, fr, fq);
#pragma unroll
                for (int cb = 0; cb < 7; ++cb) num[cb] = MFMA(ldfrag(VT, 136, cb * 16, ks * 32, fr, fq), bs, num[cb]);
            }
            const float den = __shfl(num[6][0], fr);
            const float inv = 1.0f / fmaxf(fabsf(den), expf(-(bcarr[t] + Mt)));
            const int tok = d ? Tseg - 1 - (n * 128 + t) : n * 128 + t;
            float* op = MHS + (size_t)(rowbase + tok) * 384 + h * 96 + fq * 4;
#pragma unroll
            for (int cb = 0; cb < 6; ++cb) *(f32x4*)(op + cb * 16) = num[cb] * inv;
        }
        const float decay = expf(m - Mend);
        if (wid < 6) {
#pragma unroll
            for (int cb = 0; cb < 7; ++cb) Cst[cb] = Cst[cb] * decay;
#pragma unroll
            for (int ks = 0; ks < 4; ++ks) {
                const bf16x8 bk = ldfrag(KT, 136, wid * 16, ks * 32, fr, fq);
#pragma unroll
                for (int cb = 0; cb < 7; ++cb) Cst[cb] = MFMA(ldfrag(VT, 136, cb * 16, ks * 32, fr, fq), bk, Cst[cb]);
            }
#pragma unroll
            for (int cb = 0; cb < 7; ++cb)
#pragma unroll
                for (int j = 0; j < 4; ++j) CT[(cb * 16 + fq * 4 + j) * 104 + wid * 16 + fr] = f2bf(Cst[cb][j]);
        }
        m = gsum + Mend;
        __syncthreads();
    }
}

__device__ __forceinline__ void rglru_unit(const Args& a, LAS unsigned char* lds, int l, int b, int hd, int d) {
    const int tid = opaque_tid(), wid = __builtin_amdgcn_readfirstlane(tid >> 6), lane = tid & 63, fr = lane & 15, fq = lane >> 4;
    LAS float* zf = (LAS float*)lds;
    LAS bf16_t* zi = (LAS bf16_t*)(lds + 32768);
    LAS bf16_t* Wi = (LAS bf16_t*)(lds + 51200);
    LAS float* aa = (LAS float*)(lds + 69632);
    LAS float* uu = (LAS float*)(lds + 102400);
    LAS float* segA = (LAS float*)(lds + 135168);
    LAS float* segU = segA + 512;
    LAS float* hc = segU + 512;
    LAS float* cst = hc + 128;
    const bf16_t* P = (const bf16_t*)(a.ws + WS_P); float* RGY = (float*)(a.ws + WS_RGY) + (size_t)d * TOK * 384;
    __syncthreads();
    { const float* gw = a.in[I_RGGW] + (size_t)(l * 2 + d) * 2 * 6 * 4096;
      for (int idx = tid; idx < 8192; idx += NTHREADS) { const int g = idx >> 12, i = (idx >> 6) & 63, j = idx & 63; Wi[(g * 64 + j) * 72 + i] = f2bf(gw[((size_t)(g * 6 + hd) * 64 + i) * 64 + j]); } }
    if (tid < 64) { cst[tid] = a.in[I_RGGB][((l * 2 + d) * 2 + 0) * 384 + hd * 64 + tid]; cst[64 + tid] = a.in[I_RGGB][((l * 2 + d) * 2 + 1) * 384 + hd * 64 + tid];
                    cst[128 + tid] = log1pf(expf(-a.in[I_RGLAM][(l * 2 + d) * 384 + hd * 64 + tid])); hc[tid] = 0.f; }
    const int c = lane, ch = hd * 64 + c;
    const float cw0 = a.in[I_RGCW][(l * 4 + 0) * 384 + ch], cw1 = a.in[I_RGCW][(l * 4 + 1) * 384 + ch], cw2 = a.in[I_RGCW][(l * 4 + 2) * 384 + ch], cw3 = a.in[I_RGCW][(l * 4 + 3) * 384 + ch], cbias = a.in[I_RGCB][l * 384 + ch];
    __syncthreads();
    for (int step = 0; step < 18; ++step) {
        const bool isctx = step < 2; const int n = isctx ? step : step - 2, Tseg = isctx ? CTXL : SEQ, rowbase = isctx ? NLAT + b * CTXL : b * SEQ;
        const int base = d ? Tseg - 128 * (n + 1) : 128 * n;
        const bool do_out = !isctx || l == 0;
        {
            const int tl0 = wid * 16; float xm2, xm1, x0, xp1;
            const bf16_t* pp = P + (size_t)rowbase * PW + PC_RX + ch;
#define RG_LD(pos) (((pos) >= 0 && (pos) < Tseg) ? bf2f(pp[(size_t)(pos) * PW]) : 0.f)
            xm2 = RG_LD(base + tl0 - 2); xm1 = RG_LD(base + tl0 - 1); x0 = RG_LD(base + tl0);
#pragma unroll
            for (int i = 0; i < 16; ++i) {
                xp1 = RG_LD(base + tl0 + i + 1);
                const float z = cw0 * xm2 + cw1 * xm1 + cw2 * x0 + cw3 * xp1 + cbias;
                zf[(tl0 + i) * 64 + c] = z; zi[(tl0 + i) * 72 + c] = f2bf(z);
                xm2 = xm1; xm1 = x0; x0 = xp1;
            }
        }
        __syncthreads();
        {
            f32x4 acc[8];
#pragma unroll
            for (int nb = 0; nb < 8; ++nb) acc[nb] = (f32x4){0.f, 0.f, 0.f, 0.f};
#pragma unroll
            for (int ks = 0; ks < 2; ++ks) {
                const bf16x8 bz = ldfrag(zi, 72, wid * 16, ks * 32, fr, fq);
#pragma unroll
                for (int nb = 0; nb < 8; ++nb) acc[nb] = MFMA(ldfrag(Wi, 72, nb * 16, ks * 32, fr, fq), bz, acc[nb]);
            }
            const int tl = wid * 16 + fr, p = d ? 127 - tl : tl;
#pragma unroll
            for (int nb = 0; nb < 4; ++nb) {
                const int j0 = nb * 16 + fq * 4;
                const f32x4 z4 = *(const LAS f32x4*)(zf + tl * 64 + j0), br = *(const LAS f32x4*)(cst + j0), bi4 = *(const LAS f32x4*)(cst + 64 + j0), sp = *(const LAS f32x4*)(cst + 128 + j0);
                f32x4 av, uv;
#pragma unroll
                for (int j = 0; j < 4; ++j) {
                    const float rg = sigmoidf_(acc[nb][j] + br[j]), ig = sigmoidf_(acc[nb + 4][j] + bi4[j]);
                    const float la = -8.0f * rg * sp[j];
                    av[j] = expf(la); uv[j] = sqrtf(fmaxf(-expm1f(2.0f * la), 0.f)) * ig * z4[j];
                }
                *(LAS f32x4*)(aa + p * 64 + j0) = av; *(LAS f32x4*)(uu + p * 64 + j0) = uv;
            }
        }
        __syncthreads();
        {
            float A = 1.f, U = 0.f;
#pragma unroll
            for (int i = 0; i < 16; ++i) { const float av = aa[(wid * 16 + i) * 64 + c], uv = uu[(wid * 16 + i) * 64 + c]; U = av * U + uv; A *= av; }
            segA[wid * 64 + c] = A; segU[wid * 64 + c] = U;
        }
        __syncthreads();
        {
            float hv = hc[(step & 1) * 64 + c];
            for (int s2 = 0; s2 < wid; ++s2) hv = segA[s2 * 64 + c] * hv + segU[s2 * 64 + c];
#pragma unroll
            for (int i = 0; i < 16; ++i) {
                const int p = wid * 16 + i; hv = aa[p * 64 + c] * hv + uu[p * 64 + c];
                if (do_out) { const int tl = d ? 127 - p : p; RGY[(size_t)(rowbase + base + tl) * 384 + ch] = hv; }
            }
            if (wid == 7) hc[((step + 1) & 1) * 64 + c] = hv;
        }
    }
    __syncthreads();
}

__device__ __forceinline__ void gmlp_unit(const Args& a, LAS unsigned char* lds, int l, int chunk) {
    const int tid = opaque_tid(), wid = __builtin_amdgcn_readfirstlane(tid >> 6), lane = tid & 63, fr = lane & 15, fq = lane >> 4;
    LAS bf16_t* vT = (LAS bf16_t*)lds;
    const bf16_t* P = (const bf16_t*)(a.ws + WS_P); bf16_t* MIX = (bf16_t*)(a.ws + WS_MIX);
    const int row0 = chunk * 128;
    __syncthreads();
    {
        const f32x4 g = *(const f32x4*)(a.in[I_CMNG] + l * 256 + lane * 4);
        for (int i = 0; i < 16; ++i) {
            const int s = wid * 16 + i;
            const u32x2 w = *(const u32x2*)(P + (size_t)(row0 + s) * PW + PC_CV + lane * 4);
            const float v0 = __uint_as_float(w.x << 16), v1 = __uint_as_float(w.x & 0xffff0000u), v2 = __uint_as_float(w.y << 16), v3 = __uint_as_float(w.y & 0xffff0000u);
            const float ss = wave_sum(v0 * v0 + v1 * v1 + v2 * v2 + v3 * v3);
            const float rstd = rsqrtf(ss * (1.0f / 256.0f) + EPS);
            vT[(lane * 4 + 0) * 136 + s] = f2bf(v0 * rstd * g[0]); vT[(lane * 4 + 1) * 136 + s] = f2bf(v1 * rstd * g[1]);
            vT[(lane * 4 + 2) * 136 + s] = f2bf(v2 * rstd * g[2]); vT[(lane * 4 + 3) * 136 + s] = f2bf(v3 * rstd * g[3]);
        }
    }
    __syncthreads();
    const int g = wid >> 1, th = wid & 1;
    const float* ws = a.in[I_CMW] + ((size_t)(l * 4 + g) * 128) * 128;
    f32x4 acc[4][4];
#pragma unroll
    for (int m = 0; m < 4; ++m)
#pragma unroll
        for (int n = 0; n < 4; ++n) acc[m][n] = (f32x4){0.f, 0.f, 0.f, 0.f};
#pragma unroll
    for (int ks = 0; ks < 4; ++ks) {
        bf16x8 bw[4];
#pragma unroll
        for (int m = 0; m < 4; ++m) {
            const float* wp = ws + (size_t)(th * 64 + m * 16 + fr) * 128 + ks * 32 + fq * 8;
            const f32x4 w0 = *(const f32x4*)wp, w1 = *(const f32x4*)(wp + 4);
            u32x4 pk; pk.x = cvt_pk_bf16(w0[0], w0[1]); pk.y = cvt_pk_bf16(w0[2], w0[3]); pk.z = cvt_pk_bf16(w1[0], w1[1]); pk.w = cvt_pk_bf16(w1[2], w1[3]);
            bw[m] = __builtin_bit_cast(bf16x8, pk);
        }
#pragma unroll
        for (int n = 0; n < 4; ++n) {
            const bf16x8 av = ldfrag(vT, 136, g * 64 + n * 16, ks * 32, fr, fq);
#pragma unroll
            for (int m = 0; m < 4; ++m) acc[m][n] = MFMA(av, bw[m], acc[m][n]);
        }
    }
#pragma unroll
    for (int m = 0; m < 4; ++m) {
        const int t = th * 64 + m * 16 + fr; const float bsv = a.in[I_CMB][(l * 4 + g) * 128 + t];
#pragma unroll
        for (int n = 0; n < 4; ++n) {
            const int cc = g * 64 + n * 16 + fq * 4;
            const u32x2 uw = *(const u32x2*)(P + (size_t)(row0 + t) * PW + PC_CU + cc);
            const float u0 = __uint_as_float(uw.x << 16), u1 = __uint_as_float(uw.x & 0xffff0000u), u2 = __uint_as_float(uw.y << 16), u3 = __uint_as_float(uw.y & 0xffff0000u);
            u32x2 o; o.x = cvt_pk_bf16(u0 * (acc[m][n][0] + bsv), u1 * (acc[m][n][1] + bsv)); o.y = cvt_pk_bf16(u2 * (acc[m][n][2] + bsv), u3 * (acc[m][n][3] + bsv));
            *(u32x2*)(MIX + (size_t)(row0 + t) * 1024 + 768 + cc) = o;
        }
    }
}

__device__ __forceinline__ void phase_mx(const Args& a, LAS unsigned char* lds, int l) {
    unsigned* q = (unsigned*)(a.ws + WS_CTL + CTL_QUEUE) + l * 256;
    LAS int* qv = (LAS int*)(lds + LDS_BARW - 16);
    const int tid = opaque_tid();
#define MX_NEXT(head) ({ __syncthreads(); if (tid == 0) *qv = (int)atomicAdd(q + (head) * 64, 1u); __syncthreads(); *qv; })
#ifndef MXSEL
#define MXSEL 7
#endif
    if (MXSEL & 1) for (;;) { const int u = MX_NEXT(0); if (u >= 128) break; mlstm_unit(a, lds, l, u >> 3, (u >> 1) & 3, u & 1); }
    if (MXSEL & 2) for (;;) { const int u = MX_NEXT(1); if (u >= 192) break; rglru_unit(a, lds, l, u / 12, (u >> 1) % 6, u & 1); }
    const int ngm = (l == 0 ? TOK : NLAT) / 128;
    if (MXSEL & 4) for (;;) { const int u = MX_NEXT(2); if (u >= ngm) break; gmlp_unit(a, lds, l, u); }
#undef MX_NEXT
}

__device__ __forceinline__ void phase_mr(const Args& a, int l, int T) {
    const int tid = opaque_tid(), wid = tid >> 6, lane = tid & 63;
    const bf16_t* P = (const bf16_t*)(a.ws + WS_P); bf16_t* MIX = (bf16_t*)(a.ws + WS_MIX);
    const float* MH0 = (const float*)(a.ws + WS_MHS); const float* MH1 = MH0 + (size_t)TOK * 384;
    const float* RG0 = (const float*)(a.ws + WS_RGY); const float* RG1 = RG0 + (size_t)TOK * 384;
    const int c0 = lane * 6;
    float ng[6];
#pragma unroll
    for (int j = 0; j < 6; ++j) ng[j] = a.in[I_MNG][l * 384 + c0 + j];
    for (int row = blockIdx.x * 8 + wid; row < T; row += gridDim.x * 8) {
        const size_t o = (size_t)row * 384 + c0; const bf16_t* pr = P + (size_t)row * PW;
        float hs[6], y[6], ss = 0.f;
#pragma unroll
        for (int j = 0; j < 6; j += 2) { const f32x2 x0 = *(const f32x2*)(MH0 + o + j), x1 = *(const f32x2*)(MH1 + o + j), r0 = *(const f32x2*)(RG0 + o + j), r1 = *(const f32x2*)(RG1 + o + j);
            hs[j] = x0[0] + x1[0]; hs[j + 1] = x0[1] + x1[1]; y[j] = r0[0] + r1[0]; y[j + 1] = r0[1] + r1[1]; }
#pragma unroll
        for (int j = 0; j < 6; ++j) ss += hs[j] * hs[j];
        ss += __shfl_xor(ss, 1); ss += __shfl_xor(ss, 2); ss += __shfl_xor(ss, 4); ss += __shfl_xor(ss, 8);
        const float rstd = rsqrtf(ss * (1.0f / 96.0f) + EPS);
        unsigned om[3], og[3];
#pragma unroll
        for (int j = 0; j < 6; j += 2) {
            const unsigned ow = *(const unsigned*)(pr + PC_O + c0 + j), gw = *(const unsigned*)(pr + PC_RG + c0 + j);
            const float o0 = __uint_as_float(ow << 16), o1 = __uint_as_float(ow & 0xffff0000u), g0 = __uint_as_float(gw << 16), g1 = __uint_as_float(gw & 0xffff0000u);
            om[j >> 1] = cvt_pk_bf16(sigmoidf_(o0) * hs[j] * rstd * ng[j], sigmoidf_(o1) * hs[j + 1] * rstd * ng[j + 1]);
            og[j >> 1] = cvt_pk_bf16(g0 * y[j], g1 * y[j + 1]);
        }
        unsigned* mo = (unsigned*)(MIX + (size_t)row * 1024 + 384 + c0); unsigned* go = (unsigned*)(MIX + (size_t)row * 1024 + c0);
        mo[0] = om[0]; mo[1] = om[1]; mo[2] = om[2]; go[0] = og[0]; go[1] = og[1]; go[2] = og[2];
    }
}

constexpr int N_PHASES = 22;
__global__ void __launch_bounds__(NTHREADS, 2) fwd_kernel(Args a) {
    extern __shared__ __attribute__((aligned(16))) unsigned char lds_raw[];
    LAS unsigned char* lds = (LAS unsigned char*)lds_raw;
    const int lo = a.ph_lo, hi = a.ph_hi;
    XcdBarrier bar; bar.bar = (unsigned*)(a.ws + WS_CTL); bar.x = 0; bar.st = (volatile LAS unsigned*)(lds + LDS_BARW);
    if (hi - lo > 1) {
        if (threadIdx.x == 0) { *(LAS u32x4*)(lds + LDS_BARW) = (u32x4){0u, 0u, 0u, 0u}; }
        __syncthreads();
        bar = xcd_barrier_post((unsigned*)(a.ws + WS_CTL), (volatile LAS unsigned*)(lds + LDS_BARW));
    }
#ifndef PHSEL
#define PHSEL 0xFFF
#endif
#define SELJ(j) (((PHSEL) >> (j)) & 1)
#define IN(k) (lo <= (k) && (k) < hi)
#define SEAM(k) do { if (IN(k) && IN((k) + 1)) xcd_barrier(bar); } while (0)
    if (SELJ(10) && IN(0)) { p0_mod(a, lds); p0_conv(a, lds); }
    SEAM(0);
    for (int l = 0; l < 2; ++l) {
        const int pb = 1 + 10 * l, T = (l == 0) ? TOK : NLAT;
        if (SELJ(0) && IN(pb + 0)) phase_n1(a, l);
        SEAM(pb + 0);
        if (SELJ(1) && IN(pb + 1)) phase_g1(a, lds, l);
        SEAM(pb + 1);
        if (SELJ(2) && IN(pb + 2)) phase_mx(a, lds, l);
        SEAM(pb + 2);
        if (SELJ(3) && IN(pb + 3)) phase_mr(a, l, T);
        SEAM(pb + 3);
        if (SELJ(4) && IN(pb + 4)) phase_g2(a, lds, l, T);
        SEAM(pb + 4);
        if (SELJ(5) && IN(pb + 5)) phase_n2(a, l, T);
        SEAM(pb + 5);
        if (SELJ(6) && IN(pb + 6)) phase_rt(a, lds, l, T);
        SEAM(pb + 6);
        if (SELJ(7) && IN(pb + 7)) phase_tk(a, l, T);
        SEAM(pb + 7);
        if (SELJ(8) && IN(pb + 8)) phase_e1(a, lds, l, T);
        SEAM(pb + 8);
        if (SELJ(9) && IN(pb + 9)) phase_e2(a, lds, l, T);
        SEAM(pb + 9);
    }
    if (SELJ(11) && IN(21)) phase_fin(a);
#undef IN
#undef SEAM
}

extern "C" void kernel_launch(void* const* d_in, const int* in_sizes, int n_in, void* d_out, int out_size, void* d_ws, size_t ws_size, hipStream_t stream) {
    static int grid = 0;
    if (grid == 0) {
        if (n_in != 29 || out_size != NLAT * D || ws_size < WS_END) { fprintf(stderr, "kernel_launch: unexpected shapes (n_in %d, out %d, ws %zu, need %zu)\n", n_in, out_size, ws_size, (size_t)WS_END); grid = -1; return; }
        int dev = 0, cus = 0, per_cu = 0;
        if (hipGetDevice(&dev) != hipSuccess || hipDeviceGetAttribute(&cus, hipDeviceAttributeMultiprocessorCount, dev) != hipSuccess) { grid = -1; return; }
        if (hipFuncSetAttribute((const void*)fwd_kernel, hipFuncAttributeMaxDynamicSharedMemorySize, LDS_BYTES) != hipSuccess) { fprintf(stderr, "kernel_launch: hipFuncSetAttribute failed\n"); grid = -1; return; }
        if (hipOccupancyMaxActiveBlocksPerMultiprocessor(&per_cu, (const void*)fwd_kernel, NTHREADS, LDS_BYTES) != hipSuccess || per_cu < 1) { fprintf(stderr, "kernel_launch: occupancy query says %d\n", per_cu); (void)hipGetLastError(); grid = -1; return; }
        grid = cus;
    }
    if (grid < 0) return;
    (void)hipMemsetAsync((char*)d_ws + WS_CTL, 0, CTL_BYTES, stream);
    Args a{};
    for (int i = 0; i < 29; ++i) a.in[i] = (const float*)d_in[i];
    a.out = (float*)d_out; a.ws = (unsigned char*)d_ws;
#if MK_PER_PHASE
    for (int p = 0; p < N_PHASES; ++p) { a.ph_lo = p; a.ph_hi = p + 1; hipLaunchKernelGGL(fwd_kernel, dim3(grid), dim3(NTHREADS), LDS_BYTES, stream, a); }
#else
    a.ph_lo = 0; a.ph_hi = N_PHASES;
    hipLaunchKernelGGL(fwd_kernel, dim3(grid), dim3(NTHREADS), LDS_BYTES, stream, a);
#endif
}
```

```cpp
#include <hip/hip_runtime.h>
#include <cstdio>
#include <cstdint>

#ifndef MK_PER_PHASE
#define MK_PER_PHASE 0
#endif

#define LAS __attribute__((address_space(3)))
typedef unsigned short bf16_t;
typedef short bf16x8 __attribute__((ext_vector_type(8)));
typedef float f32x4 __attribute__((ext_vector_type(4)));
typedef float f32x2 __attribute__((ext_vector_type(2)));
typedef unsigned u32x4 __attribute__((ext_vector_type(4)));
typedef unsigned u32x2 __attribute__((ext_vector_type(2)));

constexpr int D = 1024, NBATCH = 16, SEQ = 2048, CTXL = 256;
constexpr int NLAT = NBATCH * SEQ, NCTX = NBATCH * CTXL, TOK = NLAT + NCTX;
constexpr int DIN = 2832, PW = 2816, NIN = 3072;
constexpr int NE = 256, FF = 288, NSLOT = 9, LCAP = TOK;
constexpr int NTHREADS = 512;
constexpr int LDS_BYTES = 147456;
constexpr int LDS_TAB = 139264;
constexpr int LDS_BARW = LDS_BYTES - 16;
constexpr float EPS = 1e-6f;

constexpr int PC_RX = 0, PC_RG = 384, PC_Q = 768, PC_K = 1152, PC_V = 1536, PC_O = 1920, PC_CU = 2304, PC_CV = 2560;

constexpr size_t WS_CTL = 0, CTL_BYTES = 131072;
constexpr size_t CTL_QUEUE = 16384, CTL_CNT = 32768;
constexpr int CNT_STRIDE = 32;
constexpr size_t WS_MOD = 131072;
constexpr size_t WS_X = WS_MOD + 1048576;
constexpr size_t WS_XA = WS_X + (size_t)TOK * D * 4;
constexpr size_t WS_R1 = WS_XA + (size_t)TOK * D * 2;
constexpr size_t R1_BYTES = (size_t)TOK * NSLOT * D * 2;
constexpr size_t WS_P = WS_R1;
constexpr size_t WS_MIX = WS_P + (size_t)TOK * PW * 2;
constexpr size_t WS_CTG = WS_MIX + (size_t)TOK * D * 2;
constexpr size_t WS_MST = WS_CTG + (size_t)128 * 18 * 112 * 96 * 2;
constexpr size_t WS_RGAGG = WS_MST + 16384;
constexpr size_t WS_RGPF = WS_RGAGG + (size_t)192 * 18 * 128 * 4;
static_assert(WS_RGPF + (size_t)TOK * 384 * 4 * 2 <= WS_R1 + R1_BYTES, "aliases");
constexpr int HB_ROWS = (TOK * 8 / 256 + 256 + TOK / 256) * 256;
constexpr size_t WS_HB = WS_R1 + R1_BYTES;
constexpr size_t WS_GATES = WS_HB + (size_t)HB_ROWS * FF * 2 + 256;
constexpr size_t WS_LOGITS = WS_GATES + (size_t)TOK * 16 * 4;
constexpr size_t WS_LSLOT = WS_LOGITS + (size_t)TOK * 256 * 4;
constexpr size_t WS_LW = WS_LSLOT + (size_t)NE * LCAP * 4;
constexpr size_t WS_WIN = WS_LW + (size_t)NE * LCAP * 4;
constexpr size_t WS_WOUT = WS_WIN + (size_t)2 * NIN * D * 2;
constexpr size_t WS_ROUT = WS_WOUT + (size_t)2 * D * D * 2;
constexpr size_t WS_RGWT = WS_ROUT + (size_t)2 * NE * D * 2;
constexpr size_t WS_END = WS_RGWT + (size_t)2 * 2 * 6 * 128 * 64 * 2;

__device__ __forceinline__ float bf2f(bf16_t b) { return __uint_as_float(((unsigned)b) << 16); }
__device__ __forceinline__ unsigned cvt_pk_bf16(float lo, float hi) { unsigned r; asm volatile("v_cvt_pk_bf16_f32 %0, %1, %2" : "=v"(r) : "v"(lo), "v"(hi)); return r; }
__device__ __forceinline__ bf16_t f2bf(float f) { return (bf16_t)(cvt_pk_bf16(f, 0.f) & 0xffffu); }
__device__ __forceinline__ float sigmoidf_(float x) { return __builtin_amdgcn_rcpf(1.0f + __expf(-x)); }
__device__ __forceinline__ float siluf_(float x) { return x * __builtin_amdgcn_rcpf(1.0f + __expf(-x)); }
__device__ __forceinline__ float gelu_tanh(float x) { const float u = 1.5957691216057308f * (x + 0.044715f * x * x * x); return x * __builtin_amdgcn_rcpf(1.0f + __expf(-u)); }
__device__ __forceinline__ float wave_sum(float v) {
#pragma unroll
    for (int o = 32; o >= 1; o >>= 1) v += __shfl_xor(v, o);
    return v;
}
__device__ __forceinline__ int opaque_tid() { int t = threadIdx.x; asm volatile("" : "+v"(t)); return t; }
#define WAIT_VM0() asm volatile("s_waitcnt vmcnt(0)" ::: "memory")

#define XB_TMO      128
#define XB_XCNT(j)  (256  + 64 * (j))
#define XB_XSUB(j)  (1280 + 64 * (j))
#define XB_XGEN(j)  (2304 + 64 * (j))
#define XB_TOP      3328
#define XB_TOPGEN   3392
#define XCD_BAR_WORDS 3456
#define XB_SPIN_CAP (1u << 18)

__device__ __forceinline__ unsigned xb_ld(unsigned* p)              { return __hip_atomic_load(p, __ATOMIC_RELAXED, __HIP_MEMORY_SCOPE_AGENT); }
__device__ __forceinline__ unsigned xb_add(unsigned* p, unsigned v) { return __hip_atomic_fetch_add(p, v, __ATOMIC_RELAXED, __HIP_MEMORY_SCOPE_AGENT); }
__device__ __forceinline__ unsigned xb_xcc_id() { return (unsigned)__builtin_amdgcn_s_getreg((3 << 11) | 20) & 0xFu; }
#define XB_SPIN(cond, bar) do { unsigned _sp = 0; while (cond) { __builtin_amdgcn_s_sleep(1); \
    if ((++_sp & 255u) == 0u) { if (xb_ld(&(bar)[XB_TMO])) break; if (_sp > XB_SPIN_CAP) { atomicAdd(&(bar)[XB_TMO], 1u); break; } } } } while (0)

struct XcdBarrier { unsigned* bar; unsigned x; volatile LAS unsigned* st; };

__device__ __forceinline__ XcdBarrier xcd_barrier_post(unsigned* bar, volatile LAS unsigned* st) {
    XcdBarrier b; b.bar = bar; b.x = xb_xcc_id(); b.st = st;
    if (threadIdx.x == 0) (void)xb_add(&bar[XB_XCNT(b.x)], 1u);
    return b;
}
__device__ __forceinline__ void xcd_barrier_complete(unsigned* bar, unsigned x, unsigned& nloc, unsigned& nx) {
    const unsigned G = gridDim.x * gridDim.y * gridDim.z;
    unsigned sum, cnt, mine, sp = 0u;
    for (;;) {
        sum = 0u; cnt = 0u; mine = 0u;
#pragma unroll
        for (unsigned j = 0; j < 16; ++j) { const unsigned c = xb_ld(&bar[XB_XCNT(j)]); sum += c; cnt += (c > 0u) ? 1u : 0u; mine = (j == x) ? c : mine; }
        if (sum == G) break;
        __builtin_amdgcn_s_sleep(1);
        if ((++sp & 255u) == 0u) { if (xb_ld(&bar[XB_TMO])) break; if (sp > XB_SPIN_CAP) { atomicAdd(&bar[XB_TMO], 1u); break; } }
    }
    nloc = mine > 0u ? mine : 1u; nx = cnt > 0u ? cnt : 1u;
}
__device__ __forceinline__ void xcd_barrier(const XcdBarrier& b) {
    asm volatile("s_waitcnt vmcnt(0)" ::: "memory");
    __syncthreads();
    if (threadIdx.x == 0) {
        unsigned* bar = b.bar;
        __builtin_amdgcn_s_waitcnt(0);
        unsigned nloc = b.st[0], nx = b.st[1];
        if (nloc == 0u) { xcd_barrier_complete(bar, b.x, nloc, nx); b.st[0] = nloc; b.st[1] = nx; }
        const unsigned old = xb_add(&bar[XB_XSUB(b.x)], 1u);
        const unsigned gen = old / nloc;
        if (old + 1u == (gen + 1u) * nloc) {
            __builtin_amdgcn_fence(__ATOMIC_RELEASE, "agent");
            asm volatile("s_waitcnt vmcnt(0)" ::: "memory");
            const unsigned og = xb_add(&bar[XB_TOP], 1u);
            const unsigned tg = og / nx;
            if (og + 1u == (tg + 1u) * nx) xb_add(&bar[XB_TOPGEN], 1u);
            else XB_SPIN(xb_ld(&bar[XB_TOPGEN]) == tg, bar);
            __builtin_amdgcn_fence(__ATOMIC_ACQUIRE, "agent");
            xb_add(&bar[XB_XGEN(b.x)], 1u);
            asm volatile("s_waitcnt vmcnt(0)" ::: "memory");
        } else {
            XB_SPIN(xb_ld(&bar[XB_XGEN(b.x)]) == gen, bar);
            __builtin_amdgcn_fence(__ATOMIC_ACQUIRE, "agent");
            asm volatile("s_waitcnt vmcnt(0)" ::: "memory");
        }
    }
    __syncthreads();
}

struct Args { const float* in[29]; float* out; unsigned char* ws; int ph_lo, ph_hi; };
enum { I_X = 0, I_C, I_CTX, I_CCTX, I_N1G, I_N2G, I_WMOD, I_BMOD, I_WIN, I_RGCW, I_RGCB, I_RGGW, I_RGGB, I_RGLAM, I_MGB, I_MNG, I_CMNG, I_CMW, I_CMB,
       I_WOUT, I_RW, I_RB, I_EG, I_EU, I_ED, I_SG, I_SU, I_SD, I_FNG };

__device__ __forceinline__ int lds_byte(int r, int c) { const int st = (r >> 4) * 2 + (c >> 5), ob = (r & 15) * 64 + (c & 31) * 2; return st * 1024 + (ob ^ (((ob >> 9) & 1) << 5)); }
__device__ __forceinline__ void stage_rc(int b, int& R, int& C) { const int st = b >> 10, sb = b & 1023, swz = sb ^ (((sb >> 9) & 1) << 5); R = (st >> 1) * 16 + (swz >> 6); C = (st & 1) * 32 + ((swz & 63) >> 1); }

template <int BN, int WC> struct GT { static constexpr int WR = 8 / WC, MF = 256 / WR / 16, NF = BN / WC / 16, BP = BN / 64; };

typedef short s16x4 __attribute__((ext_vector_type(4)));
__device__ __forceinline__ bf16x8 trfrag(const LAS bf16_t* img, int pitch, int k0, int n0, int fr, int fq) {
    const LAS bf16_t* p = img + (k0 + 8 * fq + (fr >> 2)) * pitch + n0 + 4 * (fr & 3);
    const s16x4 lo = __builtin_amdgcn_ds_read_tr16_b64_v4i16((LAS s16x4*)p), hi = __builtin_amdgcn_ds_read_tr16_b64_v4i16((LAS s16x4*)(p + 4 * pitch));
    return __builtin_shufflevector(lo, hi, 0, 1, 2, 3, 4, 5, 6, 7);
}

constexpr int RS_SLOT = 34816, RS_BOFF = 16384;
struct RSeg { const unsigned char* Ab; unsigned aoff[2]; const float* B0; const float* B1; };
template <int BN, int WC, bool DUAL, bool GATHER, int NSET, class PV>
__device__ __forceinline__ void ring_gemm(LAS unsigned char* lds, PV& pv, const int ns, const int ldb, const unsigned ca0, const unsigned ca1) {
    constexpr int MF = GT<BN, WC>::MF, NF = GT<BN, WC>::NF, PITCH = BN == 192 ? 200 : 280, LPS = BN / 64, VPR = BN / 4;
    const int tid = opaque_tid(), wid = __builtin_amdgcn_readfirstlane(tid >> 6), lane = tid & 63, fr = lane & 15, fq = lane >> 4;
    const int wr = wid / WC, wc = wid % WC;
    const int obA = fr * 64 + fq * 16;
    const int aro = (wr * MF) * 1024 + (obA ^ (((obA >> 9) & 1) << 5));
    const unsigned ldsb = (unsigned)(size_t)lds + (unsigned)(RS_BOFF + ((8 * fq + (fr >> 2)) * PITCH + 4 * (fr & 3) + (DUAL ? wc * 48 : wc * (NF * 16))) * 2);
    constexpr int NTB = DUAL ? LPS : 1;
    unsigned bsoff_[NTB]; unsigned bdst_[NTB];
    bool bsel_[NTB];
#pragma unroll
    for (int i = 0; i < NTB; ++i) { const int e = tid + 512 * i, row = e / VPR, c4 = e % VPR; bsel_[i] = DUAL && c4 >= 24; bsoff_[i] = (unsigned)(row * ldb + 4 * (DUAL ? c4 % 24 : c4));
        bdst_[i] = (unsigned)(size_t)lds + (unsigned)(RS_BOFF + (row * PITCH + 4 * c4) * 2); }
#define bsoff(i) (DUAL ? bsoff_[DUAL ? (i) : 0] : bsoff_[0] + (unsigned)(8 * (i) * ldb))
#define bdst(i) (DUAL ? bdst_[DUAL ? (i) : 0] : bdst_[0] + (unsigned)(8 * (i) * PITCH * 2))
#define bsel(i) (DUAL ? bsel_[DUAL ? (i) : 0] : false)
    f32x4 acc[MF][NF];
#pragma unroll
    for (int m = 0; m < MF; ++m)
#pragma unroll
        for (int n = 0; n < NF; ++n) acc[m][n] = (f32x4){0.f, 0.f, 0.f, 0.f};
    RSeg ss, nx; int si = 0, sj = 0;
    bool have = pv.seg(0, ss); if (!have) return;
    pv.finish(ss, true);
    bool have_nx = pv.seg(1, nx);
    int staged = 0, g = 0, ci = 0, cj = 0;
    f32x4 r0[LPS], r1[NSET == 2 ? LPS : 1];
#define RS_STAGEA() do { _Pragma("unroll") for (int _i = 0; _i < 2; ++_i) __builtin_amdgcn_global_load_lds((const unsigned*)(ss.Ab + (GATHER ? ss.aoff[_i] : (_i ? ca1 : ca0)) + (size_t)sj * 64), (LAS unsigned*)(lds + (staged & 3) * RS_SLOT + (wid + 8 * _i) * 1024), 16, 0, 0); } while (0)
#define RS_LOADB(rr) do { _Pragma("unroll") for (int _i = 0; _i < LPS; ++_i) { const float* _p = (bsel(_i) ? ss.B1 : ss.B0) + bsoff(_i) + (size_t)(sj * 32) * ldb; \
        asm volatile("global_load_dwordx4 %0, %1, off" : "=&v"(rr[_i]) : "v"(_p)); } } while (0)
#define RS_WAITB(rr, steady) do { if (steady) { if (NSET == 1) asm volatile("s_waitcnt vmcnt(2)" ::: "memory"); else if (LPS == 3) asm volatile("s_waitcnt vmcnt(7)" ::: "memory"); else asm volatile("s_waitcnt vmcnt(8)" ::: "memory"); } else asm volatile("s_waitcnt vmcnt(0)" ::: "memory"); \
        __builtin_amdgcn_sched_barrier(0);        \
        if (LPS == 3) asm volatile("" : "+v"(rr[0]), "+v"(rr[1]), "+v"(rr[2])); else asm volatile("" : "+v"(rr[0]), "+v"(rr[1]), "+v"(rr[2]), "+v"(rr[LPS > 3 ? 3 : 0])); } while (0)
#define RS_WRITEB(rr, slot) do { _Pragma("unroll") for (int _i = 0; _i < LPS; ++_i) { u32x2 _w; _w.x = cvt_pk_bf16(rr[_i][0], rr[_i][1]); _w.y = cvt_pk_bf16(rr[_i][2], rr[_i][3]); \
        asm volatile("ds_write_b64 %0, %1" :: "v"(bdst(_i) + (unsigned)((slot) * RS_SLOT)), "v"(_w) : "memory"); } } while (0)
#define RS_ADVANCE() do { ++staged; if (++sj == ns) { sj = 0; ++si; if (have_nx) pv.finish(nx, false); ss = nx; have = have_nx; have_nx = have ? pv.seg(si + 1, nx) : false; } } while (0)
#define RS_TR(dst, slot, off) asm volatile("ds_read_b64_tr_b16 %0, %1 offset:%2" : "=v"(dst) : "v"(ldsb + (unsigned)((slot) * RS_SLOT)), "n"(off))
#define RS_KSTEP(slot) do { bf16x8 At[MF], Bf[NF]; s16x4 _lo[NF], _hi[NF]; \
        _Pragma("unroll") for (int n = 0; n < NF; ++n) { \
            if (DUAL) { if (n < 3) { RS_TR(_lo[n], slot, (16 * (n % 3)) * 2); RS_TR(_hi[n], slot, (16 * (n % 3) + 4 * PITCH) * 2); } else { RS_TR(_lo[n], slot, (96 + 16 * (n % 3)) * 2); RS_TR(_hi[n], slot, (96 + 16 * (n % 3) + 4 * PITCH) * 2); } } \
            else { RS_TR(_lo[n], slot, (16 * n) * 2); RS_TR(_hi[n], slot, (16 * n + 4 * PITCH) * 2); } } \
        _Pragma("unroll") for (int m = 0; m < MF; ++m) At[m] = *(const LAS bf16x8*)(lds + (slot) * RS_SLOT + aro + m * 1024); \
        if (NF == 6) asm volatile("s_waitcnt lgkmcnt(0)" : "+v"(_lo[0]), "+v"(_hi[0]), "+v"(_lo[1]), "+v"(_hi[1]), "+v"(_lo[2]), "+v"(_hi[2]), "+v"(_lo[3]), "+v"(_hi[3]), "+v"(_lo[NF > 4 ? 4 : 0]), "+v"(_hi[NF > 4 ? 4 : 0]), "+v"(_lo[NF > 5 ? 5 : 1]), "+v"(_hi[NF > 5 ? 5 : 1])); \
        else asm volatile("s_waitcnt lgkmcnt(0)" : "+v"(_lo[0]), "+v"(_hi[0]), "+v"(_lo[1]), "+v"(_hi[1]), "+v"(_lo[2]), "+v"(_hi[2]), "+v"(_lo[3]), "+v"(_hi[3])); \
        _Pragma("unroll") for (int n = 0; n < NF; ++n) Bf[n] = __builtin_shufflevector(_lo[n], _hi[n], 0, 1, 2, 3, 4, 5, 6, 7); \
        _Pragma("unroll") for (int m = 0; m < MF; ++m) _Pragma("unroll") for (int n = 0; n < NF; ++n) acc[m][n] = __builtin_amdgcn_mfma_f32_16x16x32_bf16(Bf[n], At[m], acc[m][n], 0, 0, 0); __builtin_amdgcn_sched_barrier(0); } while (0)
#define RS_BARRIER() do { asm volatile("s_waitcnt lgkmcnt(0)" ::: "memory"); __builtin_amdgcn_s_barrier(); asm volatile("" ::: "memory"); } while (0)
    if (NSET == 2) {
        RS_STAGEA(); RS_LOADB(r0); RS_WAITB(r0, false); RS_WRITEB(r0, 0); RS_ADVANCE();
        if (have) { RS_STAGEA(); RS_LOADB(r1); RS_ADVANCE(); }
        if (have) { RS_STAGEA(); RS_LOADB(r0); RS_ADVANCE(); }
    } else {
        RS_STAGEA(); RS_LOADB(r0); RS_WAITB(r0, false); RS_WRITEB(r0, 0); RS_ADVANCE();
        if (have) { RS_STAGEA(); RS_LOADB(r0); RS_ADVANCE(); }
    }
    WAIT_VM0(); RS_BARRIER();
#define RS_ITER(rw, STEADY) do { \
        const bool st = have; \
        if (st) RS_STAGEA(); \
        RS_KSTEP(g & 3); \
        if (++cj == ns) { pv.epi(ci, acc); _Pragma("unroll") for (int m = 0; m < MF; ++m) _Pragma("unroll") for (int n = 0; n < NF; ++n) acc[m][n] = (f32x4){0.f, 0.f, 0.f, 0.f}; cj = 0; ++ci; } \
        if (g + 1 < staged) { RS_WAITB(rw, STEADY); RS_WRITEB(rw, (g + 1) & 3); } \
        if (st) { RS_LOADB(rw); RS_ADVANCE(); } \
        st_prev = st; ++g; RS_BARRIER(); } while (0)
    bool st_prev = true;
    if (NSET == 2) {
        for (;;) {
            RS_ITER(r1, st && st_prev); if (g >= staged) break;
            RS_ITER(r0, st && st_prev); if (g >= staged) break;
        }
    } else {
        for (;;) { RS_ITER(r0, st); if (g >= staged) break; }
    }
    WAIT_VM0(); __syncthreads();
#undef RS_STAGEA
#undef RS_LOADB
#undef RS_WAITB
#undef RS_WRITEB
#undef RS_ADVANCE
#undef RS_TR
#undef RS_KSTEP
#undef RS_BARRIER
#undef RS_ITER
#undef bsoff
#undef bdst
#undef bsel
}

__device__ __forceinline__ bf16x8 ldfrag(const LAS bf16_t* img, int pitch, int row0, int k0, int fr, int fq) { return *(const LAS bf16x8*)(img + (row0 + fr) * pitch + k0 + fq * 8); }
#define MFMA(a, b, c) __builtin_amdgcn_mfma_f32_16x16x32_bf16(a, b, c, 0, 0, 0)

__device__ __forceinline__ void p0_mod(const Args& a, LAS unsigned char* lds) {
    { bf16_t* wt = (bf16_t*)(a.ws + WS_RGWT);
      for (int idx = blockIdx.x * NTHREADS + threadIdx.x; idx < 2 * 2 * 2 * 6 * 4096; idx += gridDim.x * NTHREADS) { const int j = idx & 63, i = (idx >> 6) & 63, hd = (idx >> 12) % 6, g = ((idx >> 12) / 6) & 1, ld = (idx >> 12) / 12;
          wt[((size_t)(ld * 6 + hd) * 128 + g * 64 + j) * 64 + i] = f2bf(a.in[I_RGGW][idx]); } }
    LAS float* sc = (LAS float*)lds;
    LAS float* red = (LAS float*)(lds + 69632);
    const int tid = opaque_tid();
    for (int i = tid; i < 17 * 1024; i += NTHREADS) { const int s = i >> 10, k = i & 1023; const float v = s < 16 ? a.in[I_C][s * 1024 + k] : a.in[I_CCTX][k]; sc[i] = siluf_(v); }
    __syncthreads();
    float* MOD = (float*)(a.ws + WS_MOD);
    for (int u = blockIdx.x; u < 192; u += gridDim.x) {
        const int l = u / 96, cb = (u % 96) * 64, col = tid & 63, ks = tid >> 6;
        const float* w = a.in[I_WMOD] + (size_t)l * 1024 * 6144 + cb + col;
        float acc[17];
#pragma unroll
        for (int s = 0; s < 17; ++s) acc[s] = 0.f;
#pragma unroll 4
        for (int k = ks * 128; k < ks * 128 + 128; ++k) {
            const float wv = w[(size_t)k * 6144];
#pragma unroll
            for (int s = 0; s < 17; ++s) acc[s] += sc[s * 1024 + k] * wv;
        }
#pragma unroll
        for (int s = 0; s < 17; ++s) red[(ks * 17 + s) * 64 + col] = acc[s];
        __syncthreads();
        for (int i = tid; i < 17 * 64; i += NTHREADS) {
            const int s = i >> 6, c = i & 63; float v = 0.f;
#pragma unroll
            for (int k2 = 0; k2 < 8; ++k2) v += red[(k2 * 17 + s) * 64 + c];
            MOD[((size_t)l * 17 + s) * 6144 + cb + c] = v + a.in[I_BMOD][l * 6144 + cb + c];
        }
        __syncthreads();
    }
}

template <int KT>
__device__ __forceinline__ void conv_tile(LAS float* tile, const float* p0, const float* p1, const float* p2, const float* p3, int ldn, int k0, bf16_t* dst, int K) {
    const int tid = opaque_tid(), r = tid >> 4, c4 = tid & 15, grp = c4 >> 2, within = (c4 & 3) * 4;
    const float* p = grp == 0 ? p0 : grp == 1 ? p1 : grp == 2 ? p2 : p3;
#pragma unroll
    for (int i = 0; i < KT / 32; ++i) {
        const int k = r + 32 * i; f32x4 v = (f32x4){0.f, 0.f, 0.f, 0.f};
        if (p) v = *(const f32x4*)(p + (size_t)(k0 + k) * ldn + within);
        tile[k * 65 + c4 * 4 + 0] = v[0]; tile[k * 65 + c4 * 4 + 1] = v[1]; tile[k * 65 + c4 * 4 + 2] = v[2]; tile[k * 65 + c4 * 4 + 3] = v[3];
    }
    __syncthreads();
    constexpr int CPR = KT / 16;
    const int row = tid / CPR, ch = tid % CPR;
    if (row < 64) {
        float v[16];
#pragma unroll
        for (int j = 0; j < 16; ++j) v[j] = tile[(ch * 16 + j) * 65 + row];
        u32x4 w0, w1;
        w0.x = cvt_pk_bf16(v[0], v[1]); w0.y = cvt_pk_bf16(v[2], v[3]); w0.z = cvt_pk_bf16(v[4], v[5]); w0.w = cvt_pk_bf16(v[6], v[7]);
        w1.x = cvt_pk_bf16(v[8], v[9]); w1.y = cvt_pk_bf16(v[10], v[11]); w1.z = cvt_pk_bf16(v[12], v[13]); w1.w = cvt_pk_bf16(v[14], v[15]);
        bf16_t* dp = dst + (size_t)row * K + k0 + ch * 16;
        *(u32x4*)dp = w0; *(u32x4*)(dp + 8) = w1;
    }
    __syncthreads();
}

constexpr int CV_WIN = 384, CV_WOUT = 128, CV_ROUT = 32, CV_LAYER = CV_WIN + CV_WOUT + CV_ROUT;
__device__ __forceinline__ void p0_conv(const Args& a, LAS unsigned char* lds) {
    LAS float* tile = (LAS float*)lds;
    for (int u = blockIdx.x; u < 2 * CV_LAYER; u += gridDim.x) {
        const int l = u / CV_LAYER; int j = u % CV_LAYER;
        if (j < CV_WIN) {
            const int rho0 = (j >> 3) * 64, kt = j & 7; const float* src = a.in[I_WIN] + (size_t)l * 1024 * DIN; const float* p[4];
#pragma unroll
            for (int g = 0; g < 4; ++g) { const int rho = rho0 + 16 * g; const int col = rho < 2304 ? rho : rho < 2816 ? rho + 16 : rho < 2832 ? rho - 512 : -1; p[g] = col >= 0 ? src + col : nullptr; }
            conv_tile<128>(tile, p[0], p[1], p[2], p[3], DIN, kt * 128, (bf16_t*)(a.ws + WS_WIN) + ((size_t)l * NIN + rho0) * 1024, 1024);
            continue;
        }
        j -= CV_WIN;
        if (j < CV_WOUT) {
            const int rho0 = (j >> 3) * 64, kt = j & 7; const float* src = a.in[I_WOUT] + (size_t)l * 1024 * 1024 + rho0;
            conv_tile<128>(tile, src, src + 16, src + 32, src + 48, 1024, kt * 128, (bf16_t*)(a.ws + WS_WOUT) + ((size_t)l * 1024 + rho0) * 1024, 1024);
            continue;
        }
        j -= CV_WOUT;
        if (j < CV_ROUT) {
            const int rho0 = (j >> 3) * 64, kt = j & 7; const float* src = a.in[I_RW] + (size_t)l * 1024 * 256 + rho0;
            conv_tile<128>(tile, src, src + 16, src + 32, src + 48, 256, kt * 128, (bf16_t*)(a.ws + WS_ROUT) + ((size_t)l * 256 + rho0) * 1024, 1024);
            continue;
        }
    }
}

__device__ __forceinline__ int sample_of(int row) { return row < NLAT ? (row >> 11) : 16; }

__device__ __forceinline__ void slot_sum(const bf16_t* Y, int row, int lane, f32x4 (&s)[4]) {
#pragma unroll
    for (int ii = 0; ii < 4; ++ii) s[ii] = (f32x4){0.f, 0.f, 0.f, 0.f};
#pragma unroll
    for (int k = 0; k < NSLOT; ++k) {
        const bf16_t* yp = Y + ((size_t)row * NSLOT + k) * 1024 + lane * 4;
#pragma unroll
        for (int ii = 0; ii < 4; ++ii) { const u32x2 w = *(const u32x2*)(yp + ii * 256); s[ii][0] += __uint_as_float(w.x << 16); s[ii][1] += __uint_as_float(w.x & 0xffff0000u); s[ii][2] += __uint_as_float(w.y << 16); s[ii][3] += __uint_as_float(w.y & 0xffff0000u); }
    }
}
__device__ __forceinline__ void norm_mod_store(const f32x4 (&v)[4], const float* g, const float* shift, const float* scale, bf16_t* dst, int lane) {
    float ss = 0.f;
#pragma unroll
    for (int ii = 0; ii < 4; ++ii) ss += v[ii][0] * v[ii][0] + v[ii][1] * v[ii][1] + v[ii][2] * v[ii][2] + v[ii][3] * v[ii][3];
    ss = wave_sum(ss);
    const float rstd = rsqrtf(ss * (1.0f / 1024.0f) + EPS);
#pragma unroll
    for (int ii = 0; ii < 4; ++ii) {
        const int c = ii * 256 + lane * 4;
        const f32x4 gg = *(const f32x4*)(g + c), sh = *(const f32x4*)(shift + c), sc = *(const f32x4*)(scale + c);
        f32x4 y;
#pragma unroll
        for (int j = 0; j < 4; ++j) y[j] = v[ii][j] * rstd * gg[j] * (1.0f + sc[j]) + sh[j];
        u32x2 w; w.x = cvt_pk_bf16(y[0], y[1]); w.y = cvt_pk_bf16(y[2], y[3]);
        *(u32x2*)(dst + c) = w;
    }
}

__device__ __forceinline__ void phase_n1(const Args& a, int l) {
    const int tid = opaque_tid(), wid = tid >> 6, lane = tid & 63;
    float* X = (float*)(a.ws + WS_X); bf16_t* XA = (bf16_t*)(a.ws + WS_XA); const float* MOD = (const float*)(a.ws + WS_MOD); const bf16_t* Y = (const bf16_t*)(a.ws + WS_R1);
    for (int row = blockIdx.x * 8 + wid; row < TOK; row += gridDim.x * 8) {
        const int s = sample_of(row);
        f32x4 v[4];
        if (l == 0) {
            if (row < NLAT) {
                const float* xp = a.in[I_X] + (size_t)row * 1024 + lane * 4;
                const int tp = row & 2047; const float pr = (float)(tp >> 6), pc = (float)(tp & 63);
#pragma unroll
                for (int ii = 0; ii < 4; ++ii) v[ii] = *(const f32x4*)(xp + ii * 256);
#pragma unroll
                for (int j = 0; j < 4; ++j) {
                    const float om = exp2f(-13.287712379549449f * (float)(lane * 4 + j) * (1.0f / 256.0f));
                    const float ar = pr * om, ac = pc * om;
                    v[0][j] += sinf(ar); v[1][j] += cosf(ar); v[2][j] += sinf(ac); v[3][j] += cosf(ac);
                }
            } else {
                const float* xp = a.in[I_CTX] + (size_t)(row - NLAT) * 1024 + lane * 4;
#pragma unroll
                for (int ii = 0; ii < 4; ++ii) v[ii] = *(const f32x4*)(xp + ii * 256);
            }
        } else {
            f32x4 ys[4]; slot_sum(Y, row, lane, ys);
            const float* gate = MOD + ((size_t)(l - 1) * 17 + s) * 6144 + 5 * 1024 + lane * 4;
#pragma unroll
            for (int ii = 0; ii < 4; ++ii) { const f32x4 xv = *(const f32x4*)(X + (size_t)row * 1024 + ii * 256 + lane * 4), gv = *(const f32x4*)(gate + ii * 256); v[ii] = xv + gv * ys[ii]; }
        }
#pragma unroll
        for (int ii = 0; ii < 4; ++ii) *(f32x4*)(X + (size_t)row * 1024 + ii * 256 + lane * 4) = v[ii];
        const float* m = MOD + ((size_t)l * 17 + s) * 6144;
        norm_mod_store(v, a.in[I_N1G] + l * 1024, m, m + 1024, XA + (size_t)row * 1024, lane);
    }
}
__device__ __forceinline__ void phase_n2(const Args& a, int l, int T) {
    const int tid = opaque_tid(), wid = tid >> 6, lane = tid & 63;
    const float* X = (const float*)(a.ws + WS_X); bf16_t* XA = (bf16_t*)(a.ws + WS_XA); const float* MOD = (const float*)(a.ws + WS_MOD);
    for (int row = blockIdx.x * 8 + wid; row < T; row += gridDim.x * 8) {
        const int s = sample_of(row);
        f32x4 v[4];
#pragma unroll
        for (int ii = 0; ii < 4; ++ii) v[ii] = *(const f32x4*)(X + (size_t)row * 1024 + ii * 256 + lane * 4);
        const float* m = MOD + ((size_t)l * 17 + s) * 6144;
        norm_mod_store(v, a.in[I_N2G] + l * 1024, m + 3 * 1024, m + 4 * 1024, XA + (size_t)row * 1024, lane);
    }
}
__device__ __forceinline__ void phase_fin(const Args& a) {
    const int tid = opaque_tid(), wid = tid >> 6, lane = tid & 63;
    const float* X = (const float*)(a.ws + WS_X); const float* MOD = (const float*)(a.ws + WS_MOD); const bf16_t* Y = (const bf16_t*)(a.ws + WS_R1);
    for (int row = blockIdx.x * 8 + wid; row < NLAT; row += gridDim.x * 8) {
        const int s = sample_of(row);
        f32x4 ys[4], v[4]; slot_sum(Y, row, lane, ys);
        const float* gate = MOD + ((size_t)17 + s) * 6144 + 5 * 1024 + lane * 4;
        float ss = 0.f;
#pragma unroll
        for (int ii = 0; ii < 4; ++ii) { const f32x4 xv = *(const f32x4*)(X + (size_t)row * 1024 + ii * 256 + lane * 4), gv = *(const f32x4*)(gate + ii * 256); v[ii] = xv + gv * ys[ii];
            ss += v[ii][0] * v[ii][0] + v[ii][1] * v[ii][1] + v[ii][2] * v[ii][2] + v[ii][3] * v[ii][3]; }
        ss = wave_sum(ss);
        const float rstd = rsqrtf(ss * (1.0f / 1024.0f) + EPS);
#pragma unroll
        for (int ii = 0; ii < 4; ++ii) { const f32x4 g = *(const f32x4*)(a.in[I_FNG] + ii * 256 + lane * 4); *(f32x4*)(a.out + (size_t)row * 1024 + ii * 256 + lane * 4) = v[ii] * rstd * g; }
    }
}

namespace pg8 {
#define PG8_LAS __attribute__((address_space(3)))
typedef unsigned short bf16_t;
typedef short bf16x8 __attribute__((ext_vector_type(8)));
typedef float f32x4 __attribute__((ext_vector_type(4)));
typedef unsigned u32x4 __attribute__((ext_vector_type(4)));
constexpr int BM = 256, BK = 64, HALF = 128, HTB = HALF * BK * 2  , STAGE_BYTES = 8 * HTB, NXCD = 8, WGM = 8;

__host__ __device__ __forceinline__ int lds_byte(int r, int c) { const int st = (r >> 4) * 2 + (c >> 5), rr = r & 15, cc = c & 31, ob = rr * 64 + cc * 2; return st * 1024 + (ob ^ (((ob >> 9) & 1) << 5)); }
__host__ __device__ __forceinline__ void stage_rc(int b, int& R, int& C) { const int st = b / 1024, sb = b % 1024, swz = sb ^ (((sb >> 9) & 1) << 5); R = (st >> 1) * 16 + swz / 64; C = (st & 1) * 32 + (swz % 64) / 2; }
__host__ __device__ __forceinline__ int perm32(int rho) { const int n = rho >> 4, i = rho & 15; return 8 * (i >> 2) + 4 * n + (i & 3); }

struct Unit { int pm, pn; };
struct Gemm { const bf16_t* A; const bf16_t* Bt; int M, N, K; };

struct StaticOrder {
    int nM, nN, nwg, G, c;
    __host__ __device__ void init(int M, int N, int G_, int c_) { nM = M / BM; nN = N / BM; nwg = nM * nN; G = G_; c = c_; }
    __host__ __device__ bool next(int i, Unit& u) const {
        const long L = (long)i * G + c; if (L >= nwg) return false;
        int wgid = (int)L; { const int q = nwg / NXCD, r = nwg % NXCD, xcd = wgid % NXCD, off = wgid / NXCD; wgid = (xcd < r ? xcd * (q + 1) : r * (q + 1) + (xcd - r) * q) + off; }
        const int nig = WGM * nN, gid = wgid / nig, fm = gid * WGM, gsz = (nM - fm) < WGM ? (nM - fm) : WGM;
        u.pm = fm + ((wgid % nig) % gsz); u.pn = (wgid % nig) / gsz; return true;
    }
    __device__ __forceinline__ void a_ready(const Unit&) const {}
    __device__ __forceinline__ void done(const Unit&) const {}
};
template <class Epi, class Sched, bool STAMP = false>
__device__ __forceinline__ void gemm_phase(PG8_LAS unsigned char* lds, const Gemm g, const Sched& S, const Epi& E, unsigned long long* stamps) {
    const int tid = opaque_tid(), wid = __builtin_amdgcn_readfirstlane(tid >> 6), lane = tid & 63, wr = wid >> 2, wc = wid & 3, fr = lane & 15, fq = lane >> 4;
    const int K = g.K, nt = K / BK;
    int ts_lo = 0, ts_hi = 0, nts = 0; const unsigned long long rt_entry = STAMP ? (unsigned long long)wall_clock64() : 0ull;
#define PG8_STAMP() do { if (STAMP && wid == 0 && nts < 64) { const unsigned long long _c = (unsigned long long)clock64(); \
        ts_lo = (lane == nts) ? (int)(unsigned)_c : ts_lo; ts_hi = (lane == nts) ? (int)(unsigned)(_c >> 32) : ts_hi; ++nts; } } while (0)
    PG8_STAMP();
    unsigned voffA[2], voffB[2];
#pragma unroll
    for (int i = 0; i < 2; ++i) { int R, C; stage_rc(tid * 16 + i * 8192, R, C); const int Rb = Epi::PERM ? ((R & ~31) + perm32(R & 31)) : R;
        voffA[i] = (unsigned)(R * K + C) * 2u; voffB[i] = (unsigned)(Rb * K + C) * 2u; }
    const size_t kstep = (size_t)(BK * 2);
    const size_t hstep = (size_t)HALF * K * 2;
    const size_t tstep = 2 * hstep;
    const unsigned ldsw = (unsigned)wid * 1024u;
    const int aoff = lds_byte(wr * 64 + fr, fq * 8), boff = lds_byte(wc * 32 + fr, fq * 8);
#define PG8_SA(b, h) (((b) * 2 + (h)) * HTB)
#define PG8_SB(b, h) ((4 + (b) * 2 + (h)) * HTB)
#define PG8_STAGE(bufoff, gbase, voff) do { _Pragma("unroll") for (int _i = 0; _i < 2; ++_i) \
        __builtin_amdgcn_global_load_lds((const unsigned*)((const char*)(gbase) + (voff)[_i]), (PG8_LAS unsigned*)(lds + (bufoff) + ldsw + _i * 8192), 16, 0, 0); } while (0)
#define PG8_LDA(dst, b, h) do { _Pragma("unroll") for (int m = 0; m < 4; ++m) _Pragma("unroll") for (int k = 0; k < 2; ++k) dst[m][k] = *(const PG8_LAS bf16x8*)(lds + PG8_SA(b, h) + aoff + m * 2048 + k * 1024); } while (0)
#define PG8_LDB(dst, b, h) do { _Pragma("unroll") for (int n = 0; n < 2; ++n) _Pragma("unroll") for (int k = 0; k < 2; ++k) dst[n][k] = *(const PG8_LAS bf16x8*)(lds + PG8_SB(b, h) + boff + n * 2048 + k * 1024); } while (0)
#define PG8_MMA(ai, bj, At, Bt) do { __builtin_amdgcn_s_setprio(1); _Pragma("unroll") for (int m = 0; m < 4; ++m) _Pragma("unroll") for (int n = 0; n < 2; ++n) _Pragma("unroll") for (int k = 0; k < 2; ++k) \
        acc[ai][bj][m][n] = __builtin_amdgcn_mfma_f32_16x16x32_bf16(Bt[n][k], At[m][k], acc[ai][bj][m][n], 0, 0, 0); __builtin_amdgcn_s_setprio(0); } while (0)
#define PG8_WAIT_V(n) asm volatile("s_waitcnt vmcnt(" #n ")" ::: "memory")
#define PG8_WAIT_L(n) asm volatile("s_waitcnt lgkmcnt(" #n ")" ::: "memory")
#define PG8_BAR __builtin_amdgcn_s_barrier()
#define PG8_SCHED __builtin_amdgcn_sched_barrier(0)
    Unit cur, nxt; int ui = 0;
    if (!S.next(0, cur)) return;
    f32x4 acc[2][2][4][2];
#pragma unroll
    for (int a = 0; a < 2; ++a)
#pragma unroll
        for (int b = 0; b < 2; ++b)
#pragma unroll
            for (int m = 0; m < 4; ++m)
#pragma unroll
                for (int n = 0; n < 2; ++n) acc[a][b][m][n] = (f32x4){0.f, 0.f, 0.f, 0.f};
    bf16x8 At[4][2], B0[2][2], B1[2][2];
    const char* cA = (const char*)g.A + (size_t)cur.pm * tstep; const char* cB = (const char*)g.Bt + (size_t)cur.pn * tstep;
    S.a_ready(cur);
    PG8_STAGE(PG8_SB(0, 0), cB, voffB); PG8_STAGE(PG8_SA(0, 0), cA, voffA); PG8_STAGE(PG8_SB(0, 1), cB + hstep, voffB); PG8_STAGE(PG8_SA(0, 1), cA + hstep, voffA);
    if (wr == 1) PG8_BAR;
    PG8_WAIT_V(4); PG8_BAR;
    PG8_STAGE(PG8_SB(1, 0), cB + kstep, voffB); PG8_STAGE(PG8_SA(1, 0), cA + kstep, voffA); PG8_STAGE(PG8_SB(1, 1), cB + hstep + kstep, voffB);
    PG8_WAIT_V(6); PG8_BAR;
    PG8_STAMP();
    for (;;) {
        const bool has_next = S.next(ui + 1, nxt);
        const char* nA = has_next ? (const char*)g.A + (size_t)nxt.pm * tstep : cA; const char* nB = has_next ? (const char*)g.Bt + (size_t)nxt.pn * tstep : cB;
        for (int t = 0; t < nt; t += 2) {
            const bool last = (t == nt - 2);
            const char* a1 = cA + (size_t)(t + 1) * kstep;
            const char* a2 = last ? nA : cA + (size_t)(t + 2) * kstep; const char* b2 = last ? nB : cB + (size_t)(t + 2) * kstep;
            const char* a3 = a2 + kstep; const char* b3 = b2 + kstep;
            if (last && has_next) S.a_ready(nxt);
            PG8_LDB(B0, 0, 0); PG8_SCHED; PG8_LDA(At, 0, 0); PG8_STAGE(PG8_SA(1, 1), a1 + hstep, voffA);
            PG8_WAIT_L(8); PG8_BAR; PG8_WAIT_L(0); PG8_MMA(0, 0, At, B0); PG8_BAR; PG8_SCHED;
            PG8_LDB(B1, 0, 1); PG8_STAGE(PG8_SB(0, 0), b2, voffB);
            PG8_BAR; PG8_WAIT_L(0); PG8_MMA(0, 1, At, B1); PG8_BAR;
            PG8_LDA(At, 0, 1); PG8_STAGE(PG8_SA(0, 0), a2, voffA);
            PG8_BAR; PG8_WAIT_L(0); PG8_MMA(1, 0, At, B0); PG8_BAR; PG8_SCHED;
            PG8_STAGE(PG8_SB(0, 1), b2 + hstep, voffB);
            PG8_WAIT_V(6); PG8_BAR; PG8_MMA(1, 1, At, B1); PG8_BAR;
            PG8_LDB(B0, 1, 0); PG8_SCHED; PG8_LDA(At, 1, 0); PG8_STAGE(PG8_SA(0, 1), a2 + hstep, voffA);
            PG8_WAIT_L(8); PG8_BAR; PG8_WAIT_L(0); PG8_MMA(0, 0, At, B0); PG8_BAR; PG8_SCHED;
            PG8_LDB(B1, 1, 1); PG8_STAGE(PG8_SB(1, 0), b3, voffB);
            PG8_BAR; PG8_WAIT_L(0); PG8_MMA(0, 1, At, B1); PG8_BAR;
            PG8_LDA(At, 1, 1); PG8_STAGE(PG8_SA(1, 0), a3, voffA);
            PG8_BAR; PG8_WAIT_L(0); PG8_MMA(1, 0, At, B0); PG8_BAR; PG8_SCHED;
            PG8_STAGE(PG8_SB(1, 1), b3 + hstep, voffB);
            PG8_WAIT_V(6); PG8_BAR; PG8_MMA(1, 1, At, B1); PG8_BAR;
        }
        PG8_STAMP();
        if constexpr (!Epi::AFTER_DRAIN) { E(acc, cur, wr, wc, fr, fq); S.done(cur); }
        PG8_STAMP();
        if (!has_next) break;
#pragma unroll
        for (int a = 0; a < 2; ++a)
#pragma unroll
            for (int b = 0; b < 2; ++b)
#pragma unroll
                for (int m = 0; m < 4; ++m)
#pragma unroll
                    for (int n = 0; n < 2; ++n) acc[a][b][m][n] = (f32x4){0.f, 0.f, 0.f, 0.f};
        cur = nxt; cA = nA; cB = nB; ++ui;
    }
    PG8_WAIT_V(0);
    if (wr == 0) PG8_BAR;
    PG8_BAR;
    if constexpr (Epi::AFTER_DRAIN) { E.fused(acc, cur, wr, wc, fr, fq, lds, wid, lane); S.done(cur); }
    PG8_STAMP();
    if (STAMP && wid == 0) { stamps[lane] = lane < nts ? (((unsigned long long)(unsigned)ts_hi << 32) | (unsigned)ts_lo) : 0ull;
        if (lane == 62) stamps[62] = rt_entry; if (lane == 63) stamps[63] = (unsigned long long)wall_clock64(); }
#undef PG8_STAMP
#undef PG8_SA
#undef PG8_SB
#undef PG8_STAGE
#undef PG8_LDA
#undef PG8_LDB
#undef PG8_MMA
#undef PG8_WAIT_V
#undef PG8_WAIT_L
#undef PG8_BAR
#undef PG8_SCHED
}
}

struct EpiG1 {
    static constexpr bool PERM = false, AFTER_DRAIN = false;
    bf16_t* P; float* GATES;
    __device__ __forceinline__ void operator()(const f32x4 (&acc)[2][2][4][2], const pg8::Unit& u, int wr, int wc, int fr, int fq) const {
        const int row0 = u.pm * 256 + wr * 64 + fr;
#pragma unroll
        for (int bj = 0; bj < 2; ++bj)
#pragma unroll
            for (int n = 0; n < 2; ++n) {
                const int cb = u.pn * 256 + bj * 128 + wc * 32 + n * 16;
                if (cb >= DIN) continue;
                if (cb >= PW) {
#pragma unroll
                    for (int ai = 0; ai < 2; ++ai)
#pragma unroll
                        for (int m = 0; m < 4; ++m) *(f32x4*)(GATES + (size_t)(row0 + ai * 128 + m * 16) * 16 + fq * 4) = acc[ai][bj][m][n];
                } else {
                    const bool g = (cb >= PC_RG && cb < PC_Q) || cb >= PC_CU;
                    const float sc = (cb >= PC_K && cb < PC_V) ? 0.10206207261596575f : 1.0f;
#pragma unroll
                    for (int ai = 0; ai < 2; ++ai)
#pragma unroll
                        for (int m = 0; m < 4; ++m) {
                            f32x4 v = acc[ai][bj][m][n];
                            if (g) { v[0] = gelu_tanh(v[0]); v[1] = gelu_tanh(v[1]); v[2] = gelu_tanh(v[2]); v[3] = gelu_tanh(v[3]); } else v = v * sc;
                            u32x2 w; w.x = cvt_pk_bf16(v[0], v[1]); w.y = cvt_pk_bf16(v[2], v[3]);
                            *(u32x2*)(P + (size_t)(row0 + ai * 128 + m * 16) * PW + cb + fq * 4) = w;
                        }
                }
            }
    }
};
__device__ __forceinline__ void phase_g1(const Args& a, LAS unsigned char* lds, int l) {
    pg8::Gemm g{(const bf16_t*)(a.ws + WS_XA), (const bf16_t*)(a.ws + WS_WIN) + (size_t)l * NIN * 1024, TOK, NIN, 1024};
    pg8::StaticOrder S; S.init(TOK, NIN, (int)gridDim.x, (int)blockIdx.x);
    EpiG1 E{(bf16_t*)(a.ws + WS_P), (float*)(a.ws + WS_GATES)};
    pg8::gemm_phase<EpiG1, pg8::StaticOrder>(lds, g, S, E, nullptr);
}
struct EpiG2 {
    static constexpr bool PERM = false, AFTER_DRAIN = false;
    float* X; const float* MODl;
    __device__ __forceinline__ void operator()(const f32x4 (&acc)[2][2][4][2], const pg8::Unit& u, int wr, int wc, int fr, int fq) const {
        const int row0 = u.pm * 256 + wr * 64 + fr; const float* gate = MODl + (size_t)sample_of(u.pm * 256) * 6144 + 2 * 1024;
#pragma unroll
        for (int bj = 0; bj < 2; ++bj)
#pragma unroll
            for (int n = 0; n < 2; ++n) {
                const int col = u.pn * 256 + bj * 128 + wc * 32 + n * 16 + fq * 4; const f32x4 gv = *(const f32x4*)(gate + col);
#pragma unroll
                for (int ai = 0; ai < 2; ++ai)
#pragma unroll
                    for (int m = 0; m < 4; ++m) { float* xp = X + (size_t)(row0 + ai * 128 + m * 16) * 1024 + col; *(f32x4*)xp = *(const f32x4*)xp + gv * acc[ai][bj][m][n]; }
            }
    }
};
__device__ __forceinline__ void phase_g2(const Args& a, LAS unsigned char* lds, int l, int T) {
    pg8::Gemm g{(const bf16_t*)(a.ws + WS_MIX), (const bf16_t*)(a.ws + WS_WOUT) + (size_t)l * 1024 * 1024, T, 1024, 1024};
    pg8::StaticOrder S; S.init(T, 1024, (int)gridDim.x, (int)blockIdx.x);
    EpiG2 E{(float*)(a.ws + WS_X), (const float*)(a.ws + WS_MOD) + (size_t)l * 17 * 6144};
    pg8::gemm_phase<EpiG2, pg8::StaticOrder>(lds, g, S, E, nullptr);
}
struct EpiRT {
    static constexpr bool PERM = false, AFTER_DRAIN = false;
    float* LG;
    __device__ __forceinline__ void operator()(const f32x4 (&acc)[2][2][4][2], const pg8::Unit& u, int wr, int wc, int fr, int fq) const {
        const int row0 = u.pm * 256 + wr * 64 + fr;
#pragma unroll
        for (int bj = 0; bj < 2; ++bj)
#pragma unroll
            for (int n = 0; n < 2; ++n)
#pragma unroll
                for (int ai = 0; ai < 2; ++ai)
#pragma unroll
                    for (int m = 0; m < 4; ++m) *(f32x4*)(LG + (size_t)(row0 + ai * 128 + m * 16) * 256 + bj * 128 + wc * 32 + n * 16 + fq * 4) = acc[ai][bj][m][n];
    }
};
__device__ __forceinline__ void phase_rt(const Args& a, LAS unsigned char* lds, int l, int T) {
    pg8::Gemm g{(const bf16_t*)(a.ws + WS_XA), (const bf16_t*)(a.ws + WS_ROUT) + (size_t)l * 256 * 1024, T, 256, 1024};
    pg8::StaticOrder S; S.init(T, 256, (int)gridDim.x, (int)blockIdx.x);
    EpiRT E{(float*)(a.ws + WS_LOGITS)};
    pg8::gemm_phase<EpiRT, pg8::StaticOrder>(lds, g, S, E, nullptr);
}

template <int CTRL> __device__ __forceinline__ float dppf(float old, float src) { return __int_as_float(__builtin_amdgcn_update_dpp(__float_as_int(old), __float_as_int(src), CTRL, 0xF, 0xF, false)); }
constexpr int TK_MAXTOK = 512;
__device__ __forceinline__ void phase_tk(const Args& a, LAS unsigned char* lds, int l, int T) {
    const int tid = opaque_tid(), wid = tid >> 6, lane = tid & 63;
    const float* LG = (const float*)(a.ws + WS_LOGITS); const float* rb = a.in[I_RB] + l * 256;
    unsigned* CNT = (unsigned*)(a.ws + WS_CTL + CTL_CNT) + (size_t)l * 256 * CNT_STRIDE; int* LS = (int*)(a.ws + WS_LSLOT); float* LWt = (float*)(a.ws + WS_LW);
    LAS unsigned* lcnt = (LAS unsigned*)lds; LAS unsigned* lbase = lcnt + 256; LAS unsigned* ent = lbase + 256; LAS float* entw = (LAS float*)(ent + TK_MAXTOK * 8);
    const f32x4 bias = *(const f32x4*)(rb + lane * 4);
    const float NEG = -__builtin_huge_valf();
    const int per = (T + (int)gridDim.x - 1) / (int)gridDim.x;
    for (int base0 = blockIdx.x * per; base0 < (int)(blockIdx.x + 1) * per && base0 < T; base0 += TK_MAXTOK) {
        int ntok = (int)(blockIdx.x + 1) * per - base0; if (ntok > TK_MAXTOK) ntok = TK_MAXTOK; if (ntok > T - base0) ntok = T - base0;
        __syncthreads();
        if (tid < 256) lcnt[tid] = 0u;
        __syncthreads();
        for (int tl = wid; tl < ntok; tl += 8) {
            const int t = base0 + tl;
            const f32x4 lg = *(const f32x4*)(LG + (size_t)t * 256 + lane * 4);
            float sc[4], sel[4];
#pragma unroll
            for (int j = 0; j < 4; ++j) { sc[j] = 1.0f / (1.0f + expf(-lg[j])); sel[j] = sc[j] + bias[j]; }
            float a1 = fmaxf(sel[0], sel[1]), a2 = fminf(sel[0], sel[1]);
#pragma unroll
            for (int j = 2; j < 4; ++j) { const float v = sel[j]; a2 = fmaxf(a2, fminf(a1, v)); a1 = fmaxf(a1, v); }
#define TK_MERGE(CTRL) { const float b1 = dppf<CTRL>(a1, a1), b2 = dppf<CTRL>(a2, a2); const float n1 = fmaxf(a1, b1), n2 = fmaxf(fminf(a1, b1), fmaxf(a2, b2)); a1 = n1; a2 = n2; }
            TK_MERGE(0xB1) TK_MERGE(0x4E) TK_MERGE(0x141)
#undef TK_MERGE
            const float gs = a1 + a2; const int g = lane >> 3; int rank = 0;
#pragma unroll
            for (int g2 = 0; g2 < 8; ++g2) { const float s2 = __int_as_float(__builtin_amdgcn_readlane(__float_as_int(gs), g2 * 8)); rank += (s2 > gs || (s2 == gs && g2 < g)) ? 1 : 0; }
            float ms[4];
#pragma unroll
            for (int j = 0; j < 4; ++j) ms[j] = rank < 4 ? sel[j] : NEG;
            int my_e = 0; float my_s = 0.f, ssum = 0.f;
#pragma unroll
            for (int k = 0; k < 8; ++k) {
                float mx = fmaxf(fmaxf(ms[0], ms[1]), fmaxf(ms[2], ms[3]));
                mx = fmaxf(mx, dppf<0x111>(NEG, mx)); mx = fmaxf(mx, dppf<0x112>(NEG, mx)); mx = fmaxf(mx, dppf<0x114>(NEG, mx)); mx = fmaxf(mx, dppf<0x118>(NEG, mx));
                const float gmax = fmaxf(fmaxf(__int_as_float(__builtin_amdgcn_readlane(__float_as_int(mx), 15)), __int_as_float(__builtin_amdgcn_readlane(__float_as_int(mx), 31))),
                                         fmaxf(__int_as_float(__builtin_amdgcn_readlane(__float_as_int(mx), 47)), __int_as_float(__builtin_amdgcn_readlane(__float_as_int(mx), 63))));
                const int cand = ms[0] == gmax ? 0 : ms[1] == gmax ? 1 : ms[2] == gmax ? 2 : ms[3] == gmax ? 3 : -1;
                const unsigned long long bal = __ballot(cand >= 0);
                const int wl = __builtin_amdgcn_readfirstlane(__ffsll((unsigned long long)bal) - 1);
                const int jj = __builtin_amdgcn_readlane(cand, wl), bi = wl * 4 + jj;
                const float mysc = jj == 0 ? sc[0] : jj == 1 ? sc[1] : jj == 2 ? sc[2] : sc[3];
                const float sk = __int_as_float(__builtin_amdgcn_readlane(__float_as_int(mysc), wl));
#pragma unroll
                for (int j = 0; j < 4; ++j) if (lane == wl && j == jj) ms[j] = NEG;
                if (lane == k) { my_e = bi; my_s = sk; }
                ssum += sk;
            }
            if (lane < 8) {
                const unsigned r = __hip_atomic_fetch_add(&lcnt[my_e], 1u, __ATOMIC_RELAXED, __HIP_MEMORY_SCOPE_WORKGROUP);
                ent[tl * 8 + lane] = ((unsigned)my_e << 16) | r; entw[tl * 8 + lane] = my_s / ssum * 2.5f;
            }
        }
        __syncthreads();
        if (tid < 256) { const unsigned c = lcnt[tid]; lbase[tid] = c ? atomicAdd(&CNT[tid * CNT_STRIDE], c) : 0u; }
        __syncthreads();
        for (int i = tid; i < ntok * 8; i += NTHREADS) {
            const unsigned v = ent[i]; const int e = (int)(v >> 16); const unsigned pos = lbase[e] + (v & 0xffffu);
            LS[(size_t)e * LCAP + pos] = (base0 + (i >> 3)) * NSLOT + (i & 7); LWt[(size_t)e * LCAP + pos] = entw[i];
        }
    }
}

__device__ __forceinline__ void moe_tables(const Args& a, LAS unsigned char* lds, int l, int T) {
    LAS int* cntE = (LAS int*)(lds + LDS_TAB); LAS int* blkoff = cntE + 264;
    const int tid = opaque_tid(); const unsigned* CNT = (const unsigned*)(a.ws + WS_CTL + CTL_CNT) + (size_t)l * 256 * CNT_STRIDE;
    if (tid < 256) cntE[tid] = (int)CNT[tid * CNT_STRIDE]; else if (tid == 256) cntE[256] = T;
    __syncthreads();
    if (tid < 258) { int s = 0; for (int e = 0; e < tid && e < 257; ++e) s += (cntE[e] + 255) >> 8; blkoff[tid] = s; }
    __syncthreads();
}
__device__ __forceinline__ int moe_find(const LAS int* blkoff, int mbg) { int lo = 0, hi = 257; while (hi - lo > 1) { const int mid = (lo + hi) >> 1; if (blkoff[mid] <= mbg) lo = mid; else hi = mid; } return lo; }

#define PV_LOAD32(dst, ptr) asm volatile("global_load_dword %0, %1, off" : "=&v"(dst) : "v"(ptr))
struct E1Prov {
    const Args& a; LAS unsigned char* lds; int l, nunit, R0, R1, C0, C1, wr, wc, fr, fq; int q0, q1; bool sh;
    __device__ __forceinline__ void decode(int i, int& mbg, int& nt, int& e, int& mb, int& cnt) const {
        const LAS int* cntE = (const LAS int*)(lds + LDS_TAB); const LAS int* blkoff = cntE + 264;
        const int u = blockIdx.x + i * gridDim.x; mbg = u / 3; nt = u - mbg * 3; e = moe_find(blkoff, mbg); mb = mbg - blkoff[e]; cnt = cntE[e];
    }
    __device__ __forceinline__ bool seg(int i, RSeg& d) {
        if ((int)(blockIdx.x + i * gridDim.x) >= nunit) return false;
        int mbg, nt, e, mb, cnt; decode(i, mbg, nt, e, mb, cnt);
        const int* LS = (const int*)(a.ws + WS_LSLOT) + (e < 256 ? (size_t)e * LCAP : 0);
        const int p0 = mb * 256 + R0, p1 = mb * 256 + R1; sh = e >= 256; q0 = p0 < cnt ? p0 : -1; q1 = p1 < cnt ? p1 : -1;
        const int* a0 = LS + (q0 >= 0 && !sh ? q0 : 0); const int* a1 = LS + (q1 >= 0 && !sh ? q1 : 0);
        PV_LOAD32(d.aoff[0], a0); PV_LOAD32(d.aoff[1], a1);
        d.Ab = (const unsigned char*)(a.ws + WS_XA);
        d.B0 = (e < 256 ? a.in[I_EG] + ((size_t)l * 256 + e) * 1024 * FF : a.in[I_SG] + (size_t)l * 1024 * FF) + nt * 96;
        d.B1 = (e < 256 ? a.in[I_EU] + ((size_t)l * 256 + e) * 1024 * FF : a.in[I_SU] + (size_t)l * 1024 * FF) + nt * 96;
        return true;
    }
    __device__ __forceinline__ void finish(RSeg& d, bool first) const {
        if (first) asm volatile("s_waitcnt vmcnt(0)" ::: "memory"); else asm volatile("s_waitcnt vmcnt(16)" ::: "memory");
        __builtin_amdgcn_sched_barrier(0); asm volatile("" : "+v"(d.aoff[0]), "+v"(d.aoff[1]));
        const int t0 = q0 < 0 ? 0 : sh ? q0 : (int)d.aoff[0] / NSLOT, t1 = q1 < 0 ? 0 : sh ? q1 : (int)d.aoff[1] / NSLOT;
        d.aoff[0] = (unsigned)t0 * 2048u + (unsigned)C0 * 2u; d.aoff[1] = (unsigned)t1 * 2048u + (unsigned)C1 * 2u;
    }
    __device__ __forceinline__ void epi(int i, f32x4 (&acc)[4][6]) const {
        int mbg, nt, e, mb, cnt; decode(i, mbg, nt, e, mb, cnt);
        bf16_t* HB = (bf16_t*)(a.ws + WS_HB);
#pragma unroll
        for (int m = 0; m < 4; ++m) {
            bf16_t* hp = HB + (size_t)(mbg * 256 + wr * 64 + m * 16 + fr) * FF + nt * 96 + wc * 48 + fq * 4;
#pragma unroll
            for (int n = 0; n < 3; ++n) {
                const f32x4 g = acc[m][n], uu = acc[m][n + 3];
                u32x2 w; w.x = cvt_pk_bf16(siluf_(g[0]) * uu[0], siluf_(g[1]) * uu[1]); w.y = cvt_pk_bf16(siluf_(g[2]) * uu[2], siluf_(g[3]) * uu[3]);
                *(u32x2*)(hp + n * 16) = w;
            }
        }
    }
};
__device__ __forceinline__ void ring_piece_rc(int wid, int lane, int k, int& R, int& C) { const int sb = lane * 16, swz = sb ^ (((sb >> 9) & 1) << 5); R = (wid + 8 * k) * 16 + (swz >> 6); C = (swz & 63) >> 1; }
__device__ __forceinline__ void phase_e1(const Args& a, LAS unsigned char* lds, int l, int T) {
    const int tid = opaque_tid(), wid = __builtin_amdgcn_readfirstlane(tid >> 6), lane = tid & 63;
    moe_tables(a, lds, l, T);
    const LAS int* blkoff = (const LAS int*)(lds + LDS_TAB) + 264;
    int R0, C0, R1, C1; ring_piece_rc(wid, lane, 0, R0, C0); ring_piece_rc(wid, lane, 1, R1, C1);
    E1Prov pv{a, lds, l, blkoff[257] * 3, R0, R1, C0, C1, wid >> 1, wid & 1, lane & 15, lane >> 4, -1, -1, false};
    ring_gemm<192, 2, true, true, 2, E1Prov>(lds, pv, 32, FF, 0u, 0u);
}

struct E2Prov {
    const Args& a; LAS unsigned char* lds; int l, nunit, tid; int pslot; float pw; int pidx, ppos; bool psh;
    __device__ __forceinline__ void decode(int i, int& mbg, int& pn, int& e, int& mb, int& cnt) const {
        const LAS int* cntE = (const LAS int*)(lds + LDS_TAB); const LAS int* blkoff = cntE + 264;
        const int u = blockIdx.x + i * gridDim.x; mbg = u >> 2; pn = u & 3; e = moe_find(blkoff, mbg); mb = mbg - blkoff[e]; cnt = cntE[e];
    }
    __device__ __forceinline__ bool seg(int i, RSeg& d) {
        if ((int)(blockIdx.x + i * gridDim.x) >= nunit) return false;
        int mbg, pn, e, mb, cnt; decode(i, mbg, pn, e, mb, cnt);
        const int pos = mb * 256 + (tid & 255); psh = e >= 256; ppos = (tid < 256 && pos < cnt) ? pos : -1; pidx = i;
        const size_t idx = (ppos >= 0 && !psh) ? (size_t)e * LCAP + pos : 0;
        const int* sp = (const int*)(a.ws + WS_LSLOT) + idx; const float* wp = (const float*)(a.ws + WS_LW) + idx;
        PV_LOAD32(pslot, sp); PV_LOAD32(pw, wp);
        d.Ab = (const unsigned char*)(a.ws + WS_HB) + (size_t)mbg * 256 * FF * 2;
        d.B0 = (e < 256 ? a.in[I_ED] + ((size_t)l * 256 + e) * FF * 1024 : a.in[I_SD] + (size_t)l * FF * 1024) + pn * 256; d.B1 = d.B0;
        return true;
    }
    __device__ __forceinline__ void finish(RSeg&, bool first) {
        if (first) asm volatile("s_waitcnt vmcnt(0)" ::: "memory"); else asm volatile("s_waitcnt vmcnt(16)" ::: "memory");
        __builtin_amdgcn_sched_barrier(0); asm volatile("" : "+v"(pslot), "+v"(pw));
        LAS int* tab = (LAS int*)(lds + LDS_TAB) + 528 + (pidx & 1) * 512;
        if (tid < 256) { tab[tid] = ppos < 0 ? -1 : psh ? ppos * NSLOT + 8 : pslot; ((LAS float*)tab)[256 + tid] = psh ? 1.0f : pw; }
    }
    __device__ __forceinline__ void epi(int i, f32x4 (&acc)[8][4]) const {
        int mbg, pn, e, mb, cnt; decode(i, mbg, pn, e, mb, cnt);
        const LAS int* tab = (const LAS int*)(lds + LDS_TAB) + 528 + (i & 1) * 512; bf16_t* Y = (bf16_t*)(a.ws + WS_R1);
        const int wr = tid >> 8, wc = (tid >> 6) & 3, fr = tid & 15, fq = (tid >> 4) & 3;
#pragma unroll
        for (int m = 0; m < 8; ++m) {
            const int r = wr * 128 + m * 16 + fr, slot = tab[r];
            if (slot >= 0) {
                const float w = ((const LAS float*)tab)[256 + r]; bf16_t* yp = Y + (size_t)slot * 1024 + pn * 256 + wc * 64 + fq * 4;
#pragma unroll
                for (int n = 0; n < 4; ++n) { const f32x4 v = acc[m][n] * w; u32x2 o; o.x = cvt_pk_bf16(v[0], v[1]); o.y = cvt_pk_bf16(v[2], v[3]); *(u32x2*)(yp + n * 16) = o; }
            }
        }
    }
};
__device__ __forceinline__ void phase_e2(const Args& a, LAS unsigned char* lds, int l, int T) {
    const int tid = opaque_tid(), wid = __builtin_amdgcn_readfirstlane(tid >> 6), lane = tid & 63;
    moe_tables(a, lds, l, T);
    const LAS int* blkoff = (const LAS int*)(lds + LDS_TAB) + 264;
    int R0, C0, R1, C1; ring_piece_rc(wid, lane, 0, R0, C0); ring_piece_rc(wid, lane, 1, R1, C1);
    E2Prov pv{a, lds, l, blkoff[257] * 4, tid, -1, 0.f, -1, -1, false};
    ring_gemm<256, 4, false, false, 1, E2Prov>(lds, pv, 9, 1024, (unsigned)(R0 * FF * 2 + C0 * 2), (unsigned)(R1 * FF * 2 + C1 * 2));
}

__device__ __forceinline__ float logsigmoidf_(float x) { return fminf(x, 0.f) - log1pf(expf(-fabsf(x))); }

__device__ __forceinline__ void mlstm_gates(const float* GATES, int row0, int rstep, int gcol, float bi, float bfg, float m, LAS float* colterm, LAS float* Marr, LAS float* bcarr, int lane) {
    const int p0 = 2 * lane;
    const float* g0 = GATES + (size_t)(row0 + rstep * p0) * 16 + gcol; const float* g1 = g0 + rstep * 16;
    const float gi0 = g0[0] + bi, gi1 = g1[0] + bi, lf0 = logsigmoidf_(g0[4] + bfg), lf1 = logsigmoidf_(g1[4] + bfg);
    float s = lf0 + lf1;
#pragma unroll
    for (int o = 1; o < 64; o <<= 1) { const float t = __shfl_up(s, o); if (lane >= o) s += t; }
    const float bc1 = s, bc0 = s - lf1, ct0 = gi0 - bc0, ct1 = gi1 - bc1;
    float pm = fmaxf(ct0, ct1);
#pragma unroll
    for (int o = 1; o < 64; o <<= 1) { const float t = __shfl_up(pm, o); if (lane >= o) pm = fmaxf(pm, t); }
    float prev = __shfl_up(pm, 1); if (lane == 0) prev = -__builtin_huge_valf();
    const float pm0 = fmaxf(prev, ct0);
    colterm[p0] = ct0; colterm[p0 + 1] = ct1; bcarr[p0] = bc0; bcarr[p0 + 1] = bc1; Marr[p0] = fmaxf(m, pm0); Marr[p0 + 1] = fmaxf(m, pm);
}

__device__ __forceinline__ void ms_unit(const Args& a, LAS unsigned char* lds, int l, int b, int h, int d) {
    const int tid = opaque_tid(), wid = __builtin_amdgcn_readfirstlane(tid >> 6), lane = tid & 63, fr = lane & 15, fq = lane >> 4;
    LAS bf16_t* Ks = (LAS bf16_t*)(lds);
    LAS bf16_t* Vp = (LAS bf16_t*)(lds + 26624);
    LAS float* colterm = (LAS float*)(lds + 57344); LAS float* Marr = colterm + 128; LAS float* bcarr = Marr + 128;
    const bf16_t* P = (const bf16_t*)(a.ws + WS_P); const float* GATES = (const float*)(a.ws + WS_GATES);
    const int seq = (b * 4 + h) * 2 + d;
    bf16_t* CTG = (bf16_t*)(a.ws + WS_CTG) + (size_t)seq * 18 * (112 * 96); float* MST = (float*)(a.ws + WS_MST) + seq * 18;
    const float bi = a.in[I_MGB][((l * 2 + d) * 2 + 0) * 4 + h], bfg = a.in[I_MGB][((l * 2 + d) * 2 + 1) * 4 + h];
    const int rstep = d ? -1 : 1, gcol = d * 8 + h;
    int pp[3], pch[3];
#pragma unroll
    for (int i = 0; i < 3; ++i) { const int rem = tid + 512 * i; pp[i] = rem / 12; pch[i] = rem - pp[i] * 12; }
#define MS_ROW0(step) (((step) < 2 ? NLAT + b * CTXL : b * SEQ) + (d ? ((step) < 2 ? CTXL : SEQ) - 1 - ((step) < 2 ? (step) : (step) - 2) * 128 : ((step) < 2 ? (step) : (step) - 2) * 128))
    u32x4 kv[6]; float gq[4];
#define MS_FETCH(step) do { const int _r0 = MS_ROW0(step); \
        _Pragma("unroll") for (int i = 0; i < 6; ++i) kv[i] = *(const u32x4*)(P + (size_t)(_r0 + rstep * pp[i % 3]) * PW + (i < 3 ? PC_K : PC_V) + h * 96 + pch[i % 3] * 8); \
        { const float* g0 = GATES + (size_t)(_r0 + rstep * 2 * lane) * 16 + gcol; gq[0] = g0[0]; gq[1] = g0[4]; gq[2] = g0[rstep * 16]; gq[3] = g0[rstep * 16 + 4]; } } while (0)
    __syncthreads();
    for (int i = tid; i < 128 * 3; i += NTHREADS) { const int p = i / 3, q = i - p * 3; u32x4 v = (u32x4){0u, 0u, 0u, 0u}; if (q == 0) v.x = 0x3F80u; *(LAS u32x4*)(Vp + p * 120 + 96 + q * 8) = v; }
    f32x4 Cst[7];
#pragma unroll
    for (int cb = 0; cb < 7; ++cb) Cst[cb] = (f32x4){0.f, 0.f, 0.f, 0.f};
    float m = 0.f;
    MS_FETCH(0);
    for (int step = 0; step < 18; ++step) {
        const bool do_out = step >= 2 || l == 0;
        if (wid == 0) {
            const int p0 = 2 * lane;
            const float gi0 = gq[0] + bi, gi1 = gq[2] + bi, lf0 = logsigmoidf_(gq[1] + bfg), lf1 = logsigmoidf_(gq[3] + bfg);
            float s = lf0 + lf1;
#pragma unroll
            for (int o = 1; o < 64; o <<= 1) { const float t = __shfl_up(s, o); if (lane >= o) s += t; }
            const float bc1 = s, bc0 = s - lf1, ct0 = gi0 - bc0, ct1 = gi1 - bc1;
            float pm = fmaxf(ct0, ct1);
#pragma unroll
            for (int o = 1; o < 64; o <<= 1) { const float t = __shfl_up(pm, o); if (lane >= o) pm = fmaxf(pm, t); }
            float prev = __shfl_up(pm, 1); if (lane == 0) prev = -__builtin_huge_valf();
            const float pm0 = fmaxf(prev, ct0);
            colterm[p0] = ct0; colterm[p0 + 1] = ct1; bcarr[p0] = bc0; bcarr[p0 + 1] = bc1; Marr[p0] = fmaxf(m, pm0); Marr[p0 + 1] = fmaxf(m, pm);
        }
        if (do_out) {
            if (tid == 0) MST[step] = m;
            if (wid < 6) {
                bf16_t* cg = CTG + (size_t)step * (112 * 96) + wid * 16 + fr;
#pragma unroll
                for (int cb = 0; cb < 7; ++cb)
#pragma unroll
                    for (int j = 0; j < 4; ++j) cg[(cb * 16 + fq * 4 + j) * 96] = f2bf(Cst[cb][j]);
            }
        }
        __syncthreads();
        const float Mend = Marr[127], gsum = bcarr[127];
#pragma unroll
        for (int i = 0; i < 6; ++i) {
            const int p = pp[i % 3], ch = pch[i % 3];
            u32x4 v = kv[i];
            if (i < 3) {
                const float w = __expf(colterm[p] - Mend);
                v.x = cvt_pk_bf16(__uint_as_float(v.x << 16) * w, __uint_as_float(v.x & 0xffff0000u) * w); v.y = cvt_pk_bf16(__uint_as_float(v.y << 16) * w, __uint_as_float(v.y & 0xffff0000u) * w);
                v.z = cvt_pk_bf16(__uint_as_float(v.z << 16) * w, __uint_as_float(v.z & 0xffff0000u) * w); v.w = cvt_pk_bf16(__uint_as_float(v.w << 16) * w, __uint_as_float(v.w & 0xffff0000u) * w);
                *(LAS u32x4*)(Ks + p * 104 + ch * 8) = v;
            } else *(LAS u32x4*)(Vp + p * 120 + ch * 8) = v;
        }
        if (step + 1 < 18) MS_FETCH(step + 1);
        __syncthreads();
        const float decay = __expf(m - Mend);
        if (wid < 6) {
#pragma unroll
            for (int cb = 0; cb < 7; ++cb) Cst[cb] = Cst[cb] * decay;
#pragma unroll
            for (int ks = 0; ks < 4; ++ks) {
                const bf16x8 bk = trfrag(Ks, 104, ks * 32, wid * 16, fr, fq);
#pragma unroll
                for (int cb = 0; cb < 7; ++cb) Cst[cb] = MFMA(trfrag(Vp, 120, ks * 32, cb * 16, fr, fq), bk, Cst[cb]);
            }
        }
        m = gsum + Mend;
        __syncthreads();
    }
#undef MS_FETCH
#undef MS_ROW0
}

__device__ __forceinline__ void mo_unit(const Args& a, LAS unsigned char* lds, int l, int b, int h, int cidx) {
    const int tid = opaque_tid(), wid = __builtin_amdgcn_readfirstlane(tid >> 6), lane = tid & 63, fr = lane & 15, fq = lane >> 4;
    LAS bf16_t* Qi = (LAS bf16_t*)(lds);
    LAS bf16_t* Ki = (LAS bf16_t*)(lds + 26624);
    LAS bf16_t* Si = (LAS bf16_t*)(lds);
    LAS bf16_t* Vp = (LAS bf16_t*)(lds + 53248);
    LAS float* Hs = (LAS float*)(lds + 83968);
    LAS float* colterm = (LAS float*)(lds + 135168); LAS float* Marr = colterm + 128; LAS float* bcarr = Marr + 128;
    const bf16_t* P = (const bf16_t*)(a.ws + WS_P); const float* GATES = (const float*)(a.ws + WS_GATES); bf16_t* MIX = (bf16_t*)(a.ws + WS_MIX);
    const bool isctx = cidx >= 16; const int n = isctx ? cidx - 16 : cidx, nc = isctx ? 2 : 16, rowbase = (isctx ? NLAT + b * CTXL : b * SEQ) + n * 128;
    __syncthreads();
    for (int i = tid; i < 128 * 3; i += NTHREADS) { const int p = i / 3, q = i - p * 3; u32x4 v = (u32x4){0u, 0u, 0u, 0u}; if (q == 0) v.x = 0x3F80u; *(LAS u32x4*)(Vp + p * 120 + 96 + q * 8) = v; }
    for (int d = 0; d < 2; ++d) {
        const int seq = (b * 4 + h) * 2 + d, np = d ? nc - 1 - n : n, step = isctx ? np : 2 + np;
        const float m = ((const float*)(a.ws + WS_MST))[seq * 18 + step];
        const bf16_t* CT = (const bf16_t*)(a.ws + WS_CTG) + ((size_t)seq * 18 + step) * (112 * 96);
        const float bi = a.in[I_MGB][((l * 2 + d) * 2 + 0) * 4 + h], bfg = a.in[I_MGB][((l * 2 + d) * 2 + 1) * 4 + h];
        const int row0 = rowbase + (d ? 127 : 0), rstep = d ? -1 : 1;
        if (wid == 0) mlstm_gates(GATES, row0, rstep, d * 8 + h, bi, bfg, m, colterm, Marr, bcarr, lane);
#pragma unroll
        for (int i = 0; i < 9; ++i) {
            const int rem = tid + 512 * (i % 3), p = rem / 12, ch = rem - p * 12;
            const u32x4 v = *(const u32x4*)(P + (size_t)(row0 + rstep * p) * PW + PC_Q + (i / 3) * 384 + h * 96 + ch * 8);
            if (i < 3) *(LAS u32x4*)(Qi + p * 104 + ch * 8) = v; else if (i < 6) *(LAS u32x4*)(Ki + p * 104 + ch * 8) = v; else *(LAS u32x4*)(Vp + p * 120 + ch * 8) = v;
        }
        __syncthreads();
        f32x4 num[7], sacc[8];
        const int t = wid * 16 + fr; const float Mt = Marr[t];
#pragma unroll
        for (int cb = 0; cb < 7; ++cb) num[cb] = (f32x4){0.f, 0.f, 0.f, 0.f};
#pragma unroll
        for (int ks = 0; ks < 3; ++ks) {
            const bf16x8 bq = ldfrag(Qi, 104, wid * 16, ks * 32, fr, fq);
#pragma unroll
            for (int cb = 0; cb < 7; ++cb) num[cb] = MFMA(*(const bf16x8*)(CT + (cb * 16 + fr) * 96 + ks * 32 + fq * 8), bq, num[cb]);
#pragma unroll
            for (int sb = 0; sb < 8; ++sb) if (sb <= wid) { if (ks == 0) sacc[sb] = (f32x4){0.f, 0.f, 0.f, 0.f}; sacc[sb] = MFMA(ldfrag(Ki, 104, sb * 16, ks * 32, fr, fq), bq, sacc[sb]); }
        }
        { const float ei = __expf(m - Mt);
#pragma unroll
          for (int cb = 0; cb < 7; ++cb) num[cb] = num[cb] * ei; }
        __syncthreads();
#pragma unroll
        for (int sb = 0; sb < 8; ++sb) {
            u32x2 w; w.x = 0u; w.y = 0u;
            if (sb <= wid) {
                const f32x4 ct = *(const LAS f32x4*)(colterm + sb * 16 + fq * 4); float e[4];
#pragma unroll
                for (int j = 0; j < 4; ++j) { const int s = sb * 16 + fq * 4 + j; e[j] = (s <= t) ? sacc[sb][j] * __expf(ct[j] - Mt) : 0.f; }
                w.x = cvt_pk_bf16(e[0], e[1]); w.y = cvt_pk_bf16(e[2], e[3]);
            }
            *(LAS u32x2*)(Si + t * 136 + sb * 16 + fq * 4) = w;
        }
        __syncthreads();
#pragma unroll
        for (int ks = 0; ks < 4; ++ks) {
            const bf16x8 bs = ldfrag(Si, 136, wid * 16, ks * 32, fr, fq);
#pragma unroll
            for (int cb = 0; cb < 7; ++cb) num[cb] = MFMA(trfrag(Vp, 120, ks * 32, cb * 16, fr, fq), bs, num[cb]);
        }
        const float den = __shfl(num[6][0], fr);
        const float inv = 1.0f / fmaxf(fabsf(den), __expf(-(bcarr[t] + Mt)));
        LAS float* hp = Hs + (d ? 127 - t : t) * 100 + fq * 4;
#pragma unroll
        for (int cb = 0; cb < 6; ++cb) { f32x4 hv = num[cb] * inv; if (d) hv = hv + *(const LAS f32x4*)(hp + cb * 16); *(LAS f32x4*)(hp + cb * 16) = hv; }
        __syncthreads();
    }
    {
        const int tau = wid * 16 + (lane >> 2), c0 = (lane & 3) * 24;
        float hv[24], ss = 0.f;
#pragma unroll
        for (int i = 0; i < 6; ++i) { const f32x4 x = *(const LAS f32x4*)(Hs + tau * 100 + c0 + i * 4); hv[4 * i] = x[0]; hv[4 * i + 1] = x[1]; hv[4 * i + 2] = x[2]; hv[4 * i + 3] = x[3]; ss += x[0] * x[0] + x[1] * x[1] + x[2] * x[2] + x[3] * x[3]; }
        ss += __shfl_xor(ss, 1); ss += __shfl_xor(ss, 2);
        const float rstd = rsqrtf(ss * (1.0f / 96.0f) + EPS);
        const bf16_t* op = P + (size_t)(rowbase + tau) * PW + PC_O + h * 96 + c0; const float* ng = a.in[I_MNG] + l * 384 + h * 96 + c0;
        bf16_t* mp = MIX + (size_t)(rowbase + tau) * 1024 + 384 + h * 96 + c0;
#pragma unroll
        for (int i = 0; i < 3; ++i) {
            const u32x4 ow = *(const u32x4*)(op + i * 8); const unsigned oo[4] = {ow.x, ow.y, ow.z, ow.w}; unsigned r[4];
#pragma unroll
            for (int j = 0; j < 4; ++j) { const int c = i * 8 + 2 * j; r[j] = cvt_pk_bf16(sigmoidf_(__uint_as_float(oo[j] << 16)) * hv[c] * rstd * ng[c], sigmoidf_(__uint_as_float(oo[j] & 0xffff0000u)) * hv[c + 1] * rstd * ng[c + 1]); }
            *(u32x4*)(mp + i * 8) = (u32x4){r[0], r[1], r[2], r[3]};
        }
    }
}

template <int D> __device__ __forceinline__ void scan16(float& A, float& U) {
#define RG_STEP(o) { const float Ao = dppf<(D ? 0x100 : 0x110) | (o)>(1.0f, A), Uo = dppf<(D ? 0x100 : 0x110) | (o)>(0.0f, U); U = fmaf(A, Uo, U); A *= Ao; }
    RG_STEP(1) RG_STEP(2) RG_STEP(4) RG_STEP(8)
#undef RG_STEP
}
template <bool FINAL>
__device__ __forceinline__ void rg_unit(const Args& a, LAS unsigned char* lds, int l, int b, int hd, int cidx) {
    const int tid = opaque_tid(), wid = __builtin_amdgcn_readfirstlane(tid >> 6), lane = tid & 63, fr = lane & 15, fq = lane >> 4;
    LAS bf16_t* zi = (LAS bf16_t*)lds;
    LAS bf16_t* Wi = (LAS bf16_t*)(lds + 18432);
    LAS float* zf = (LAS float*)(lds + 55296);
    LAS float* cst = (LAS float*)(lds + 88064);
    LAS float* wagg = (LAS float*)(lds + 89600);
    LAS float* hin = (LAS float*)(lds + 97792);
    const bf16_t* P = (const bf16_t*)(a.ws + WS_P); bf16_t* MIX = (bf16_t*)(a.ws + WS_MIX);
    float* AGG = (float*)(a.ws + WS_RGAGG);
    const bool isctx = cidx >= 16; const int n = isctx ? cidx - 16 : cidx, nc = isctx ? 2 : 16, Tseg = isctx ? CTXL : SEQ, segbase = isctx ? NLAT + b * CTXL : b * SEQ, base = n * 128;
    const int c = lane, ch = hd * 64 + c;
    __syncthreads();
    { const bf16_t* wt = (const bf16_t*)(a.ws + WS_RGWT) + (size_t)((l * 2) * 6 + hd) * 8192;
#pragma unroll
      for (int i = 0; i < 4; ++i) { const int idx = tid + 512 * i, dd = idx >> 10, r = (idx >> 3) & 127, k8 = idx & 7; *(LAS u32x4*)(Wi + (dd * 128 + r) * 72 + k8 * 8) = *(const u32x4*)(wt + (size_t)dd * 6 * 8192 + r * 64 + k8 * 8); } }
    if (tid < 128) { const int dd = tid >> 6, cc = tid & 63;
        cst[(dd * 3 + 0) * 64 + cc] = -1.4426950408889634f * a.in[I_RGGB][((l * 2 + dd) * 2 + 0) * 384 + hd * 64 + cc]; cst[(dd * 3 + 1) * 64 + cc] = -1.4426950408889634f * a.in[I_RGGB][((l * 2 + dd) * 2 + 1) * 384 + hd * 64 + cc];
        cst[(dd * 3 + 2) * 64 + cc] = -8.0f * 1.4426950408889634f * log1pf(expf(-a.in[I_RGLAM][(l * 2 + dd) * 384 + hd * 64 + cc]));
        if (FINAL) {
            const int np = dd ? nc - 1 - n : n, step = isctx ? np : 2 + np; const float* ag = AGG + (size_t)((b * 6 + hd) * 2 + dd) * 18 * 128 + cc;
            float Av[17], Uv[17];
#pragma unroll
            for (int s2 = 0; s2 < 17; ++s2) { Av[s2] = 1.f; Uv[s2] = 0.f; if (s2 < step) { Av[s2] = ag[s2 * 128]; Uv[s2] = ag[s2 * 128 + 64]; } }
            float hv = 0.f;
#pragma unroll
            for (int s2 = 0; s2 < 17; ++s2) hv = Av[s2] * hv + Uv[s2];
            hin[dd * 64 + cc] = hv;
        } }
    {
        const float cw0 = a.in[I_RGCW][(l * 4 + 0) * 384 + ch], cw1 = a.in[I_RGCW][(l * 4 + 1) * 384 + ch], cw2 = a.in[I_RGCW][(l * 4 + 2) * 384 + ch], cw3 = a.in[I_RGCW][(l * 4 + 3) * 384 + ch], cbias = a.in[I_RGCB][l * 384 + ch];
        const int tl0 = wid * 16; const bf16_t* pp = P + (size_t)segbase * PW + PC_RX + ch;
#define RG_LD(pos) (((pos) >= 0 && (pos) < Tseg) ? bf2f(pp[(size_t)(pos) * PW]) : 0.f)
        float xv[19];
#pragma unroll
        for (int i = 0; i < 19; ++i) xv[i] = RG_LD(base + tl0 - 2 + i);
#pragma unroll
        for (int i = 0; i < 16; ++i) { const float z = cw0 * xv[i] + cw1 * xv[i + 1] + cw2 * xv[i + 2] + cw3 * xv[i + 3] + cbias; zf[(tl0 + i) * 64 + c] = z; zi[(tl0 + i) * 72 + c] = f2bf(z); }
#undef RG_LD
    }
    __syncthreads();
    const int tl = wid * 16 + fr;
    f32x4 ysum[4];
#pragma unroll
    for (int nb = 0; nb < 4; ++nb) ysum[nb] = (f32x4){0.f, 0.f, 0.f, 0.f};
    f32x4 Ad[2][4], Ud[2][4];
#pragma unroll
    for (int d = 0; d < 2; ++d) {
        f32x4 acc[8];
#pragma unroll
        for (int nb = 0; nb < 8; ++nb) acc[nb] = (f32x4){0.f, 0.f, 0.f, 0.f};
#pragma unroll
        for (int ks = 0; ks < 2; ++ks) {
            const bf16x8 bz = ldfrag(zi, 72, wid * 16, ks * 32, fr, fq);
#pragma unroll
            for (int nb = 0; nb < 8; ++nb) acc[nb] = MFMA(ldfrag(Wi + d * 128 * 72, 72, nb * 16, ks * 32, fr, fq), bz, acc[nb]);
        }
#pragma unroll
        for (int nb = 0; nb < 4; ++nb) {
            const int j0 = nb * 16 + fq * 4;
            const f32x4 z4 = *(const LAS f32x4*)(zf + tl * 64 + j0), br = *(const LAS f32x4*)(cst + (d * 3 + 0) * 64 + j0), bi4 = *(const LAS f32x4*)(cst + (d * 3 + 1) * 64 + j0), sp = *(const LAS f32x4*)(cst + (d * 3 + 2) * 64 + j0);
#pragma unroll
            for (int j = 0; j < 4; ++j) {
                const float rg = __builtin_amdgcn_rcpf(1.0f + __builtin_amdgcn_exp2f(fmaf(acc[nb][j], -1.4426950408889634f, br[j])));
                const float ig = __builtin_amdgcn_rcpf(1.0f + __builtin_amdgcn_exp2f(fmaf(acc[nb + 4][j], -1.4426950408889634f, bi4[j])));
                const float av = __builtin_amdgcn_exp2f(rg * sp[j]);
                Ad[d][nb][j] = av; Ud[d][nb][j] = __builtin_amdgcn_sqrtf(fmaxf(fmaf(-av, av, 1.0f), 0.f)) * (ig * z4[j]);
            }
        }
#pragma unroll
        for (int nb = 0; nb < 4; ++nb)
#pragma unroll
            for (int j = 0; j < 4; ++j) { float A = Ad[d][nb][j], U = Ud[d][nb][j]; if (d == 0) scan16<0>(A, U); else scan16<1>(A, U); Ad[d][nb][j] = A; Ud[d][nb][j] = U; }
        if (fr == (d ? 0 : 15)) {
#pragma unroll
            for (int nb = 0; nb < 4; ++nb) { *(LAS f32x4*)(wagg + ((d * 8 + wid) * 2 + 0) * 64 + nb * 16 + fq * 4) = Ad[d][nb]; *(LAS f32x4*)(wagg + ((d * 8 + wid) * 2 + 1) * 64 + nb * 16 + fq * 4) = Ud[d][nb]; }
        }
    }
    __syncthreads();
    {
        bf16_t* PF = (bf16_t*)(a.ws + WS_RGPF) + ((size_t)(segbase + base + tl) * 384 + hd * 64) * 4;
#pragma unroll
        for (int nb = 0; nb < 4; ++nb) {
            const int j0 = nb * 16 + fq * 4;
            f32x4 Ap[2], Up[2];
#pragma unroll
            for (int d = 0; d < 2; ++d) {
                f32x4 Aw = (f32x4){1.f, 1.f, 1.f, 1.f}, Uw = (f32x4){0.f, 0.f, 0.f, 0.f};
                for (int w2 = 0; w2 < 7; ++w2) { const int w = d ? 7 - w2 : w2; if (d ? (w > wid) : (w < wid)) { const f32x4 aw = *(const LAS f32x4*)(wagg + ((d * 8 + w) * 2 + 0) * 64 + j0), uw = *(const LAS f32x4*)(wagg + ((d * 8 + w) * 2 + 1) * 64 + j0); Uw = aw * Uw + uw; Aw = Aw * aw; } }
                Ap[d] = Aw * Ad[d][nb]; Up[d] = Ad[d][nb] * Uw + Ud[d][nb];
            }
            u32x4 w0, w1;
            w0.x = cvt_pk_bf16(Ap[0][0], Up[0][0]); w0.y = cvt_pk_bf16(Ap[1][0], Up[1][0]); w0.z = cvt_pk_bf16(Ap[0][1], Up[0][1]); w0.w = cvt_pk_bf16(Ap[1][1], Up[1][1]);
            w1.x = cvt_pk_bf16(Ap[0][2], Up[0][2]); w1.y = cvt_pk_bf16(Ap[1][2], Up[1][2]); w1.z = cvt_pk_bf16(Ap[0][3], Up[0][3]); w1.w = cvt_pk_bf16(Ap[1][3], Up[1][3]);
            *(u32x4*)(PF + j0 * 4) = w0; *(u32x4*)(PF + j0 * 4 + 8) = w1;
        }
        if (tid < 128) { const int dd = tid >> 6, cc = tid & 63; float A = 1.f, U = 0.f;
#pragma unroll
            for (int w2 = 0; w2 < 8; ++w2) { const int w = dd ? 7 - w2 : w2; const float aw = wagg[((dd * 8 + w) * 2 + 0) * 64 + cc], uw = wagg[((dd * 8 + w) * 2 + 1) * 64 + cc]; U = aw * U + uw; A *= aw; }
            const int np = dd ? nc - 1 - n : n, step = isctx ? np : 2 + np; float* ag = AGG + ((size_t)((b * 6 + hd) * 2 + dd) * 18 + step) * 128 + cc;
            ag[0] = A; ag[64] = U; }
    }
}

__device__ __forceinline__ void rgc_unit(const Args& a, LAS unsigned char* lds, int l, int b, int hd, int cidx) {
    const int tid = opaque_tid();
    LAS float* hin = (LAS float*)lds;
    const bf16_t* P = (const bf16_t*)(a.ws + WS_P); bf16_t* MIX = (bf16_t*)(a.ws + WS_MIX); const float* AGG = (const float*)(a.ws + WS_RGAGG);
    const bool isctx = cidx >= 16; const int n = isctx ? cidx - 16 : cidx, nc = isctx ? 2 : 16, rowbase = (isctx ? NLAT + b * CTXL : b * SEQ) + n * 128;
    __syncthreads();
    if (tid < 128) { const int dd = tid >> 6, cc = tid & 63;
        const int np = dd ? nc - 1 - n : n, step = isctx ? np : 2 + np; const float* ag = AGG + (size_t)((b * 6 + hd) * 2 + dd) * 18 * 128 + cc;
        float Av[17], Uv[17];
#pragma unroll
        for (int s2 = 0; s2 < 17; ++s2) { Av[s2] = 1.f; Uv[s2] = 0.f; if (s2 < step) { Av[s2] = ag[s2 * 128]; Uv[s2] = ag[s2 * 128 + 64]; } }
        float hv = 0.f;
#pragma unroll
        for (int s2 = 0; s2 < 17; ++s2) hv = Av[s2] * hv + Uv[s2];
        hin[dd * 64 + cc] = hv; }
    __syncthreads();
    const int c4 = (tid & 15) * 4;
    const f32x4 hf = *(const LAS f32x4*)(hin + c4), hb = *(const LAS f32x4*)(hin + 64 + c4);
#pragma unroll
    for (int i = 0; i < 4; ++i) {
        const size_t row = (size_t)rowbase + (tid >> 4) + 32 * i;
        const bf16_t* pf = (const bf16_t*)(a.ws + WS_RGPF) + (row * 384 + hd * 64 + c4) * 4;
        const u32x4 w0 = *(const u32x4*)pf, w1 = *(const u32x4*)(pf + 8);
        const u32x2 gw = *(const u32x2*)(P + row * PW + PC_RG + hd * 64 + c4);
        const unsigned ww[8] = {w0.x, w0.y, w0.z, w0.w, w1.x, w1.y, w1.z, w1.w};
        float y[4];
#pragma unroll
        for (int j = 0; j < 4; ++j) y[j] = __uint_as_float(ww[2 * j] << 16) * hf[j] + __uint_as_float(ww[2 * j] & 0xffff0000u) + __uint_as_float(ww[2 * j + 1] << 16) * hb[j] + __uint_as_float(ww[2 * j + 1] & 0xffff0000u);
        u32x2 o; o.x = cvt_pk_bf16(__uint_as_float(gw.x << 16) * y[0], __uint_as_float(gw.x & 0xffff0000u) * y[1]); o.y = cvt_pk_bf16(__uint_as_float(gw.y << 16) * y[2], __uint_as_float(gw.y & 0xffff0000u) * y[3]);
        *(u32x2*)(MIX + row * 1024 + hd * 64 + c4) = o;
    }
}

__device__ __forceinline__ void gmlp_unit(const Args& a, LAS unsigned char* lds, int l, int chunk) {
    const int tid = opaque_tid(), wid = __builtin_amdgcn_readfirstlane(tid >> 6), lane = tid & 63, fr = lane & 15, fq = lane >> 4;
    LAS bf16_t* vn = (LAS bf16_t*)lds;
    const bf16_t* P = (const bf16_t*)(a.ws + WS_P); bf16_t* MIX = (bf16_t*)(a.ws + WS_MIX);
    const int row0 = chunk * 128;
    __syncthreads();
    {
        const f32x4 g = *(const f32x4*)(a.in[I_CMNG] + l * 256 + lane * 4);
        u32x2 wv[16];
#pragma unroll
        for (int i = 0; i < 16; ++i) wv[i] = *(const u32x2*)(P + (size_t)(row0 + wid * 16 + i) * PW + PC_CV + lane * 4);
#pragma unroll
        for (int i = 0; i < 16; ++i) {
            const int s = wid * 16 + i;
            const u32x2 w = wv[i];
            const float v0 = __uint_as_float(w.x << 16), v1 = __uint_as_float(w.x & 0xffff0000u), v2 = __uint_as_float(w.y << 16), v3 = __uint_as_float(w.y & 0xffff0000u);
            const float ss = wave_sum(v0 * v0 + v1 * v1 + v2 * v2 + v3 * v3);
            const float rstd = rsqrtf(ss * (1.0f / 256.0f) + EPS);
            u32x2 o; o.x = cvt_pk_bf16(v0 * rstd * g[0], v1 * rstd * g[1]); o.y = cvt_pk_bf16(v2 * rstd * g[2], v3 * rstd * g[3]);
            *(LAS u32x2*)(vn + s * 264 + lane * 4) = o;
        }
    }
    __syncthreads();
    const int g = wid >> 1, th = wid & 1;
    const float* ws = a.in[I_CMW] + ((size_t)(l * 4 + g) * 128) * 128;
    f32x4 acc[4][4];
#pragma unroll
    for (int m = 0; m < 4; ++m)
#pragma unroll
        for (int n = 0; n < 4; ++n) acc[m][n] = (f32x4){0.f, 0.f, 0.f, 0.f};
#pragma unroll
    for (int ks = 0; ks < 4; ++ks) {
        bf16x8 bw[4];
#pragma unroll
        for (int m = 0; m < 4; ++m) {
            const float* wp = ws + (size_t)(th * 64 + m * 16 + fr) * 128 + ks * 32 + fq * 8;
            const f32x4 w0 = *(const f32x4*)wp, w1 = *(const f32x4*)(wp + 4);
            u32x4 pk; pk.x = cvt_pk_bf16(w0[0], w0[1]); pk.y = cvt_pk_bf16(w0[2], w0[3]); pk.z = cvt_pk_bf16(w1[0], w1[1]); pk.w = cvt_pk_bf16(w1[2], w1[3]);
            bw[m] = __builtin_bit_cast(bf16x8, pk);
        }
#pragma unroll
        for (int n = 0; n < 4; ++n) {
            const bf16x8 av = trfrag(vn, 264, ks * 32, g * 64 + n * 16, fr, fq);
#pragma unroll
            for (int m = 0; m < 4; ++m) acc[m][n] = MFMA(av, bw[m], acc[m][n]);
        }
    }
#pragma unroll
    for (int m = 0; m < 4; ++m) {
        const int t = th * 64 + m * 16 + fr; const float bsv = a.in[I_CMB][(l * 4 + g) * 128 + t];
#pragma unroll
        for (int n = 0; n < 4; ++n) {
            const int cc = g * 64 + n * 16 + fq * 4;
            const u32x2 uw = *(const u32x2*)(P + (size_t)(row0 + t) * PW + PC_CU + cc);
            const float u0 = __uint_as_float(uw.x << 16), u1 = __uint_as_float(uw.x & 0xffff0000u), u2 = __uint_as_float(uw.y << 16), u3 = __uint_as_float(uw.y & 0xffff0000u);
            u32x2 o; o.x = cvt_pk_bf16(u0 * (acc[m][n][0] + bsv), u1 * (acc[m][n][1] + bsv)); o.y = cvt_pk_bf16(u2 * (acc[m][n][2] + bsv), u3 * (acc[m][n][3] + bsv));
            *(u32x2*)(MIX + (size_t)(row0 + t) * 1024 + 768 + cc) = o;
        }
    }
}

#define MX_NEXT(head) ({ __syncthreads(); if (tid == 0) *qv = (int)atomicAdd(q + (head) * 64, 1u); __syncthreads(); *qv; })
__device__ __forceinline__ void phase_mxa(const Args& a, LAS unsigned char* lds, int l) {
    unsigned* q = (unsigned*)(a.ws + WS_CTL + CTL_QUEUE) + l * 8 * 64; LAS int* qv = (LAS int*)(lds + LDS_BARW - 16); const int tid = opaque_tid();
    const int nch = (l == 0) ? 18 : 18;
    for (;;) { const int u = MX_NEXT(0); if (u >= 128) break; ms_unit(a, lds, l, u >> 3, (u >> 1) & 3, u & 1); }
    for (;;) { const int u = MX_NEXT(1); if (u >= 16 * 6 * nch) break; rg_unit<false>(a, lds, l, u / (6 * nch), (u / nch) % 6, u % nch); }
    const int ngm = (l == 0 ? TOK : NLAT) / 128;
    for (;;) { const int u = MX_NEXT(2); if (u >= ngm) break; gmlp_unit(a, lds, l, u); }
}
__device__ __forceinline__ void phase_mxc(const Args& a, LAS unsigned char* lds, int l) {
    unsigned* q = (unsigned*)(a.ws + WS_CTL + CTL_QUEUE) + l * 8 * 64; LAS int* qv = (LAS int*)(lds + LDS_BARW - 16); const int tid = opaque_tid();
    const int nch = (l == 0) ? 18 : 16;
    for (;;) { const int u = MX_NEXT(3); if (u >= 16 * 4 * nch) break; mo_unit(a, lds, l, u / (4 * nch), (u / nch) & 3, u % nch); }
    for (;;) { const int u = MX_NEXT(4); if (u >= 16 * 6 * nch) break; rgc_unit(a, lds, l, u / (6 * nch), (u / nch) % 6, u % nch); }
}
#undef MX_NEXT

constexpr int N_PHASES = 22;
__global__ void __launch_bounds__(NTHREADS, 2) fwd_kernel(Args a) {
    extern __shared__ __attribute__((aligned(16))) unsigned char lds_raw[];
    LAS unsigned char* lds = (LAS unsigned char*)lds_raw;
    const int lo = a.ph_lo, hi = a.ph_hi;
    XcdBarrier bar; bar.bar = (unsigned*)(a.ws + WS_CTL); bar.x = 0; bar.st = (volatile LAS unsigned*)(lds + LDS_BARW);
    if (hi - lo > 1) {
        if (threadIdx.x == 0) { *(LAS u32x4*)(lds + LDS_BARW) = (u32x4){0u, 0u, 0u, 0u}; }
        __syncthreads();
        bar = xcd_barrier_post((unsigned*)(a.ws + WS_CTL), (volatile LAS unsigned*)(lds + LDS_BARW));
    }
#ifndef PHSEL
#define PHSEL 0xFFF
#endif
#define SELJ(j) (((PHSEL) >> (j)) & 1)
#define IN(k) (lo <= (k) && (k) < hi)
#ifndef PROBE_MASK
#define PROBE_MASK 0u
#endif
    unsigned long long t_ph = PROBE_MASK ? __builtin_amdgcn_s_memrealtime() : 0ull;
#define SEAM(k) do { if (IN(k) && IN((k) + 1)) xcd_barrier(bar); \
    if (PROBE_MASK) { if (((PROBE_MASK) >> (k)) & 1u) { const unsigned long long t1 = __builtin_amdgcn_s_memrealtime(); while (__builtin_amdgcn_s_memrealtime() < t1 + (t1 - t_ph)) __builtin_amdgcn_s_sleep(4); } \
        __syncthreads(); t_ph = __builtin_amdgcn_s_memrealtime(); } } while (0)
    if (SELJ(10) && IN(0)) { p0_mod(a, lds); p0_conv(a, lds); }
    SEAM(0);
    for (int l = 0; l < 2; ++l) {
        const int pb = 1 + 10 * l, T = (l == 0) ? TOK : NLAT;
        if (SELJ(0) && IN(pb + 0)) phase_n1(a, l);
        SEAM(pb + 0);
        if (SELJ(1) && IN(pb + 1)) phase_g1(a, lds, l);
        SEAM(pb + 1);
        if (SELJ(2) && IN(pb + 2)) phase_mxa(a, lds, l);
        SEAM(pb + 2);
        if (SELJ(3) && IN(pb + 3)) phase_mxc(a, lds, l);
        SEAM(pb + 3);
        if (SELJ(4) && IN(pb + 4)) phase_g2(a, lds, l, T);
        SEAM(pb + 4);
        if (SELJ(5) && IN(pb + 5)) phase_n2(a, l, T);
        SEAM(pb + 5);
        if (SELJ(6) && IN(pb + 6)) phase_rt(a, lds, l, T);
        SEAM(pb + 6);
        if (SELJ(7) && IN(pb + 7)) phase_tk(a, lds, l, T);
        SEAM(pb + 7);
        if (SELJ(8) && IN(pb + 8)) phase_e1(a, lds, l, T);
        SEAM(pb + 8);
        if (SELJ(9) && IN(pb + 9)) phase_e2(a, lds, l, T);
        SEAM(pb + 9);
    }
    if (SELJ(11) && IN(21)) phase_fin(a);
#undef IN
#undef SEAM
}

extern "C" void kernel_launch(void* const* d_in, const int* in_sizes, int n_in, void* d_out, int out_size, void* d_ws, size_t ws_size, hipStream_t stream) {
    static int grid = 0;
    if (grid == 0) {
        if (n_in != 29 || out_size != NLAT * D || ws_size < WS_END) { fprintf(stderr, "kernel_launch: unexpected shapes (n_in %d, out %d, ws %zu, need %zu)\n", n_in, out_size, ws_size, (size_t)WS_END); grid = -1; return; }
        int dev = 0, cus = 0, per_cu = 0;
        if (hipGetDevice(&dev) != hipSuccess || hipDeviceGetAttribute(&cus, hipDeviceAttributeMultiprocessorCount, dev) != hipSuccess) { grid = -1; return; }
        if (hipFuncSetAttribute((const void*)fwd_kernel, hipFuncAttributeMaxDynamicSharedMemorySize, LDS_BYTES) != hipSuccess) { fprintf(stderr, "kernel_launch: hipFuncSetAttribute failed\n"); grid = -1; return; }
        if (hipOccupancyMaxActiveBlocksPerMultiprocessor(&per_cu, (const void*)fwd_kernel, NTHREADS, LDS_BYTES) != hipSuccess || per_cu < 1) { fprintf(stderr, "kernel_launch: occupancy query says %d\n", per_cu); (void)hipGetLastError(); grid = -1; return; }
        grid = cus;
    }
    if (grid < 0) return;
    (void)hipMemsetAsync((char*)d_ws + WS_CTL, 0, CTL_BYTES, stream);
    Args a{};
    for (int i = 0; i < 29; ++i) a.in[i] = (const float*)d_in[i];
    a.out = (float*)d_out; a.ws = (unsigned char*)d_ws;
#if MK_PER_PHASE
    for (int p = 0; p < N_PHASES; ++p) { a.ph_lo = p; a.ph_hi = p + 1; hipLaunchKernelGGL(fwd_kernel, dim3(grid), dim3(NTHREADS), LDS_BYTES, stream, a); }
#else
    a.ph_lo = 0; a.ph_hi = N_PHASES;
    hipLaunchKernelGGL(fwd_kernel, dim3(grid), dim3(NTHREADS), LDS_BYTES, stream, a);
#endif
}
```

```cpp
#include <hip/hip_runtime.h>
#include <cstdio>
#include <cstdint>

#ifndef MK_PER_PHASE
#define MK_PER_PHASE 0
#endif

#define LAS __attribute__((address_space(3)))
typedef unsigned short bf16_t;
typedef short bf16x8 __attribute__((ext_vector_type(8)));
typedef float f32x4 __attribute__((ext_vector_type(4)));
typedef float f32x2 __attribute__((ext_vector_type(2)));
typedef unsigned u32x4 __attribute__((ext_vector_type(4)));
typedef unsigned u32x2 __attribute__((ext_vector_type(2)));

constexpr int D = 1024, NBATCH = 16, SEQ = 2048, CTXL = 256;
constexpr int NLAT = NBATCH * SEQ, NCTX = NBATCH * CTXL, TOK = NLAT + NCTX;
constexpr int DIN = 2832, PW = 2816, NIN = 3072;
constexpr int NE = 256, FF = 288, NSLOT = 9, LCAP = TOK;
constexpr int NTHREADS = 512;
constexpr int LDS_BYTES = 147456;
constexpr int LDS_TAB = 139264;
constexpr int LDS_BARW = LDS_BYTES - 16;
constexpr float EPS = 1e-6f;

constexpr int PC_RX = 0, PC_RG = 384, PC_Q = 768, PC_K = 1152, PC_V = 1536, PC_O = 1920, PC_CU = 2304, PC_CV = 2560;

constexpr size_t WS_CTL = 0, CTL_BYTES = 131072;
constexpr size_t CTL_QUEUE = 16384, CTL_CNT = 32768;
constexpr int CNT_STRIDE = 32;
constexpr size_t WS_MOD = 131072;
constexpr size_t WS_X = WS_MOD + 1048576;
constexpr size_t WS_XA = WS_X + (size_t)TOK * D * 4;
constexpr size_t WS_R1 = WS_XA + (size_t)TOK * D * 2;
constexpr size_t R1_BYTES = (size_t)TOK * NSLOT * D * 2;
constexpr size_t WS_P = WS_R1;
constexpr size_t WS_MIX = WS_P + (size_t)TOK * PW * 2;
constexpr size_t WS_CTG = WS_MIX + (size_t)TOK * D * 2;
constexpr size_t WS_MST = WS_CTG + (size_t)128 * 18 * 112 * 96 * 2;
constexpr size_t WS_RGAGG = WS_MST + 16384;
constexpr size_t WS_RGPF = WS_RGAGG + (size_t)192 * 18 * 128 * 4;
static_assert(WS_RGPF + (size_t)TOK * 384 * 4 * 2 <= WS_R1 + R1_BYTES, "aliases");
constexpr int HB_ROWS = (TOK * 8 / 256 + 256 + TOK / 256) * 256;
constexpr size_t WS_HB = WS_R1 + R1_BYTES;
constexpr size_t WS_GATES = WS_HB + (size_t)HB_ROWS * FF * 2 + 256;
constexpr size_t WS_LOGITS = WS_GATES + (size_t)TOK * 16 * 4;
constexpr size_t WS_LSLOT = WS_LOGITS + (size_t)TOK * 256 * 4;
constexpr size_t WS_LW = WS_LSLOT + (size_t)NE * LCAP * 4;
constexpr size_t WS_WIN = WS_LW + (size_t)NE * LCAP * 4;
constexpr size_t WS_WOUT = WS_WIN + (size_t)2 * NIN * D * 2;
constexpr size_t WS_ROUT = WS_WOUT + (size_t)2 * D * D * 2;
constexpr size_t WS_RGWT = WS_ROUT + (size_t)2 * NE * D * 2;
constexpr size_t WS_END = WS_RGWT + (size_t)2 * 2 * 6 * 128 * 64 * 2;

__device__ __forceinline__ float bf2f(bf16_t b) { return __uint_as_float(((unsigned)b) << 16); }
__device__ __forceinline__ unsigned cvt_pk_bf16(float lo, float hi) { unsigned r; asm volatile("v_cvt_pk_bf16_f32 %0, %1, %2" : "=v"(r) : "v"(lo), "v"(hi)); return r; }
__device__ __forceinline__ bf16_t f2bf(float f) { return (bf16_t)(cvt_pk_bf16(f, 0.f) & 0xffffu); }
__device__ __forceinline__ float sigmoidf_(float x) { return __builtin_amdgcn_rcpf(1.0f + __expf(-x)); }
__device__ __forceinline__ float siluf_(float x) { return x * __builtin_amdgcn_rcpf(1.0f + __expf(-x)); }
__device__ __forceinline__ float gelu_tanh(float x) { const float u = 1.5957691216057308f * (x + 0.044715f * x * x * x); return x * __builtin_amdgcn_rcpf(1.0f + __expf(-u)); }
__device__ __forceinline__ float wave_sum(float v) {
#pragma unroll
    for (int o = 32; o >= 1; o >>= 1) v += __shfl_xor(v, o);
    return v;
}
__device__ __forceinline__ int opaque_tid() { int t = threadIdx.x; asm volatile("" : "+v"(t)); return t; }
#define WAIT_VM0() asm volatile("s_waitcnt vmcnt(0)" ::: "memory")

#define XB_TMO      128
#define XB_XCNT(j)  (256  + 64 * (j))
#define XB_XSUB(j)  (1280 + 64 * (j))
#define XB_XGEN(j)  (2304 + 64 * (j))
#define XB_TOP      3328
#define XB_TOPGEN   3392
#define XCD_BAR_WORDS 3456
#define XB_SPIN_CAP (1u << 18)

__device__ __forceinline__ unsigned xb_ld(unsigned* p)              { return __hip_atomic_load(p, __ATOMIC_RELAXED, __HIP_MEMORY_SCOPE_AGENT); }
__device__ __forceinline__ unsigned xb_add(unsigned* p, unsigned v) { return __hip_atomic_fetch_add(p, v, __ATOMIC_RELAXED, __HIP_MEMORY_SCOPE_AGENT); }
__device__ __forceinline__ unsigned xb_xcc_id() { return (unsigned)__builtin_amdgcn_s_getreg((3 << 11) | 20) & 0xFu; }
#define XB_SPIN(cond, bar) do { unsigned _sp = 0; while (cond) { __builtin_amdgcn_s_sleep(1); \
    if ((++_sp & 255u) == 0u) { if (xb_ld(&(bar)[XB_TMO])) break; if (_sp > XB_SPIN_CAP) { atomicAdd(&(bar)[XB_TMO], 1u); break; } } } } while (0)

struct XcdBarrier { unsigned* bar; unsigned x; volatile LAS unsigned* st; };

__device__ __forceinline__ XcdBarrier xcd_barrier_post(unsigned* bar, volatile LAS unsigned* st) {
    XcdBarrier b; b.bar = bar; b.x = xb_xcc_id(); b.st = st;
    if (threadIdx.x == 0) (void)xb_add(&bar[XB_XCNT(b.x)], 1u);
    return b;
}
__device__ __forceinline__ void xcd_barrier_complete(unsigned* bar, unsigned x, unsigned& nloc, unsigned& nx) {
    const unsigned G = gridDim.x * gridDim.y * gridDim.z;
    unsigned sum, cnt, mine, sp = 0u;
    for (;;) {
        sum = 0u; cnt = 0u; mine = 0u;
#pragma unroll
        for (unsigned j = 0; j < 16; ++j) { const unsigned c = xb_ld(&bar[XB_XCNT(j)]); sum += c; cnt += (c > 0u) ? 1u : 0u; mine = (j == x) ? c : mine; }
        if (sum == G) break;
        __builtin_amdgcn_s_sleep(1);
        if ((++sp & 255u) == 0u) { if (xb_ld(&bar[XB_TMO])) break; if (sp > XB_SPIN_CAP) { atomicAdd(&bar[XB_TMO], 1u); break; } }
    }
    nloc = mine > 0u ? mine : 1u; nx = cnt > 0u ? cnt : 1u;
}
__device__ __forceinline__ void xcd_barrier(const XcdBarrier& b) {
    asm volatile("s_waitcnt vmcnt(0)" ::: "memory");
    __syncthreads();
    if (threadIdx.x == 0) {
        unsigned* bar = b.bar;
        __builtin_amdgcn_s_waitcnt(0);
        unsigned nloc = b.st[0], nx = b.st[1];
        if (nloc == 0u) { xcd_barrier_complete(bar, b.x, nloc, nx); b.st[0] = nloc; b.st[1] = nx; }
        const unsigned old = xb_add(&bar[XB_XSUB(b.x)], 1u);
        const unsigned gen = old / nloc;
        if (old + 1u == (gen + 1u) * nloc) {
            __builtin_amdgcn_fence(__ATOMIC_RELEASE, "agent");
            asm volatile("s_waitcnt vmcnt(0)" ::: "memory");
            const unsigned og = xb_add(&bar[XB_TOP], 1u);
            const unsigned tg = og / nx;
            if (og + 1u == (tg + 1u) * nx) xb_add(&bar[XB_TOPGEN], 1u);
            else XB_SPIN(xb_ld(&bar[XB_TOPGEN]) == tg, bar);
            __builtin_amdgcn_fence(__ATOMIC_ACQUIRE, "agent");
            xb_add(&bar[XB_XGEN(b.x)], 1u);
            asm volatile("s_waitcnt vmcnt(0)" ::: "memory");
        } else {
            XB_SPIN(xb_ld(&bar[XB_XGEN(b.x)]) == gen, bar);
            __builtin_amdgcn_fence(__ATOMIC_ACQUIRE, "agent");
            asm volatile("s_waitcnt vmcnt(0)" ::: "memory");
        }
    }
    __syncthreads();
}

struct Args { const float* in[29]; float* out; unsigned char* ws; int ph_lo, ph_hi; };
enum { I_X = 0, I_C, I_CTX, I_CCTX, I_N1G, I_N2G, I_WMOD, I_BMOD, I_WIN, I_RGCW, I_RGCB, I_RGGW, I_RGGB, I_RGLAM, I_MGB, I_MNG, I_CMNG, I_CMW, I_CMB,
       I_WOUT, I_RW, I_RB, I_EG, I_EU, I_ED, I_SG, I_SU, I_SD, I_FNG };

__device__ __forceinline__ int lds_byte(int r, int c) { const int st = (r >> 4) * 2 + (c >> 5), ob = (r & 15) * 64 + (c & 31) * 2; return st * 1024 + (ob ^ (((ob >> 9) & 1) << 5)); }
__device__ __forceinline__ void stage_rc(int b, int& R, int& C) { const int st = b >> 10, sb = b & 1023, swz = sb ^ (((sb >> 9) & 1) << 5); R = (st >> 1) * 16 + (swz >> 6); C = (st & 1) * 32 + ((swz & 63) >> 1); }

template <int BN, int WC> struct GT { static constexpr int WR = 8 / WC, MF = 256 / WR / 16, NF = BN / WC / 16, BP = BN / 64; };

typedef short s16x4 __attribute__((ext_vector_type(4)));
__device__ __forceinline__ bf16x8 trfrag(const LAS bf16_t* img, int pitch, int k0, int n0, int fr, int fq) {
    const LAS bf16_t* p = img + (k0 + 8 * fq + (fr >> 2)) * pitch + n0 + 4 * (fr & 3);
    const s16x4 lo = __builtin_amdgcn_ds_read_tr16_b64_v4i16((LAS s16x4*)p), hi = __builtin_amdgcn_ds_read_tr16_b64_v4i16((LAS s16x4*)(p + 4 * pitch));
    return __builtin_shufflevector(lo, hi, 0, 1, 2, 3, 4, 5, 6, 7);
}

constexpr int RS_SLOT = 34816, RS_BOFF = 16384;
struct RSeg { const unsigned char* Ab; unsigned aoff[2]; const float* B0; const float* B1; };
template <int BN, int WC, bool DUAL, bool GATHER, int NSET, class PV>
__device__ __forceinline__ void ring_gemm(LAS unsigned char* lds, PV& pv, const int ns, const int ldb, const unsigned ca0, const unsigned ca1) {
    constexpr int MF = GT<BN, WC>::MF, NF = GT<BN, WC>::NF, PITCH = BN == 192 ? 200 : 280, LPS = BN / 64, VPR = BN / 4;
    const int tid = opaque_tid(), wid = __builtin_amdgcn_readfirstlane(tid >> 6), lane = tid & 63, fr = lane & 15, fq = lane >> 4;
    const int wr = wid / WC, wc = wid % WC;
    const int obA = fr * 64 + fq * 16;
    const int aro = (wr * MF) * 1024 + (obA ^ (((obA >> 9) & 1) << 5));
    const unsigned ldsb = (unsigned)(size_t)lds + (unsigned)(RS_BOFF + ((8 * fq + (fr >> 2)) * PITCH + (DUAL ? 4 * (fr & 3) + wc * 48 : 16 * (fr & 3) + wc * (NF * 16))) * 2);
    constexpr int NTB = DUAL ? LPS : 1;
    unsigned bsoff_[NTB]; unsigned bdst_[NTB];
    bool bsel_[NTB];
#pragma unroll
    for (int i = 0; i < NTB; ++i) { const int e = tid + 512 * i, row = e / VPR, c4 = e % VPR; bsel_[i] = DUAL && c4 >= 24; bsoff_[i] = (unsigned)(row * ldb + 4 * (DUAL ? c4 % 24 : c4));
        bdst_[i] = (unsigned)(size_t)lds + (unsigned)(RS_BOFF + (row * PITCH + 4 * c4) * 2); }
#define bsoff(i) (DUAL ? bsoff_[DUAL ? (i) : 0] : bsoff_[0] + (unsigned)(8 * (i) * ldb))
#define bdst(i) (DUAL ? bdst_[DUAL ? (i) : 0] : bdst_[0] + (unsigned)(8 * (i) * PITCH * 2))
#define bsel(i) (DUAL ? bsel_[DUAL ? (i) : 0] : false)
    f32x4 acc[MF][NF];
#pragma unroll
    for (int m = 0; m < MF; ++m)
#pragma unroll
        for (int n = 0; n < NF; ++n) acc[m][n] = (f32x4){0.f, 0.f, 0.f, 0.f};
    RSeg ss, nx; int si = 0, sj = 0;
    bool have = pv.seg(0, ss); if (!have) return;
    pv.finish(ss, true);
    bool have_nx = pv.seg(1, nx);
    int staged = 0, g = 0, ci = 0, cj = 0;
    f32x4 r0[LPS], r1[NSET == 2 ? LPS : 1];
#define RS_STAGEA() do { _Pragma("unroll") for (int _i = 0; _i < 2; ++_i) __builtin_amdgcn_global_load_lds((const unsigned*)(ss.Ab + (GATHER ? ss.aoff[_i] : (_i ? ca1 : ca0)) + (size_t)sj * 64), (LAS unsigned*)(lds + (staged & 3) * RS_SLOT + (wid + 8 * _i) * 1024), 16, 0, 0); } while (0)
#define RS_LOADB(rr) do { _Pragma("unroll") for (int _i = 0; _i < LPS; ++_i) { const float* _p = (bsel(_i) ? ss.B1 : ss.B0) + bsoff(_i) + (size_t)(sj * 32) * ldb; \
        asm volatile("global_load_dwordx4 %0, %1, off" : "=&v"(rr[_i]) : "v"(_p)); } } while (0)
#define RS_WAITB(rr, steady) do { if (steady) { if (NSET == 1) asm volatile("s_waitcnt vmcnt(2)" ::: "memory"); else if (LPS == 3) asm volatile("s_waitcnt vmcnt(7)" ::: "memory"); else asm volatile("s_waitcnt vmcnt(8)" ::: "memory"); } else asm volatile("s_waitcnt vmcnt(0)" ::: "memory"); \
        __builtin_amdgcn_sched_barrier(0);        \
        if (LPS == 3) asm volatile("" : "+v"(rr[0]), "+v"(rr[1]), "+v"(rr[2])); else asm volatile("" : "+v"(rr[0]), "+v"(rr[1]), "+v"(rr[2]), "+v"(rr[LPS > 3 ? 3 : 0])); } while (0)
#define RS_WRITEB(rr, slot) do { _Pragma("unroll") for (int _i = 0; _i < LPS; ++_i) { u32x2 _w; _w.x = cvt_pk_bf16(rr[_i][0], rr[_i][1]); _w.y = cvt_pk_bf16(rr[_i][2], rr[_i][3]); \
        asm volatile("ds_write_b64 %0, %1" :: "v"(bdst(_i) + (unsigned)((slot) * RS_SLOT)), "v"(_w) : "memory"); } } while (0)
#define RS_ADVANCE() do { ++staged; if (++sj == ns) { sj = 0; ++si; if (have_nx) pv.finish(nx, false); ss = nx; have = have_nx; have_nx = have ? pv.seg(si + 1, nx) : false; } } while (0)
#define RS_TR(dst, slot, off) asm volatile("ds_read_b64_tr_b16 %0, %1 offset:%2" : "=v"(dst) : "v"(ldsb + (unsigned)((slot) * RS_SLOT)), "n"(off))
#define RS_KSTEP(slot) do { bf16x8 At[MF], Bf[NF]; s16x4 _lo[NF], _hi[NF]; \
        _Pragma("unroll") for (int n = 0; n < NF; ++n) { \
            if (DUAL) { if (n < 3) { RS_TR(_lo[n], slot, (16 * (n % 3)) * 2); RS_TR(_hi[n], slot, (16 * (n % 3) + 4 * PITCH) * 2); } else { RS_TR(_lo[n], slot, (96 + 16 * (n % 3)) * 2); RS_TR(_hi[n], slot, (96 + 16 * (n % 3) + 4 * PITCH) * 2); } } \
            else { RS_TR(_lo[n], slot, (4 * n) * 2); RS_TR(_hi[n], slot, (4 * n + 4 * PITCH) * 2); } } \
        _Pragma("unroll") for (int m = 0; m < MF; ++m) At[m] = *(const LAS bf16x8*)(lds + (slot) * RS_SLOT + aro + m * 1024); \
        if (NF == 6) asm volatile("s_waitcnt lgkmcnt(0)" : "+v"(_lo[0]), "+v"(_hi[0]), "+v"(_lo[1]), "+v"(_hi[1]), "+v"(_lo[2]), "+v"(_hi[2]), "+v"(_lo[3]), "+v"(_hi[3]), "+v"(_lo[NF > 4 ? 4 : 0]), "+v"(_hi[NF > 4 ? 4 : 0]), "+v"(_lo[NF > 5 ? 5 : 1]), "+v"(_hi[NF > 5 ? 5 : 1])); \
        else asm volatile("s_waitcnt lgkmcnt(0)" : "+v"(_lo[0]), "+v"(_hi[0]), "+v"(_lo[1]), "+v"(_hi[1]), "+v"(_lo[2]), "+v"(_hi[2]), "+v"(_lo[3]), "+v"(_hi[3])); \
        _Pragma("unroll") for (int n = 0; n < NF; ++n) Bf[n] = __builtin_shufflevector(_lo[n], _hi[n], 0, 1, 2, 3, 4, 5, 6, 7); \
        _Pragma("unroll") for (int m = 0; m < MF; ++m) _Pragma("unroll") for (int n = 0; n < NF; ++n) acc[m][n] = __builtin_amdgcn_mfma_f32_16x16x32_bf16(Bf[n], At[m], acc[m][n], 0, 0, 0); __builtin_amdgcn_sched_barrier(0); } while (0)
#define RS_BARRIER() do { asm volatile("s_waitcnt lgkmcnt(0)" ::: "memory"); __builtin_amdgcn_s_barrier(); asm volatile("" ::: "memory"); } while (0)
    if (NSET == 2) {
        RS_STAGEA(); RS_LOADB(r0); RS_WAITB(r0, false); RS_WRITEB(r0, 0); RS_ADVANCE();
        if (have) { RS_STAGEA(); RS_LOADB(r1); RS_ADVANCE(); }
        if (have) { RS_STAGEA(); RS_LOADB(r0); RS_ADVANCE(); }
    } else {
        RS_STAGEA(); RS_LOADB(r0); RS_WAITB(r0, false); RS_WRITEB(r0, 0); RS_ADVANCE();
        if (have) { RS_STAGEA(); RS_LOADB(r0); RS_ADVANCE(); }
    }
    WAIT_VM0(); RS_BARRIER();
#define RS_ITER(rw, STEADY) do { \
        const bool st = have; \
        if (st) RS_STAGEA(); \
        RS_KSTEP(g & 3); \
        if (++cj == ns) { pv.epi(ci, acc); _Pragma("unroll") for (int m = 0; m < MF; ++m) _Pragma("unroll") for (int n = 0; n < NF; ++n) acc[m][n] = (f32x4){0.f, 0.f, 0.f, 0.f}; cj = 0; ++ci; } \
        if (g + 1 < staged) { RS_WAITB(rw, STEADY); RS_WRITEB(rw, (g + 1) & 3); } \
        if (st) { RS_LOADB(rw); RS_ADVANCE(); } \
        st_prev = st; ++g; RS_BARRIER(); } while (0)
    bool st_prev = true;
    if (NSET == 2) {
        for (;;) {
            RS_ITER(r1, st && st_prev); if (g >= staged) break;
            RS_ITER(r0, st && st_prev); if (g >= staged) break;
        }
    } else {
        for (;;) { RS_ITER(r0, st); if (g >= staged) break; }
    }
    WAIT_VM0(); __syncthreads();
#undef RS_STAGEA
#undef RS_LOADB
#undef RS_WAITB
#undef RS_WRITEB
#undef RS_ADVANCE
#undef RS_TR
#undef RS_KSTEP
#undef RS_BARRIER
#undef RS_ITER
#undef bsoff
#undef bdst
#undef bsel
}

__device__ __forceinline__ bf16x8 ldfrag(const LAS bf16_t* img, int pitch, int row0, int k0, int fr, int fq) { return *(const LAS bf16x8*)(img + (row0 + fr) * pitch + k0 + fq * 8); }
#define MFMA(a, b, c) __builtin_amdgcn_mfma_f32_16x16x32_bf16(a, b, c, 0, 0, 0)

__device__ __forceinline__ void p0_mod(const Args& a, LAS unsigned char* lds) {
    { bf16_t* wt = (bf16_t*)(a.ws + WS_RGWT);
      for (int idx = blockIdx.x * NTHREADS + threadIdx.x; idx < 2 * 2 * 2 * 6 * 4096; idx += gridDim.x * NTHREADS) { const int j = idx & 63, i = (idx >> 6) & 63, hd = (idx >> 12) % 6, g = ((idx >> 12) / 6) & 1, ld = (idx >> 12) / 12;
          wt[((size_t)(ld * 6 + hd) * 128 + g * 64 + j) * 64 + i] = f2bf(a.in[I_RGGW][idx]); } }
    LAS float* sc = (LAS float*)lds;
    LAS float* red = (LAS float*)(lds + 69632);
    const int tid = opaque_tid();
    for (int i = tid; i < 17 * 1024; i += NTHREADS) { const int s = i >> 10, k = i & 1023; const float v = s < 16 ? a.in[I_C][s * 1024 + k] : a.in[I_CCTX][k]; sc[i] = siluf_(v); }
    __syncthreads();
    float* MOD = (float*)(a.ws + WS_MOD);
    for (int u = blockIdx.x; u < 192; u += gridDim.x) {
        const int l = u / 96, cb = (u % 96) * 64, col = tid & 63, ks = tid >> 6;
        const float* w = a.in[I_WMOD] + (size_t)l * 1024 * 6144 + cb + col;
        float acc[17];
#pragma unroll
        for (int s = 0; s < 17; ++s) acc[s] = 0.f;
#pragma unroll 4
        for (int k = ks * 128; k < ks * 128 + 128; ++k) {
            const float wv = w[(size_t)k * 6144];
#pragma unroll
            for (int s = 0; s < 17; ++s) acc[s] += sc[s * 1024 + k] * wv;
        }
#pragma unroll
        for (int s = 0; s < 17; ++s) red[(ks * 17 + s) * 64 + col] = acc[s];
        __syncthreads();
        for (int i = tid; i < 17 * 64; i += NTHREADS) {
            const int s = i >> 6, c = i & 63; float v = 0.f;
#pragma unroll
            for (int k2 = 0; k2 < 8; ++k2) v += red[(k2 * 17 + s) * 64 + c];
            MOD[((size_t)l * 17 + s) * 6144 + cb + c] = v + a.in[I_BMOD][l * 6144 + cb + c];
        }
        __syncthreads();
    }
}

template <int KT>
__device__ __forceinline__ void conv_tile(LAS float* tile, const float* p0, const float* p1, const float* p2, const float* p3, int ldn, int k0, bf16_t* dst, int K) {
    const int tid = opaque_tid(), r = tid >> 4, c4 = tid & 15, grp = c4 >> 2, within = (c4 & 3) * 4;
    const float* p = grp == 0 ? p0 : grp == 1 ? p1 : grp == 2 ? p2 : p3;
#pragma unroll
    for (int i = 0; i < KT / 32; ++i) {
        const int k = r + 32 * i; f32x4 v = (f32x4){0.f, 0.f, 0.f, 0.f};
        if (p) v = *(const f32x4*)(p + (size_t)(k0 + k) * ldn + within);
        tile[k * 65 + c4 * 4 + 0] = v[0]; tile[k * 65 + c4 * 4 + 1] = v[1]; tile[k * 65 + c4 * 4 + 2] = v[2]; tile[k * 65 + c4 * 4 + 3] = v[3];
    }
    __syncthreads();
    constexpr int CPR = KT / 16;
    const int row = tid / CPR, ch = tid % CPR;
    if (row < 64) {
        float v[16];
#pragma unroll
        for (int j = 0; j < 16; ++j) v[j] = tile[(ch * 16 + j) * 65 + row];
        u32x4 w0, w1;
        w0.x = cvt_pk_bf16(v[0], v[1]); w0.y = cvt_pk_bf16(v[2], v[3]); w0.z = cvt_pk_bf16(v[4], v[5]); w0.w = cvt_pk_bf16(v[6], v[7]);
        w1.x = cvt_pk_bf16(v[8], v[9]); w1.y = cvt_pk_bf16(v[10], v[11]); w1.z = cvt_pk_bf16(v[12], v[13]); w1.w = cvt_pk_bf16(v[14], v[15]);
        bf16_t* dp = dst + (size_t)row * K + k0 + ch * 16;
        *(u32x4*)dp = w0; *(u32x4*)(dp + 8) = w1;
    }
    __syncthreads();
}

constexpr int CV_WIN = 384, CV_WOUT = 128, CV_ROUT = 32, CV_LAYER = CV_WIN + CV_WOUT + CV_ROUT;
__device__ __forceinline__ void p0_conv(const Args& a, LAS unsigned char* lds) {
    LAS float* tile = (LAS float*)lds;
    for (int u = blockIdx.x; u < 2 * CV_LAYER; u += gridDim.x) {
        const int l = u / CV_LAYER; int j = u % CV_LAYER;
        if (j < CV_WIN) {
            const int rho0 = (j >> 3) * 64, kt = j & 7; const float* src = a.in[I_WIN] + (size_t)l * 1024 * DIN; const float* p[4];
#pragma unroll
            for (int g = 0; g < 4; ++g) { const int rho = rho0 + 16 * g; const int col = rho < 2304 ? rho : rho < 2816 ? rho + 16 : rho < 2832 ? rho - 512 : -1; p[g] = col >= 0 ? src + col : nullptr; }
            conv_tile<128>(tile, p[0], p[1], p[2], p[3], DIN, kt * 128, (bf16_t*)(a.ws + WS_WIN) + ((size_t)l * NIN + rho0) * 1024, 1024);
            continue;
        }
        j -= CV_WIN;
        if (j < CV_WOUT) {
            const int rho0 = (j >> 3) * 64, kt = j & 7; const float* src = a.in[I_WOUT] + (size_t)l * 1024 * 1024 + rho0;
            conv_tile<128>(tile, src, src + 16, src + 32, src + 48, 1024, kt * 128, (bf16_t*)(a.ws + WS_WOUT) + ((size_t)l * 1024 + rho0) * 1024, 1024);
            continue;
        }
        j -= CV_WOUT;
        if (j < CV_ROUT) {
            const int rho0 = (j >> 3) * 64, kt = j & 7; const float* src = a.in[I_RW] + (size_t)l * 1024 * 256 + rho0;
            conv_tile<128>(tile, src, src + 16, src + 32, src + 48, 256, kt * 128, (bf16_t*)(a.ws + WS_ROUT) + ((size_t)l * 256 + rho0) * 1024, 1024);
            continue;
        }
    }
}

__device__ __forceinline__ int sample_of(int row) { return row < NLAT ? (row >> 11) : 16; }

__device__ __forceinline__ void slot_sum(const bf16_t* Y, int row, int lane, f32x4 (&s)[4]) {
#pragma unroll
    for (int ii = 0; ii < 4; ++ii) s[ii] = (f32x4){0.f, 0.f, 0.f, 0.f};
#pragma unroll
    for (int k = 0; k < NSLOT; ++k) {
        const bf16_t* yp = Y + ((size_t)row * NSLOT + k) * 1024 + lane * 4;
#pragma unroll
        for (int ii = 0; ii < 4; ++ii) { const u32x2 w = *(const u32x2*)(yp + ii * 256); s[ii][0] += __uint_as_float(w.x << 16); s[ii][1] += __uint_as_float(w.x & 0xffff0000u); s[ii][2] += __uint_as_float(w.y << 16); s[ii][3] += __uint_as_float(w.y & 0xffff0000u); }
    }
}
__device__ __forceinline__ void norm_mod_store(const f32x4 (&v)[4], const float* g, const float* shift, const float* scale, bf16_t* dst, int lane) {
    float ss = 0.f;
#pragma unroll
    for (int ii = 0; ii < 4; ++ii) ss += v[ii][0] * v[ii][0] + v[ii][1] * v[ii][1] + v[ii][2] * v[ii][2] + v[ii][3] * v[ii][3];
    ss = wave_sum(ss);
    const float rstd = rsqrtf(ss * (1.0f / 1024.0f) + EPS);
#pragma unroll
    for (int ii = 0; ii < 4; ++ii) {
        const int c = ii * 256 + lane * 4;
        const f32x4 gg = *(const f32x4*)(g + c), sh = *(const f32x4*)(shift + c), sc = *(const f32x4*)(scale + c);
        f32x4 y;
#pragma unroll
        for (int j = 0; j < 4; ++j) y[j] = v[ii][j] * rstd * gg[j] * (1.0f + sc[j]) + sh[j];
        u32x2 w; w.x = cvt_pk_bf16(y[0], y[1]); w.y = cvt_pk_bf16(y[2], y[3]);
        *(u32x2*)(dst + c) = w;
    }
}

__device__ __forceinline__ void phase_n1(const Args& a, int l) {
    const int tid = opaque_tid(), wid = tid >> 6, lane = tid & 63;
    float* X = (float*)(a.ws + WS_X); bf16_t* XA = (bf16_t*)(a.ws + WS_XA); const float* MOD = (const float*)(a.ws + WS_MOD); const bf16_t* Y = (const bf16_t*)(a.ws + WS_R1);
    for (int row = blockIdx.x * 8 + wid; row < TOK; row += gridDim.x * 8) {
        const int s = sample_of(row);
        f32x4 v[4];
        if (l == 0) {
            if (row < NLAT) {
                const float* xp = a.in[I_X] + (size_t)row * 1024 + lane * 4;
                const int tp = row & 2047; const float pr = (float)(tp >> 6), pc = (float)(tp & 63);
#pragma unroll
                for (int ii = 0; ii < 4; ++ii) v[ii] = *(const f32x4*)(xp + ii * 256);
#pragma unroll
                for (int j = 0; j < 4; ++j) {
                    const float om = exp2f(-13.287712379549449f * (float)(lane * 4 + j) * (1.0f / 256.0f));
                    const float ar = pr * om, ac = pc * om;
                    v[0][j] += sinf(ar); v[1][j] += cosf(ar); v[2][j] += sinf(ac); v[3][j] += cosf(ac);
                }
            } else {
                const float* xp = a.in[I_CTX] + (size_t)(row - NLAT) * 1024 + lane * 4;
#pragma unroll
                for (int ii = 0; ii < 4; ++ii) v[ii] = *(const f32x4*)(xp + ii * 256);
            }
        } else {
            f32x4 ys[4]; slot_sum(Y, row, lane, ys);
            const float* gate = MOD + ((size_t)(l - 1) * 17 + s) * 6144 + 5 * 1024 + lane * 4;
#pragma unroll
            for (int ii = 0; ii < 4; ++ii) { const f32x4 xv = *(const f32x4*)(X + (size_t)row * 1024 + ii * 256 + lane * 4), gv = *(const f32x4*)(gate + ii * 256); v[ii] = xv + gv * ys[ii]; }
        }
#pragma unroll
        for (int ii = 0; ii < 4; ++ii) *(f32x4*)(X + (size_t)row * 1024 + ii * 256 + lane * 4) = v[ii];
        const float* m = MOD + ((size_t)l * 17 + s) * 6144;
        norm_mod_store(v, a.in[I_N1G] + l * 1024, m, m + 1024, XA + (size_t)row * 1024, lane);
    }
}
__device__ __forceinline__ void phase_n2(const Args& a, int l, int T) {
    const int tid = opaque_tid(), wid = tid >> 6, lane = tid & 63;
    const float* X = (const float*)(a.ws + WS_X); bf16_t* XA = (bf16_t*)(a.ws + WS_XA); const float* MOD = (const float*)(a.ws + WS_MOD);
    for (int row = blockIdx.x * 8 + wid; row < T; row += gridDim.x * 8) {
        const int s = sample_of(row);
        f32x4 v[4];
#pragma unroll
        for (int ii = 0; ii < 4; ++ii) v[ii] = *(const f32x4*)(X + (size_t)row * 1024 + ii * 256 + lane * 4);
        const float* m = MOD + ((size_t)l * 17 + s) * 6144;
        norm_mod_store(v, a.in[I_N2G] + l * 1024, m + 3 * 1024, m + 4 * 1024, XA + (size_t)row * 1024, lane);
    }
}
__device__ __forceinline__ void phase_fin(const Args& a) {
    const int tid = opaque_tid(), wid = tid >> 6, lane = tid & 63;
    const float* X = (const float*)(a.ws + WS_X); const float* MOD = (const float*)(a.ws + WS_MOD); const bf16_t* Y = (const bf16_t*)(a.ws + WS_R1);
    for (int row = blockIdx.x * 8 + wid; row < NLAT; row += gridDim.x * 8) {
        const int s = sample_of(row);
        f32x4 ys[4], v[4]; slot_sum(Y, row, lane, ys);
        const float* gate = MOD + ((size_t)17 + s) * 6144 + 5 * 1024 + lane * 4;
        float ss = 0.f;
#pragma unroll
        for (int ii = 0; ii < 4; ++ii) { const f32x4 xv = *(const f32x4*)(X + (size_t)row * 1024 + ii * 256 + lane * 4), gv = *(const f32x4*)(gate + ii * 256); v[ii] = xv + gv * ys[ii];
            ss += v[ii][0] * v[ii][0] + v[ii][1] * v[ii][1] + v[ii][2] * v[ii][2] + v[ii][3] * v[ii][3]; }
        ss = wave_sum(ss);
        const float rstd = rsqrtf(ss * (1.0f / 1024.0f) + EPS);
#pragma unroll
        for (int ii = 0; ii < 4; ++ii) { const f32x4 g = *(const f32x4*)(a.in[I_FNG] + ii * 256 + lane * 4); *(f32x4*)(a.out + (size_t)row * 1024 + ii * 256 + lane * 4) = v[ii] * rstd * g; }
    }
}

namespace pg8 {
#define PG8_LAS __attribute__((address_space(3)))
typedef unsigned short bf16_t;
typedef short bf16x8 __attribute__((ext_vector_type(8)));
typedef float f32x4 __attribute__((ext_vector_type(4)));
typedef unsigned u32x4 __attribute__((ext_vector_type(4)));
constexpr int BM = 256, BK = 64, HALF = 128, HTB = HALF * BK * 2  , STAGE_BYTES = 8 * HTB, NXCD = 8, WGM = 8;

__host__ __device__ __forceinline__ int lds_byte(int r, int c) { const int st = (r >> 4) * 2 + (c >> 5), rr = r & 15, cc = c & 31, ob = rr * 64 + cc * 2; return st * 1024 + (ob ^ (((ob >> 9) & 1) << 5)); }
__host__ __device__ __forceinline__ void stage_rc(int b, int& R, int& C) { const int st = b / 1024, sb = b % 1024, swz = sb ^ (((sb >> 9) & 1) << 5); R = (st >> 1) * 16 + swz / 64; C = (st & 1) * 32 + (swz % 64) / 2; }
__host__ __device__ __forceinline__ int perm32(int rho) { const int n = rho >> 4, i = rho & 15; return 8 * (i >> 2) + 4 * n + (i & 3); }

struct Unit { int pm, pn; };
struct Gemm { const bf16_t* A; const bf16_t* Bt; int M, N, K; };

struct StaticOrder {
    int nM, nN, nwg, G, c;
    __host__ __device__ void init(int M, int N, int G_, int c_) { nM = M / BM; nN = N / BM; nwg = nM * nN; G = G_; c = c_; }
    __host__ __device__ bool next(int i, Unit& u) const {
        const long L = (long)i * G + c; if (L >= nwg) return false;
        int wgid = (int)L; { const int q = nwg / NXCD, r = nwg % NXCD, xcd = wgid % NXCD, off = wgid / NXCD; wgid = (xcd < r ? xcd * (q + 1) : r * (q + 1) + (xcd - r) * q) + off; }
        const int nig = WGM * nN, gid = wgid / nig, fm = gid * WGM, gsz = (nM - fm) < WGM ? (nM - fm) : WGM;
        u.pm = fm + ((wgid % nig) % gsz); u.pn = (wgid % nig) / gsz; return true;
    }
    __device__ __forceinline__ void a_ready(const Unit&) const {}
    __device__ __forceinline__ void done(const Unit&) const {}
};
template <class Epi, class Sched, bool STAMP = false>
__device__ __forceinline__ void gemm_phase(PG8_LAS unsigned char* lds, const Gemm g, const Sched& S, const Epi& E, unsigned long long* stamps) {
    const int tid = opaque_tid(), wid = __builtin_amdgcn_readfirstlane(tid >> 6), lane = tid & 63, wr = wid >> 2, wc = wid & 3, fr = lane & 15, fq = lane >> 4;
    const int K = g.K, nt = K / BK;
    int ts_lo = 0, ts_hi = 0, nts = 0; const unsigned long long rt_entry = STAMP ? (unsigned long long)wall_clock64() : 0ull;
#define PG8_STAMP() do { if (STAMP && wid == 0 && nts < 64) { const unsigned long long _c = (unsigned long long)clock64(); \
        ts_lo = (lane == nts) ? (int)(unsigned)_c : ts_lo; ts_hi = (lane == nts) ? (int)(unsigned)(_c >> 32) : ts_hi; ++nts; } } while (0)
    PG8_STAMP();
    unsigned voffA[2], voffB[2];
#pragma unroll
    for (int i = 0; i < 2; ++i) { int R, C; stage_rc(tid * 16 + i * 8192, R, C); const int Rb = Epi::PERM ? ((R & ~31) + perm32(R & 31)) : R;
        voffA[i] = (unsigned)(R * K + C) * 2u; voffB[i] = (unsigned)(Rb * K + C) * 2u; }
    const size_t kstep = (size_t)(BK * 2);
    const size_t hstep = (size_t)HALF * K * 2;
    const size_t tstep = 2 * hstep;
    const unsigned ldsw = (unsigned)wid * 1024u;
    const int aoff = lds_byte(wr * 64 + fr, fq * 8), boff = lds_byte(wc * 32 + fr, fq * 8);
#define PG8_SA(b, h) (((b) * 2 + (h)) * HTB)
#define PG8_SB(b, h) ((4 + (b) * 2 + (h)) * HTB)
#define PG8_STAGE(bufoff, gbase, voff) do { _Pragma("unroll") for (int _i = 0; _i < 2; ++_i) \
        __builtin_amdgcn_global_load_lds((const unsigned*)((const char*)(gbase) + (voff)[_i]), (PG8_LAS unsigned*)(lds + (bufoff) + ldsw + _i * 8192), 16, 0, 0); } while (0)
#define PG8_LDA(dst, b, h) do { _Pragma("unroll") for (int m = 0; m < 4; ++m) _Pragma("unroll") for (int k = 0; k < 2; ++k) dst[m][k] = *(const PG8_LAS bf16x8*)(lds + PG8_SA(b, h) + aoff + m * 2048 + k * 1024); } while (0)
#define PG8_LDB(dst, b, h) do { _Pragma("unroll") for (int n = 0; n < 2; ++n) _Pragma("unroll") for (int k = 0; k < 2; ++k) dst[n][k] = *(const PG8_LAS bf16x8*)(lds + PG8_SB(b, h) + boff + n * 2048 + k * 1024); } while (0)
#define PG8_MMA(ai, bj, At, Bt) do { __builtin_amdgcn_s_setprio(1); _Pragma("unroll") for (int m = 0; m < 4; ++m) _Pragma("unroll") for (int n = 0; n < 2; ++n) _Pragma("unroll") for (int k = 0; k < 2; ++k) \
        acc[ai][bj][m][n] = __builtin_amdgcn_mfma_f32_16x16x32_bf16(Bt[n][k], At[m][k], acc[ai][bj][m][n], 0, 0, 0); __builtin_amdgcn_s_setprio(0); } while (0)
#define PG8_WAIT_V(n) asm volatile("s_waitcnt vmcnt(" #n ")" ::: "memory")
#define PG8_WAIT_L(n) asm volatile("s_waitcnt lgkmcnt(" #n ")" ::: "memory")
#define PG8_BAR __builtin_amdgcn_s_barrier()
#define PG8_SCHED __builtin_amdgcn_sched_barrier(0)
    Unit cur, nxt; int ui = 0;
    if (!S.next(0, cur)) return;
    f32x4 acc[2][2][4][2];
#pragma unroll
    for (int a = 0; a < 2; ++a)
#pragma unroll
        for (int b = 0; b < 2; ++b)
#pragma unroll
            for (int m = 0; m < 4; ++m)
#pragma unroll
                for (int n = 0; n < 2; ++n) acc[a][b][m][n] = (f32x4){0.f, 0.f, 0.f, 0.f};
    bf16x8 At[4][2], B0[2][2], B1[2][2];
    const char* cA = (const char*)g.A + (size_t)cur.pm * tstep; const char* cB = (const char*)g.Bt + (size_t)cur.pn * tstep;
    S.a_ready(cur);
    PG8_STAGE(PG8_SB(0, 0), cB, voffB); PG8_STAGE(PG8_SA(0, 0), cA, voffA); PG8_STAGE(PG8_SB(0, 1), cB + hstep, voffB); PG8_STAGE(PG8_SA(0, 1), cA + hstep, voffA);
    if (wr == 1) PG8_BAR;
    PG8_WAIT_V(4); PG8_BAR;
    PG8_STAGE(PG8_SB(1, 0), cB + kstep, voffB); PG8_STAGE(PG8_SA(1, 0), cA + kstep, voffA); PG8_STAGE(PG8_SB(1, 1), cB + hstep + kstep, voffB);
    PG8_WAIT_V(6); PG8_BAR;
    PG8_STAMP();
    for (;;) {
        const bool has_next = S.next(ui + 1, nxt);
        const char* nA = has_next ? (const char*)g.A + (size_t)nxt.pm * tstep : cA; const char* nB = has_next ? (const char*)g.Bt + (size_t)nxt.pn * tstep : cB;
        for (int t = 0; t < nt; t += 2) {
            const bool last = (t == nt - 2);
            const char* a1 = cA + (size_t)(t + 1) * kstep;
            const char* a2 = last ? nA : cA + (size_t)(t + 2) * kstep; const char* b2 = last ? nB : cB + (size_t)(t + 2) * kstep;
            const char* a3 = a2 + kstep; const char* b3 = b2 + kstep;
            if (last && has_next) S.a_ready(nxt);
            PG8_LDB(B0, 0, 0); PG8_SCHED; PG8_LDA(At, 0, 0); PG8_STAGE(PG8_SA(1, 1), a1 + hstep, voffA);
            PG8_WAIT_L(8); PG8_BAR; PG8_WAIT_L(0); PG8_MMA(0, 0, At, B0); PG8_BAR; PG8_SCHED;
            PG8_LDB(B1, 0, 1); PG8_STAGE(PG8_SB(0, 0), b2, voffB);
            PG8_BAR; PG8_WAIT_L(0); PG8_MMA(0, 1, At, B1); PG8_BAR;
            PG8_LDA(At, 0, 1); PG8_STAGE(PG8_SA(0, 0), a2, voffA);
            PG8_BAR; PG8_WAIT_L(0); PG8_MMA(1, 0, At, B0); PG8_BAR; PG8_SCHED;
            PG8_STAGE(PG8_SB(0, 1), b2 + hstep, voffB);
            PG8_WAIT_V(6); PG8_BAR; PG8_MMA(1, 1, At, B1); PG8_BAR;
            PG8_LDB(B0, 1, 0); PG8_SCHED; PG8_LDA(At, 1, 0); PG8_STAGE(PG8_SA(0, 1), a2 + hstep, voffA);
            PG8_WAIT_L(8); PG8_BAR; PG8_WAIT_L(0); PG8_MMA(0, 0, At, B0); PG8_BAR; PG8_SCHED;
            PG8_LDB(B1, 1, 1); PG8_STAGE(PG8_SB(1, 0), b3, voffB);
            PG8_BAR; PG8_WAIT_L(0); PG8_MMA(0, 1, At, B1); PG8_BAR;
            PG8_LDA(At, 1, 1); PG8_STAGE(PG8_SA(1, 0), a3, voffA);
            PG8_BAR; PG8_WAIT_L(0); PG8_MMA(1, 0, At, B0); PG8_BAR; PG8_SCHED;
            PG8_STAGE(PG8_SB(1, 1), b3 + hstep, voffB);
            PG8_WAIT_V(6); PG8_BAR; PG8_MMA(1, 1, At, B1); PG8_BAR;
        }
        PG8_STAMP();
        if constexpr (!Epi::AFTER_DRAIN) { E(acc, cur, wr, wc, fr, fq); S.done(cur); }
        PG8_STAMP();
        if (!has_next) break;
#pragma unroll
        for (int a = 0; a < 2; ++a)
#pragma unroll
            for (int b = 0; b < 2; ++b)
#pragma unroll
                for (int m = 0; m < 4; ++m)
#pragma unroll
                    for (int n = 0; n < 2; ++n) acc[a][b][m][n] = (f32x4){0.f, 0.f, 0.f, 0.f};
        cur = nxt; cA = nA; cB = nB; ++ui;
    }
    PG8_WAIT_V(0);
    if (wr == 0) PG8_BAR;
    PG8_BAR;
    if constexpr (Epi::AFTER_DRAIN) { E.fused(acc, cur, wr, wc, fr, fq, lds, wid, lane); S.done(cur); }
    PG8_STAMP();
    if (STAMP && wid == 0) { stamps[lane] = lane < nts ? (((unsigned long long)(unsigned)ts_hi << 32) | (unsigned)ts_lo) : 0ull;
        if (lane == 62) stamps[62] = rt_entry; if (lane == 63) stamps[63] = (unsigned long long)wall_clock64(); }
#undef PG8_STAMP
#undef PG8_SA
#undef PG8_SB
#undef PG8_STAGE
#undef PG8_LDA
#undef PG8_LDB
#undef PG8_MMA
#undef PG8_WAIT_V
#undef PG8_WAIT_L
#undef PG8_BAR
#undef PG8_SCHED
}
}

struct EpiG1 {
    static constexpr bool PERM = true, AFTER_DRAIN = false;
    bf16_t* P; float* GATES;
    __device__ __forceinline__ void operator()(const f32x4 (&acc)[2][2][4][2], const pg8::Unit& u, int wr, int wc, int fr, int fq) const {
        const int row0 = u.pm * 256 + wr * 64 + fr;
#pragma unroll
        for (int bj = 0; bj < 2; ++bj) {
            const int cb = u.pn * 256 + bj * 128 + wc * 32;
            if (cb >= DIN) continue;
            if (cb >= PW) {
                if (fq < 2) {
#pragma unroll
                    for (int ai = 0; ai < 2; ++ai)
#pragma unroll
                        for (int m = 0; m < 4; ++m) { float* gp = GATES + (size_t)(row0 + ai * 128 + m * 16) * 16 + fq * 8; *(f32x4*)gp = acc[ai][bj][m][0]; *(f32x4*)(gp + 4) = acc[ai][bj][m][1]; }
                }
            } else {
                const bool g = (cb >= PC_RG && cb < PC_Q) || cb >= PC_CU;
                const float sc = (cb >= PC_K && cb < PC_V) ? 0.10206207261596575f : 1.0f;
#pragma unroll
                for (int ai = 0; ai < 2; ++ai)
#pragma unroll
                    for (int m = 0; m < 4; ++m) {
                        f32x4 v0 = acc[ai][bj][m][0], v1 = acc[ai][bj][m][1];
                        if (g) { v0[0] = gelu_tanh(v0[0]); v0[1] = gelu_tanh(v0[1]); v0[2] = gelu_tanh(v0[2]); v0[3] = gelu_tanh(v0[3]); v1[0] = gelu_tanh(v1[0]); v1[1] = gelu_tanh(v1[1]); v1[2] = gelu_tanh(v1[2]); v1[3] = gelu_tanh(v1[3]); }
                        else { v0 = v0 * sc; v1 = v1 * sc; }
                        u32x4 w; w.x = cvt_pk_bf16(v0[0], v0[1]); w.y = cvt_pk_bf16(v0[2], v0[3]); w.z = cvt_pk_bf16(v1[0], v1[1]); w.w = cvt_pk_bf16(v1[2], v1[3]);
                        *(u32x4*)(P + (size_t)(row0 + ai * 128 + m * 16) * PW + cb + fq * 8) = w;
                    }
            }
        }
    }
};
__device__ __forceinline__ void phase_g1(const Args& a, LAS unsigned char* lds, int l) {
    pg8::Gemm g{(const bf16_t*)(a.ws + WS_XA), (const bf16_t*)(a.ws + WS_WIN) + (size_t)l * NIN * 1024, TOK, NIN, 1024};
    pg8::StaticOrder S; S.init(TOK, NIN, (int)gridDim.x, (int)blockIdx.x);
    EpiG1 E{(bf16_t*)(a.ws + WS_P), (float*)(a.ws + WS_GATES)};
    pg8::gemm_phase<EpiG1, pg8::StaticOrder>(lds, g, S, E, nullptr);
}
struct EpiG2 {
    static constexpr bool PERM = true, AFTER_DRAIN = false;
    float* X; const float* MODl;
    __device__ __forceinline__ void operator()(const f32x4 (&acc)[2][2][4][2], const pg8::Unit& u, int wr, int wc, int fr, int fq) const {
        const int row0 = u.pm * 256 + wr * 64 + fr; const float* gate = MODl + (size_t)sample_of(u.pm * 256) * 6144 + 2 * 1024;
#pragma unroll
        for (int bj = 0; bj < 2; ++bj) {
            const int col = u.pn * 256 + bj * 128 + wc * 32 + fq * 8; const f32x4 g0 = *(const f32x4*)(gate + col), g1 = *(const f32x4*)(gate + col + 4);
#pragma unroll
            for (int ai = 0; ai < 2; ++ai)
#pragma unroll
                for (int m = 0; m < 4; ++m) { float* xp = X + (size_t)(row0 + ai * 128 + m * 16) * 1024 + col;
                    const f32x4 x0 = *(const f32x4*)xp, x1 = *(const f32x4*)(xp + 4); *(f32x4*)xp = x0 + g0 * acc[ai][bj][m][0]; *(f32x4*)(xp + 4) = x1 + g1 * acc[ai][bj][m][1]; }
        }
    }
};
__device__ __forceinline__ void phase_g2(const Args& a, LAS unsigned char* lds, int l, int T) {
    pg8::Gemm g{(const bf16_t*)(a.ws + WS_MIX), (const bf16_t*)(a.ws + WS_WOUT) + (size_t)l * 1024 * 1024, T, 1024, 1024};
    pg8::StaticOrder S; S.init(T, 1024, (int)gridDim.x, (int)blockIdx.x);
    EpiG2 E{(float*)(a.ws + WS_X), (const float*)(a.ws + WS_MOD) + (size_t)l * 17 * 6144};
    pg8::gemm_phase<EpiG2, pg8::StaticOrder>(lds, g, S, E, nullptr);
}
struct EpiRT {
    static constexpr bool PERM = false, AFTER_DRAIN = false;
    float* LG;
    __device__ __forceinline__ void operator()(const f32x4 (&acc)[2][2][4][2], const pg8::Unit& u, int wr, int wc, int fr, int fq) const {
        const int row0 = u.pm * 256 + wr * 64 + fr;
#pragma unroll
        for (int bj = 0; bj < 2; ++bj)
#pragma unroll
            for (int n = 0; n < 2; ++n)
#pragma unroll
                for (int ai = 0; ai < 2; ++ai)
#pragma unroll
                    for (int m = 0; m < 4; ++m) *(f32x4*)(LG + (size_t)(row0 + ai * 128 + m * 16) * 256 + bj * 128 + wc * 32 + n * 16 + fq * 4) = acc[ai][bj][m][n];
    }
};
__device__ __forceinline__ void phase_rt(const Args& a, LAS unsigned char* lds, int l, int T) {
    pg8::Gemm g{(const bf16_t*)(a.ws + WS_XA), (const bf16_t*)(a.ws + WS_ROUT) + (size_t)l * 256 * 1024, T, 256, 1024};
    pg8::StaticOrder S; S.init(T, 256, (int)gridDim.x, (int)blockIdx.x);
    EpiRT E{(float*)(a.ws + WS_LOGITS)};
    pg8::gemm_phase<EpiRT, pg8::StaticOrder>(lds, g, S, E, nullptr);
}

template <int CTRL> __device__ __forceinline__ float dppf(float old, float src) { return __int_as_float(__builtin_amdgcn_update_dpp(__float_as_int(old), __float_as_int(src), CTRL, 0xF, 0xF, false)); }
constexpr int TK_MAXTOK = 512;
__device__ __forceinline__ void phase_tk(const Args& a, LAS unsigned char* lds, int l, int T) {
    const int tid = opaque_tid(), wid = tid >> 6, lane = tid & 63;
    const float* LG = (const float*)(a.ws + WS_LOGITS); const float* rb = a.in[I_RB] + l * 256;
    unsigned* CNT = (unsigned*)(a.ws + WS_CTL + CTL_CNT) + (size_t)l * 256 * CNT_STRIDE; int* LS = (int*)(a.ws + WS_LSLOT); float* LWt = (float*)(a.ws + WS_LW);
    LAS unsigned* lcnt = (LAS unsigned*)lds; LAS unsigned* lbase = lcnt + 256; LAS unsigned* ent = lbase + 256; LAS float* entw = (LAS float*)(ent + TK_MAXTOK * 8);
    const f32x4 bias = *(const f32x4*)(rb + lane * 4);
    const float NEG = -__builtin_huge_valf();
    const int per = (T + (int)gridDim.x - 1) / (int)gridDim.x;
    for (int base0 = blockIdx.x * per; base0 < (int)(blockIdx.x + 1) * per && base0 < T; base0 += TK_MAXTOK) {
        int ntok = (int)(blockIdx.x + 1) * per - base0; if (ntok > TK_MAXTOK) ntok = TK_MAXTOK; if (ntok > T - base0) ntok = T - base0;
        __syncthreads();
        if (tid < 256) lcnt[tid] = 0u;
        __syncthreads();
        for (int tl = wid; tl < ntok; tl += 8) {
            const int t = base0 + tl;
            const f32x4 lg = *(const f32x4*)(LG + (size_t)t * 256 + lane * 4);
            float sc[4], sel[4];
#pragma unroll
            for (int j = 0; j < 4; ++j) { sc[j] = 1.0f / (1.0f + expf(-lg[j])); sel[j] = sc[j] + bias[j]; }
            float a1 = fmaxf(sel[0], sel[1]), a2 = fminf(sel[0], sel[1]);
#pragma unroll
            for (int j = 2; j < 4; ++j) { const float v = sel[j]; a2 = fmaxf(a2, fminf(a1, v)); a1 = fmaxf(a1, v); }
#define TK_MERGE(CTRL) { const float b1 = dppf<CTRL>(a1, a1), b2 = dppf<CTRL>(a2, a2); const float n1 = fmaxf(a1, b1), n2 = fmaxf(fminf(a1, b1), fmaxf(a2, b2)); a1 = n1; a2 = n2; }
            TK_MERGE(0xB1) TK_MERGE(0x4E) TK_MERGE(0x141)
#undef TK_MERGE
            const float gs = a1 + a2; const int g = lane >> 3; int rank = 0;
#pragma unroll
            for (int g2 = 0; g2 < 8; ++g2) { const float s2 = __int_as_float(__builtin_amdgcn_readlane(__float_as_int(gs), g2 * 8)); rank += (s2 > gs || (s2 == gs && g2 < g)) ? 1 : 0; }
            float ms[4];
#pragma unroll
            for (int j = 0; j < 4; ++j) ms[j] = rank < 4 ? sel[j] : NEG;
            int my_e = 0; float my_s = 0.f, ssum = 0.f;
#pragma unroll
            for (int k = 0; k < 8; ++k) {
                float mx = fmaxf(fmaxf(ms[0], ms[1]), fmaxf(ms[2], ms[3]));
                mx = fmaxf(mx, dppf<0x111>(NEG, mx)); mx = fmaxf(mx, dppf<0x112>(NEG, mx)); mx = fmaxf(mx, dppf<0x114>(NEG, mx)); mx = fmaxf(mx, dppf<0x118>(NEG, mx));
                const float gmax = fmaxf(fmaxf(__int_as_float(__builtin_amdgcn_readlane(__float_as_int(mx), 15)), __int_as_float(__builtin_amdgcn_readlane(__float_as_int(mx), 31))),
                                         fmaxf(__int_as_float(__builtin_amdgcn_readlane(__float_as_int(mx), 47)), __int_as_float(__builtin_amdgcn_readlane(__float_as_int(mx), 63))));
                const int cand = ms[0] == gmax ? 0 : ms[1] == gmax ? 1 : ms[2] == gmax ? 2 : ms[3] == gmax ? 3 : -1;
                const unsigned long long bal = __ballot(cand >= 0);
                const int wl = __builtin_amdgcn_readfirstlane(__ffsll((unsigned long long)bal) - 1);
                const int jj = __builtin_amdgcn_readlane(cand, wl), bi = wl * 4 + jj;
                const float mysc = jj == 0 ? sc[0] : jj == 1 ? sc[1] : jj == 2 ? sc[2] : sc[3];
                const float sk = __int_as_float(__builtin_amdgcn_readlane(__float_as_int(mysc), wl));
#pragma unroll
                for (int j = 0; j < 4; ++j) if (lane == wl && j == jj) ms[j] = NEG;
                if (lane == k) { my_e = bi; my_s = sk; }
                ssum += sk;
            }
            if (lane < 8) {
                const unsigned r = __hip_atomic_fetch_add(&lcnt[my_e], 1u, __ATOMIC_RELAXED, __HIP_MEMORY_SCOPE_WORKGROUP);
                ent[tl * 8 + lane] = ((unsigned)my_e << 16) | r; entw[tl * 8 + lane] = my_s / ssum * 2.5f;
            }
        }
        __syncthreads();
        if (tid < 256) { const unsigned c = lcnt[tid]; lbase[tid] = c ? atomicAdd(&CNT[tid * CNT_STRIDE], c) : 0u; }
        __syncthreads();
        for (int i = tid; i < ntok * 8; i += NTHREADS) {
            const unsigned v = ent[i]; const int e = (int)(v >> 16); const unsigned pos = lbase[e] + (v & 0xffffu);
            LS[(size_t)e * LCAP + pos] = (base0 + (i >> 3)) * NSLOT + (i & 7); LWt[(size_t)e * LCAP + pos] = entw[i];
        }
    }
}

__device__ __forceinline__ void moe_tables(const Args& a, LAS unsigned char* lds, int l, int T) {
    LAS int* cntE = (LAS int*)(lds + LDS_TAB); LAS int* blkoff = cntE + 264;
    const int tid = opaque_tid(); const unsigned* CNT = (const unsigned*)(a.ws + WS_CTL + CTL_CNT) + (size_t)l * 256 * CNT_STRIDE;
    if (tid < 256) cntE[tid] = (int)CNT[tid * CNT_STRIDE]; else if (tid == 256) cntE[256] = T;
    __syncthreads();
    if (tid < 258) { int s = 0; for (int e = 0; e < tid && e < 257; ++e) s += (cntE[e] + 255) >> 8; blkoff[tid] = s; }
    __syncthreads();
}
__device__ __forceinline__ int moe_find(const LAS int* blkoff, int mbg) { int lo = 0, hi = 257; while (hi - lo > 1) { const int mid = (lo + hi) >> 1; if (blkoff[mid] <= mbg) lo = mid; else hi = mid; } return lo; }

#define PV_LOAD32(dst, ptr) asm volatile("global_load_dword %0, %1, off" : "=&v"(dst) : "v"(ptr))
struct E1Prov {
    const Args& a; LAS unsigned char* lds; int l, nunit, R0, R1, C0, C1, wr, wc, fr, fq; int q0, q1; bool sh;
    __device__ __forceinline__ void decode(int i, int& mbg, int& nt, int& e, int& mb, int& cnt) const {
        const LAS int* cntE = (const LAS int*)(lds + LDS_TAB); const LAS int* blkoff = cntE + 264;
        const int u = blockIdx.x + i * gridDim.x; mbg = u / 3; nt = u - mbg * 3; e = moe_find(blkoff, mbg); mb = mbg - blkoff[e]; cnt = cntE[e];
    }
    __device__ __forceinline__ bool seg(int i, RSeg& d) {
        if ((int)(blockIdx.x + i * gridDim.x) >= nunit) return false;
        int mbg, nt, e, mb, cnt; decode(i, mbg, nt, e, mb, cnt);
        const int* LS = (const int*)(a.ws + WS_LSLOT) + (e < 256 ? (size_t)e * LCAP : 0);
        const int p0 = mb * 256 + R0, p1 = mb * 256 + R1; sh = e >= 256; q0 = p0 < cnt ? p0 : -1; q1 = p1 < cnt ? p1 : -1;
        const int* a0 = LS + (q0 >= 0 && !sh ? q0 : 0); const int* a1 = LS + (q1 >= 0 && !sh ? q1 : 0);
        PV_LOAD32(d.aoff[0], a0); PV_LOAD32(d.aoff[1], a1);
        d.Ab = (const unsigned char*)(a.ws + WS_XA);
        d.B0 = (e < 256 ? a.in[I_EG] + ((size_t)l * 256 + e) * 1024 * FF : a.in[I_SG] + (size_t)l * 1024 * FF) + nt * 96;
        d.B1 = (e < 256 ? a.in[I_EU] + ((size_t)l * 256 + e) * 1024 * FF : a.in[I_SU] + (size_t)l * 1024 * FF) + nt * 96;
        return true;
    }
    __device__ __forceinline__ void finish(RSeg& d, bool first) const {
        if (first) asm volatile("s_waitcnt vmcnt(0)" ::: "memory"); else asm volatile("s_waitcnt vmcnt(16)" ::: "memory");
        __builtin_amdgcn_sched_barrier(0); asm volatile("" : "+v"(d.aoff[0]), "+v"(d.aoff[1]));
        const int t0 = q0 < 0 ? 0 : sh ? q0 : (int)d.aoff[0] / NSLOT, t1 = q1 < 0 ? 0 : sh ? q1 : (int)d.aoff[1] / NSLOT;
        d.aoff[0] = (unsigned)t0 * 2048u + (unsigned)C0 * 2u; d.aoff[1] = (unsigned)t1 * 2048u + (unsigned)C1 * 2u;
    }
    __device__ __forceinline__ void epi(int i, f32x4 (&acc)[4][6]) const {
        int mbg, nt, e, mb, cnt; decode(i, mbg, nt, e, mb, cnt);
        bf16_t* HB = (bf16_t*)(a.ws + WS_HB);
#pragma unroll
        for (int m = 0; m < 4; ++m) {
            bf16_t* hp = HB + (size_t)(mbg * 256 + wr * 64 + m * 16 + fr) * FF + nt * 96 + wc * 48 + fq * 4;
#pragma unroll
            for (int n = 0; n < 3; ++n) {
                const f32x4 g = acc[m][n], uu = acc[m][n + 3];
                u32x2 w; w.x = cvt_pk_bf16(siluf_(g[0]) * uu[0], siluf_(g[1]) * uu[1]); w.y = cvt_pk_bf16(siluf_(g[2]) * uu[2], siluf_(g[3]) * uu[3]);
                *(u32x2*)(hp + n * 16) = w;
            }
        }
    }
};
__device__ __forceinline__ void ring_piece_rc(int wid, int lane, int k, int& R, int& C) { const int sb = lane * 16, swz = sb ^ (((sb >> 9) & 1) << 5); R = (wid + 8 * k) * 16 + (swz >> 6); C = (swz & 63) >> 1; }
__device__ __forceinline__ void phase_e1(const Args& a, LAS unsigned char* lds, int l, int T) {
    const int tid = opaque_tid(), wid = __builtin_amdgcn_readfirstlane(tid >> 6), lane = tid & 63;
    moe_tables(a, lds, l, T);
    const LAS int* blkoff = (const LAS int*)(lds + LDS_TAB) + 264;
    int R0, C0, R1, C1; ring_piece_rc(wid, lane, 0, R0, C0); ring_piece_rc(wid, lane, 1, R1, C1);
    E1Prov pv{a, lds, l, blkoff[257] * 3, R0, R1, C0, C1, wid >> 1, wid & 1, lane & 15, lane >> 4, -1, -1, false};
    ring_gemm<192, 2, true, true, 2, E1Prov>(lds, pv, 32, FF, 0u, 0u);
}

struct E2Prov {
    const Args& a; LAS unsigned char* lds; int l, nunit, tid; int pslot; float pw; int pidx, ppos; bool psh;
    __device__ __forceinline__ void decode(int i, int& mbg, int& pn, int& e, int& mb, int& cnt) const {
        const LAS int* cntE = (const LAS int*)(lds + LDS_TAB); const LAS int* blkoff = cntE + 264;
        const int u = blockIdx.x + i * gridDim.x; mbg = u >> 2; pn = u & 3; e = moe_find(blkoff, mbg); mb = mbg - blkoff[e]; cnt = cntE[e];
    }
    __device__ __forceinline__ bool seg(int i, RSeg& d) {
        if ((int)(blockIdx.x + i * gridDim.x) >= nunit) return false;
        int mbg, pn, e, mb, cnt; decode(i, mbg, pn, e, mb, cnt);
        const int pos = mb * 256 + (tid & 255); psh = e >= 256; ppos = (tid < 256 && pos < cnt) ? pos : -1; pidx = i;
        const size_t idx = (ppos >= 0 && !psh) ? (size_t)e * LCAP + pos : 0;
        const int* sp = (const int*)(a.ws + WS_LSLOT) + idx; const float* wp = (const float*)(a.ws + WS_LW) + idx;
        PV_LOAD32(pslot, sp); PV_LOAD32(pw, wp);
        d.Ab = (const unsigned char*)(a.ws + WS_HB) + (size_t)mbg * 256 * FF * 2;
        d.B0 = (e < 256 ? a.in[I_ED] + ((size_t)l * 256 + e) * FF * 1024 : a.in[I_SD] + (size_t)l * FF * 1024) + pn * 256; d.B1 = d.B0;
        return true;
    }
    __device__ __forceinline__ void finish(RSeg&, bool first) {
        if (first) asm volatile("s_waitcnt vmcnt(0)" ::: "memory"); else asm volatile("s_waitcnt vmcnt(16)" ::: "memory");
        __builtin_amdgcn_sched_barrier(0); asm volatile("" : "+v"(pslot), "+v"(pw));
        LAS int* tab = (LAS int*)(lds + LDS_TAB) + 528 + (pidx & 1) * 512;
        if (tid < 256) { tab[tid] = ppos < 0 ? -1 : psh ? ppos * NSLOT + 8 : pslot; ((LAS float*)tab)[256 + tid] = psh ? 1.0f : pw; }
    }
    __device__ __forceinline__ void epi(int i, f32x4 (&acc)[8][4]) const {
        int mbg, pn, e, mb, cnt; decode(i, mbg, pn, e, mb, cnt);
        const LAS int* tab = (const LAS int*)(lds + LDS_TAB) + 528 + (i & 1) * 512; bf16_t* Y = (bf16_t*)(a.ws + WS_R1);
        const int wr = tid >> 8, wc = (tid >> 6) & 3, fr = tid & 15, fq = (tid >> 4) & 3;
#pragma unroll
        for (int m = 0; m < 8; ++m) {
            const int r = wr * 128 + m * 16 + fr, slot = tab[r];
            if (slot >= 0) {
                const float w = ((const LAS float*)tab)[256 + r]; bf16_t* yp = Y + (size_t)slot * 1024 + pn * 256 + wc * 64 + fq * 16;
                const f32x4 v0 = acc[m][0] * w, v1 = acc[m][1] * w, v2 = acc[m][2] * w, v3 = acc[m][3] * w;
                u32x4 o0, o1; o0.x = cvt_pk_bf16(v0[0], v0[1]); o0.y = cvt_pk_bf16(v0[2], v0[3]); o0.z = cvt_pk_bf16(v1[0], v1[1]); o0.w = cvt_pk_bf16(v1[2], v1[3]);
                o1.x = cvt_pk_bf16(v2[0], v2[1]); o1.y = cvt_pk_bf16(v2[2], v2[3]); o1.z = cvt_pk_bf16(v3[0], v3[1]); o1.w = cvt_pk_bf16(v3[2], v3[3]);
                *(u32x4*)yp = o0; *(u32x4*)(yp + 8) = o1;
            }
        }
    }
};
__device__ __forceinline__ void phase_e2(const Args& a, LAS unsigned char* lds, int l, int T) {
    const int tid = opaque_tid(), wid = __builtin_amdgcn_readfirstlane(tid >> 6), lane = tid & 63;
    moe_tables(a, lds, l, T);
    const LAS int* blkoff = (const LAS int*)(lds + LDS_TAB) + 264;
    int R0, C0, R1, C1; ring_piece_rc(wid, lane, 0, R0, C0); ring_piece_rc(wid, lane, 1, R1, C1);
    E2Prov pv{a, lds, l, blkoff[257] * 4, tid, -1, 0.f, -1, -1, false};
    ring_gemm<256, 4, false, false, 1, E2Prov>(lds, pv, 9, 1024, (unsigned)(R0 * FF * 2 + C0 * 2), (unsigned)(R1 * FF * 2 + C1 * 2));
}

__device__ __forceinline__ float logsigmoidf_(float x) { return fminf(x, 0.f) - log1pf(expf(-fabsf(x))); }

__device__ __forceinline__ void mlstm_gates(const float* GATES, int row0, int rstep, int gcol, float bi, float bfg, float m, LAS float* colterm, LAS float* Marr, LAS float* bcarr, int lane) {
    const int p0 = 2 * lane;
    const float* g0 = GATES + (size_t)(row0 + rstep * p0) * 16 + gcol; const float* g1 = g0 + rstep * 16;
    const float gi0 = g0[0] + bi, gi1 = g1[0] + bi, lf0 = logsigmoidf_(g0[4] + bfg), lf1 = logsigmoidf_(g1[4] + bfg);
    float s = lf0 + lf1;
#pragma unroll
    for (int o = 1; o < 64; o <<= 1) { const float t = __shfl_up(s, o); if (lane >= o) s += t; }
    const float bc1 = s, bc0 = s - lf1, ct0 = gi0 - bc0, ct1 = gi1 - bc1;
    float pm = fmaxf(ct0, ct1);
#pragma unroll
    for (int o = 1; o < 64; o <<= 1) { const float t = __shfl_up(pm, o); if (lane >= o) pm = fmaxf(pm, t); }
    float prev = __shfl_up(pm, 1); if (lane == 0) prev = -__builtin_huge_valf();
    const float pm0 = fmaxf(prev, ct0);
    colterm[p0] = ct0; colterm[p0 + 1] = ct1; bcarr[p0] = bc0; bcarr[p0 + 1] = bc1; Marr[p0] = fmaxf(m, pm0); Marr[p0 + 1] = fmaxf(m, pm);
}

__device__ __forceinline__ void ms_unit(const Args& a, LAS unsigned char* lds, int l, int b, int h, int d) {
    const int tid = opaque_tid(), wid = __builtin_amdgcn_readfirstlane(tid >> 6), lane = tid & 63, fr = lane & 15, fq = lane >> 4;
    LAS bf16_t* Ks = (LAS bf16_t*)(lds);
    LAS bf16_t* Vp = (LAS bf16_t*)(lds + 26624);
    LAS float* colterm = (LAS float*)(lds + 57344); LAS float* Marr = colterm + 128; LAS float* bcarr = Marr + 128;
    const bf16_t* P = (const bf16_t*)(a.ws + WS_P); const float* GATES = (const float*)(a.ws + WS_GATES);
    const int seq = (b * 4 + h) * 2 + d;
    bf16_t* CTG = (bf16_t*)(a.ws + WS_CTG) + (size_t)seq * 18 * (112 * 96); float* MST = (float*)(a.ws + WS_MST) + seq * 18;
    const float bi = a.in[I_MGB][((l * 2 + d) * 2 + 0) * 4 + h], bfg = a.in[I_MGB][((l * 2 + d) * 2 + 1) * 4 + h];
    const int rstep = d ? -1 : 1, gcol = d * 8 + h;
    int pp[3], pch[3];
#pragma unroll
    for (int i = 0; i < 3; ++i) { const int rem = tid + 512 * i; pp[i] = rem / 12; pch[i] = rem - pp[i] * 12; }
#define MS_ROW0(step) (((step) < 2 ? NLAT + b * CTXL : b * SEQ) + (d ? ((step) < 2 ? CTXL : SEQ) - 1 - ((step) < 2 ? (step) : (step) - 2) * 128 : ((step) < 2 ? (step) : (step) - 2) * 128))
    u32x4 kv[6]; float gq[4];
#define MS_FETCH(step) do { const int _r0 = MS_ROW0(step); \
        _Pragma("unroll") for (int i = 0; i < 6; ++i) kv[i] = *(const u32x4*)(P + (size_t)(_r0 + rstep * pp[i % 3]) * PW + (i < 3 ? PC_K : PC_V) + h * 96 + pch[i % 3] * 8); \
        { const float* g0 = GATES + (size_t)(_r0 + rstep * 2 * lane) * 16 + gcol; gq[0] = g0[0]; gq[1] = g0[4]; gq[2] = g0[rstep * 16]; gq[3] = g0[rstep * 16 + 4]; } } while (0)
    __syncthreads();
    for (int i = tid; i < 128 * 3; i += NTHREADS) { const int p = i / 3, q = i - p * 3; u32x4 v = (u32x4){0u, 0u, 0u, 0u}; if (q == 0) v.x = 0x3F80u; *(LAS u32x4*)(Vp + p * 120 + 96 + q * 8) = v; }
    f32x4 Cst[7];
#pragma unroll
    for (int cb = 0; cb < 7; ++cb) Cst[cb] = (f32x4){0.f, 0.f, 0.f, 0.f};
    float m = 0.f;
    MS_FETCH(0);
    for (int step = 0; step < 18; ++step) {
        const bool do_out = step >= 2 || l == 0;
        if (wid == 0) {
            const int p0 = 2 * lane;
            const float gi0 = gq[0] + bi, gi1 = gq[2] + bi, lf0 = logsigmoidf_(gq[1] + bfg), lf1 = logsigmoidf_(gq[3] + bfg);
            float s = lf0 + lf1;
#pragma unroll
            for (int o = 1; o < 64; o <<= 1) { const float t = __shfl_up(s, o); if (lane >= o) s += t; }
            const float bc1 = s, bc0 = s - lf1, ct0 = gi0 - bc0, ct1 = gi1 - bc1;
            float pm = fmaxf(ct0, ct1);
#pragma unroll
            for (int o = 1; o < 64; o <<= 1) { const float t = __shfl_up(pm, o); if (lane >= o) pm = fmaxf(pm, t); }
            float prev = __shfl_up(pm, 1); if (lane == 0) prev = -__builtin_huge_valf();
            const float pm0 = fmaxf(prev, ct0);
            colterm[p0] = ct0; colterm[p0 + 1] = ct1; bcarr[p0] = bc0; bcarr[p0 + 1] = bc1; Marr[p0] = fmaxf(m, pm0); Marr[p0 + 1] = fmaxf(m, pm);
        }
        if (do_out) {
            if (tid == 0) MST[step] = m;
            if (wid < 6) {
                bf16_t* cg = CTG + (size_t)step * (112 * 96) + wid * 16 + fr;
#pragma unroll
                for (int cb = 0; cb < 7; ++cb)
#pragma unroll
                    for (int j = 0; j < 4; ++j) cg[(cb * 16 + fq * 4 + j) * 96] = f2bf(Cst[cb][j]);
            }
        }
        __syncthreads();
        const float Mend = Marr[127], gsum = bcarr[127];
#pragma unroll
        for (int i = 0; i < 6; ++i) {
            const int p = pp[i % 3], ch = pch[i % 3];
            u32x4 v = kv[i];
            if (i < 3) {
                const float w = __expf(colterm[p] - Mend);
                v.x = cvt_pk_bf16(__uint_as_float(v.x << 16) * w, __uint_as_float(v.x & 0xffff0000u) * w); v.y = cvt_pk_bf16(__uint_as_float(v.y << 16) * w, __uint_as_float(v.y & 0xffff0000u) * w);
                v.z = cvt_pk_bf16(__uint_as_float(v.z << 16) * w, __uint_as_float(v.z & 0xffff0000u) * w); v.w = cvt_pk_bf16(__uint_as_float(v.w << 16) * w, __uint_as_float(v.w & 0xffff0000u) * w);
                *(LAS u32x4*)(Ks + p * 104 + ch * 8) = v;
            } else *(LAS u32x4*)(Vp + p * 120 + ch * 8) = v;
        }
        if (step + 1 < 18) MS_FETCH(step + 1);
        __syncthreads();
        const float decay = __expf(m - Mend);
        if (wid < 6) {
#pragma unroll
            for (int cb = 0; cb < 7; ++cb) Cst[cb] = Cst[cb] * decay;
#pragma unroll
            for (int ks = 0; ks < 4; ++ks) {
                const bf16x8 bk = trfrag(Ks, 104, ks * 32, wid * 16, fr, fq);
#pragma unroll
                for (int cb = 0; cb < 7; ++cb) Cst[cb] = MFMA(trfrag(Vp, 120, ks * 32, cb * 16, fr, fq), bk, Cst[cb]);
            }
        }
        m = gsum + Mend;
        __syncthreads();
    }
#undef MS_FETCH
#undef MS_ROW0
}

__device__ __forceinline__ void mo_unit(const Args& a, LAS unsigned char* lds, int l, int b, int h, int cidx) {
    const int tid = opaque_tid(), wid = __builtin_amdgcn_readfirstlane(tid >> 6), lane = tid & 63, fr = lane & 15, fq = lane >> 4;
    LAS bf16_t* Qi = (LAS bf16_t*)(lds);
    LAS bf16_t* Ki = (LAS bf16_t*)(lds + 26624);
    LAS bf16_t* Si = (LAS bf16_t*)(lds);
    LAS bf16_t* Vp = (LAS bf16_t*)(lds + 53248);
    LAS float* Hs = (LAS float*)(lds + 83968);
    LAS float* colterm = (LAS float*)(lds + 135168); LAS float* Marr = colterm + 128; LAS float* bcarr = Marr + 128;
    const bf16_t* P = (const bf16_t*)(a.ws + WS_P); const float* GATES = (const float*)(a.ws + WS_GATES); bf16_t* MIX = (bf16_t*)(a.ws + WS_MIX);
    const bool isctx = cidx >= 16; const int n = isctx ? cidx - 16 : cidx, nc = isctx ? 2 : 16, rowbase = (isctx ? NLAT + b * CTXL : b * SEQ) + n * 128;
    __syncthreads();
    for (int i = tid; i < 128 * 3; i += NTHREADS) { const int p = i / 3, q = i - p * 3; u32x4 v = (u32x4){0u, 0u, 0u, 0u}; if (q == 0) v.x = 0x3F80u; *(LAS u32x4*)(Vp + p * 120 + 96 + q * 8) = v; }
    for (int d = 0; d < 2; ++d) {
        const int seq = (b * 4 + h) * 2 + d, np = d ? nc - 1 - n : n, step = isctx ? np : 2 + np;
        const float m = ((const float*)(a.ws + WS_MST))[seq * 18 + step];
        const bf16_t* CT = (const bf16_t*)(a.ws + WS_CTG) + ((size_t)seq * 18 + step) * (112 * 96);
        const float bi = a.in[I_MGB][((l * 2 + d) * 2 + 0) * 4 + h], bfg = a.in[I_MGB][((l * 2 + d) * 2 + 1) * 4 + h];
        const int row0 = rowbase + (d ? 127 : 0), rstep = d ? -1 : 1;
        if (wid == 0) mlstm_gates(GATES, row0, rstep, d * 8 + h, bi, bfg, m, colterm, Marr, bcarr, lane);
#pragma unroll
        for (int i = 0; i < 9; ++i) {
            const int rem = tid + 512 * (i % 3), p = rem / 12, ch = rem - p * 12;
            const u32x4 v = *(const u32x4*)(P + (size_t)(row0 + rstep * p) * PW + PC_Q + (i / 3) * 384 + h * 96 + ch * 8);
            if (i < 3) *(LAS u32x4*)(Qi + p * 104 + ch * 8) = v; else if (i < 6) *(LAS u32x4*)(Ki + p * 104 + ch * 8) = v; else *(LAS u32x4*)(Vp + p * 120 + ch * 8) = v;
        }
        __syncthreads();
        f32x4 num[7], sacc[8];
        const int t = wid * 16 + fr; const float Mt = Marr[t];
#pragma unroll
        for (int cb = 0; cb < 7; ++cb) num[cb] = (f32x4){0.f, 0.f, 0.f, 0.f};
#pragma unroll
        for (int ks = 0; ks < 3; ++ks) {
            const bf16x8 bq = ldfrag(Qi, 104, wid * 16, ks * 32, fr, fq);
#pragma unroll
            for (int cb = 0; cb < 7; ++cb) num[cb] = MFMA(*(const bf16x8*)(CT + (cb * 16 + fr) * 96 + ks * 32 + fq * 8), bq, num[cb]);
#pragma unroll
            for (int sb = 0; sb < 8; ++sb) if (sb <= wid) { if (ks == 0) sacc[sb] = (f32x4){0.f, 0.f, 0.f, 0.f}; sacc[sb] = MFMA(ldfrag(Ki, 104, sb * 16, ks * 32, fr, fq), bq, sacc[sb]); }
        }
        { const float ei = __expf(m - Mt);
#pragma unroll
          for (int cb = 0; cb < 7; ++cb) num[cb] = num[cb] * ei; }
        __syncthreads();
#pragma unroll
        for (int sb = 0; sb < 8; ++sb) {
            u32x2 w; w.x = 0u; w.y = 0u;
            if (sb <= wid) {
                const f32x4 ct = *(const LAS f32x4*)(colterm + sb * 16 + fq * 4); float e[4];
#pragma unroll
                for (int j = 0; j < 4; ++j) { const int s = sb * 16 + fq * 4 + j; e[j] = (s <= t) ? sacc[sb][j] * __expf(ct[j] - Mt) : 0.f; }
                w.x = cvt_pk_bf16(e[0], e[1]); w.y = cvt_pk_bf16(e[2], e[3]);
            }
            *(LAS u32x2*)(Si + t * 136 + sb * 16 + fq * 4) = w;
        }
        __syncthreads();
#pragma unroll
        for (int ks = 0; ks < 4; ++ks) {
            const bf16x8 bs = ldfrag(Si, 136, wid * 16, ks * 32, fr, fq);
#pragma unroll
            for (int cb = 0; cb < 7; ++cb) num[cb] = MFMA(trfrag(Vp, 120, ks * 32, cb * 16, fr, fq), bs, num[cb]);
        }
        const float den = __shfl(num[6][0], fr);
        const float inv = 1.0f / fmaxf(fabsf(den), __expf(-(bcarr[t] + Mt)));
        LAS float* hp = Hs + (d ? 127 - t : t) * 100 + fq * 4;
#pragma unroll
        for (int cb = 0; cb < 6; ++cb) { f32x4 hv = num[cb] * inv; if (d) hv = hv + *(const LAS f32x4*)(hp + cb * 16); *(LAS f32x4*)(hp + cb * 16) = hv; }
        __syncthreads();
    }
    {
        const int tau = wid * 16 + (lane >> 2), c0 = (lane & 3) * 24;
        float hv[24], ss = 0.f;
#pragma unroll
        for (int i = 0; i < 6; ++i) { const f32x4 x = *(const LAS f32x4*)(Hs + tau * 100 + c0 + i * 4); hv[4 * i] = x[0]; hv[4 * i + 1] = x[1]; hv[4 * i + 2] = x[2]; hv[4 * i + 3] = x[3]; ss += x[0] * x[0] + x[1] * x[1] + x[2] * x[2] + x[3] * x[3]; }
        ss += __shfl_xor(ss, 1); ss += __shfl_xor(ss, 2);
        const float rstd = rsqrtf(ss * (1.0f / 96.0f) + EPS);
        const bf16_t* op = P + (size_t)(rowbase + tau) * PW + PC_O + h * 96 + c0; const float* ng = a.in[I_MNG] + l * 384 + h * 96 + c0;
        bf16_t* mp = MIX + (size_t)(rowbase + tau) * 1024 + 384 + h * 96 + c0;
#pragma unroll
        for (int i = 0; i < 3; ++i) {
            const u32x4 ow = *(const u32x4*)(op + i * 8); const unsigned oo[4] = {ow.x, ow.y, ow.z, ow.w}; unsigned r[4];
#pragma unroll
            for (int j = 0; j < 4; ++j) { const int c = i * 8 + 2 * j; r[j] = cvt_pk_bf16(sigmoidf_(__uint_as_float(oo[j] << 16)) * hv[c] * rstd * ng[c], sigmoidf_(__uint_as_float(oo[j] & 0xffff0000u)) * hv[c + 1] * rstd * ng[c + 1]); }
            *(u32x4*)(mp + i * 8) = (u32x4){r[0], r[1], r[2], r[3]};
        }
    }
}

template <int D> __device__ __forceinline__ void scan16(float& A, float& U) {
#define RG_STEP(o) { const float Ao = dppf<(D ? 0x100 : 0x110) | (o)>(1.0f, A), Uo = dppf<(D ? 0x100 : 0x110) | (o)>(0.0f, U); U = fmaf(A, Uo, U); A *= Ao; }
    RG_STEP(1) RG_STEP(2) RG_STEP(4) RG_STEP(8)
#undef RG_STEP
}
template <bool FINAL>
__device__ __forceinline__ void rg_unit(const Args& a, LAS unsigned char* lds, int l, int b, int hd, int cidx) {
    const int tid = opaque_tid(), wid = __builtin_amdgcn_readfirstlane(tid >> 6), lane = tid & 63, fr = lane & 15, fq = lane >> 4;
    LAS bf16_t* zi = (LAS bf16_t*)lds;
    LAS bf16_t* Wi = (LAS bf16_t*)(lds + 18432);
    LAS float* zf = (LAS float*)(lds + 55296);
    LAS float* cst = (LAS float*)(lds + 88064);
    LAS float* wagg = (LAS float*)(lds + 89600);
    LAS float* hin = (LAS float*)(lds + 97792);
    const bf16_t* P = (const bf16_t*)(a.ws + WS_P); bf16_t* MIX = (bf16_t*)(a.ws + WS_MIX);
    float* AGG = (float*)(a.ws + WS_RGAGG);
    const bool isctx = cidx >= 16; const int n = isctx ? cidx - 16 : cidx, nc = isctx ? 2 : 16, Tseg = isctx ? CTXL : SEQ, segbase = isctx ? NLAT + b * CTXL : b * SEQ, base = n * 128;
    const int c = lane, ch = hd * 64 + c;
    __syncthreads();
    { const bf16_t* wt = (const bf16_t*)(a.ws + WS_RGWT) + (size_t)((l * 2) * 6 + hd) * 8192;
#pragma unroll
      for (int i = 0; i < 4; ++i) { const int idx = tid + 512 * i, dd = idx >> 10, r = (idx >> 3) & 127, k8 = idx & 7; *(LAS u32x4*)(Wi + (dd * 128 + r) * 72 + k8 * 8) = *(const u32x4*)(wt + (size_t)dd * 6 * 8192 + r * 64 + k8 * 8); } }
    if (tid < 128) { const int dd = tid >> 6, cc = tid & 63;
        cst[(dd * 3 + 0) * 64 + cc] = -1.4426950408889634f * a.in[I_RGGB][((l * 2 + dd) * 2 + 0) * 384 + hd * 64 + cc]; cst[(dd * 3 + 1) * 64 + cc] = -1.4426950408889634f * a.in[I_RGGB][((l * 2 + dd) * 2 + 1) * 384 + hd * 64 + cc];
        cst[(dd * 3 + 2) * 64 + cc] = -8.0f * 1.4426950408889634f * log1pf(expf(-a.in[I_RGLAM][(l * 2 + dd) * 384 + hd * 64 + cc]));
        if (FINAL) {
            const int np = dd ? nc - 1 - n : n, step = isctx ? np : 2 + np; const float* ag = AGG + (size_t)((b * 6 + hd) * 2 + dd) * 18 * 128 + cc;
            float Av[17], Uv[17];
#pragma unroll
            for (int s2 = 0; s2 < 17; ++s2) { Av[s2] = 1.f; Uv[s2] = 0.f; if (s2 < step) { Av[s2] = ag[s2 * 128]; Uv[s2] = ag[s2 * 128 + 64]; } }
            float hv = 0.f;
#pragma unroll
            for (int s2 = 0; s2 < 17; ++s2) hv = Av[s2] * hv + Uv[s2];
            hin[dd * 64 + cc] = hv;
        } }
    {
        const float cw0 = a.in[I_RGCW][(l * 4 + 0) * 384 + ch], cw1 = a.in[I_RGCW][(l * 4 + 1) * 384 + ch], cw2 = a.in[I_RGCW][(l * 4 + 2) * 384 + ch], cw3 = a.in[I_RGCW][(l * 4 + 3) * 384 + ch], cbias = a.in[I_RGCB][l * 384 + ch];
        const int tl0 = wid * 16; const bf16_t* pp = P + (size_t)segbase * PW + PC_RX + ch;
#define RG_LD(pos) (((pos) >= 0 && (pos) < Tseg) ? bf2f(pp[(size_t)(pos) * PW]) : 0.f)
        float xv[19];
#pragma unroll
        for (int i = 0; i < 19; ++i) xv[i] = RG_LD(base + tl0 - 2 + i);
#pragma unroll
        for (int i = 0; i < 16; ++i) { const float z = cw0 * xv[i] + cw1 * xv[i + 1] + cw2 * xv[i + 2] + cw3 * xv[i + 3] + cbias; zf[(tl0 + i) * 64 + c] = z; zi[(tl0 + i) * 72 + c] = f2bf(z); }
#undef RG_LD
    }
    __syncthreads();
    const int tl = wid * 16 + fr;
    f32x4 ysum[4];
#pragma unroll
    for (int nb = 0; nb < 4; ++nb) ysum[nb] = (f32x4){0.f, 0.f, 0.f, 0.f};
    f32x4 Ad[2][4], Ud[2][4];
#pragma unroll
    for (int d = 0; d < 2; ++d) {
        f32x4 acc[8];
#pragma unroll
        for (int nb = 0; nb < 8; ++nb) acc[nb] = (f32x4){0.f, 0.f, 0.f, 0.f};
#pragma unroll
        for (int ks = 0; ks < 2; ++ks) {
            const bf16x8 bz = ldfrag(zi, 72, wid * 16, ks * 32, fr, fq);
#pragma unroll
            for (int nb = 0; nb < 8; ++nb) acc[nb] = MFMA(ldfrag(Wi + d * 128 * 72, 72, nb * 16, ks * 32, fr, fq), bz, acc[nb]);
        }
#pragma unroll
        for (int nb = 0; nb < 4; ++nb) {
            const int j0 = nb * 16 + fq * 4;
            const f32x4 z4 = *(const LAS f32x4*)(zf + tl * 64 + j0), br = *(const LAS f32x4*)(cst + (d * 3 + 0) * 64 + j0), bi4 = *(const LAS f32x4*)(cst + (d * 3 + 1) * 64 + j0), sp = *(const LAS f32x4*)(cst + (d * 3 + 2) * 64 + j0);
#pragma unroll
            for (int j = 0; j < 4; ++j) {
                const float rg = __builtin_amdgcn_rcpf(1.0f + __builtin_amdgcn_exp2f(fmaf(acc[nb][j], -1.4426950408889634f, br[j])));
                const float ig = __builtin_amdgcn_rcpf(1.0f + __builtin_amdgcn_exp2f(fmaf(acc[nb + 4][j], -1.4426950408889634f, bi4[j])));
                const float av = __builtin_amdgcn_exp2f(rg * sp[j]);
                Ad[d][nb][j] = av; Ud[d][nb][j] = __builtin_amdgcn_sqrtf(fmaxf(fmaf(-av, av, 1.0f), 0.f)) * (ig * z4[j]);
            }
        }
#pragma unroll
        for (int nb = 0; nb < 4; ++nb)
#pragma unroll
            for (int j = 0; j < 4; ++j) { float A = Ad[d][nb][j], U = Ud[d][nb][j]; if (d == 0) scan16<0>(A, U); else scan16<1>(A, U); Ad[d][nb][j] = A; Ud[d][nb][j] = U; }
        if (fr == (d ? 0 : 15)) {
#pragma unroll
            for (int nb = 0; nb < 4; ++nb) { *(LAS f32x4*)(wagg + ((d * 8 + wid) * 2 + 0) * 64 + nb * 16 + fq * 4) = Ad[d][nb]; *(LAS f32x4*)(wagg + ((d * 8 + wid) * 2 + 1) * 64 + nb * 16 + fq * 4) = Ud[d][nb]; }
        }
    }
    __syncthreads();
    {
        bf16_t* PF = (bf16_t*)(a.ws + WS_RGPF) + ((size_t)(segbase + base + tl) * 384 + hd * 64) * 4;
#pragma unroll
        for (int nb = 0; nb < 4; ++nb) {
            const int j0 = nb * 16 + fq * 4;
            f32x4 Ap[2], Up[2];
#pragma unroll
            for (int d = 0; d < 2; ++d) {
                f32x4 Aw = (f32x4){1.f, 1.f, 1.f, 1.f}, Uw = (f32x4){0.f, 0.f, 0.f, 0.f};
                for (int w2 = 0; w2 < 7; ++w2) { const int w = d ? 7 - w2 : w2; if (d ? (w > wid) : (w < wid)) { const f32x4 aw = *(const LAS f32x4*)(wagg + ((d * 8 + w) * 2 + 0) * 64 + j0), uw = *(const LAS f32x4*)(wagg + ((d * 8 + w) * 2 + 1) * 64 + j0); Uw = aw * Uw + uw; Aw = Aw * aw; } }
                Ap[d] = Aw * Ad[d][nb]; Up[d] = Ad[d][nb] * Uw + Ud[d][nb];
            }
            u32x4 w0, w1;
            w0.x = cvt_pk_bf16(Ap[0][0], Up[0][0]); w0.y = cvt_pk_bf16(Ap[1][0], Up[1][0]); w0.z = cvt_pk_bf16(Ap[0][1], Up[0][1]); w0.w = cvt_pk_bf16(Ap[1][1], Up[1][1]);
            w1.x = cvt_pk_bf16(Ap[0][2], Up[0][2]); w1.y = cvt_pk_bf16(Ap[1][2], Up[1][2]); w1.z = cvt_pk_bf16(Ap[0][3], Up[0][3]); w1.w = cvt_pk_bf16(Ap[1][3], Up[1][3]);
            *(u32x4*)(PF + j0 * 4) = w0; *(u32x4*)(PF + j0 * 4 + 8) = w1;
        }
        if (tid < 128) { const int dd = tid >> 6, cc = tid & 63; float A = 1.f, U = 0.f;
#pragma unroll
            for (int w2 = 0; w2 < 8; ++w2) { const int w = dd ? 7 - w2 : w2; const float aw = wagg[((dd * 8 + w) * 2 + 0) * 64 + cc], uw = wagg[((dd * 8 + w) * 2 + 1) * 64 + cc]; U = aw * U + uw; A *= aw; }
            const int np = dd ? nc - 1 - n : n, step = isctx ? np : 2 + np; float* ag = AGG + ((size_t)((b * 6 + hd) * 2 + dd) * 18 + step) * 128 + cc;
            ag[0] = A; ag[64] = U; }
    }
}

__device__ __forceinline__ void rgc_unit(const Args& a, LAS unsigned char* lds, int l, int b, int hd, int cidx) {
    const int tid = opaque_tid();
    LAS float* hin = (LAS float*)lds;
    const bf16_t* P = (const bf16_t*)(a.ws + WS_P); bf16_t* MIX = (bf16_t*)(a.ws + WS_MIX); const float* AGG = (const float*)(a.ws + WS_RGAGG);
    const bool isctx = cidx >= 16; const int n = isctx ? cidx - 16 : cidx, nc = isctx ? 2 : 16, rowbase = (isctx ? NLAT + b * CTXL : b * SEQ) + n * 128;
    __syncthreads();
    if (tid < 128) { const int dd = tid >> 6, cc = tid & 63;
        const int np = dd ? nc - 1 - n : n, step = isctx ? np : 2 + np; const float* ag = AGG + (size_t)((b * 6 + hd) * 2 + dd) * 18 * 128 + cc;
        float Av[17], Uv[17];
#pragma unroll
        for (int s2 = 0; s2 < 17; ++s2) { Av[s2] = 1.f; Uv[s2] = 0.f; if (s2 < step) { Av[s2] = ag[s2 * 128]; Uv[s2] = ag[s2 * 128 + 64]; } }
        float hv = 0.f;
#pragma unroll
        for (int s2 = 0; s2 < 17; ++s2) hv = Av[s2] * hv + Uv[s2];
        hin[dd * 64 + cc] = hv; }
    __syncthreads();
    const int c4 = (tid & 15) * 4;
    const f32x4 hf = *(const LAS f32x4*)(hin + c4), hb = *(const LAS f32x4*)(hin + 64 + c4);
#pragma unroll
    for (int i = 0; i < 4; ++i) {
        const size_t row = (size_t)rowbase + (tid >> 4) + 32 * i;
        const bf16_t* pf = (const bf16_t*)(a.ws + WS_RGPF) + (row * 384 + hd * 64 + c4) * 4;
        const u32x4 w0 = *(const u32x4*)pf, w1 = *(const u32x4*)(pf + 8);
        const u32x2 gw = *(const u32x2*)(P + row * PW + PC_RG + hd * 64 + c4);
        const unsigned ww[8] = {w0.x, w0.y, w0.z, w0.w, w1.x, w1.y, w1.z, w1.w};
        float y[4];
#pragma unroll
        for (int j = 0; j < 4; ++j) y[j] = __uint_as_float(ww[2 * j] << 16) * hf[j] + __uint_as_float(ww[2 * j] & 0xffff0000u) + __uint_as_float(ww[2 * j + 1] << 16) * hb[j] + __uint_as_float(ww[2 * j + 1] & 0xffff0000u);
        u32x2 o; o.x = cvt_pk_bf16(__uint_as_float(gw.x << 16) * y[0], __uint_as_float(gw.x & 0xffff0000u) * y[1]); o.y = cvt_pk_bf16(__uint_as_float(gw.y << 16) * y[2], __uint_as_float(gw.y & 0xffff0000u) * y[3]);
        *(u32x2*)(MIX + row * 1024 + hd * 64 + c4) = o;
    }
}

__device__ __forceinline__ void gmlp_unit(const Args& a, LAS unsigned char* lds, int l, int chunk) {
    const int tid = opaque_tid(), wid = __builtin_amdgcn_readfirstlane(tid >> 6), lane = tid & 63, fr = lane & 15, fq = lane >> 4;
    LAS bf16_t* vn = (LAS bf16_t*)lds;
    const bf16_t* P = (const bf16_t*)(a.ws + WS_P); bf16_t* MIX = (bf16_t*)(a.ws + WS_MIX);
    const int row0 = chunk * 128;
    __syncthreads();
    {
        const f32x4 g = *(const f32x4*)(a.in[I_CMNG] + l * 256 + lane * 4);
        u32x2 wv[16];
#pragma unroll
        for (int i = 0; i < 16; ++i) wv[i] = *(const u32x2*)(P + (size_t)(row0 + wid * 16 + i) * PW + PC_CV + lane * 4);
#pragma unroll
        for (int i = 0; i < 16; ++i) {
            const int s = wid * 16 + i;
            const u32x2 w = wv[i];
            const float v0 = __uint_as_float(w.x << 16), v1 = __uint_as_float(w.x & 0xffff0000u), v2 = __uint_as_float(w.y << 16), v3 = __uint_as_float(w.y & 0xffff0000u);
            const float ss = wave_sum(v0 * v0 + v1 * v1 + v2 * v2 + v3 * v3);
            const float rstd = rsqrtf(ss * (1.0f / 256.0f) + EPS);
            u32x2 o; o.x = cvt_pk_bf16(v0 * rstd * g[0], v1 * rstd * g[1]); o.y = cvt_pk_bf16(v2 * rstd * g[2], v3 * rstd * g[3]);
            *(LAS u32x2*)(vn + s * 264 + lane * 4) = o;
        }
    }
    __syncthreads();
    const int g = wid >> 1, th = wid & 1;
    const float* ws = a.in[I_CMW] + ((size_t)(l * 4 + g) * 128) * 128;
    f32x4 acc[4][4];
#pragma unroll
    for (int m = 0; m < 4; ++m)
#pragma unroll
        for (int n = 0; n < 4; ++n) acc[m][n] = (f32x4){0.f, 0.f, 0.f, 0.f};
#pragma unroll
    for (int ks = 0; ks < 4; ++ks) {
        bf16x8 bw[4];
#pragma unroll
        for (int m = 0; m < 4; ++m) {
            const float* wp = ws + (size_t)(th * 64 + m * 16 + fr) * 128 + ks * 32 + fq * 8;
            const f32x4 w0 = *(const f32x4*)wp, w1 = *(const f32x4*)(wp + 4);
            u32x4 pk; pk.x = cvt_pk_bf16(w0[0], w0[1]); pk.y = cvt_pk_bf16(w0[2], w0[3]); pk.z = cvt_pk_bf16(w1[0], w1[1]); pk.w = cvt_pk_bf16(w1[2], w1[3]);
            bw[m] = __builtin_bit_cast(bf16x8, pk);
        }
#pragma unroll
        for (int n = 0; n < 4; ++n) {
            const bf16x8 av = trfrag(vn, 264, ks * 32, g * 64 + n * 16, fr, fq);
#pragma unroll
            for (int m = 0; m < 4; ++m) acc[m][n] = MFMA(av, bw[m], acc[m][n]);
        }
    }
#pragma unroll
    for (int m = 0; m < 4; ++m) {
        const int t = th * 64 + m * 16 + fr; const float bsv = a.in[I_CMB][(l * 4 + g) * 128 + t];
#pragma unroll
        for (int n = 0; n < 4; ++n) {
            const int cc = g * 64 + n * 16 + fq * 4;
            const u32x2 uw = *(const u32x2*)(P + (size_t)(row0 + t) * PW + PC_CU + cc);
            const float u0 = __uint_as_float(uw.x << 16), u1 = __uint_as_float(uw.x & 0xffff0000u), u2 = __uint_as_float(uw.y << 16), u3 = __uint_as_float(uw.y & 0xffff0000u);
            u32x2 o; o.x = cvt_pk_bf16(u0 * (acc[m][n][0] + bsv), u1 * (acc[m][n][1] + bsv)); o.y = cvt_pk_bf16(u2 * (acc[m][n][2] + bsv), u3 * (acc[m][n][3] + bsv));
            *(u32x2*)(MIX + (size_t)(row0 + t) * 1024 + 768 + cc) = o;
        }
    }
}

#define MX_NEXT(head) ({ __syncthreads(); if (tid == 0) *qv = (int)atomicAdd(q + (head) * 64, 1u); __syncthreads(); *qv; })
__device__ __forceinline__ void phase_mxa(const Args& a, LAS unsigned char* lds, int l) {
    unsigned* q = (unsigned*)(a.ws + WS_CTL + CTL_QUEUE) + l * 8 * 64; LAS int* qv = (LAS int*)(lds + LDS_BARW - 16); const int tid = opaque_tid();
    const int nch = (l == 0) ? 18 : 18;
    for (;;) { const int u = MX_NEXT(0); if (u >= 128) break; ms_unit(a, lds, l, u >> 3, (u >> 1) & 3, u & 1); }
    for (;;) { const int u = MX_NEXT(1); if (u >= 16 * 6 * nch) break; rg_unit<false>(a, lds, l, u / (6 * nch), (u / nch) % 6, u % nch); }
    const int ngm = (l == 0 ? TOK : NLAT) / 128;
    for (;;) { const int u = MX_NEXT(2); if (u >= ngm) break; gmlp_unit(a, lds, l, u); }
}
__device__ __forceinline__ void phase_mxc(const Args& a, LAS unsigned char* lds, int l) {
    unsigned* q = (unsigned*)(a.ws + WS_CTL + CTL_QUEUE) + l * 8 * 64; LAS int* qv = (LAS int*)(lds + LDS_BARW - 16); const int tid = opaque_tid();
    const int nch = (l == 0) ? 18 : 16;
    for (;;) { const int u = MX_NEXT(3); if (u >= 16 * 4 * nch) break; mo_unit(a, lds, l, u / (4 * nch), (u / nch) & 3, u % nch); }
    for (;;) { const int u = MX_NEXT(4); if (u >= 16 * 6 * nch) break; rgc_unit(a, lds, l, u / (6 * nch), (u / nch) % 6, u % nch); }
}
#undef MX_NEXT

constexpr int N_PHASES = 22;
__global__ void __launch_bounds__(NTHREADS, 2) fwd_kernel(Args a) {
    extern __shared__ __attribute__((aligned(16))) unsigned char lds_raw[];
    LAS unsigned char* lds = (LAS unsigned char*)lds_raw;
    const int lo = a.ph_lo, hi = a.ph_hi;
    XcdBarrier bar; bar.bar = (unsigned*)(a.ws + WS_CTL); bar.x = 0; bar.st = (volatile LAS unsigned*)(lds + LDS_BARW);
    if (hi - lo > 1) {
        if (threadIdx.x == 0) { *(LAS u32x4*)(lds + LDS_BARW) = (u32x4){0u, 0u, 0u, 0u}; }
        __syncthreads();
        bar = xcd_barrier_post((unsigned*)(a.ws + WS_CTL), (volatile LAS unsigned*)(lds + LDS_BARW));
    }
#ifndef PHSEL
#define PHSEL 0xFFF
#endif
#define SELJ(j) (((PHSEL) >> (j)) & 1)
#define IN(k) (lo <= (k) && (k) < hi)
#ifndef PROBE_MASK
#define PROBE_MASK 0u
#endif
    unsigned long long t_ph = PROBE_MASK ? __builtin_amdgcn_s_memrealtime() : 0ull;
#define SEAM(k) do { if (IN(k) && IN((k) + 1)) xcd_barrier(bar); \
    if (PROBE_MASK) { if (((PROBE_MASK) >> (k)) & 1u) { const unsigned long long t1 = __builtin_amdgcn_s_memrealtime(); while (__builtin_amdgcn_s_memrealtime() < t1 + (t1 - t_ph)) __builtin_amdgcn_s_sleep(4); } \
        __syncthreads(); t_ph = __builtin_amdgcn_s_memrealtime(); } } while (0)
    if (SELJ(10) && IN(0)) { p0_mod(a, lds); p0_conv(a, lds); }
    SEAM(0);
    for (int l = 0; l < 2; ++l) {
        const int pb = 1 + 10 * l, T = (l == 0) ? TOK : NLAT;
        if (SELJ(0) && IN(pb + 0)) phase_n1(a, l);
        SEAM(pb + 0);
        if (SELJ(1) && IN(pb + 1)) phase_g1(a, lds, l);
        SEAM(pb + 1);
        if (SELJ(2) && IN(pb + 2)) phase_mxa(a, lds, l);
        SEAM(pb + 2);
        if (SELJ(3) && IN(pb + 3)) phase_mxc(a, lds, l);
        SEAM(pb + 3);
        if (SELJ(4) && IN(pb + 4)) phase_g2(a, lds, l, T);
        SEAM(pb + 4);
        if (SELJ(5) && IN(pb + 5)) phase_n2(a, l, T);
        SEAM(pb + 5);
        if (SELJ(6) && IN(pb + 6)) phase_rt(a, lds, l, T);
        SEAM(pb + 6);
        if (SELJ(7) && IN(pb + 7)) phase_tk(a, lds, l, T);
        SEAM(pb + 7);
        if (SELJ(8) && IN(pb + 8)) phase_e1(a, lds, l, T);
        SEAM(pb + 8);
        if (SELJ(9) && IN(pb + 9)) phase_e2(a, lds, l, T);
        SEAM(pb + 9);
    }
    if (SELJ(11) && IN(21)) phase_fin(a);
#undef IN
#undef SEAM
}

extern "C" void kernel_launch(void* const* d_in, const int* in_sizes, int n_in, void* d_out, int out_size, void* d_ws, size_t ws_size, hipStream_t stream) {
    static int grid = 0;
    if (grid == 0) {
        if (n_in != 29 || out_size != NLAT * D || ws_size < WS_END) { fprintf(stderr, "kernel_launch: unexpected shapes (n_in %d, out %d, ws %zu, need %zu)\n", n_in, out_size, ws_size, (size_t)WS_END); grid = -1; return; }
        int dev = 0, cus = 0, per_cu = 0;
        if (hipGetDevice(&dev) != hipSuccess || hipDeviceGetAttribute(&cus, hipDeviceAttributeMultiprocessorCount, dev) != hipSuccess) { grid = -1; return; }
        if (hipFuncSetAttribute((const void*)fwd_kernel, hipFuncAttributeMaxDynamicSharedMemorySize, LDS_BYTES) != hipSuccess) { fprintf(stderr, "kernel_launch: hipFuncSetAttribute failed\n"); grid = -1; return; }
        if (hipOccupancyMaxActiveBlocksPerMultiprocessor(&per_cu, (const void*)fwd_kernel, NTHREADS, LDS_BYTES) != hipSuccess || per_cu < 1) { fprintf(stderr, "kernel_launch: occupancy query says %d\n", per_cu); (void)hipGetLastError(); grid = -1; return; }
        grid = cus;
    }
    if (grid < 0) return;
    (void)hipMemsetAsync((char*)d_ws + WS_CTL, 0, CTL_BYTES, stream);
    Args a{};
    for (int i = 0; i < 29; ++i) a.in[i] = (const float*)d_in[i];
    a.out = (float*)d_out; a.ws = (unsigned char*)d_ws;
#if MK_PER_PHASE
    for (int p = 0; p < N_PHASES; ++p) { a.ph_lo = p; a.ph_hi = p + 1; hipLaunchKernelGGL(fwd_kernel, dim3(grid), dim3(NTHREADS), LDS_BYTES, stream, a); }
#else
    a.ph_lo = 0; a.ph_hi = N_PHASES;
    hipLaunchKernelGGL(fwd_kernel, dim3(grid), dim3(NTHREADS), LDS_BYTES, stream, a);
#endif
}
```

```cpp
#include <hip/hip_runtime.h>
#include <cstdio>
#include <cstdint>

#ifndef MK_PER_PHASE
#define MK_PER_PHASE 0
#endif

#define LAS __attribute__((address_space(3)))
typedef unsigned short bf16_t;
typedef short bf16x8 __attribute__((ext_vector_type(8)));
typedef float f32x4 __attribute__((ext_vector_type(4)));
typedef float f32x2 __attribute__((ext_vector_type(2)));
typedef unsigned u32x4 __attribute__((ext_vector_type(4)));
typedef unsigned u32x2 __attribute__((ext_vector_type(2)));

constexpr int D = 1024, NBATCH = 16, SEQ = 2048, CTXL = 256;
constexpr int NLAT = NBATCH * SEQ, NCTX = NBATCH * CTXL, TOK = NLAT + NCTX;
constexpr int DIN = 2832, PW = 2816, NIN = 3072;
constexpr int NE = 256, FF = 288, NSLOT = 9, LCAP = TOK;
constexpr int NTHREADS = 512;
constexpr int LDS_BYTES = 147456;
constexpr int LDS_TAB = 139264;
constexpr int LDS_BARW = LDS_BYTES - 16;
constexpr float EPS = 1e-6f;

constexpr int PC_RX = 0, PC_RG = 384, PC_Q = 768, PC_K = 1152, PC_V = 1536, PC_O = 1920, PC_CU = 2304, PC_CV = 2560;

constexpr size_t WS_CTL = 0, CTL_BYTES = 131072;
constexpr size_t CTL_QUEUE = 16384, CTL_CNT = 32768;
constexpr int CNT_STRIDE = 32;
constexpr size_t WS_MOD = 131072;
constexpr size_t WS_X = WS_MOD + 1048576;
constexpr size_t WS_XA = WS_X + (size_t)TOK * D * 4;
constexpr size_t WS_R1 = WS_XA + (size_t)TOK * D * 2;
constexpr size_t R1_BYTES = (size_t)TOK * NSLOT * D * 2;
constexpr size_t WS_P = WS_R1;
constexpr size_t WS_MIX = WS_P + (size_t)TOK * PW * 2;
constexpr size_t WS_CTG = WS_MIX + (size_t)TOK * D * 2;
constexpr size_t WS_MST = WS_CTG + (size_t)128 * 18 * 112 * 96 * 2;
constexpr size_t WS_RGAGG = WS_MST + 16384;
constexpr size_t WS_RGPF = WS_RGAGG + (size_t)192 * 18 * 128 * 4;
static_assert(WS_RGPF + (size_t)TOK * 384 * 4 * 2 <= WS_R1 + R1_BYTES, "aliases");
constexpr int HB_ROWS = (TOK * 8 / 256 + 256 + TOK / 256) * 256;
constexpr size_t WS_HB = WS_R1 + R1_BYTES;
constexpr size_t WS_GATES = WS_HB + (size_t)HB_ROWS * FF * 2 + 256;
constexpr size_t WS_LOGITS = WS_GATES + (size_t)TOK * 16 * 4;
constexpr size_t WS_LSLOT = WS_LOGITS + (size_t)TOK * 256 * 4;
constexpr size_t WS_LW = WS_LSLOT + (size_t)NE * LCAP * 4;
constexpr size_t WS_WIN = WS_LW + (size_t)NE * LCAP * 4;
constexpr size_t WS_WOUT = WS_WIN + (size_t)2 * NIN * D * 2;
constexpr size_t WS_ROUT = WS_WOUT + (size_t)2 * D * D * 2;
constexpr size_t WS_RGWT = WS_ROUT + (size_t)2 * NE * D * 2;
constexpr size_t WS_END = WS_RGWT + (size_t)2 * 2 * 6 * 128 * 64 * 2;

__device__ __forceinline__ float bf2f(bf16_t b) { return __uint_as_float(((unsigned)b) << 16); }
__device__ __forceinline__ unsigned cvt_pk_bf16(float lo, float hi) { unsigned r; asm volatile("v_cvt_pk_bf16_f32 %0, %1, %2" : "=v"(r) : "v"(lo), "v"(hi)); return r; }
__device__ __forceinline__ bf16_t f2bf(float f) { return (bf16_t)(cvt_pk_bf16(f, 0.f) & 0xffffu); }
__device__ __forceinline__ float sigmoidf_(float x) { return __builtin_amdgcn_rcpf(1.0f + __expf(-x)); }
__device__ __forceinline__ float siluf_(float x) { return x * __builtin_amdgcn_rcpf(1.0f + __expf(-x)); }
__device__ __forceinline__ float gelu_tanh(float x) { const float u = 1.5957691216057308f * (x + 0.044715f * x * x * x); return x * __builtin_amdgcn_rcpf(1.0f + __expf(-u)); }
__device__ __forceinline__ float wave_sum(float v) {
#pragma unroll
    for (int o = 32; o >= 1; o >>= 1) v += __shfl_xor(v, o);
    return v;
}
__device__ __forceinline__ int opaque_tid() { int t = threadIdx.x; asm volatile("" : "+v"(t)); return t; }
#define WAIT_VM0() asm volatile("s_waitcnt vmcnt(0)" ::: "memory")

#define XB_TMO      128
#define XB_XCNT(j)  (256  + 64 * (j))
#define XB_XSUB(j)  (1280 + 64 * (j))
#define XB_XGEN(j)  (2304 + 64 * (j))
#define XB_TOP      3328
#define XB_TOPGEN   3392
#define XCD_BAR_WORDS 3456
#define XB_SPIN_CAP (1u << 18)

__device__ __forceinline__ unsigned xb_ld(unsigned* p)              { return __hip_atomic_load(p, __ATOMIC_RELAXED, __HIP_MEMORY_SCOPE_AGENT); }
__device__ __forceinline__ unsigned xb_add(unsigned* p, unsigned v) { return __hip_atomic_fetch_add(p, v, __ATOMIC_RELAXED, __HIP_MEMORY_SCOPE_AGENT); }
__device__ __forceinline__ unsigned xb_xcc_id() { return (unsigned)__builtin_amdgcn_s_getreg((3 << 11) | 20) & 0xFu; }
#define XB_SPIN(cond, bar) do { unsigned _sp = 0; while (cond) { __builtin_amdgcn_s_sleep(1); \
    if ((++_sp & 255u) == 0u) { if (xb_ld(&(bar)[XB_TMO])) break; if (_sp > XB_SPIN_CAP) { atomicAdd(&(bar)[XB_TMO], 1u); break; } } } } while (0)

struct XcdBarrier { unsigned* bar; unsigned x; volatile LAS unsigned* st; };

__device__ __forceinline__ XcdBarrier xcd_barrier_post(unsigned* bar, volatile LAS unsigned* st) {
    XcdBarrier b; b.bar = bar; b.x = xb_xcc_id(); b.st = st;
    if (threadIdx.x == 0) (void)xb_add(&bar[XB_XCNT(b.x)], 1u);
    return b;
}
__device__ __forceinline__ void xcd_barrier_complete(unsigned* bar, unsigned x, unsigned& nloc, unsigned& nx) {
    const unsigned G = gridDim.x * gridDim.y * gridDim.z;
    unsigned sum, cnt, mine, sp = 0u;
    for (;;) {
        sum = 0u; cnt = 0u; mine = 0u;
#pragma unroll
        for (unsigned j = 0; j < 16; ++j) { const unsigned c = xb_ld(&bar[XB_XCNT(j)]); sum += c; cnt += (c > 0u) ? 1u : 0u; mine = (j == x) ? c : mine; }
        if (sum == G) break;
        __builtin_amdgcn_s_sleep(1);
        if ((++sp & 255u) == 0u) { if (xb_ld(&bar[XB_TMO])) break; if (sp > XB_SPIN_CAP) { atomicAdd(&bar[XB_TMO], 1u); break; } }
    }
    nloc = mine > 0u ? mine : 1u; nx = cnt > 0u ? cnt : 1u;
}
__device__ __forceinline__ void xcd_barrier(const XcdBarrier& b) {
    asm volatile("s_waitcnt vmcnt(0)" ::: "memory");
    __syncthreads();
    if (threadIdx.x == 0) {
        unsigned* bar = b.bar;
        __builtin_amdgcn_s_waitcnt(0);
        unsigned nloc = b.st[0], nx = b.st[1];
        if (nloc == 0u) { xcd_barrier_complete(bar, b.x, nloc, nx); b.st[0] = nloc; b.st[1] = nx; }
        const unsigned old = xb_add(&bar[XB_XSUB(b.x)], 1u);
        const unsigned gen = old / nloc;
        if (old + 1u == (gen + 1u) * nloc) {
            __builtin_amdgcn_fence(__ATOMIC_RELEASE, "agent");
            asm volatile("s_waitcnt vmcnt(0)" ::: "memory");
            const unsigned og = xb_add(&bar[XB_TOP], 1u);
            const unsigned tg = og / nx;
            if (og + 1u == (tg + 1u) * nx) xb_add(&bar[XB_TOPGEN], 1u);
            else XB_SPIN(xb_ld(&bar[XB_TOPGEN]) == tg, bar);
            __builtin_amdgcn_fence(__ATOMIC_ACQUIRE, "agent");
            xb_add(&bar[XB_XGEN(b.x)], 1u);
            asm volatile("s_waitcnt vmcnt(0)" ::: "memory");
        } else {
            XB_SPIN(xb_ld(&bar[XB_XGEN(b.x)]) == gen, bar);
            __builtin_amdgcn_fence(__ATOMIC_ACQUIRE, "agent");
            asm volatile("s_waitcnt vmcnt(0)" ::: "memory");
        }
    }
    __syncthreads();
}

struct Args { const float* in[29]; float* out; unsigned char* ws; int ph_lo, ph_hi; };
enum { I_X = 0, I_C, I_CTX, I_CCTX, I_N1G, I_N2G, I_WMOD, I_BMOD, I_WIN, I_RGCW, I_RGCB, I_RGGW, I_RGGB, I_RGLAM, I_MGB, I_MNG, I_CMNG, I_CMW, I_CMB,
       I_WOUT, I_RW, I_RB, I_EG, I_EU, I_ED, I_SG, I_SU, I_SD, I_FNG };

__device__ __forceinline__ int lds_byte(int r, int c) { const int st = (r >> 4) * 2 + (c >> 5), ob = (r & 15) * 64 + (c & 31) * 2; return st * 1024 + (ob ^ (((ob >> 9) & 1) << 5)); }
__device__ __forceinline__ void stage_rc(int b, int& R, int& C) { const int st = b >> 10, sb = b & 1023, swz = sb ^ (((sb >> 9) & 1) << 5); R = (st >> 1) * 16 + (swz >> 6); C = (st & 1) * 32 + ((swz & 63) >> 1); }

template <int BN, int WC> struct GT { static constexpr int WR = 8 / WC, MF = 256 / WR / 16, NF = BN / WC / 16, BP = BN / 64; };

typedef short s16x4 __attribute__((ext_vector_type(4)));
__device__ __forceinline__ bf16x8 trfrag(const LAS bf16_t* img, int pitch, int k0, int n0, int fr, int fq) {
    const LAS bf16_t* p = img + (k0 + 8 * fq + (fr >> 2)) * pitch + n0 + 4 * (fr & 3);
    const s16x4 lo = __builtin_amdgcn_ds_read_tr16_b64_v4i16((LAS s16x4*)p), hi = __builtin_amdgcn_ds_read_tr16_b64_v4i16((LAS s16x4*)(p + 4 * pitch));
    return __builtin_shufflevector(lo, hi, 0, 1, 2, 3, 4, 5, 6, 7);
}

constexpr int RS_SLOT = 34816, RS_BOFF = 16384;
struct RSeg { const unsigned char* Ab; unsigned aoff[2]; const float* B0; const float* B1; };
template <int BN, int WC, bool DUAL, bool GATHER, int NSET, class PV>
__device__ __forceinline__ void ring_gemm(LAS unsigned char* lds, PV& pv, const int ns, const int ldb, const unsigned ca0, const unsigned ca1) {
    constexpr int MF = GT<BN, WC>::MF, NF = GT<BN, WC>::NF, PITCH = BN == 192 ? 200 : 280, LPS = BN / 64, VPR = BN / 4;
    const int tid = opaque_tid(), wid = __builtin_amdgcn_readfirstlane(tid >> 6), lane = tid & 63, fr = lane & 15, fq = lane >> 4;
    const int wr = wid / WC, wc = wid % WC;
    const int obA = fr * 64 + fq * 16;
    const int aro = (wr * MF) * 1024 + (obA ^ (((obA >> 9) & 1) << 5));
    const unsigned ldsb = (unsigned)(size_t)lds + (unsigned)(RS_BOFF + ((8 * fq + (fr >> 2)) * PITCH + (DUAL ? 4 * (fr & 3) + wc * 48 : 16 * (fr & 3) + wc * (NF * 16))) * 2);
    constexpr int NTB = DUAL ? LPS : 1;
    unsigned bsoff_[NTB]; unsigned bdst_[NTB];
    bool bsel_[NTB];
#pragma unroll
    for (int i = 0; i < NTB; ++i) { const int e = tid + 512 * i, row = e / VPR, c4 = e % VPR; bsel_[i] = DUAL && c4 >= 24; bsoff_[i] = (unsigned)(row * ldb + 4 * (DUAL ? c4 % 24 : c4));
        bdst_[i] = (unsigned)(size_t)lds + (unsigned)(RS_BOFF + (row * PITCH + 4 * c4) * 2); }
#define bsoff(i) (DUAL ? bsoff_[DUAL ? (i) : 0] : bsoff_[0] + (unsigned)(8 * (i) * ldb))
#define bdst(i) (DUAL ? bdst_[DUAL ? (i) : 0] : bdst_[0] + (unsigned)(8 * (i) * PITCH * 2))
#define bsel(i) (DUAL ? bsel_[DUAL ? (i) : 0] : false)
    f32x4 acc[MF][NF];
#pragma unroll
    for (int m = 0; m < MF; ++m)
#pragma unroll
        for (int n = 0; n < NF; ++n) acc[m][n] = (f32x4){0.f, 0.f, 0.f, 0.f};
    RSeg ss, nx; int si = 0, sj = 0;
    bool have = pv.seg(0, ss); if (!have) return;
    pv.finish(ss, true);
    bool have_nx = pv.seg(1, nx);
    int staged = 0, g = 0, ci = 0, cj = 0;
    f32x4 r0[LPS], r1[NSET == 2 ? LPS : 1];
#define RS_STAGEA() do { _Pragma("unroll") for (int _i = 0; _i < 2; ++_i) __builtin_amdgcn_global_load_lds((const unsigned*)(ss.Ab + (GATHER ? ss.aoff[_i] : (_i ? ca1 : ca0)) + (size_t)sj * 64), (LAS unsigned*)(lds + (staged & 3) * RS_SLOT + (wid + 8 * _i) * 1024), 16, 0, 0); } while (0)
#define RS_LOADB(rr) do { if (DUAL) { _Pragma("unroll") for (int _i = 0; _i < LPS; ++_i) { const float* _p = (bsel(_i) ? ss.B1 : ss.B0) + bsoff(_i) + (size_t)(sj * 32) * ldb; \
            asm volatile("global_load_dwordx4 %0, %1, off" : "=&v"(rr[_i]) : "v"(_p)); } } \
        else { const float* _sb = ss.B0 + (size_t)(sj * 32) * ldb; _Pragma("unroll") for (int _i = 0; _i < LPS; ++_i) { const unsigned _o = bsoff(_i) * 4u; \
            asm volatile("global_load_dwordx4 %0, %1, %2" : "=&v"(rr[_i]) : "v"(_o), "s"(_sb)); } } } while (0)
#define RS_WAITB(rr, steady) do { if (steady) { if (NSET == 1) asm volatile("s_waitcnt vmcnt(2)" ::: "memory"); else if (LPS == 3) asm volatile("s_waitcnt vmcnt(7)" ::: "memory"); else asm volatile("s_waitcnt vmcnt(8)" ::: "memory"); } else asm volatile("s_waitcnt vmcnt(0)" ::: "memory"); \
        __builtin_amdgcn_sched_barrier(0);        \
        if (LPS == 3) asm volatile("" : "+v"(rr[0]), "+v"(rr[1]), "+v"(rr[2])); else asm volatile("" : "+v"(rr[0]), "+v"(rr[1]), "+v"(rr[2]), "+v"(rr[LPS > 3 ? 3 : 0])); } while (0)
#define RS_WRITEB(rr, slot) do { _Pragma("unroll") for (int _i = 0; _i < LPS; ++_i) { u32x2 _w; _w.x = cvt_pk_bf16(rr[_i][0], rr[_i][1]); _w.y = cvt_pk_bf16(rr[_i][2], rr[_i][3]); \
        asm volatile("ds_write_b64 %0, %1" :: "v"(bdst(_i) + (unsigned)((slot) * RS_SLOT)), "v"(_w) : "memory"); } } while (0)
#define RS_ADVANCE() do { ++staged; if (++sj == ns) { sj = 0; ++si; if (have_nx) pv.finish(nx, false); ss = nx; have = have_nx; have_nx = have ? pv.seg(si + 1, nx) : false; } } while (0)
#define RS_TR(dst, slot, off) asm volatile("ds_read_b64_tr_b16 %0, %1 offset:%2" : "=v"(dst) : "v"(ldsb + (unsigned)((slot) * RS_SLOT)), "n"(off))
#define RS_KSTEP(slot) do { bf16x8 At[MF], Bf[NF]; s16x4 _lo[NF], _hi[NF]; \
        _Pragma("unroll") for (int n = 0; n < NF; ++n) { \
            if (DUAL) { if (n < 3) { RS_TR(_lo[n], slot, (16 * (n % 3)) * 2); RS_TR(_hi[n], slot, (16 * (n % 3) + 4 * PITCH) * 2); } else { RS_TR(_lo[n], slot, (96 + 16 * (n % 3)) * 2); RS_TR(_hi[n], slot, (96 + 16 * (n % 3) + 4 * PITCH) * 2); } } \
            else { RS_TR(_lo[n], slot, (4 * n) * 2); RS_TR(_hi[n], slot, (4 * n + 4 * PITCH) * 2); } } \
        _Pragma("unroll") for (int m = 0; m < MF; ++m) At[m] = *(const LAS bf16x8*)(lds + (slot) * RS_SLOT + aro + m * 1024); \
        if (NF == 6) asm volatile("s_waitcnt lgkmcnt(0)" : "+v"(_lo[0]), "+v"(_hi[0]), "+v"(_lo[1]), "+v"(_hi[1]), "+v"(_lo[2]), "+v"(_hi[2]), "+v"(_lo[3]), "+v"(_hi[3]), "+v"(_lo[NF > 4 ? 4 : 0]), "+v"(_hi[NF > 4 ? 4 : 0]), "+v"(_lo[NF > 5 ? 5 : 1]), "+v"(_hi[NF > 5 ? 5 : 1])); \
        else asm volatile("s_waitcnt lgkmcnt(0)" : "+v"(_lo[0]), "+v"(_hi[0]), "+v"(_lo[1]), "+v"(_hi[1]), "+v"(_lo[2]), "+v"(_hi[2]), "+v"(_lo[3]), "+v"(_hi[3])); \
        _Pragma("unroll") for (int n = 0; n < NF; ++n) Bf[n] = __builtin_shufflevector(_lo[n], _hi[n], 0, 1, 2, 3, 4, 5, 6, 7); \
        _Pragma("unroll") for (int m = 0; m < MF; ++m) _Pragma("unroll") for (int n = 0; n < NF; ++n) acc[m][n] = __builtin_amdgcn_mfma_f32_16x16x32_bf16(Bf[n], At[m], acc[m][n], 0, 0, 0); __builtin_amdgcn_sched_barrier(0); } while (0)
#define RS_BARRIER() do { asm volatile("s_waitcnt lgkmcnt(0)" ::: "memory"); __builtin_amdgcn_s_barrier(); asm volatile("" ::: "memory"); } while (0)
    if (NSET == 2) {
        RS_STAGEA(); RS_LOADB(r0); RS_WAITB(r0, false); RS_WRITEB(r0, 0); RS_ADVANCE();
        if (have) { RS_STAGEA(); RS_LOADB(r1); RS_ADVANCE(); }
        if (have) { RS_STAGEA(); RS_LOADB(r0); RS_ADVANCE(); }
    } else {
        RS_STAGEA(); RS_LOADB(r0); RS_WAITB(r0, false); RS_WRITEB(r0, 0); RS_ADVANCE();
        if (have) { RS_STAGEA(); RS_LOADB(r0); RS_ADVANCE(); }
    }
    WAIT_VM0(); RS_BARRIER();
#define RS_ITER(rw, STEADY) do { \
        const bool st = have; \
        if (st) RS_STAGEA(); \
        RS_KSTEP(g & 3); \
        if (++cj == ns) { pv.epi(ci, acc); _Pragma("unroll") for (int m = 0; m < MF; ++m) _Pragma("unroll") for (int n = 0; n < NF; ++n) acc[m][n] = (f32x4){0.f, 0.f, 0.f, 0.f}; cj = 0; ++ci; } \
        if (g + 1 < staged) { RS_WAITB(rw, STEADY); RS_WRITEB(rw, (g + 1) & 3); } \
        if (st) { RS_LOADB(rw); RS_ADVANCE(); } \
        st_prev = st; ++g; RS_BARRIER(); } while (0)
    bool st_prev = true;
    if (NSET == 2) {
        for (;;) {
            RS_ITER(r1, st && st_prev); if (g >= staged) break;
            RS_ITER(r0, st && st_prev); if (g >= staged) break;
        }
    } else {
        for (;;) { RS_ITER(r0, st); if (g >= staged) break; }
    }
    WAIT_VM0(); __syncthreads();
#undef RS_STAGEA
#undef RS_LOADB
#undef RS_WAITB
#undef RS_WRITEB
#undef RS_ADVANCE
#undef RS_TR
#undef RS_KSTEP
#undef RS_BARRIER
#undef RS_ITER
#undef bsoff
#undef bdst
#undef bsel
}

__device__ __forceinline__ bf16x8 ldfrag(const LAS bf16_t* img, int pitch, int row0, int k0, int fr, int fq) { return *(const LAS bf16x8*)(img + (row0 + fr) * pitch + k0 + fq * 8); }
#define MFMA(a, b, c) __builtin_amdgcn_mfma_f32_16x16x32_bf16(a, b, c, 0, 0, 0)

__device__ __forceinline__ void p0_mod(const Args& a, LAS unsigned char* lds) {
    { bf16_t* wt = (bf16_t*)(a.ws + WS_RGWT);
      for (int idx = blockIdx.x * NTHREADS + threadIdx.x; idx < 2 * 2 * 2 * 6 * 4096; idx += gridDim.x * NTHREADS) { const int j = idx & 63, i = (idx >> 6) & 63, hd = (idx >> 12) % 6, g = ((idx >> 12) / 6) & 1, ld = (idx >> 12) / 12;
          wt[((size_t)(ld * 6 + hd) * 128 + g * 64 + j) * 64 + i] = f2bf(a.in[I_RGGW][idx]); } }
    LAS float* sc = (LAS float*)lds;
    LAS float* red = (LAS float*)(lds + 69632);
    const int tid = opaque_tid();
    for (int i = tid; i < 17 * 1024; i += NTHREADS) { const int s = i >> 10, k = i & 1023; const float v = s < 16 ? a.in[I_C][s * 1024 + k] : a.in[I_CCTX][k]; sc[i] = siluf_(v); }
    __syncthreads();
    float* MOD = (float*)(a.ws + WS_MOD);
    for (int u = blockIdx.x; u < 192; u += gridDim.x) {
        const int l = u / 96, cb = (u % 96) * 64, col = tid & 63, ks = tid >> 6;
        const float* w = a.in[I_WMOD] + (size_t)l * 1024 * 6144 + cb + col;
        float acc[17];
#pragma unroll
        for (int s = 0; s < 17; ++s) acc[s] = 0.f;
#pragma unroll 4
        for (int k = ks * 128; k < ks * 128 + 128; ++k) {
            const float wv = w[(size_t)k * 6144];
#pragma unroll
            for (int s = 0; s < 17; ++s) acc[s] += sc[s * 1024 + k] * wv;
        }
#pragma unroll
        for (int s = 0; s < 17; ++s) red[(ks * 17 + s) * 64 + col] = acc[s];
        __syncthreads();
        for (int i = tid; i < 17 * 64; i += NTHREADS) {
            const int s = i >> 6, c = i & 63; float v = 0.f;
#pragma unroll
            for (int k2 = 0; k2 < 8; ++k2) v += red[(k2 * 17 + s) * 64 + c];
            MOD[((size_t)l * 17 + s) * 6144 + cb + c] = v + a.in[I_BMOD][l * 6144 + cb + c];
        }
        __syncthreads();
    }
}

template <int KT>
__device__ __forceinline__ void conv_tile(LAS float* tile, const float* p0, const float* p1, const float* p2, const float* p3, int ldn, int k0, bf16_t* dst, int K) {
    const int tid = opaque_tid(), r = tid >> 4, c4 = tid & 15, grp = c4 >> 2, within = (c4 & 3) * 4;
    const float* p = grp == 0 ? p0 : grp == 1 ? p1 : grp == 2 ? p2 : p3;
#pragma unroll
    for (int i = 0; i < KT / 32; ++i) {
        const int k = r + 32 * i; f32x4 v = (f32x4){0.f, 0.f, 0.f, 0.f};
        if (p) v = *(const f32x4*)(p + (size_t)(k0 + k) * ldn + within);
        tile[k * 65 + c4 * 4 + 0] = v[0]; tile[k * 65 + c4 * 4 + 1] = v[1]; tile[k * 65 + c4 * 4 + 2] = v[2]; tile[k * 65 + c4 * 4 + 3] = v[3];
    }
    __syncthreads();
    constexpr int CPR = KT / 16;
    const int row = tid / CPR, ch = tid % CPR;
    if (row < 64) {
        float v[16];
#pragma unroll
        for (int j = 0; j < 16; ++j) v[j] = tile[(ch * 16 + j) * 65 + row];
        u32x4 w0, w1;
        w0.x = cvt_pk_bf16(v[0], v[1]); w0.y = cvt_pk_bf16(v[2], v[3]); w0.z = cvt_pk_bf16(v[4], v[5]); w0.w = cvt_pk_bf16(v[6], v[7]);
        w1.x = cvt_pk_bf16(v[8], v[9]); w1.y = cvt_pk_bf16(v[10], v[11]); w1.z = cvt_pk_bf16(v[12], v[13]); w1.w = cvt_pk_bf16(v[14], v[15]);
        bf16_t* dp = dst + (size_t)row * K + k0 + ch * 16;
        *(u32x4*)dp = w0; *(u32x4*)(dp + 8) = w1;
    }
    __syncthreads();
}

constexpr int CV_WIN = 384, CV_WOUT = 128, CV_ROUT = 32, CV_LAYER = CV_WIN + CV_WOUT + CV_ROUT;
__device__ __forceinline__ void p0_conv(const Args& a, LAS unsigned char* lds) {
    LAS float* tile = (LAS float*)lds;
    for (int u = blockIdx.x; u < 2 * CV_LAYER; u += gridDim.x) {
        const int l = u / CV_LAYER; int j = u % CV_LAYER;
        if (j < CV_WIN) {
            const int rho0 = (j >> 3) * 64, kt = j & 7; const float* src = a.in[I_WIN] + (size_t)l * 1024 * DIN; const float* p[4];
#pragma unroll
            for (int g = 0; g < 4; ++g) { const int rho = rho0 + 16 * g; const int col = rho < 2304 ? rho : rho < 2816 ? rho + 16 : rho < 2832 ? rho - 512 : -1; p[g] = col >= 0 ? src + col : nullptr; }
            conv_tile<128>(tile, p[0], p[1], p[2], p[3], DIN, kt * 128, (bf16_t*)(a.ws + WS_WIN) + ((size_t)l * NIN + rho0) * 1024, 1024);
            continue;
        }
        j -= CV_WIN;
        if (j < CV_WOUT) {
            const int rho0 = (j >> 3) * 64, kt = j & 7; const float* src = a.in[I_WOUT] + (size_t)l * 1024 * 1024 + rho0;
            conv_tile<128>(tile, src, src + 16, src + 32, src + 48, 1024, kt * 128, (bf16_t*)(a.ws + WS_WOUT) + ((size_t)l * 1024 + rho0) * 1024, 1024);
            continue;
        }
        j -= CV_WOUT;
        if (j < CV_ROUT) {
            const int rho0 = (j >> 3) * 64, kt = j & 7; const float* src = a.in[I_RW] + (size_t)l * 1024 * 256 + rho0;
            conv_tile<128>(tile, src, src + 16, src + 32, src + 48, 256, kt * 128, (bf16_t*)(a.ws + WS_ROUT) + ((size_t)l * 256 + rho0) * 1024, 1024);
            continue;
        }
    }
}

__device__ __forceinline__ int sample_of(int row) { return row < NLAT ? (row >> 11) : 16; }

__device__ __forceinline__ void slot_sum(const bf16_t* Y, int row, int lane, f32x4 (&s)[4]) {
#pragma unroll
    for (int ii = 0; ii < 4; ++ii) s[ii] = (f32x4){0.f, 0.f, 0.f, 0.f};
#pragma unroll
    for (int k = 0; k < NSLOT; ++k) {
        const bf16_t* yp = Y + ((size_t)row * NSLOT + k) * 1024 + lane * 4;
#pragma unroll
        for (int ii = 0; ii < 4; ++ii) { const u32x2 w = *(const u32x2*)(yp + ii * 256); s[ii][0] += __uint_as_float(w.x << 16); s[ii][1] += __uint_as_float(w.x & 0xffff0000u); s[ii][2] += __uint_as_float(w.y << 16); s[ii][3] += __uint_as_float(w.y & 0xffff0000u); }
    }
}
__device__ __forceinline__ void norm_mod_store(const f32x4 (&v)[4], const float* g, const float* shift, const float* scale, bf16_t* dst, int lane) {
    float ss = 0.f;
#pragma unroll
    for (int ii = 0; ii < 4; ++ii) ss += v[ii][0] * v[ii][0] + v[ii][1] * v[ii][1] + v[ii][2] * v[ii][2] + v[ii][3] * v[ii][3];
    ss = wave_sum(ss);
    const float rstd = rsqrtf(ss * (1.0f / 1024.0f) + EPS);
#pragma unroll
    for (int ii = 0; ii < 4; ++ii) {
        const int c = ii * 256 + lane * 4;
        const f32x4 gg = *(const f32x4*)(g + c), sh = *(const f32x4*)(shift + c), sc = *(const f32x4*)(scale + c);
        f32x4 y;
#pragma unroll
        for (int j = 0; j < 4; ++j) y[j] = v[ii][j] * rstd * gg[j] * (1.0f + sc[j]) + sh[j];
        u32x2 w; w.x = cvt_pk_bf16(y[0], y[1]); w.y = cvt_pk_bf16(y[2], y[3]);
        *(u32x2*)(dst + c) = w;
    }
}

__device__ __forceinline__ void phase_n1(const Args& a, int l) {
    const int tid = opaque_tid(), wid = tid >> 6, lane = tid & 63;
    float* X = (float*)(a.ws + WS_X); bf16_t* XA = (bf16_t*)(a.ws + WS_XA); const float* MOD = (const float*)(a.ws + WS_MOD); const bf16_t* Y = (const bf16_t*)(a.ws + WS_R1);
    for (int row = blockIdx.x * 8 + wid; row < TOK; row += gridDim.x * 8) {
        const int s = sample_of(row);
        f32x4 v[4];
        if (l == 0) {
            if (row < NLAT) {
                const float* xp = a.in[I_X] + (size_t)row * 1024 + lane * 4;
                const int tp = row & 2047; const float pr = (float)(tp >> 6), pc = (float)(tp & 63);
#pragma unroll
                for (int ii = 0; ii < 4; ++ii) v[ii] = *(const f32x4*)(xp + ii * 256);
#pragma unroll
                for (int j = 0; j < 4; ++j) {
                    const float om = exp2f(-13.287712379549449f * (float)(lane * 4 + j) * (1.0f / 256.0f));
                    const float ar = pr * om, ac = pc * om;
                    v[0][j] += sinf(ar); v[1][j] += cosf(ar); v[2][j] += sinf(ac); v[3][j] += cosf(ac);
                }
            } else {
                const float* xp = a.in[I_CTX] + (size_t)(row - NLAT) * 1024 + lane * 4;
#pragma unroll
                for (int ii = 0; ii < 4; ++ii) v[ii] = *(const f32x4*)(xp + ii * 256);
            }
        } else {
            f32x4 ys[4]; slot_sum(Y, row, lane, ys);
            const float* gate = MOD + ((size_t)(l - 1) * 17 + s) * 6144 + 5 * 1024 + lane * 4;
#pragma unroll
            for (int ii = 0; ii < 4; ++ii) { const f32x4 xv = *(const f32x4*)(X + (size_t)row * 1024 + ii * 256 + lane * 4), gv = *(const f32x4*)(gate + ii * 256); v[ii] = xv + gv * ys[ii]; }
        }
#pragma unroll
        for (int ii = 0; ii < 4; ++ii) *(f32x4*)(X + (size_t)row * 1024 + ii * 256 + lane * 4) = v[ii];
        const float* m = MOD + ((size_t)l * 17 + s) * 6144;
        norm_mod_store(v, a.in[I_N1G] + l * 1024, m, m + 1024, XA + (size_t)row * 1024, lane);
    }
}
__device__ __forceinline__ void phase_n2(const Args& a, int l, int T) {
    const int tid = opaque_tid(), wid = tid >> 6, lane = tid & 63;
    const float* X = (const float*)(a.ws + WS_X); bf16_t* XA = (bf16_t*)(a.ws + WS_XA); const float* MOD = (const float*)(a.ws + WS_MOD);
    for (int row = blockIdx.x * 8 + wid; row < T; row += gridDim.x * 8) {
        const int s = sample_of(row);
        f32x4 v[4];
#pragma unroll
        for (int ii = 0; ii < 4; ++ii) v[ii] = *(const f32x4*)(X + (size_t)row * 1024 + ii * 256 + lane * 4);
        const float* m = MOD + ((size_t)l * 17 + s) * 6144;
        norm_mod_store(v, a.in[I_N2G] + l * 1024, m + 3 * 1024, m + 4 * 1024, XA + (size_t)row * 1024, lane);
    }
}
__device__ __forceinline__ void phase_fin(const Args& a) {
    const int tid = opaque_tid(), wid = tid >> 6, lane = tid & 63;
    const float* X = (const float*)(a.ws + WS_X); const float* MOD = (const float*)(a.ws + WS_MOD); const bf16_t* Y = (const bf16_t*)(a.ws + WS_R1);
    for (int row = blockIdx.x * 8 + wid; row < NLAT; row += gridDim.x * 8) {
        const int s = sample_of(row);
        f32x4 ys[4], v[4]; slot_sum(Y, row, lane, ys);
        const float* gate = MOD + ((size_t)17 + s) * 6144 + 5 * 1024 + lane * 4;
        float ss = 0.f;
#pragma unroll
        for (int ii = 0; ii < 4; ++ii) { const f32x4 xv = *(const f32x4*)(X + (size_t)row * 1024 + ii * 256 + lane * 4), gv = *(const f32x4*)(gate + ii * 256); v[ii] = xv + gv * ys[ii];
            ss += v[ii][0] * v[ii][0] + v[ii][1] * v[ii][1] + v[ii][2] * v[ii][2] + v[ii][3] * v[ii][3]; }
        ss = wave_sum(ss);
        const float rstd = rsqrtf(ss * (1.0f / 1024.0f) + EPS);
#pragma unroll
        for (int ii = 0; ii < 4; ++ii) { const f32x4 g = *(const f32x4*)(a.in[I_FNG] + ii * 256 + lane * 4); *(f32x4*)(a.out + (size_t)row * 1024 + ii * 256 + lane * 4) = v[ii] * rstd * g; }
    }
}

namespace pg8 {
#define PG8_LAS __attribute__((address_space(3)))
typedef unsigned short bf16_t;
typedef short bf16x8 __attribute__((ext_vector_type(8)));
typedef float f32x4 __attribute__((ext_vector_type(4)));
typedef unsigned u32x4 __attribute__((ext_vector_type(4)));
constexpr int BM = 256, BK = 64, HALF = 128, HTB = HALF * BK * 2  , STAGE_BYTES = 8 * HTB, NXCD = 8, WGM = 8;

__host__ __device__ __forceinline__ int lds_byte(int r, int c) { const int st = (r >> 4) * 2 + (c >> 5), rr = r & 15, cc = c & 31, ob = rr * 64 + cc * 2; return st * 1024 + (ob ^ (((ob >> 9) & 1) << 5)); }
__host__ __device__ __forceinline__ void stage_rc(int b, int& R, int& C) { const int st = b / 1024, sb = b % 1024, swz = sb ^ (((sb >> 9) & 1) << 5); R = (st >> 1) * 16 + swz / 64; C = (st & 1) * 32 + (swz % 64) / 2; }
__host__ __device__ __forceinline__ int perm32(int rho) { const int n = rho >> 4, i = rho & 15; return 8 * (i >> 2) + 4 * n + (i & 3); }

struct Unit { int pm, pn; };
struct Gemm { const bf16_t* A; const bf16_t* Bt; int M, N, K; };

struct StaticOrder {
    int nM, nN, nwg, G, c;
    __host__ __device__ void init(int M, int N, int G_, int c_) { nM = M / BM; nN = N / BM; nwg = nM * nN; G = G_; c = c_; }
    __host__ __device__ bool next(int i, Unit& u) const {
        const long L = (long)i * G + c; if (L >= nwg) return false;
        int wgid = (int)L; { const int q = nwg / NXCD, r = nwg % NXCD, xcd = wgid % NXCD, off = wgid / NXCD; wgid = (xcd < r ? xcd * (q + 1) : r * (q + 1) + (xcd - r) * q) + off; }
        const int nig = WGM * nN, gid = wgid / nig, fm = gid * WGM, gsz = (nM - fm) < WGM ? (nM - fm) : WGM;
        u.pm = fm + ((wgid % nig) % gsz); u.pn = (wgid % nig) / gsz; return true;
    }
    __device__ __forceinline__ void a_ready(const Unit&) const {}
    __device__ __forceinline__ void done(const Unit&) const {}
};
template <class Epi, class Sched, bool STAMP = false>
__device__ __forceinline__ void gemm_phase(PG8_LAS unsigned char* lds, const Gemm g, const Sched& S, const Epi& E, unsigned long long* stamps) {
    const int tid = opaque_tid(), wid = __builtin_amdgcn_readfirstlane(tid >> 6), lane = tid & 63, wr = wid >> 2, wc = wid & 3, fr = lane & 15, fq = lane >> 4;
    const int K = g.K, nt = K / BK;
    int ts_lo = 0, ts_hi = 0, nts = 0; const unsigned long long rt_entry = STAMP ? (unsigned long long)wall_clock64() : 0ull;
#define PG8_STAMP() do { if (STAMP && wid == 0 && nts < 64) { const unsigned long long _c = (unsigned long long)clock64(); \
        ts_lo = (lane == nts) ? (int)(unsigned)_c : ts_lo; ts_hi = (lane == nts) ? (int)(unsigned)(_c >> 32) : ts_hi; ++nts; } } while (0)
    PG8_STAMP();
    unsigned voffA[2], voffB[2];
#pragma unroll
    for (int i = 0; i < 2; ++i) { int R, C; stage_rc(tid * 16 + i * 8192, R, C); const int Rb = Epi::PERM ? ((R & ~31) + perm32(R & 31)) : R;
        voffA[i] = (unsigned)(R * K + C) * 2u; voffB[i] = (unsigned)(Rb * K + C) * 2u; }
    const size_t kstep = (size_t)(BK * 2);
    const size_t hstep = (size_t)HALF * K * 2;
    const size_t tstep = 2 * hstep;
    const unsigned ldsw = (unsigned)wid * 1024u;
    const int aoff = lds_byte(wr * 64 + fr, fq * 8), boff = lds_byte(wc * 32 + fr, fq * 8);
#define PG8_SA(b, h) (((b) * 2 + (h)) * HTB)
#define PG8_SB(b, h) ((4 + (b) * 2 + (h)) * HTB)
#define PG8_STAGE(bufoff, gbase, voff) do { _Pragma("unroll") for (int _i = 0; _i < 2; ++_i) \
        __builtin_amdgcn_global_load_lds((const unsigned*)((const char*)(gbase) + (voff)[_i]), (PG8_LAS unsigned*)(lds + (bufoff) + ldsw + _i * 8192), 16, 0, 0); } while (0)
#define PG8_LDA(dst, b, h) do { _Pragma("unroll") for (int m = 0; m < 4; ++m) _Pragma("unroll") for (int k = 0; k < 2; ++k) dst[m][k] = *(const PG8_LAS bf16x8*)(lds + PG8_SA(b, h) + aoff + m * 2048 + k * 1024); } while (0)
#define PG8_LDB(dst, b, h) do { _Pragma("unroll") for (int n = 0; n < 2; ++n) _Pragma("unroll") for (int k = 0; k < 2; ++k) dst[n][k] = *(const PG8_LAS bf16x8*)(lds + PG8_SB(b, h) + boff + n * 2048 + k * 1024); } while (0)
#define PG8_MMA(ai, bj, At, Bt) do { __builtin_amdgcn_s_setprio(1); _Pragma("unroll") for (int m = 0; m < 4; ++m) _Pragma("unroll") for (int n = 0; n < 2; ++n) _Pragma("unroll") for (int k = 0; k < 2; ++k) \
        acc[ai][bj][m][n] = __builtin_amdgcn_mfma_f32_16x16x32_bf16(Bt[n][k], At[m][k], acc[ai][bj][m][n], 0, 0, 0); __builtin_amdgcn_s_setprio(0); } while (0)
#define PG8_WAIT_V(n) asm volatile("s_waitcnt vmcnt(" #n ")" ::: "memory")
#define PG8_WAIT_L(n) asm volatile("s_waitcnt lgkmcnt(" #n ")" ::: "memory")
#define PG8_BAR __builtin_amdgcn_s_barrier()
#define PG8_SCHED __builtin_amdgcn_sched_barrier(0)
    Unit cur, nxt; int ui = 0;
    if (!S.next(0, cur)) return;
    f32x4 acc[2][2][4][2];
#pragma unroll
    for (int a = 0; a < 2; ++a)
#pragma unroll
        for (int b = 0; b < 2; ++b)
#pragma unroll
            for (int m = 0; m < 4; ++m)
#pragma unroll
                for (int n = 0; n < 2; ++n) acc[a][b][m][n] = (f32x4){0.f, 0.f, 0.f, 0.f};
    bf16x8 At[4][2], B0[2][2], B1[2][2];
    const char* cA = (const char*)g.A + (size_t)cur.pm * tstep; const char* cB = (const char*)g.Bt + (size_t)cur.pn * tstep;
    S.a_ready(cur);
    PG8_STAGE(PG8_SB(0, 0), cB, voffB); PG8_STAGE(PG8_SA(0, 0), cA, voffA); PG8_STAGE(PG8_SB(0, 1), cB + hstep, voffB); PG8_STAGE(PG8_SA(0, 1), cA + hstep, voffA);
    if (wr == 1) PG8_BAR;
    PG8_WAIT_V(4); PG8_BAR;
    PG8_STAGE(PG8_SB(1, 0), cB + kstep, voffB); PG8_STAGE(PG8_SA(1, 0), cA + kstep, voffA); PG8_STAGE(PG8_SB(1, 1), cB + hstep + kstep, voffB);
    PG8_WAIT_V(6); PG8_BAR;
    PG8_STAMP();
    for (;;) {
        const bool has_next = S.next(ui + 1, nxt);
        const char* nA = has_next ? (const char*)g.A + (size_t)nxt.pm * tstep : cA; const char* nB = has_next ? (const char*)g.Bt + (size_t)nxt.pn * tstep : cB;
        for (int t = 0; t < nt; t += 2) {
            const bool last = (t == nt - 2);
            const char* a1 = cA + (size_t)(t + 1) * kstep;
            const char* a2 = last ? nA : cA + (size_t)(t + 2) * kstep; const char* b2 = last ? nB : cB + (size_t)(t + 2) * kstep;
            const char* a3 = a2 + kstep; const char* b3 = b2 + kstep;
            if (last && has_next) S.a_ready(nxt);
            PG8_LDB(B0, 0, 0); PG8_SCHED; PG8_LDA(At, 0, 0); PG8_STAGE(PG8_SA(1, 1), a1 + hstep, voffA);
            PG8_WAIT_L(8); PG8_BAR; PG8_WAIT_L(0); PG8_MMA(0, 0, At, B0); PG8_BAR; PG8_SCHED;
            PG8_LDB(B1, 0, 1); PG8_STAGE(PG8_SB(0, 0), b2, voffB);
            PG8_BAR; PG8_WAIT_L(0); PG8_MMA(0, 1, At, B1); PG8_BAR;
            PG8_LDA(At, 0, 1); PG8_STAGE(PG8_SA(0, 0), a2, voffA);
            PG8_BAR; PG8_WAIT_L(0); PG8_MMA(1, 0, At, B0); PG8_BAR; PG8_SCHED;
            PG8_STAGE(PG8_SB(0, 1), b2 + hstep, voffB);
            PG8_WAIT_V(6); PG8_BAR; PG8_MMA(1, 1, At, B1); PG8_BAR;
            PG8_LDB(B0, 1, 0); PG8_SCHED; PG8_LDA(At, 1, 0); PG8_STAGE(PG8_SA(0, 1), a2 + hstep, voffA);
            PG8_WAIT_L(8); PG8_BAR; PG8_WAIT_L(0); PG8_MMA(0, 0, At, B0); PG8_BAR; PG8_SCHED;
            PG8_LDB(B1, 1, 1); PG8_STAGE(PG8_SB(1, 0), b3, voffB);
            PG8_BAR; PG8_WAIT_L(0); PG8_MMA(0, 1, At, B1); PG8_BAR;
            PG8_LDA(At, 1, 1); PG8_STAGE(PG8_SA(1, 0), a3, voffA);
            PG8_BAR; PG8_WAIT_L(0); PG8_MMA(1, 0, At, B0); PG8_BAR; PG8_SCHED;
            PG8_STAGE(PG8_SB(1, 1), b3 + hstep, voffB);
            PG8_WAIT_V(6); PG8_BAR; PG8_MMA(1, 1, At, B1); PG8_BAR;
        }
        PG8_STAMP();
        if constexpr (!Epi::AFTER_DRAIN) { E(acc, cur, wr, wc, fr, fq); S.done(cur); }
        PG8_STAMP();
        if (!has_next) break;
#pragma unroll
        for (int a = 0; a < 2; ++a)
#pragma unroll
            for (int b = 0; b < 2; ++b)
#pragma unroll
                for (int m = 0; m < 4; ++m)
#pragma unroll
                    for (int n = 0; n < 2; ++n) acc[a][b][m][n] = (f32x4){0.f, 0.f, 0.f, 0.f};
        cur = nxt; cA = nA; cB = nB; ++ui;
    }
    PG8_WAIT_V(0);
    if (wr == 0) PG8_BAR;
    PG8_BAR;
    if constexpr (Epi::AFTER_DRAIN) { E.fused(acc, cur, wr, wc, fr, fq, lds, wid, lane); S.done(cur); }
    PG8_STAMP();
    if (STAMP && wid == 0) { stamps[lane] = lane < nts ? (((unsigned long long)(unsigned)ts_hi << 32) | (unsigned)ts_lo) : 0ull;
        if (lane == 62) stamps[62] = rt_entry; if (lane == 63) stamps[63] = (unsigned long long)wall_clock64(); }
#undef PG8_STAMP
#undef PG8_SA
#undef PG8_SB
#undef PG8_STAGE
#undef PG8_LDA
#undef PG8_LDB
#undef PG8_MMA
#undef PG8_WAIT_V
#undef PG8_WAIT_L
#undef PG8_BAR
#undef PG8_SCHED
}
}

struct EpiG1 {
    static constexpr bool PERM = true, AFTER_DRAIN = false;
    bf16_t* P; float* GATES;
    __device__ __forceinline__ void operator()(const f32x4 (&acc)[2][2][4][2], const pg8::Unit& u, int wr, int wc, int fr, int fq) const {
        const int row0 = u.pm * 256 + wr * 64 + fr;
#pragma unroll
        for (int bj = 0; bj < 2; ++bj) {
            const int cb = u.pn * 256 + bj * 128 + wc * 32;
            if (cb >= DIN) continue;
            if (cb >= PW) {
                if (fq < 2) {
#pragma unroll
                    for (int ai = 0; ai < 2; ++ai)
#pragma unroll
                        for (int m = 0; m < 4; ++m) { float* gp = GATES + (size_t)(row0 + ai * 128 + m * 16) * 16 + fq * 8; *(f32x4*)gp = acc[ai][bj][m][0]; *(f32x4*)(gp + 4) = acc[ai][bj][m][1]; }
                }
            } else {
                const bool g = (cb >= PC_RG && cb < PC_Q) || cb >= PC_CU;
                const float sc = (cb >= PC_K && cb < PC_V) ? 0.10206207261596575f : 1.0f;
#pragma unroll
                for (int ai = 0; ai < 2; ++ai)
#pragma unroll
                    for (int m = 0; m < 4; ++m) {
                        f32x4 v0 = acc[ai][bj][m][0], v1 = acc[ai][bj][m][1];
                        if (g) { v0[0] = gelu_tanh(v0[0]); v0[1] = gelu_tanh(v0[1]); v0[2] = gelu_tanh(v0[2]); v0[3] = gelu_tanh(v0[3]); v1[0] = gelu_tanh(v1[0]); v1[1] = gelu_tanh(v1[1]); v1[2] = gelu_tanh(v1[2]); v1[3] = gelu_tanh(v1[3]); }
                        else { v0 = v0 * sc; v1 = v1 * sc; }
                        u32x4 w; w.x = cvt_pk_bf16(v0[0], v0[1]); w.y = cvt_pk_bf16(v0[2], v0[3]); w.z = cvt_pk_bf16(v1[0], v1[1]); w.w = cvt_pk_bf16(v1[2], v1[3]);
                        *(u32x4*)(P + (size_t)(row0 + ai * 128 + m * 16) * PW + cb + fq * 8) = w;
                    }
            }
        }
    }
};
__device__ __forceinline__ void phase_g1(const Args& a, LAS unsigned char* lds, int l) {
    pg8::Gemm g{(const bf16_t*)(a.ws + WS_XA), (const bf16_t*)(a.ws + WS_WIN) + (size_t)l * NIN * 1024, TOK, NIN, 1024};
    pg8::StaticOrder S; S.init(TOK, NIN, (int)gridDim.x, (int)blockIdx.x);
    EpiG1 E{(bf16_t*)(a.ws + WS_P), (float*)(a.ws + WS_GATES)};
    pg8::gemm_phase<EpiG1, pg8::StaticOrder>(lds, g, S, E, nullptr);
}
struct EpiG2 {
    static constexpr bool PERM = true, AFTER_DRAIN = false;
    float* X; const float* MODl;
    __device__ __forceinline__ void operator()(const f32x4 (&acc)[2][2][4][2], const pg8::Unit& u, int wr, int wc, int fr, int fq) const {
        const int row0 = u.pm * 256 + wr * 64 + fr; const float* gate = MODl + (size_t)sample_of(u.pm * 256) * 6144 + 2 * 1024;
#pragma unroll
        for (int bj = 0; bj < 2; ++bj) {
            const int col = u.pn * 256 + bj * 128 + wc * 32 + fq * 8; const f32x4 g0 = *(const f32x4*)(gate + col), g1 = *(const f32x4*)(gate + col + 4);
#pragma unroll
            for (int ai = 0; ai < 2; ++ai)
#pragma unroll
                for (int m = 0; m < 4; ++m) { float* xp = X + (size_t)(row0 + ai * 128 + m * 16) * 1024 + col;
                    const f32x4 x0 = *(const f32x4*)xp, x1 = *(const f32x4*)(xp + 4); *(f32x4*)xp = x0 + g0 * acc[ai][bj][m][0]; *(f32x4*)(xp + 4) = x1 + g1 * acc[ai][bj][m][1]; }
        }
    }
};
__device__ __forceinline__ void phase_g2(const Args& a, LAS unsigned char* lds, int l, int T) {
    pg8::Gemm g{(const bf16_t*)(a.ws + WS_MIX), (const bf16_t*)(a.ws + WS_WOUT) + (size_t)l * 1024 * 1024, T, 1024, 1024};
    pg8::StaticOrder S; S.init(T, 1024, (int)gridDim.x, (int)blockIdx.x);
    EpiG2 E{(float*)(a.ws + WS_X), (const float*)(a.ws + WS_MOD) + (size_t)l * 17 * 6144};
    pg8::gemm_phase<EpiG2, pg8::StaticOrder>(lds, g, S, E, nullptr);
}
struct EpiRT {
    static constexpr bool PERM = false, AFTER_DRAIN = false;
    float* LG;
    __device__ __forceinline__ void operator()(const f32x4 (&acc)[2][2][4][2], const pg8::Unit& u, int wr, int wc, int fr, int fq) const {
        const int row0 = u.pm * 256 + wr * 64 + fr;
#pragma unroll
        for (int bj = 0; bj < 2; ++bj)
#pragma unroll
            for (int n = 0; n < 2; ++n)
#pragma unroll
                for (int ai = 0; ai < 2; ++ai)
#pragma unroll
                    for (int m = 0; m < 4; ++m) *(f32x4*)(LG + (size_t)(row0 + ai * 128 + m * 16) * 256 + bj * 128 + wc * 32 + n * 16 + fq * 4) = acc[ai][bj][m][n];
    }
};
__device__ __forceinline__ void phase_rt(const Args& a, LAS unsigned char* lds, int l, int T) {
    pg8::Gemm g{(const bf16_t*)(a.ws + WS_XA), (const bf16_t*)(a.ws + WS_ROUT) + (size_t)l * 256 * 1024, T, 256, 1024};
    pg8::StaticOrder S; S.init(T, 256, (int)gridDim.x, (int)blockIdx.x);
    EpiRT E{(float*)(a.ws + WS_LOGITS)};
    pg8::gemm_phase<EpiRT, pg8::StaticOrder>(lds, g, S, E, nullptr);
}

template <int CTRL> __device__ __forceinline__ float dppf(float old, float src) { return __int_as_float(__builtin_amdgcn_update_dpp(__float_as_int(old), __float_as_int(src), CTRL, 0xF, 0xF, false)); }
constexpr int TK_MAXTOK = 512;
__device__ __forceinline__ void phase_tk(const Args& a, LAS unsigned char* lds, int l, int T) {
    const int tid = opaque_tid(), wid = tid >> 6, lane = tid & 63;
    const float* LG = (const float*)(a.ws + WS_LOGITS); const float* rb = a.in[I_RB] + l * 256;
    unsigned* CNT = (unsigned*)(a.ws + WS_CTL + CTL_CNT) + (size_t)l * 256 * CNT_STRIDE; int* LS = (int*)(a.ws + WS_LSLOT); float* LWt = (float*)(a.ws + WS_LW);
    LAS unsigned* lcnt = (LAS unsigned*)lds; LAS unsigned* lbase = lcnt + 256; LAS unsigned* ent = lbase + 256; LAS float* entw = (LAS float*)(ent + TK_MAXTOK * 8);
    const f32x4 bias = *(const f32x4*)(rb + lane * 4);
    const float NEG = -__builtin_huge_valf();
    const int per = (T + (int)gridDim.x - 1) / (int)gridDim.x;
    for (int base0 = blockIdx.x * per; base0 < (int)(blockIdx.x + 1) * per && base0 < T; base0 += TK_MAXTOK) {
        int ntok = (int)(blockIdx.x + 1) * per - base0; if (ntok > TK_MAXTOK) ntok = TK_MAXTOK; if (ntok > T - base0) ntok = T - base0;
        __syncthreads();
        if (tid < 256) lcnt[tid] = 0u;
        __syncthreads();
        for (int tl = wid; tl < ntok; tl += 8) {
            const int t = base0 + tl;
            const f32x4 lg = *(const f32x4*)(LG + (size_t)t * 256 + lane * 4);
            float sc[4], sel[4];
#pragma unroll
            for (int j = 0; j < 4; ++j) { sc[j] = 1.0f / (1.0f + expf(-lg[j])); sel[j] = sc[j] + bias[j]; }
            float a1 = fmaxf(sel[0], sel[1]), a2 = fminf(sel[0], sel[1]);
#pragma unroll
            for (int j = 2; j < 4; ++j) { const float v = sel[j]; a2 = fmaxf(a2, fminf(a1, v)); a1 = fmaxf(a1, v); }
#define TK_MERGE(CTRL) { const float b1 = dppf<CTRL>(a1, a1), b2 = dppf<CTRL>(a2, a2); const float n1 = fmaxf(a1, b1), n2 = fmaxf(fminf(a1, b1), fmaxf(a2, b2)); a1 = n1; a2 = n2; }
            TK_MERGE(0xB1) TK_MERGE(0x4E) TK_MERGE(0x141)
#undef TK_MERGE
            const float gs = a1 + a2; const int g = lane >> 3; int rank = 0;
#pragma unroll
            for (int g2 = 0; g2 < 8; ++g2) { const float s2 = __int_as_float(__builtin_amdgcn_readlane(__float_as_int(gs), g2 * 8)); rank += (s2 > gs || (s2 == gs && g2 < g)) ? 1 : 0; }
            float ms[4];
#pragma unroll
            for (int j = 0; j < 4; ++j) ms[j] = rank < 4 ? sel[j] : NEG;
            int my_e = 0; float my_s = 0.f, ssum = 0.f;
#pragma unroll
            for (int k = 0; k < 8; ++k) {
                float mx = fmaxf(fmaxf(ms[0], ms[1]), fmaxf(ms[2], ms[3]));
                mx = fmaxf(mx, dppf<0x111>(NEG, mx)); mx = fmaxf(mx, dppf<0x112>(NEG, mx)); mx = fmaxf(mx, dppf<0x114>(NEG, mx)); mx = fmaxf(mx, dppf<0x118>(NEG, mx));
                const float gmax = fmaxf(fmaxf(__int_as_float(__builtin_amdgcn_readlane(__float_as_int(mx), 15)), __int_as_float(__builtin_amdgcn_readlane(__float_as_int(mx), 31))),
                                         fmaxf(__int_as_float(__builtin_amdgcn_readlane(__float_as_int(mx), 47)), __int_as_float(__builtin_amdgcn_readlane(__float_as_int(mx), 63))));
                const int cand = ms[0] == gmax ? 0 : ms[1] == gmax ? 1 : ms[2] == gmax ? 2 : ms[3] == gmax ? 3 : -1;
                const unsigned long long bal = __ballot(cand >= 0);
                const int wl = __builtin_amdgcn_readfirstlane(__ffsll((unsigned long long)bal) - 1);
                const int jj = __builtin_amdgcn_readlane(cand, wl), bi = wl * 4 + jj;
                const float mysc = jj == 0 ? sc[0] : jj == 1 ? sc[1] : jj == 2 ? sc[2] : sc[3];
                const float sk = __int_as_float(__builtin_amdgcn_readlane(__float_as_int(mysc), wl));
#pragma unroll
                for (int j = 0; j < 4; ++j) if (lane == wl && j == jj) ms[j] = NEG;
                if (lane == k) { my_e = bi; my_s = sk; }
                ssum += sk;
            }
            if (lane < 8) {
                const unsigned r = __hip_atomic_fetch_add(&lcnt[my_e], 1u, __ATOMIC_RELAXED, __HIP_MEMORY_SCOPE_WORKGROUP);
                ent[tl * 8 + lane] = ((unsigned)my_e << 16) | r; entw[tl * 8 + lane] = my_s / ssum * 2.5f;
            }
        }
        __syncthreads();
        if (tid < 256) { const unsigned c = lcnt[tid]; lbase[tid] = c ? atomicAdd(&CNT[tid * CNT_STRIDE], c) : 0u; }
        __syncthreads();
        for (int i = tid; i < ntok * 8; i += NTHREADS) {
            const unsigned v = ent[i]; const int e = (int)(v >> 16); const unsigned pos = lbase[e] + (v & 0xffffu);
            LS[(size_t)e * LCAP + pos] = (base0 + (i >> 3)) * NSLOT + (i & 7); LWt[(size_t)e * LCAP + pos] = entw[i];
        }
    }
}

__device__ __forceinline__ void moe_tables(const Args& a, LAS unsigned char* lds, int l, int T) {
    LAS int* cntE = (LAS int*)(lds + LDS_TAB); LAS int* blkoff = cntE + 264;
    const int tid = opaque_tid(); const unsigned* CNT = (const unsigned*)(a.ws + WS_CTL + CTL_CNT) + (size_t)l * 256 * CNT_STRIDE;
    if (tid < 256) cntE[tid] = (int)CNT[tid * CNT_STRIDE]; else if (tid == 256) cntE[256] = T;
    __syncthreads();
    if (tid < 258) { int s = 0; for (int e = 0; e < tid && e < 257; ++e) s += (cntE[e] + 255) >> 8; blkoff[tid] = s; }
    __syncthreads();
}
__device__ __forceinline__ int moe_find(const LAS int* blkoff, int mbg) { int lo = 0, hi = 257; while (hi - lo > 1) { const int mid = (lo + hi) >> 1; if (blkoff[mid] <= mbg) lo = mid; else hi = mid; } return lo; }

#define PV_LOAD32(dst, ptr) asm volatile("global_load_dword %0, %1, off" : "=&v"(dst) : "v"(ptr))
struct E1Prov {
    const Args& a; LAS unsigned char* lds; int l, nunit, R0, R1, C0, C1, wr, wc, fr, fq; int q0, q1; bool sh;
    __device__ __forceinline__ void decode(int i, int& mbg, int& nt, int& e, int& mb, int& cnt) const {
        const LAS int* cntE = (const LAS int*)(lds + LDS_TAB); const LAS int* blkoff = cntE + 264;
        const int u = blockIdx.x + i * gridDim.x; mbg = u / 3; nt = u - mbg * 3; e = moe_find(blkoff, mbg); mb = mbg - blkoff[e]; cnt = cntE[e];
    }
    __device__ __forceinline__ bool seg(int i, RSeg& d) {
        if ((int)(blockIdx.x + i * gridDim.x) >= nunit) return false;
        int mbg, nt, e, mb, cnt; decode(i, mbg, nt, e, mb, cnt);
        const int* LS = (const int*)(a.ws + WS_LSLOT) + (e < 256 ? (size_t)e * LCAP : 0);
        const int p0 = mb * 256 + R0, p1 = mb * 256 + R1; sh = e >= 256; q0 = p0 < cnt ? p0 : -1; q1 = p1 < cnt ? p1 : -1;
        const int* a0 = LS + (q0 >= 0 && !sh ? q0 : 0); const int* a1 = LS + (q1 >= 0 && !sh ? q1 : 0);
        PV_LOAD32(d.aoff[0], a0); PV_LOAD32(d.aoff[1], a1);
        d.Ab = (const unsigned char*)(a.ws + WS_XA);
        d.B0 = (e < 256 ? a.in[I_EG] + ((size_t)l * 256 + e) * 1024 * FF : a.in[I_SG] + (size_t)l * 1024 * FF) + nt * 96;
        d.B1 = (e < 256 ? a.in[I_EU] + ((size_t)l * 256 + e) * 1024 * FF : a.in[I_SU] + (size_t)l * 1024 * FF) + nt * 96;
        return true;
    }
    __device__ __forceinline__ void finish(RSeg& d, bool first) const {
        if (first) asm volatile("s_waitcnt vmcnt(0)" ::: "memory"); else asm volatile("s_waitcnt vmcnt(16)" ::: "memory");
        __builtin_amdgcn_sched_barrier(0); asm volatile("" : "+v"(d.aoff[0]), "+v"(d.aoff[1]));
        const int t0 = q0 < 0 ? 0 : sh ? q0 : (int)d.aoff[0] / NSLOT, t1 = q1 < 0 ? 0 : sh ? q1 : (int)d.aoff[1] / NSLOT;
        d.aoff[0] = (unsigned)t0 * 2048u + (unsigned)C0 * 2u; d.aoff[1] = (unsigned)t1 * 2048u + (unsigned)C1 * 2u;
    }
    __device__ __forceinline__ void epi(int i, f32x4 (&acc)[4][6]) const {
        int mbg, nt, e, mb, cnt; decode(i, mbg, nt, e, mb, cnt);
        bf16_t* HB = (bf16_t*)(a.ws + WS_HB);
#pragma unroll
        for (int m = 0; m < 4; ++m) {
            bf16_t* hp = HB + (size_t)(mbg * 256 + wr * 64 + m * 16 + fr) * FF + nt * 96 + wc * 48 + fq * 4;
#pragma unroll
            for (int n = 0; n < 3; ++n) {
                const f32x4 g = acc[m][n], uu = acc[m][n + 3];
                u32x2 w; w.x = cvt_pk_bf16(siluf_(g[0]) * uu[0], siluf_(g[1]) * uu[1]); w.y = cvt_pk_bf16(siluf_(g[2]) * uu[2], siluf_(g[3]) * uu[3]);
                *(u32x2*)(hp + n * 16) = w;
            }
        }
    }
};
__device__ __forceinline__ void ring_piece_rc(int wid, int lane, int k, int& R, int& C) { const int sb = lane * 16, swz = sb ^ (((sb >> 9) & 1) << 5); R = (wid + 8 * k) * 16 + (swz >> 6); C = (swz & 63) >> 1; }
__device__ __forceinline__ void phase_e1(const Args& a, LAS unsigned char* lds, int l, int T) {
    const int tid = opaque_tid(), wid = __builtin_amdgcn_readfirstlane(tid >> 6), lane = tid & 63;
    moe_tables(a, lds, l, T);
    const LAS int* blkoff = (const LAS int*)(lds + LDS_TAB) + 264;
    int R0, C0, R1, C1; ring_piece_rc(wid, lane, 0, R0, C0); ring_piece_rc(wid, lane, 1, R1, C1);
    E1Prov pv{a, lds, l, blkoff[257] * 3, R0, R1, C0, C1, wid >> 1, wid & 1, lane & 15, lane >> 4, -1, -1, false};
    ring_gemm<192, 2, true, true, 2, E1Prov>(lds, pv, 32, FF, 0u, 0u);
}

struct E2Prov {
    const Args& a; LAS unsigned char* lds; int l, nunit, tid; int pslot; float pw; int pidx, ppos; bool psh;
    __device__ __forceinline__ void decode(int i, int& mbg, int& pn, int& e, int& mb, int& cnt) const {
        const LAS int* cntE = (const LAS int*)(lds + LDS_TAB); const LAS int* blkoff = cntE + 264;
        const int u = blockIdx.x + i * gridDim.x; mbg = u >> 2; pn = u & 3; e = moe_find(blkoff, mbg); mb = mbg - blkoff[e]; cnt = cntE[e];
    }
    __device__ __forceinline__ bool seg(int i, RSeg& d) {
        if ((int)(blockIdx.x + i * gridDim.x) >= nunit) return false;
        int mbg, pn, e, mb, cnt; decode(i, mbg, pn, e, mb, cnt);
        const int pos = mb * 256 + (tid & 255); psh = e >= 256; ppos = (tid < 256 && pos < cnt) ? pos : -1; pidx = i;
        const size_t idx = (ppos >= 0 && !psh) ? (size_t)e * LCAP + pos : 0;
        const int* sp = (const int*)(a.ws + WS_LSLOT) + idx; const float* wp = (const float*)(a.ws + WS_LW) + idx;
        PV_LOAD32(pslot, sp); PV_LOAD32(pw, wp);
        d.Ab = (const unsigned char*)(a.ws + WS_HB) + (size_t)mbg * 256 * FF * 2;
        d.B0 = (e < 256 ? a.in[I_ED] + ((size_t)l * 256 + e) * FF * 1024 : a.in[I_SD] + (size_t)l * FF * 1024) + pn * 256; d.B1 = d.B0;
        return true;
    }
    __device__ __forceinline__ void finish(RSeg&, bool first) {
        if (first) asm volatile("s_waitcnt vmcnt(0)" ::: "memory"); else asm volatile("s_waitcnt vmcnt(16)" ::: "memory");
        __builtin_amdgcn_sched_barrier(0); asm volatile("" : "+v"(pslot), "+v"(pw));
        LAS int* tab = (LAS int*)(lds + LDS_TAB) + 528 + (pidx & 1) * 512;
        if (tid < 256) { tab[tid] = ppos < 0 ? -1 : psh ? ppos * NSLOT + 8 : pslot; ((LAS float*)tab)[256 + tid] = psh ? 1.0f : pw; }
    }
    __device__ __forceinline__ void epi(int i, f32x4 (&acc)[8][4]) const {
        int mbg, pn, e, mb, cnt; decode(i, mbg, pn, e, mb, cnt);
        const LAS int* tab = (const LAS int*)(lds + LDS_TAB) + 528 + (i & 1) * 512; bf16_t* Y = (bf16_t*)(a.ws + WS_R1);
        const int wr = tid >> 8, wc = (tid >> 6) & 3, fr = tid & 15, fq = (tid >> 4) & 3;
#pragma unroll
        for (int m = 0; m < 8; ++m) {
            const int r = wr * 128 + m * 16 + fr, slot = tab[r];
            if (slot >= 0) {
                const float w = ((const LAS float*)tab)[256 + r]; bf16_t* yp = Y + (size_t)slot * 1024 + pn * 256 + wc * 64 + fq * 16;
                const f32x4 v0 = acc[m][0] * w, v1 = acc[m][1] * w, v2 = acc[m][2] * w, v3 = acc[m][3] * w;
                u32x4 o0, o1; o0.x = cvt_pk_bf16(v0[0], v0[1]); o0.y = cvt_pk_bf16(v0[2], v0[3]); o0.z = cvt_pk_bf16(v1[0], v1[1]); o0.w = cvt_pk_bf16(v1[2], v1[3]);
                o1.x = cvt_pk_bf16(v2[0], v2[1]); o1.y = cvt_pk_bf16(v2[2], v2[3]); o1.z = cvt_pk_bf16(v3[0], v3[1]); o1.w = cvt_pk_bf16(v3[2], v3[3]);
                *(u32x4*)yp = o0; *(u32x4*)(yp + 8) = o1;
            }
        }
    }
};
__device__ __forceinline__ void phase_e2(const Args& a, LAS unsigned char* lds, int l, int T) {
    const int tid = opaque_tid(), wid = __builtin_amdgcn_readfirstlane(tid >> 6), lane = tid & 63;
    moe_tables(a, lds, l, T);
    const LAS int* blkoff = (const LAS int*)(lds + LDS_TAB) + 264;
    int R0, C0, R1, C1; ring_piece_rc(wid, lane, 0, R0, C0); ring_piece_rc(wid, lane, 1, R1, C1);
    E2Prov pv{a, lds, l, blkoff[257] * 4, tid, -1, 0.f, -1, -1, false};
    ring_gemm<256, 4, false, false, 1, E2Prov>(lds, pv, 9, 1024, (unsigned)(R0 * FF * 2 + C0 * 2), (unsigned)(R1 * FF * 2 + C1 * 2));
}

__device__ __forceinline__ float logsigmoidf_(float x) { return fminf(x, 0.f) - log1pf(expf(-fabsf(x))); }

__device__ __forceinline__ void mlstm_gates(const float* GATES, int row0, int rstep, int gcol, float bi, float bfg, float m, LAS float* colterm, LAS float* Marr, LAS float* bcarr, int lane) {
    const int p0 = 2 * lane;
    const float* g0 = GATES + (size_t)(row0 + rstep * p0) * 16 + gcol; const float* g1 = g0 + rstep * 16;
    const float gi0 = g0[0] + bi, gi1 = g1[0] + bi, lf0 = logsigmoidf_(g0[4] + bfg), lf1 = logsigmoidf_(g1[4] + bfg);
    float s = lf0 + lf1;
#pragma unroll
    for (int o = 1; o < 64; o <<= 1) { const float t = __shfl_up(s, o); if (lane >= o) s += t; }
    const float bc1 = s, bc0 = s - lf1, ct0 = gi0 - bc0, ct1 = gi1 - bc1;
    float pm = fmaxf(ct0, ct1);
#pragma unroll
    for (int o = 1; o < 64; o <<= 1) { const float t = __shfl_up(pm, o); if (lane >= o) pm = fmaxf(pm, t); }
    float prev = __shfl_up(pm, 1); if (lane == 0) prev = -__builtin_huge_valf();
    const float pm0 = fmaxf(prev, ct0);
    colterm[p0] = ct0; colterm[p0 + 1] = ct1; bcarr[p0] = bc0; bcarr[p0 + 1] = bc1; Marr[p0] = fmaxf(m, pm0); Marr[p0 + 1] = fmaxf(m, pm);
}

__device__ __forceinline__ void ms_unit(const Args& a, LAS unsigned char* lds, int l, int b, int h, int d) {
    const int tid = opaque_tid(), wid = __builtin_amdgcn_readfirstlane(tid >> 6), lane = tid & 63, fr = lane & 15, fq = lane >> 4;
    LAS bf16_t* Ks = (LAS bf16_t*)(lds);
    LAS bf16_t* Vp = (LAS bf16_t*)(lds + 26624);
    LAS float* colterm = (LAS float*)(lds + 57344); LAS float* Marr = colterm + 128; LAS float* bcarr = Marr + 128;
    const bf16_t* P = (const bf16_t*)(a.ws + WS_P); const float* GATES = (const float*)(a.ws + WS_GATES);
    const int seq = (b * 4 + h) * 2 + d;
    bf16_t* CTG = (bf16_t*)(a.ws + WS_CTG) + (size_t)seq * 18 * (112 * 96); float* MST = (float*)(a.ws + WS_MST) + seq * 18;
    const float bi = a.in[I_MGB][((l * 2 + d) * 2 + 0) * 4 + h], bfg = a.in[I_MGB][((l * 2 + d) * 2 + 1) * 4 + h];
    const int rstep = d ? -1 : 1, gcol = d * 8 + h;
    int pp[3], pch[3];
#pragma unroll
    for (int i = 0; i < 3; ++i) { const int rem = tid + 512 * i; pp[i] = rem / 12; pch[i] = rem - pp[i] * 12; }
#define MS_ROW0(step) (((step) < 2 ? NLAT + b * CTXL : b * SEQ) + (d ? ((step) < 2 ? CTXL : SEQ) - 1 - ((step) < 2 ? (step) : (step) - 2) * 128 : ((step) < 2 ? (step) : (step) - 2) * 128))
    u32x4 kv[6]; float gq[4];
#define MS_FETCH(step) do { const int _r0 = MS_ROW0(step); \
        _Pragma("unroll") for (int i = 0; i < 6; ++i) kv[i] = *(const u32x4*)(P + (size_t)(_r0 + rstep * pp[i % 3]) * PW + (i < 3 ? PC_K : PC_V) + h * 96 + pch[i % 3] * 8); \
        { const float* g0 = GATES + (size_t)(_r0 + rstep * 2 * lane) * 16 + gcol; gq[0] = g0[0]; gq[1] = g0[4]; gq[2] = g0[rstep * 16]; gq[3] = g0[rstep * 16 + 4]; } } while (0)
    __syncthreads();
    for (int i = tid; i < 128 * 3; i += NTHREADS) { const int p = i / 3, q = i - p * 3; u32x4 v = (u32x4){0u, 0u, 0u, 0u}; if (q == 0) v.x = 0x3F80u; *(LAS u32x4*)(Vp + p * 120 + 96 + q * 8) = v; }
    f32x4 Cst[7];
#pragma unroll
    for (int cb = 0; cb < 7; ++cb) Cst[cb] = (f32x4){0.f, 0.f, 0.f, 0.f};
    float m = 0.f;
    MS_FETCH(0);
    for (int step = 0; step < 18; ++step) {
        const bool do_out = step >= 2 || l == 0;
        if (wid == 0) {
            const int p0 = 2 * lane;
            const float gi0 = gq[0] + bi, gi1 = gq[2] + bi, lf0 = logsigmoidf_(gq[1] + bfg), lf1 = logsigmoidf_(gq[3] + bfg);
            float s = lf0 + lf1;
#pragma unroll
            for (int o = 1; o < 64; o <<= 1) { const float t = __shfl_up(s, o); if (lane >= o) s += t; }
            const float bc1 = s, bc0 = s - lf1, ct0 = gi0 - bc0, ct1 = gi1 - bc1;
            float pm = fmaxf(ct0, ct1);
#pragma unroll
            for (int o = 1; o < 64; o <<= 1) { const float t = __shfl_up(pm, o); if (lane >= o) pm = fmaxf(pm, t); }
            float prev = __shfl_up(pm, 1); if (lane == 0) prev = -__builtin_huge_valf();
            const float pm0 = fmaxf(prev, ct0);
            colterm[p0] = ct0; colterm[p0 + 1] = ct1; bcarr[p0] = bc0; bcarr[p0 + 1] = bc1; Marr[p0] = fmaxf(m, pm0); Marr[p0 + 1] = fmaxf(m, pm);
        }
        if (do_out) {
            if (tid == 0) MST[step] = m;
            if (wid < 6) {
                bf16_t* cg = CTG + (size_t)step * (112 * 96) + wid * 16 + fr;
#pragma unroll
                for (int cb = 0; cb < 7; ++cb)
#pragma unroll
                    for (int j = 0; j < 4; ++j) cg[(cb * 16 + fq * 4 + j) * 96] = f2bf(Cst[cb][j]);
            }
        }
        __syncthreads();
        const float Mend = Marr[127], gsum = bcarr[127];
#pragma unroll
        for (int i = 0; i < 6; ++i) {
            const int p = pp[i % 3], ch = pch[i % 3];
            u32x4 v = kv[i];
            if (i < 3) {
                const float w = __expf(colterm[p] - Mend);
                v.x = cvt_pk_bf16(__uint_as_float(v.x << 16) * w, __uint_as_float(v.x & 0xffff0000u) * w); v.y = cvt_pk_bf16(__uint_as_float(v.y << 16) * w, __uint_as_float(v.y & 0xffff0000u) * w);
                v.z = cvt_pk_bf16(__uint_as_float(v.z << 16) * w, __uint_as_float(v.z & 0xffff0000u) * w); v.w = cvt_pk_bf16(__uint_as_float(v.w << 16) * w, __uint_as_float(v.w & 0xffff0000u) * w);
                *(LAS u32x4*)(Ks + p * 104 + ch * 8) = v;
            } else *(LAS u32x4*)(Vp + p * 120 + ch * 8) = v;
        }
        if (step + 1 < 18) MS_FETCH(step + 1);
        __syncthreads();
        const float decay = __expf(m - Mend);
        if (wid < 6) {
#pragma unroll
            for (int cb = 0; cb < 7; ++cb) Cst[cb] = Cst[cb] * decay;
#pragma unroll
            for (int ks = 0; ks < 4; ++ks) {
                const bf16x8 bk = trfrag(Ks, 104, ks * 32, wid * 16, fr, fq);
#pragma unroll
                for (int cb = 0; cb < 7; ++cb) Cst[cb] = MFMA(trfrag(Vp, 120, ks * 32, cb * 16, fr, fq), bk, Cst[cb]);
            }
        }
        m = gsum + Mend;
        __syncthreads();
    }
#undef MS_FETCH
#undef MS_ROW0
}

__device__ __forceinline__ void mo_unit(const Args& a, LAS unsigned char* lds, int l, int b, int h, int cidx) {
    const int tid = opaque_tid(), wid = __builtin_amdgcn_readfirstlane(tid >> 6), lane = tid & 63, fr = lane & 15, fq = lane >> 4;
    LAS bf16_t* Qi = (LAS bf16_t*)(lds);
    LAS bf16_t* Ki = (LAS bf16_t*)(lds + 26624);
    LAS bf16_t* Si = (LAS bf16_t*)(lds);
    LAS bf16_t* Vp = (LAS bf16_t*)(lds + 53248);
    LAS float* Hs = (LAS float*)(lds + 83968);
    LAS float* colterm = (LAS float*)(lds + 135168); LAS float* Marr = colterm + 128; LAS float* bcarr = Marr + 128;
    const bf16_t* P = (const bf16_t*)(a.ws + WS_P); const float* GATES = (const float*)(a.ws + WS_GATES); bf16_t* MIX = (bf16_t*)(a.ws + WS_MIX);
    const bool isctx = cidx >= 16; const int n = isctx ? cidx - 16 : cidx, nc = isctx ? 2 : 16, rowbase = (isctx ? NLAT + b * CTXL : b * SEQ) + n * 128;
    __syncthreads();
    for (int i = tid; i < 128 * 3; i += NTHREADS) { const int p = i / 3, q = i - p * 3; u32x4 v = (u32x4){0u, 0u, 0u, 0u}; if (q == 0) v.x = 0x3F80u; *(LAS u32x4*)(Vp + p * 120 + 96 + q * 8) = v; }
    for (int d = 0; d < 2; ++d) {
        const int seq = (b * 4 + h) * 2 + d, np = d ? nc - 1 - n : n, step = isctx ? np : 2 + np;
        const float m = ((const float*)(a.ws + WS_MST))[seq * 18 + step];
        const bf16_t* CT = (const bf16_t*)(a.ws + WS_CTG) + ((size_t)seq * 18 + step) * (112 * 96);
        const float bi = a.in[I_MGB][((l * 2 + d) * 2 + 0) * 4 + h], bfg = a.in[I_MGB][((l * 2 + d) * 2 + 1) * 4 + h];
        const int row0 = rowbase + (d ? 127 : 0), rstep = d ? -1 : 1;
        if (wid == 0) mlstm_gates(GATES, row0, rstep, d * 8 + h, bi, bfg, m, colterm, Marr, bcarr, lane);
#pragma unroll
        for (int i = 0; i < 9; ++i) {
            const int rem = tid + 512 * (i % 3), p = rem / 12, ch = rem - p * 12;
            const u32x4 v = *(const u32x4*)(P + (size_t)(row0 + rstep * p) * PW + PC_Q + (i / 3) * 384 + h * 96 + ch * 8);
            if (i < 3) *(LAS u32x4*)(Qi + p * 104 + ch * 8) = v; else if (i < 6) *(LAS u32x4*)(Ki + p * 104 + ch * 8) = v; else *(LAS u32x4*)(Vp + p * 120 + ch * 8) = v;
        }
        __syncthreads();
        f32x4 num[7], sacc[8];
        const int t = wid * 16 + fr; const float Mt = Marr[t];
#pragma unroll
        for (int cb = 0; cb < 7; ++cb) num[cb] = (f32x4){0.f, 0.f, 0.f, 0.f};
#pragma unroll
        for (int ks = 0; ks < 3; ++ks) {
            const bf16x8 bq = ldfrag(Qi, 104, wid * 16, ks * 32, fr, fq);
#pragma unroll
            for (int cb = 0; cb < 7; ++cb) num[cb] = MFMA(*(const bf16x8*)(CT + (cb * 16 + fr) * 96 + ks * 32 + fq * 8), bq, num[cb]);
#pragma unroll
            for (int sb = 0; sb < 8; ++sb) if (sb <= wid) { if (ks == 0) sacc[sb] = (f32x4){0.f, 0.f, 0.f, 0.f}; sacc[sb] = MFMA(ldfrag(Ki, 104, sb * 16, ks * 32, fr, fq), bq, sacc[sb]); }
        }
        { const float ei = __expf(m - Mt);
#pragma unroll
          for (int cb = 0; cb < 7; ++cb) num[cb] = num[cb] * ei; }
        __syncthreads();
#pragma unroll
        for (int sb = 0; sb < 8; ++sb) {
            u32x2 w; w.x = 0u; w.y = 0u;
            if (sb <= wid) {
                const f32x4 ct = *(const LAS f32x4*)(colterm + sb * 16 + fq * 4); float e[4];
#pragma unroll
                for (int j = 0; j < 4; ++j) { const int s = sb * 16 + fq * 4 + j; e[j] = (s <= t) ? sacc[sb][j] * __expf(ct[j] - Mt) : 0.f; }
                w.x = cvt_pk_bf16(e[0], e[1]); w.y = cvt_pk_bf16(e[2], e[3]);
            }
            *(LAS u32x2*)(Si + t * 136 + sb * 16 + fq * 4) = w;
        }
        __syncthreads();
#pragma unroll
        for (int ks = 0; ks < 4; ++ks) {
            const bf16x8 bs = ldfrag(Si, 136, wid * 16, ks * 32, fr, fq);
#pragma unroll
            for (int cb = 0; cb < 7; ++cb) num[cb] = MFMA(trfrag(Vp, 120, ks * 32, cb * 16, fr, fq), bs, num[cb]);
        }
        const float den = __shfl(num[6][0], fr);
        const float inv = 1.0f / fmaxf(fabsf(den), __expf(-(bcarr[t] + Mt)));
        LAS float* hp = Hs + (d ? 127 - t : t) * 100 + fq * 4;
#pragma unroll
        for (int cb = 0; cb < 6; ++cb) { f32x4 hv = num[cb] * inv; if (d) hv = hv + *(const LAS f32x4*)(hp + cb * 16); *(LAS f32x4*)(hp + cb * 16) = hv; }
        __syncthreads();
    }
    {
        const int tau = wid * 16 + (lane >> 2), c0 = (lane & 3) * 24;
        float hv[24], ss = 0.f;
#pragma unroll
        for (int i = 0; i < 6; ++i) { const f32x4 x = *(const LAS f32x4*)(Hs + tau * 100 + c0 + i * 4); hv[4 * i] = x[0]; hv[4 * i + 1] = x[1]; hv[4 * i + 2] = x[2]; hv[4 * i + 3] = x[3]; ss += x[0] * x[0] + x[1] * x[1] + x[2] * x[2] + x[3] * x[3]; }
        ss += __shfl_xor(ss, 1); ss += __shfl_xor(ss, 2);
        const float rstd = rsqrtf(ss * (1.0f / 96.0f) + EPS);
        const bf16_t* op = P + (size_t)(rowbase + tau) * PW + PC_O + h * 96 + c0; const float* ng = a.in[I_MNG] + l * 384 + h * 96 + c0;
        bf16_t* mp = MIX + (size_t)(rowbase + tau) * 1024 + 384 + h * 96 + c0;
#pragma unroll
        for (int i = 0; i < 3; ++i) {
            const u32x4 ow = *(const u32x4*)(op + i * 8); const unsigned oo[4] = {ow.x, ow.y, ow.z, ow.w}; unsigned r[4];
#pragma unroll
            for (int j = 0; j < 4; ++j) { const int c = i * 8 + 2 * j; r[j] = cvt_pk_bf16(sigmoidf_(__uint_as_float(oo[j] << 16)) * hv[c] * rstd * ng[c], sigmoidf_(__uint_as_float(oo[j] & 0xffff0000u)) * hv[c + 1] * rstd * ng[c + 1]); }
            *(u32x4*)(mp + i * 8) = (u32x4){r[0], r[1], r[2], r[3]};
        }
    }
}

template <int D> __device__ __forceinline__ void scan16(float& A, float& U) {
#define RG_STEP(o) { const float Ao = dppf<(D ? 0x100 : 0x110) | (o)>(1.0f, A), Uo = dppf<(D ? 0x100 : 0x110) | (o)>(0.0f, U); U = fmaf(A, Uo, U); A *= Ao; }
    RG_STEP(1) RG_STEP(2) RG_STEP(4) RG_STEP(8)
#undef RG_STEP
}
template <bool FINAL>
__device__ __forceinline__ void rg_unit(const Args& a, LAS unsigned char* lds, int l, int b, int hd, int cidx) {
    const int tid = opaque_tid(), wid = __builtin_amdgcn_readfirstlane(tid >> 6), lane = tid & 63, fr = lane & 15, fq = lane >> 4;
    LAS bf16_t* zi = (LAS bf16_t*)lds;
    LAS bf16_t* Wi = (LAS bf16_t*)(lds + 18432);
    LAS float* zf = (LAS float*)(lds + 55296);
    LAS float* cst = (LAS float*)(lds + 88064);
    LAS float* wagg = (LAS float*)(lds + 89600);
    LAS float* hin = (LAS float*)(lds + 97792);
    const bf16_t* P = (const bf16_t*)(a.ws + WS_P); bf16_t* MIX = (bf16_t*)(a.ws + WS_MIX);
    float* AGG = (float*)(a.ws + WS_RGAGG);
    const bool isctx = cidx >= 16; const int n = isctx ? cidx - 16 : cidx, nc = isctx ? 2 : 16, Tseg = isctx ? CTXL : SEQ, segbase = isctx ? NLAT + b * CTXL : b * SEQ, base = n * 128;
    const int c = lane, ch = hd * 64 + c;
    __syncthreads();
    { const bf16_t* wt = (const bf16_t*)(a.ws + WS_RGWT) + (size_t)((l * 2) * 6 + hd) * 8192;
#pragma unroll
      for (int i = 0; i < 4; ++i) { const int idx = tid + 512 * i, dd = idx >> 10, r = (idx >> 3) & 127, k8 = idx & 7; *(LAS u32x4*)(Wi + (dd * 128 + r) * 72 + k8 * 8) = *(const u32x4*)(wt + (size_t)dd * 6 * 8192 + r * 64 + k8 * 8); } }
    if (tid < 128) { const int dd = tid >> 6, cc = tid & 63;
        cst[(dd * 3 + 0) * 64 + cc] = -1.4426950408889634f * a.in[I_RGGB][((l * 2 + dd) * 2 + 0) * 384 + hd * 64 + cc]; cst[(dd * 3 + 1) * 64 + cc] = -1.4426950408889634f * a.in[I_RGGB][((l * 2 + dd) * 2 + 1) * 384 + hd * 64 + cc];
        cst[(dd * 3 + 2) * 64 + cc] = -8.0f * 1.4426950408889634f * log1pf(expf(-a.in[I_RGLAM][(l * 2 + dd) * 384 + hd * 64 + cc]));
        if (FINAL) {
            const int np = dd ? nc - 1 - n : n, step = isctx ? np : 2 + np; const float* ag = AGG + (size_t)((b * 6 + hd) * 2 + dd) * 18 * 128 + cc;
            float Av[17], Uv[17];
#pragma unroll
            for (int s2 = 0; s2 < 17; ++s2) { Av[s2] = 1.f; Uv[s2] = 0.f; if (s2 < step) { Av[s2] = ag[s2 * 128]; Uv[s2] = ag[s2 * 128 + 64]; } }
            float hv = 0.f;
#pragma unroll
            for (int s2 = 0; s2 < 17; ++s2) hv = Av[s2] * hv + Uv[s2];
            hin[dd * 64 + cc] = hv;
        } }
    {
        const float cw0 = a.in[I_RGCW][(l * 4 + 0) * 384 + ch], cw1 = a.in[I_RGCW][(l * 4 + 1) * 384 + ch], cw2 = a.in[I_RGCW][(l * 4 + 2) * 384 + ch], cw3 = a.in[I_RGCW][(l * 4 + 3) * 384 + ch], cbias = a.in[I_RGCB][l * 384 + ch];
        const int tl0 = wid * 16; const bf16_t* pp = P + (size_t)segbase * PW + PC_RX + ch;
#define RG_LD(pos) (((pos) >= 0 && (pos) < Tseg) ? bf2f(pp[(size_t)(pos) * PW]) : 0.f)
        float xv[19];
#pragma unroll
        for (int i = 0; i < 19; ++i) xv[i] = RG_LD(base + tl0 - 2 + i);
#pragma unroll
        for (int i = 0; i < 16; ++i) { const float z = cw0 * xv[i] + cw1 * xv[i + 1] + cw2 * xv[i + 2] + cw3 * xv[i + 3] + cbias; zf[(tl0 + i) * 64 + c] = z; zi[(tl0 + i) * 72 + c] = f2bf(z); }
#undef RG_LD
    }
    __syncthreads();
    const int tl = wid * 16 + fr;
    f32x4 ysum[4];
#pragma unroll
    for (int nb = 0; nb < 4; ++nb) ysum[nb] = (f32x4){0.f, 0.f, 0.f, 0.f};
    f32x4 Ad[2][4], Ud[2][4];
#pragma unroll
    for (int d = 0; d < 2; ++d) {
        f32x4 acc[8];
#pragma unroll
        for (int nb = 0; nb < 8; ++nb) acc[nb] = (f32x4){0.f, 0.f, 0.f, 0.f};
#pragma unroll
        for (int ks = 0; ks < 2; ++ks) {
            const bf16x8 bz = ldfrag(zi, 72, wid * 16, ks * 32, fr, fq);
#pragma unroll
            for (int nb = 0; nb < 8; ++nb) acc[nb] = MFMA(ldfrag(Wi + d * 128 * 72, 72, nb * 16, ks * 32, fr, fq), bz, acc[nb]);
        }
#pragma unroll
        for (int nb = 0; nb < 4; ++nb) {
            const int j0 = nb * 16 + fq * 4;
            const f32x4 z4 = *(const LAS f32x4*)(zf + tl * 64 + j0), br = *(const LAS f32x4*)(cst + (d * 3 + 0) * 64 + j0), bi4 = *(const LAS f32x4*)(cst + (d * 3 + 1) * 64 + j0), sp = *(const LAS f32x4*)(cst + (d * 3 + 2) * 64 + j0);
#pragma unroll
            for (int j = 0; j < 4; ++j) {
                const float rg = __builtin_amdgcn_rcpf(1.0f + __builtin_amdgcn_exp2f(fmaf(acc[nb][j], -1.4426950408889634f, br[j])));
                const float ig = __builtin_amdgcn_rcpf(1.0f + __builtin_amdgcn_exp2f(fmaf(acc[nb + 4][j], -1.4426950408889634f, bi4[j])));
                const float av = __builtin_amdgcn_exp2f(rg * sp[j]);
                Ad[d][nb][j] = av; Ud[d][nb][j] = __builtin_amdgcn_sqrtf(fmaxf(fmaf(-av, av, 1.0f), 0.f)) * (ig * z4[j]);
            }
        }
#pragma unroll
        for (int nb = 0; nb < 4; ++nb)
#pragma unroll
            for (int j = 0; j < 4; ++j) { float A = Ad[d][nb][j], U = Ud[d][nb][j]; if (d == 0) scan16<0>(A, U); else scan16<1>(A, U); Ad[d][nb][j] = A; Ud[d][nb][j] = U; }
        if (fr == (d ? 0 : 15)) {
#pragma unroll
            for (int nb = 0; nb < 4; ++nb) { *(LAS f32x4*)(wagg + ((d * 8 + wid) * 2 + 0) * 64 + nb * 16 + fq * 4) = Ad[d][nb]; *(LAS f32x4*)(wagg + ((d * 8 + wid) * 2 + 1) * 64 + nb * 16 + fq * 4) = Ud[d][nb]; }
        }
    }
    __syncthreads();
    {
        bf16_t* PF = (bf16_t*)(a.ws + WS_RGPF) + ((size_t)(segbase + base + tl) * 384 + hd * 64) * 4;
#pragma unroll
        for (int nb = 0; nb < 4; ++nb) {
            const int j0 = nb * 16 + fq * 4;
            f32x4 Ap[2], Up[2];
#pragma unroll
            for (int d = 0; d < 2; ++d) {
                f32x4 Aw = (f32x4){1.f, 1.f, 1.f, 1.f}, Uw = (f32x4){0.f, 0.f, 0.f, 0.f};
                for (int w2 = 0; w2 < 7; ++w2) { const int w = d ? 7 - w2 : w2; if (d ? (w > wid) : (w < wid)) { const f32x4 aw = *(const LAS f32x4*)(wagg + ((d * 8 + w) * 2 + 0) * 64 + j0), uw = *(const LAS f32x4*)(wagg + ((d * 8 + w) * 2 + 1) * 64 + j0); Uw = aw * Uw + uw; Aw = Aw * aw; } }
                Ap[d] = Aw * Ad[d][nb]; Up[d] = Ad[d][nb] * Uw + Ud[d][nb];
            }
            u32x4 w0, w1;
            w0.x = cvt_pk_bf16(Ap[0][0], Up[0][0]); w0.y = cvt_pk_bf16(Ap[1][0], Up[1][0]); w0.z = cvt_pk_bf16(Ap[0][1], Up[0][1]); w0.w = cvt_pk_bf16(Ap[1][1], Up[1][1]);
            w1.x = cvt_pk_bf16(Ap[0][2], Up[0][2]); w1.y = cvt_pk_bf16(Ap[1][2], Up[1][2]); w1.z = cvt_pk_bf16(Ap[0][3], Up[0][3]); w1.w = cvt_pk_bf16(Ap[1][3], Up[1][3]);
            *(u32x4*)(PF + j0 * 4) = w0; *(u32x4*)(PF + j0 * 4 + 8) = w1;
        }
        if (tid < 128) { const int dd = tid >> 6, cc = tid & 63; float A = 1.f, U = 0.f;
#pragma unroll
            for (int w2 = 0; w2 < 8; ++w2) { const int w = dd ? 7 - w2 : w2; const float aw = wagg[((dd * 8 + w) * 2 + 0) * 64 + cc], uw = wagg[((dd * 8 + w) * 2 + 1) * 64 + cc]; U = aw * U + uw; A *= aw; }
            const int np = dd ? nc - 1 - n : n, step = isctx ? np : 2 + np; float* ag = AGG + ((size_t)((b * 6 + hd) * 2 + dd) * 18 + step) * 128 + cc;
            ag[0] = A; ag[64] = U; }
    }
}

__device__ __forceinline__ void rgc_unit(const Args& a, LAS unsigned char* lds, int l, int b, int hd, int cidx) {
    const int tid = opaque_tid();
    LAS float* hin = (LAS float*)lds;
    const bf16_t* P = (const bf16_t*)(a.ws + WS_P); bf16_t* MIX = (bf16_t*)(a.ws + WS_MIX); const float* AGG = (const float*)(a.ws + WS_RGAGG);
    const bool isctx = cidx >= 16; const int n = isctx ? cidx - 16 : cidx, nc = isctx ? 2 : 16, rowbase = (isctx ? NLAT + b * CTXL : b * SEQ) + n * 128;
    __syncthreads();
    if (tid < 128) { const int dd = tid >> 6, cc = tid & 63;
        const int np = dd ? nc - 1 - n : n, step = isctx ? np : 2 + np; const float* ag = AGG + (size_t)((b * 6 + hd) * 2 + dd) * 18 * 128 + cc;
        float Av[17], Uv[17];
#pragma unroll
        for (int s2 = 0; s2 < 17; ++s2) { Av[s2] = 1.f; Uv[s2] = 0.f; if (s2 < step) { Av[s2] = ag[s2 * 128]; Uv[s2] = ag[s2 * 128 + 64]; } }
        float hv = 0.f;
#pragma unroll
        for (int s2 = 0; s2 < 17; ++s2) hv = Av[s2] * hv + Uv[s2];
        hin[dd * 64 + cc] = hv; }
    __syncthreads();
    const int c4 = (tid & 15) * 4;
    const f32x4 hf = *(const LAS f32x4*)(hin + c4), hb = *(const LAS f32x4*)(hin + 64 + c4);
#pragma unroll
    for (int i = 0; i < 4; ++i) {
        const size_t row = (size_t)rowbase + (tid >> 4) + 32 * i;
        const bf16_t* pf = (const bf16_t*)(a.ws + WS_RGPF) + (row * 384 + hd * 64 + c4) * 4;
        const u32x4 w0 = *(const u32x4*)pf, w1 = *(const u32x4*)(pf + 8);
        const u32x2 gw = *(const u32x2*)(P + row * PW + PC_RG + hd * 64 + c4);
        const unsigned ww[8] = {w0.x, w0.y, w0.z, w0.w, w1.x, w1.y, w1.z, w1.w};
        float y[4];
#pragma unroll
        for (int j = 0; j < 4; ++j) y[j] = __uint_as_float(ww[2 * j] << 16) * hf[j] + __uint_as_float(ww[2 * j] & 0xffff0000u) + __uint_as_float(ww[2 * j + 1] << 16) * hb[j] + __uint_as_float(ww[2 * j + 1] & 0xffff0000u);
        u32x2 o; o.x = cvt_pk_bf16(__uint_as_float(gw.x << 16) * y[0], __uint_as_float(gw.x & 0xffff0000u) * y[1]); o.y = cvt_pk_bf16(__uint_as_float(gw.y << 16) * y[2], __uint_as_float(gw.y & 0xffff0000u) * y[3]);
        *(u32x2*)(MIX + row * 1024 + hd * 64 + c4) = o;
    }
}

__device__ __forceinline__ void gmlp_unit(const Args& a, LAS unsigned char* lds, int l, int chunk) {
    const int tid = opaque_tid(), wid = __builtin_amdgcn_readfirstlane(tid >> 6), lane = tid & 63, fr = lane & 15, fq = lane >> 4;
    LAS bf16_t* vn = (LAS bf16_t*)lds;
    const bf16_t* P = (const bf16_t*)(a.ws + WS_P); bf16_t* MIX = (bf16_t*)(a.ws + WS_MIX);
    const int row0 = chunk * 128;
    __syncthreads();
    {
        const f32x4 g = *(const f32x4*)(a.in[I_CMNG] + l * 256 + lane * 4);
        u32x2 wv[16];
#pragma unroll
        for (int i = 0; i < 16; ++i) wv[i] = *(const u32x2*)(P + (size_t)(row0 + wid * 16 + i) * PW + PC_CV + lane * 4);
#pragma unroll
        for (int i = 0; i < 16; ++i) {
            const int s = wid * 16 + i;
            const u32x2 w = wv[i];
            const float v0 = __uint_as_float(w.x << 16), v1 = __uint_as_float(w.x & 0xffff0000u), v2 = __uint_as_float(w.y << 16), v3 = __uint_as_float(w.y & 0xffff0000u);
            const float ss = wave_sum(v0 * v0 + v1 * v1 + v2 * v2 + v3 * v3);
            const float rstd = rsqrtf(ss * (1.0f / 256.0f) + EPS);
            u32x2 o; o.x = cvt_pk_bf16(v0 * rstd * g[0], v1 * rstd * g[1]); o.y = cvt_pk_bf16(v2 * rstd * g[2], v3 * rstd * g[3]);
            *(LAS u32x2*)(vn + s * 264 + lane * 4) = o;
        }
    }
    __syncthreads();
    const int g = wid >> 1, th = wid & 1;
    const float* ws = a.in[I_CMW] + ((size_t)(l * 4 + g) * 128) * 128;
    f32x4 acc[4][4];
#pragma unroll
    for (int m = 0; m < 4; ++m)
#pragma unroll
        for (int n = 0; n < 4; ++n) acc[m][n] = (f32x4){0.f, 0.f, 0.f, 0.f};
#pragma unroll
    for (int ks = 0; ks < 4; ++ks) {
        bf16x8 bw[4];
#pragma unroll
        for (int m = 0; m < 4; ++m) {
            const float* wp = ws + (size_t)(th * 64 + m * 16 + fr) * 128 + ks * 32 + fq * 8;
            const f32x4 w0 = *(const f32x4*)wp, w1 = *(const f32x4*)(wp + 4);
            u32x4 pk; pk.x = cvt_pk_bf16(w0[0], w0[1]); pk.y = cvt_pk_bf16(w0[2], w0[3]); pk.z = cvt_pk_bf16(w1[0], w1[1]); pk.w = cvt_pk_bf16(w1[2], w1[3]);
            bw[m] = __builtin_bit_cast(bf16x8, pk);
        }
#pragma unroll
        for (int n = 0; n < 4; ++n) {
            const bf16x8 av = trfrag(vn, 264, ks * 32, g * 64 + n * 16, fr, fq);
#pragma unroll
            for (int m = 0; m < 4; ++m) acc[m][n] = MFMA(av, bw[m], acc[m][n]);
        }
    }
#pragma unroll
    for (int m = 0; m < 4; ++m) {
        const int t = th * 64 + m * 16 + fr; const float bsv = a.in[I_CMB][(l * 4 + g) * 128 + t];
#pragma unroll
        for (int n = 0; n < 4; ++n) {
            const int cc = g * 64 + n * 16 + fq * 4;
            const u32x2 uw = *(const u32x2*)(P + (size_t)(row0 + t) * PW + PC_CU + cc);
            const float u0 = __uint_as_float(uw.x << 16), u1 = __uint_as_float(uw.x & 0xffff0000u), u2 = __uint_as_float(uw.y << 16), u3 = __uint_as_float(uw.y & 0xffff0000u);
            u32x2 o; o.x = cvt_pk_bf16(u0 * (acc[m][n][0] + bsv), u1 * (acc[m][n][1] + bsv)); o.y = cvt_pk_bf16(u2 * (acc[m][n][2] + bsv), u3 * (acc[m][n][3] + bsv));
            *(u32x2*)(MIX + (size_t)(row0 + t) * 1024 + 768 + cc) = o;
        }
    }
}

#define MX_NEXT(head) ({ __syncthreads(); if (tid == 0) *qv = (int)atomicAdd(q + (head) * 64, 1u); __syncthreads(); *qv; })
__device__ __forceinline__ void phase_mxa(const Args& a, LAS unsigned char* lds, int l) {
    unsigned* q = (unsigned*)(a.ws + WS_CTL + CTL_QUEUE) + l * 8 * 64; LAS int* qv = (LAS int*)(lds + LDS_BARW - 16); const int tid = opaque_tid();
    const int nch = (l == 0) ? 18 : 18;
    for (;;) { const int u = MX_NEXT(0); if (u >= 128) break; ms_unit(a, lds, l, u >> 3, (u >> 1) & 3, u & 1); }
    for (;;) { const int u = MX_NEXT(1); if (u >= 16 * 6 * nch) break; rg_unit<false>(a, lds, l, u / (6 * nch), (u / nch) % 6, u % nch); }
    const int ngm = (l == 0 ? TOK : NLAT) / 128;
    for (;;) { const int u = MX_NEXT(2); if (u >= ngm) break; gmlp_unit(a, lds, l, u); }
}
__device__ __forceinline__ void phase_mxc(const Args& a, LAS unsigned char* lds, int l) {
    unsigned* q = (unsigned*)(a.ws + WS_CTL + CTL_QUEUE) + l * 8 * 64; LAS int* qv = (LAS int*)(lds + LDS_BARW - 16); const int tid = opaque_tid();
    const int nch = (l == 0) ? 18 : 16;
    for (;;) { const int u = MX_NEXT(3); if (u >= 16 * 4 * nch) break; mo_unit(a, lds, l, u / (4 * nch), (u / nch) & 3, u % nch); }
    for (;;) { const int u = MX_NEXT(4); if (u >= 16 * 6 * nch) break; rgc_unit(a, lds, l, u / (6 * nch), (u / nch) % 6, u % nch); }
}
#undef MX_NEXT

constexpr int N_PHASES = 22;
__global__ void __launch_bounds__(NTHREADS, 2) fwd_kernel(Args a) {
    extern __shared__ __attribute__((aligned(16))) unsigned char lds_raw[];
    LAS unsigned char* lds = (LAS unsigned char*)lds_raw;
    const int lo = a.ph_lo, hi = a.ph_hi;
    XcdBarrier bar; bar.bar = (unsigned*)(a.ws + WS_CTL); bar.x = 0; bar.st = (volatile LAS unsigned*)(lds + LDS_BARW);
    if (hi - lo > 1) {
        if (threadIdx.x == 0) { *(LAS u32x4*)(lds + LDS_BARW) = (u32x4){0u, 0u, 0u, 0u}; }
        __syncthreads();
        bar = xcd_barrier_post((unsigned*)(a.ws + WS_CTL), (volatile LAS unsigned*)(lds + LDS_BARW));
    }
#ifndef PHSEL
#define PHSEL 0xFFF
#endif
#define SELJ(j) (((PHSEL) >> (j)) & 1)
#define IN(k) (lo <= (k) && (k) < hi)
#ifndef PROBE_MASK
#define PROBE_MASK 0u
#endif
    unsigned long long t_ph = PROBE_MASK ? __builtin_amdgcn_s_memrealtime() : 0ull;
#define SEAM(k) do { if (IN(k) && IN((k) + 1)) xcd_barrier(bar); \
    if (PROBE_MASK) { if (((PROBE_MASK) >> (k)) & 1u) { const unsigned long long t1 = __builtin_amdgcn_s_memrealtime(); while (__builtin_amdgcn_s_memrealtime() < t1 + (t1 - t_ph)) __builtin_amdgcn_s_sleep(4); } \
        __syncthreads(); t_ph = __builtin_amdgcn_s_memrealtime(); } } while (0)
    if (SELJ(10) && IN(0)) { p0_mod(a, lds); p0_conv(a, lds); }
    SEAM(0);
    for (int l = 0; l < 2; ++l) {
        const int pb = 1 + 10 * l, T = (l == 0) ? TOK : NLAT;
        if (SELJ(0) && IN(pb + 0)) phase_n1(a, l);
        SEAM(pb + 0);
        if (SELJ(1) && IN(pb + 1)) phase_g1(a, lds, l);
        SEAM(pb + 1);
        if (SELJ(2) && IN(pb + 2)) phase_mxa(a, lds, l);
        SEAM(pb + 2);
        if (SELJ(3) && IN(pb + 3)) phase_mxc(a, lds, l);
        SEAM(pb + 3);
        if (SELJ(4) && IN(pb + 4)) phase_g2(a, lds, l, T);
        SEAM(pb + 4);
        if (SELJ(5) && IN(pb + 5)) phase_n2(a, l, T);
        SEAM(pb + 5);
        if (SELJ(6) && IN(pb + 6)) phase_rt(a, lds, l, T);
        SEAM(pb + 6);
        if (SELJ(7) && IN(pb + 7)) phase_tk(a, lds, l, T);
        SEAM(pb + 7);
        if (SELJ(8) && IN(pb + 8)) phase_e1(a, lds, l, T);
        SEAM(pb + 8);
        if (SELJ(9) && IN(pb + 9)) phase_e2(a, lds, l, T);
        SEAM(pb + 9);
    }
    if (SELJ(11) && IN(21)) phase_fin(a);
#undef IN
#undef SEAM
}

extern "C" void kernel_launch(void* const* d_in, const int* in_sizes, int n_in, void* d_out, int out_size, void* d_ws, size_t ws_size, hipStream_t stream) {
    static int grid = 0;
    if (grid == 0) {
        if (n_in != 29 || out_size != NLAT * D || ws_size < WS_END) { fprintf(stderr, "kernel_launch: unexpected shapes (n_in %d, out %d, ws %zu, need %zu)\n", n_in, out_size, ws_size, (size_t)WS_END); grid = -1; return; }
        int dev = 0, cus = 0, per_cu = 0;
        if (hipGetDevice(&dev) != hipSuccess || hipDeviceGetAttribute(&cus, hipDeviceAttributeMultiprocessorCount, dev) != hipSuccess) { grid = -1; return; }
        if (hipFuncSetAttribute((const void*)fwd_kernel, hipFuncAttributeMaxDynamicSharedMemorySize, LDS_BYTES) != hipSuccess) { fprintf(stderr, "kernel_launch: hipFuncSetAttribute failed\n"); grid = -1; return; }
        if (hipOccupancyMaxActiveBlocksPerMultiprocessor(&per_cu, (const void*)fwd_kernel, NTHREADS, LDS_BYTES) != hipSuccess || per_cu < 1) { fprintf(stderr, "kernel_launch: occupancy query says %d\n", per_cu); (void)hipGetLastError(); grid = -1; return; }
        grid = cus;
    }
    if (grid < 0) return;
    (void)hipMemsetAsync((char*)d_ws + WS_CTL, 0, CTL_BYTES, stream);
    Args a{};
    for (int i = 0; i < 29; ++i) a.in[i] = (const float*)d_in[i];
    a.out = (float*)d_out; a.ws = (unsigned char*)d_ws;
#if MK_PER_PHASE
    for (int p = 0; p < N_PHASES; ++p) { a.ph_lo = p; a.ph_hi = p + 1; hipLaunchKernelGGL(fwd_kernel, dim3(grid), dim3(NTHREADS), LDS_BYTES, stream, a); }
#else
    a.ph_lo = 0; a.ph_hi = N_PHASES;
    hipLaunchKernelGGL(fwd_kernel, dim3(grid), dim3(NTHREADS), LDS_BYTES, stream, a);
#endif
}
```

```cpp
#include <hip/hip_runtime.h>
#include <cstdio>
#include <cstdint>

#ifndef MK_PER_PHASE
#define MK_PER_PHASE 0
#endif

#define LAS __attribute__((address_space(3)))
typedef unsigned short bf16_t;
typedef short bf16x8 __attribute__((ext_vector_type(8)));
typedef float f32x4 __attribute__((ext_vector_type(4)));
typedef float f32x2 __attribute__((ext_vector_type(2)));
typedef unsigned u32x4 __attribute__((ext_vector_type(4)));
typedef unsigned u32x2 __attribute__((ext_vector_type(2)));

constexpr int D = 1024, NBATCH = 16, SEQ = 2048, CTXL = 256;
constexpr int NLAT = NBATCH * SEQ, NCTX = NBATCH * CTXL, TOK = NLAT + NCTX;
constexpr int DIN = 2832, PW = 2816, NIN = 3072;
constexpr int NE = 256, FF = 288, NSLOT = 9, LCAP = TOK;
constexpr int NTHREADS = 512;
constexpr int LDS_BYTES = 147456;
constexpr int LDS_TAB = 139264;
constexpr int LDS_BARW = LDS_BYTES - 16;
constexpr float EPS = 1e-6f;

constexpr int PC_RX = 0, PC_RG = 384, PC_Q = 768, PC_K = 1152, PC_V = 1536, PC_O = 1920, PC_CU = 2304, PC_CV = 2560;

constexpr size_t WS_CTL = 0, CTL_BYTES = 131072;
constexpr size_t CTL_QUEUE = 16384, CTL_CNT = 32768;
constexpr int CNT_STRIDE = 32;
constexpr size_t WS_MOD = 131072;
constexpr size_t WS_X = WS_MOD + 1048576;
constexpr size_t WS_XA = WS_X + (size_t)TOK * D * 4;
constexpr size_t WS_R1 = WS_XA + (size_t)TOK * D * 2;
constexpr size_t R1_BYTES = (size_t)TOK * NSLOT * D * 2;
constexpr size_t WS_P = WS_R1;
constexpr size_t WS_MIX = WS_P + (size_t)TOK * PW * 2;
constexpr size_t WS_CTG = WS_MIX + (size_t)TOK * D * 2;
constexpr size_t WS_MST = WS_CTG + (size_t)128 * 18 * 112 * 96 * 2;
constexpr size_t WS_RGAGG = WS_MST + 16384;
constexpr size_t WS_RGPF = WS_RGAGG + (size_t)192 * 18 * 128 * 4;
static_assert(WS_RGPF + (size_t)TOK * 384 * 4 * 2 <= WS_R1 + R1_BYTES, "aliases");
constexpr int HB_ROWS = (TOK * 8 / 256 + 256 + TOK / 256) * 256;
constexpr size_t WS_HB = WS_R1 + R1_BYTES;
constexpr size_t WS_GATES = WS_HB + (size_t)HB_ROWS * FF * 2 + 256;
constexpr size_t WS_LOGITS = WS_GATES + (size_t)TOK * 16 * 4;
constexpr size_t WS_LSLOT = WS_LOGITS + (size_t)TOK * 256 * 4;
constexpr size_t WS_LW = WS_LSLOT + (size_t)NE * LCAP * 4;
constexpr size_t WS_WIN = WS_LW + (size_t)NE * LCAP * 4;
constexpr size_t WS_WOUT = WS_WIN + (size_t)2 * NIN * D * 2;
constexpr size_t WS_ROUT = WS_WOUT + (size_t)2 * D * D * 2;
constexpr size_t WS_RGWT = WS_ROUT + (size_t)2 * NE * D * 2;
constexpr size_t WS_END = WS_RGWT + (size_t)2 * 2 * 6 * 128 * 64 * 2;

__device__ __forceinline__ float bf2f(bf16_t b) { return __uint_as_float(((unsigned)b) << 16); }
__device__ __forceinline__ unsigned cvt_pk_bf16(float lo, float hi) { unsigned r; asm volatile("v_cvt_pk_bf16_f32 %0, %1, %2" : "=v"(r) : "v"(lo), "v"(hi)); return r; }
__device__ __forceinline__ bf16_t f2bf(float f) { return (bf16_t)(cvt_pk_bf16(f, 0.f) & 0xffffu); }
__device__ __forceinline__ float sigmoidf_(float x) { return __builtin_amdgcn_rcpf(1.0f + __expf(-x)); }
__device__ __forceinline__ float siluf_(float x) { return x * __builtin_amdgcn_rcpf(1.0f + __expf(-x)); }
__device__ __forceinline__ float gelu_tanh(float x) { const float u = 1.5957691216057308f * (x + 0.044715f * x * x * x); return x * __builtin_amdgcn_rcpf(1.0f + __expf(-u)); }
__device__ __forceinline__ float wave_sum(float v) {
#pragma unroll
    for (int o = 32; o >= 1; o >>= 1) v += __shfl_xor(v, o);
    return v;
}
__device__ __forceinline__ int opaque_tid() { int t = threadIdx.x; asm volatile("" : "+v"(t)); return t; }
#define WAIT_VM0() asm volatile("s_waitcnt vmcnt(0)" ::: "memory")

#define XB_TMO      128
#define XB_XCNT(j)  (256  + 64 * (j))
#define XB_XSUB(j)  (1280 + 64 * (j))
#define XB_XGEN(j)  (2304 + 64 * (j))
#define XB_TOP      3328
#define XB_TOPGEN   3392
#define XCD_BAR_WORDS 3456
#define XB_SPIN_CAP (1u << 18)

__device__ __forceinline__ unsigned xb_ld(unsigned* p)              { return __hip_atomic_load(p, __ATOMIC_RELAXED, __HIP_MEMORY_SCOPE_AGENT); }
__device__ __forceinline__ unsigned xb_add(unsigned* p, unsigned v) { return __hip_atomic_fetch_add(p, v, __ATOMIC_RELAXED, __HIP_MEMORY_SCOPE_AGENT); }
__device__ __forceinline__ unsigned xb_xcc_id() { return (unsigned)__builtin_amdgcn_s_getreg((3 << 11) | 20) & 0xFu; }
#define XB_SPIN(cond, bar) do { unsigned _sp = 0; while (cond) { __builtin_amdgcn_s_sleep(1); \
    if ((++_sp & 255u) == 0u) { if (xb_ld(&(bar)[XB_TMO])) break; if (_sp > XB_SPIN_CAP) { atomicAdd(&(bar)[XB_TMO], 1u); break; } } } } while (0)

struct XcdBarrier { unsigned* bar; unsigned x; volatile LAS unsigned* st; };

__device__ __forceinline__ XcdBarrier xcd_barrier_post(unsigned* bar, volatile LAS unsigned* st) {
    XcdBarrier b; b.bar = bar; b.x = xb_xcc_id(); b.st = st;
    if (threadIdx.x == 0) (void)xb_add(&bar[XB_XCNT(b.x)], 1u);
    return b;
}
__device__ __forceinline__ void xcd_barrier_complete(unsigned* bar, unsigned x, unsigned& nloc, unsigned& nx) {
    const unsigned G = gridDim.x * gridDim.y * gridDim.z;
    unsigned sum, cnt, mine, sp = 0u;
    for (;;) {
        sum = 0u; cnt = 0u; mine = 0u;
#pragma unroll
        for (unsigned j = 0; j < 16; ++j) { const unsigned c = xb_ld(&bar[XB_XCNT(j)]); sum += c; cnt += (c > 0u) ? 1u : 0u; mine = (j == x) ? c : mine; }
        if (sum == G) break;
        __builtin_amdgcn_s_sleep(1);
        if ((++sp & 255u) == 0u) { if (xb_ld(&bar[XB_TMO])) break; if (sp > XB_SPIN_CAP) { atomicAdd(&bar[XB_TMO], 1u); break; } }
    }
    nloc = mine > 0u ? mine : 1u; nx = cnt > 0u ? cnt : 1u;
}
__device__ __forceinline__ void xcd_barrier(const XcdBarrier& b) {
    asm volatile("s_waitcnt vmcnt(0)" ::: "memory");
    __syncthreads();
    if (threadIdx.x == 0) {
        unsigned* bar = b.bar;
        __builtin_amdgcn_s_waitcnt(0);
        unsigned nloc = b.st[0], nx = b.st[1];
        if (nloc == 0u) { xcd_barrier_complete(bar, b.x, nloc, nx); b.st[0] = nloc; b.st[1] = nx; }
        const unsigned old = xb_add(&bar[XB_XSUB(b.x)], 1u);
        const unsigned gen = old / nloc;
        if (old + 1u == (gen + 1u) * nloc) {
            __builtin_amdgcn_fence(__ATOMIC_RELEASE, "agent");
            asm volatile("s_waitcnt vmcnt(0)" ::: "memory");
            const unsigned og = xb_add(&bar[XB_TOP], 1u);
            const unsigned tg = og / nx;
            if (og + 1u == (tg + 1u) * nx) xb_add(&bar[XB_TOPGEN], 1u);
            else XB_SPIN(xb_ld(&bar[XB_TOPGEN]) == tg, bar);
            __builtin_amdgcn_fence(__ATOMIC_ACQUIRE, "agent");
            xb_add(&bar[XB_XGEN(b.x)], 1u);
            asm volatile("s_waitcnt vmcnt(0)" ::: "memory");
        } else {
            XB_SPIN(xb_ld(&bar[XB_XGEN(b.x)]) == gen, bar);
            __builtin_amdgcn_fence(__ATOMIC_ACQUIRE, "agent");
            asm volatile("s_waitcnt vmcnt(0)" ::: "memory");
        }
    }
    __syncthreads();
}

struct Args { const float* in[29]; float* out; unsigned char* ws; int ph_lo, ph_hi; };
enum { I_X = 0, I_C, I_CTX, I_CCTX, I_N1G, I_N2G, I_WMOD, I_BMOD, I_WIN, I_RGCW, I_RGCB, I_RGGW, I_RGGB, I_RGLAM, I_MGB, I_MNG, I_CMNG, I_CMW, I_CMB,
       I_WOUT, I_RW, I_RB, I_EG, I_EU, I_ED, I_SG, I_SU, I_SD, I_FNG };

__device__ __forceinline__ int lds_byte(int r, int c) { const int st = (r >> 4) * 2 + (c >> 5), ob = (r & 15) * 64 + (c & 31) * 2; return st * 1024 + (ob ^ (((ob >> 9) & 1) << 5)); }
__device__ __forceinline__ void stage_rc(int b, int& R, int& C) { const int st = b >> 10, sb = b & 1023, swz = sb ^ (((sb >> 9) & 1) << 5); R = (st >> 1) * 16 + (swz >> 6); C = (st & 1) * 32 + ((swz & 63) >> 1); }

template <int BN, int WC> struct GT { static constexpr int WR = 8 / WC, MF = 256 / WR / 16, NF = BN / WC / 16, BP = BN / 64; };

typedef short s16x4 __attribute__((ext_vector_type(4)));
__device__ __forceinline__ bf16x8 trfrag(const LAS bf16_t* img, int pitch, int k0, int n0, int fr, int fq) {
    const LAS bf16_t* p = img + (k0 + 8 * fq + (fr >> 2)) * pitch + n0 + 4 * (fr & 3);
    const s16x4 lo = __builtin_amdgcn_ds_read_tr16_b64_v4i16((LAS s16x4*)p), hi = __builtin_amdgcn_ds_read_tr16_b64_v4i16((LAS s16x4*)(p + 4 * pitch));
    return __builtin_shufflevector(lo, hi, 0, 1, 2, 3, 4, 5, 6, 7);
}

constexpr int RS_SLOT = 34816, RS_BOFF = 16384;
struct RSeg { const unsigned char* Ab; unsigned aoff[2]; const float* B0; const float* B1; };
template <int BN, int WC, bool DUAL, bool GATHER, int NSET, class PV>
__device__ __forceinline__ void ring_gemm(LAS unsigned char* lds, PV& pv, const int ns, const int ldb, const unsigned ca0, const unsigned ca1) {
    constexpr int MF = GT<BN, WC>::MF, NF = GT<BN, WC>::NF, PITCH = BN == 192 ? 200 : 280, LPS = BN / 64, VPR = BN / 4;
    const int tid = opaque_tid(), wid = __builtin_amdgcn_readfirstlane(tid >> 6), lane = tid & 63, fr = lane & 15, fq = lane >> 4;
    const int wr = wid / WC, wc = wid % WC;
    const int obA = fr * 64 + fq * 16;
    const int aro = (wr * MF) * 1024 + (obA ^ (((obA >> 9) & 1) << 5));
    const unsigned ldsb = (unsigned)(size_t)lds + (unsigned)(RS_BOFF + ((8 * fq + (fr >> 2)) * PITCH + (DUAL ? 4 * (fr & 3) + wc * 48 : 16 * (fr & 3) + wc * (NF * 16))) * 2);
    constexpr int NTB = DUAL ? LPS : 1;
    unsigned bsoff_[NTB]; unsigned bdst_[NTB];
    bool bsel_[NTB];
#pragma unroll
    for (int i = 0; i < NTB; ++i) { const int e = tid + 512 * i, row = e / VPR, c4 = e % VPR; bsel_[i] = DUAL && c4 >= 24; bsoff_[i] = (unsigned)(row * ldb + 4 * (DUAL ? c4 % 24 : c4));
        bdst_[i] = (unsigned)(size_t)lds + (unsigned)(RS_BOFF + (row * PITCH + 4 * c4) * 2); }
#define bsoff(i) (DUAL ? bsoff_[DUAL ? (i) : 0] : bsoff_[0] + (unsigned)(8 * (i) * ldb))
#define bdst(i) (DUAL ? bdst_[DUAL ? (i) : 0] : bdst_[0] + (unsigned)(8 * (i) * PITCH * 2))
#define bsel(i) (DUAL ? bsel_[DUAL ? (i) : 0] : false)
    f32x4 acc[MF][NF];
#pragma unroll
    for (int m = 0; m < MF; ++m)
#pragma unroll
        for (int n = 0; n < NF; ++n) acc[m][n] = (f32x4){0.f, 0.f, 0.f, 0.f};
    RSeg ss, nx; int si = 0, sj = 0;
    bool have = pv.seg(0, ss); if (!have) return;
    pv.finish(ss, true);
    bool have_nx = pv.seg(1, nx);
    int staged = 0, g = 0, ci = 0, cj = 0;
    f32x4 r0[LPS], r1[NSET == 2 ? LPS : 1];
#define RS_STAGEA() do { _Pragma("unroll") for (int _i = 0; _i < 2; ++_i) __builtin_amdgcn_global_load_lds((const unsigned*)(ss.Ab + (GATHER ? ss.aoff[_i] : (_i ? ca1 : ca0)) + (size_t)sj * 64), (LAS unsigned*)(lds + (staged & 3) * RS_SLOT + (wid + 8 * _i) * 1024), 16, 0, 0); } while (0)
#define RS_LOADB(rr) do { if (DUAL) { _Pragma("unroll") for (int _i = 0; _i < LPS; ++_i) { const float* _p = (bsel(_i) ? ss.B1 : ss.B0) + bsoff(_i) + (size_t)(sj * 32) * ldb; \
            asm volatile("global_load_dwordx4 %0, %1, off" : "=&v"(rr[_i]) : "v"(_p)); } } \
        else { const float* _sb = ss.B0 + (size_t)(sj * 32) * ldb; _Pragma("unroll") for (int _i = 0; _i < LPS; ++_i) { const unsigned _o = bsoff(_i) * 4u; \
            asm volatile("global_load_dwordx4 %0, %1, %2" : "=&v"(rr[_i]) : "v"(_o), "s"(_sb)); } } } while (0)
#define RS_WAITB(rr, steady) do { if (steady) { if (NSET == 1) asm volatile("s_waitcnt vmcnt(2)" ::: "memory"); else if (LPS == 3) asm volatile("s_waitcnt vmcnt(7)" ::: "memory"); else asm volatile("s_waitcnt vmcnt(8)" ::: "memory"); } else asm volatile("s_waitcnt vmcnt(0)" ::: "memory"); \
        __builtin_amdgcn_sched_barrier(0);        \
        if (LPS == 3) asm volatile("" : "+v"(rr[0]), "+v"(rr[1]), "+v"(rr[2])); else asm volatile("" : "+v"(rr[0]), "+v"(rr[1]), "+v"(rr[2]), "+v"(rr[LPS > 3 ? 3 : 0])); } while (0)
#define RS_WRITEB(rr, slot) do { _Pragma("unroll") for (int _i = 0; _i < LPS; ++_i) { u32x2 _w; _w.x = cvt_pk_bf16(rr[_i][0], rr[_i][1]); _w.y = cvt_pk_bf16(rr[_i][2], rr[_i][3]); \
        asm volatile("ds_write_b64 %0, %1" :: "v"(bdst(_i) + (unsigned)((slot) * RS_SLOT)), "v"(_w) : "memory"); } } while (0)
#define RS_ADVANCE() do { ++staged; if (++sj == ns) { sj = 0; ++si; if (have_nx) pv.finish(nx, false); ss = nx; have = have_nx; have_nx = have ? pv.seg(si + 1, nx) : false; } } while (0)
#define RS_TR(dst, slot, off) asm volatile("ds_read_b64_tr_b16 %0, %1 offset:%2" : "=v"(dst) : "v"(ldsb + (unsigned)((slot) * RS_SLOT)), "n"(off))
#define RS_KSTEP(slot) do { bf16x8 At[MF], Bf[NF]; s16x4 _lo[NF], _hi[NF]; \
        _Pragma("unroll") for (int n = 0; n < NF; ++n) { \
            if (DUAL) { if (n < 3) { RS_TR(_lo[n], slot, (16 * (n % 3)) * 2); RS_TR(_hi[n], slot, (16 * (n % 3) + 4 * PITCH) * 2); } else { RS_TR(_lo[n], slot, (96 + 16 * (n % 3)) * 2); RS_TR(_hi[n], slot, (96 + 16 * (n % 3) + 4 * PITCH) * 2); } } \
            else { RS_TR(_lo[n], slot, (4 * n) * 2); RS_TR(_hi[n], slot, (4 * n + 4 * PITCH) * 2); } } \
        _Pragma("unroll") for (int m = 0; m < MF; ++m) At[m] = *(const LAS bf16x8*)(lds + (slot) * RS_SLOT + aro + m * 1024); \
        if (NF == 6) asm volatile("s_waitcnt lgkmcnt(0)" : "+v"(_lo[0]), "+v"(_hi[0]), "+v"(_lo[1]), "+v"(_hi[1]), "+v"(_lo[2]), "+v"(_hi[2]), "+v"(_lo[3]), "+v"(_hi[3]), "+v"(_lo[NF > 4 ? 4 : 0]), "+v"(_hi[NF > 4 ? 4 : 0]), "+v"(_lo[NF > 5 ? 5 : 1]), "+v"(_hi[NF > 5 ? 5 : 1])); \
        else asm volatile("s_waitcnt lgkmcnt(0)" : "+v"(_lo[0]), "+v"(_hi[0]), "+v"(_lo[1]), "+v"(_hi[1]), "+v"(_lo[2]), "+v"(_hi[2]), "+v"(_lo[3]), "+v"(_hi[3])); \
        _Pragma("unroll") for (int n = 0; n < NF; ++n) Bf[n] = __builtin_shufflevector(_lo[n], _hi[n], 0, 1, 2, 3, 4, 5, 6, 7); \
        _Pragma("unroll") for (int m = 0; m < MF; ++m) _Pragma("unroll") for (int n = 0; n < NF; ++n) acc[m][n] = __builtin_amdgcn_mfma_f32_16x16x32_bf16(Bf[n], At[m], acc[m][n], 0, 0, 0); __builtin_amdgcn_sched_barrier(0); } while (0)
#define RS_BARRIER() do { asm volatile("s_waitcnt lgkmcnt(0)" ::: "memory"); __builtin_amdgcn_s_barrier(); asm volatile("" ::: "memory"); } while (0)
    if (NSET == 2) {
        RS_STAGEA(); RS_LOADB(r0); RS_WAITB(r0, false); RS_WRITEB(r0, 0); RS_ADVANCE();
        if (have) { RS_STAGEA(); RS_LOADB(r1); RS_ADVANCE(); }
        if (have) { RS_STAGEA(); RS_LOADB(r0); RS_ADVANCE(); }
    } else {
        RS_STAGEA(); RS_LOADB(r0); RS_WAITB(r0, false); RS_WRITEB(r0, 0); RS_ADVANCE();
        if (have) { RS_STAGEA(); RS_LOADB(r0); RS_ADVANCE(); }
    }
    WAIT_VM0(); RS_BARRIER();
#define RS_ITER(rw, STEADY) do { \
        const bool st = have; \
        if (st) RS_STAGEA(); \
        RS_KSTEP(g & 3); \
        if (++cj == ns) { pv.epi(ci, acc); _Pragma("unroll") for (int m = 0; m < MF; ++m) _Pragma("unroll") for (int n = 0; n < NF; ++n) acc[m][n] = (f32x4){0.f, 0.f, 0.f, 0.f}; cj = 0; ++ci; } \
        if (g + 1 < staged) { RS_WAITB(rw, STEADY); RS_WRITEB(rw, (g + 1) & 3); } \
        if (st) { RS_LOADB(rw); RS_ADVANCE(); } \
        st_prev = st; ++g; RS_BARRIER(); } while (0)
    bool st_prev = true;
    if (NSET == 2) {
        for (;;) {
            RS_ITER(r1, st && st_prev); if (g >= staged) break;
            RS_ITER(r0, st && st_prev); if (g >= staged) break;
        }
    } else {
        for (;;) { RS_ITER(r0, st); if (g >= staged) break; }
    }
    WAIT_VM0(); __syncthreads();
#undef RS_STAGEA
#undef RS_LOADB
#undef RS_WAITB
#undef RS_WRITEB
#undef RS_ADVANCE
#undef RS_TR
#undef RS_KSTEP
#undef RS_BARRIER
#undef RS_ITER
#undef bsoff
#undef bdst
#undef bsel
}

__device__ __forceinline__ bf16x8 ldfrag(const LAS bf16_t* img, int pitch, int row0, int k0, int fr, int fq) { return *(const LAS bf16x8*)(img + (row0 + fr) * pitch + k0 + fq * 8); }
#define MFMA(a, b, c) __builtin_amdgcn_mfma_f32_16x16x32_bf16(a, b, c, 0, 0, 0)

__device__ __forceinline__ void p0_mod(const Args& a, LAS unsigned char* lds) {
    { bf16_t* wt = (bf16_t*)(a.ws + WS_RGWT);
      for (int idx = blockIdx.x * NTHREADS + threadIdx.x; idx < 2 * 2 * 2 * 6 * 4096; idx += gridDim.x * NTHREADS) { const int j = idx & 63, i = (idx >> 6) & 63, hd = (idx >> 12) % 6, g = ((idx >> 12) / 6) & 1, ld = (idx >> 12) / 12;
          wt[((size_t)(ld * 6 + hd) * 128 + g * 64 + j) * 64 + i] = f2bf(a.in[I_RGGW][idx]); } }
    LAS float* sc = (LAS float*)lds;
    LAS float* red = (LAS float*)(lds + 69632);
    const int tid = opaque_tid();
    for (int i = tid; i < 17 * 1024; i += NTHREADS) { const int s = i >> 10, k = i & 1023; const float v = s < 16 ? a.in[I_C][s * 1024 + k] : a.in[I_CCTX][k]; sc[i] = siluf_(v); }
    __syncthreads();
    float* MOD = (float*)(a.ws + WS_MOD);
    for (int u = blockIdx.x; u < 192; u += gridDim.x) {
        const int l = u / 96, cb = (u % 96) * 64, col = tid & 63, ks = tid >> 6;
        const float* w = a.in[I_WMOD] + (size_t)l * 1024 * 6144 + cb + col;
        float acc[17];
#pragma unroll
        for (int s = 0; s < 17; ++s) acc[s] = 0.f;
#pragma unroll 4
        for (int k = ks * 128; k < ks * 128 + 128; ++k) {
            const float wv = w[(size_t)k * 6144];
#pragma unroll
            for (int s = 0; s < 17; ++s) acc[s] += sc[s * 1024 + k] * wv;
        }
#pragma unroll
        for (int s = 0; s < 17; ++s) red[(ks * 17 + s) * 64 + col] = acc[s];
        __syncthreads();
        for (int i = tid; i < 17 * 64; i += NTHREADS) {
            const int s = i >> 6, c = i & 63; float v = 0.f;
#pragma unroll
            for (int k2 = 0; k2 < 8; ++k2) v += red[(k2 * 17 + s) * 64 + c];
            MOD[((size_t)l * 17 + s) * 6144 + cb + c] = v + a.in[I_BMOD][l * 6144 + cb + c];
        }
        __syncthreads();
    }
}

template <int KT>
__device__ __forceinline__ void conv_tile(LAS float* tile, const float* p0, const float* p1, const float* p2, const float* p3, int ldn, int k0, bf16_t* dst, int K) {
    const int tid = opaque_tid(), r = tid >> 4, c4 = tid & 15, grp = c4 >> 2, within = (c4 & 3) * 4;
    const float* p = grp == 0 ? p0 : grp == 1 ? p1 : grp == 2 ? p2 : p3;
#pragma unroll
    for (int i = 0; i < KT / 32; ++i) {
        const int k = r + 32 * i; f32x4 v = (f32x4){0.f, 0.f, 0.f, 0.f};
        if (p) v = *(const f32x4*)(p + (size_t)(k0 + k) * ldn + within);
        tile[k * 65 + c4 * 4 + 0] = v[0]; tile[k * 65 + c4 * 4 + 1] = v[1]; tile[k * 65 + c4 * 4 + 2] = v[2]; tile[k * 65 + c4 * 4 + 3] = v[3];
    }
    __syncthreads();
    constexpr int CPR = KT / 16;
    const int row = tid / CPR, ch = tid % CPR;
    if (row < 64) {
        float v[16];
#pragma unroll
        for (int j = 0; j < 16; ++j) v[j] = tile[(ch * 16 + j) * 65 + row];
        u32x4 w0, w1;
        w0.x = cvt_pk_bf16(v[0], v[1]); w0.y = cvt_pk_bf16(v[2], v[3]); w0.z = cvt_pk_bf16(v[4], v[5]); w0.w = cvt_pk_bf16(v[6], v[7]);
        w1.x = cvt_pk_bf16(v[8], v[9]); w1.y = cvt_pk_bf16(v[10], v[11]); w1.z = cvt_pk_bf16(v[12], v[13]); w1.w = cvt_pk_bf16(v[14], v[15]);
        bf16_t* dp = dst + (size_t)row * K + k0 + ch * 16;
        *(u32x4*)dp = w0; *(u32x4*)(dp + 8) = w1;
    }
    __syncthreads();
}

constexpr int CV_WIN = 384, CV_WOUT = 128, CV_ROUT = 32, CV_LAYER = CV_WIN + CV_WOUT + CV_ROUT;
__device__ __forceinline__ void p0_conv(const Args& a, LAS unsigned char* lds) {
    LAS float* tile = (LAS float*)lds;
    for (int u = blockIdx.x; u < 2 * CV_LAYER; u += gridDim.x) {
        const int l = u / CV_LAYER; int j = u % CV_LAYER;
        if (j < CV_WIN) {
            const int rho0 = (j >> 3) * 64, kt = j & 7; const float* src = a.in[I_WIN] + (size_t)l * 1024 * DIN; const float* p[4];
#pragma unroll
            for (int g = 0; g < 4; ++g) { const int rho = rho0 + 16 * g; const int col = rho < 2304 ? rho : rho < 2816 ? rho + 16 : rho < 2832 ? rho - 512 : -1; p[g] = col >= 0 ? src + col : nullptr; }
            conv_tile<128>(tile, p[0], p[1], p[2], p[3], DIN, kt * 128, (bf16_t*)(a.ws + WS_WIN) + ((size_t)l * NIN + rho0) * 1024, 1024);
            continue;
        }
        j -= CV_WIN;
        if (j < CV_WOUT) {
            const int rho0 = (j >> 3) * 64, kt = j & 7; const float* src = a.in[I_WOUT] + (size_t)l * 1024 * 1024 + rho0;
            conv_tile<128>(tile, src, src + 16, src + 32, src + 48, 1024, kt * 128, (bf16_t*)(a.ws + WS_WOUT) + ((size_t)l * 1024 + rho0) * 1024, 1024);
            continue;
        }
        j -= CV_WOUT;
        if (j < CV_ROUT) {
            const int rho0 = (j >> 3) * 64, kt = j & 7; const float* src = a.in[I_RW] + (size_t)l * 1024 * 256 + rho0;
            conv_tile<128>(tile, src, src + 16, src + 32, src + 48, 256, kt * 128, (bf16_t*)(a.ws + WS_ROUT) + ((size_t)l * 256 + rho0) * 1024, 1024);
            continue;
        }
    }
}

__device__ __forceinline__ int sample_of(int row) { return row < NLAT ? (row >> 11) : 16; }

__device__ __forceinline__ void slot_sum(const bf16_t* Y, int row, int lane, f32x4 (&s)[4]) {
#pragma unroll
    for (int ii = 0; ii < 4; ++ii) s[ii] = (f32x4){0.f, 0.f, 0.f, 0.f};
#pragma unroll
    for (int k = 0; k < NSLOT; ++k) {
        const bf16_t* yp = Y + ((size_t)row * NSLOT + k) * 1024 + lane * 4;
#pragma unroll
        for (int ii = 0; ii < 4; ++ii) { const u32x2 w = *(const u32x2*)(yp + ii * 256); s[ii][0] += __uint_as_float(w.x << 16); s[ii][1] += __uint_as_float(w.x & 0xffff0000u); s[ii][2] += __uint_as_float(w.y << 16); s[ii][3] += __uint_as_float(w.y & 0xffff0000u); }
    }
}
__device__ __forceinline__ f32x4 xrow_ld(const bf16_t* p) { const u32x2 w = *(const u32x2*)p; return (f32x4){__uint_as_float(w.x << 16), __uint_as_float(w.x & 0xffff0000u), __uint_as_float(w.y << 16), __uint_as_float(w.y & 0xffff0000u)}; }
__device__ __forceinline__ void xrow_st(bf16_t* p, const f32x4 v) { u32x2 w; w.x = cvt_pk_bf16(v[0], v[1]); w.y = cvt_pk_bf16(v[2], v[3]); *(u32x2*)p = w; }
__device__ __forceinline__ void norm_mod_store(const f32x4 (&v)[4], const float* g, const float* shift, const float* scale, bf16_t* dst, int lane) {
    float ss = 0.f;
#pragma unroll
    for (int ii = 0; ii < 4; ++ii) ss += v[ii][0] * v[ii][0] + v[ii][1] * v[ii][1] + v[ii][2] * v[ii][2] + v[ii][3] * v[ii][3];
    ss = wave_sum(ss);
    const float rstd = rsqrtf(ss * (1.0f / 1024.0f) + EPS);
#pragma unroll
    for (int ii = 0; ii < 4; ++ii) {
        const int c = ii * 256 + lane * 4;
        const f32x4 gg = *(const f32x4*)(g + c), sh = *(const f32x4*)(shift + c), sc = *(const f32x4*)(scale + c);
        f32x4 y;
#pragma unroll
        for (int j = 0; j < 4; ++j) y[j] = v[ii][j] * rstd * gg[j] * (1.0f + sc[j]) + sh[j];
        u32x2 w; w.x = cvt_pk_bf16(y[0], y[1]); w.y = cvt_pk_bf16(y[2], y[3]);
        *(u32x2*)(dst + c) = w;
    }
}

__device__ __forceinline__ void phase_n1(const Args& a, int l) {
    const int tid = opaque_tid(), wid = tid >> 6, lane = tid & 63;
    bf16_t* X = (bf16_t*)(a.ws + WS_X); bf16_t* XA = (bf16_t*)(a.ws + WS_XA); const float* MOD = (const float*)(a.ws + WS_MOD); const bf16_t* Y = (const bf16_t*)(a.ws + WS_R1);
    for (int row = blockIdx.x * 8 + wid; row < TOK; row += gridDim.x * 8) {
        const int s = sample_of(row);
        f32x4 v[4];
        if (l == 0) {
            if (row < NLAT) {
                const float* xp = a.in[I_X] + (size_t)row * 1024 + lane * 4;
                const int tp = row & 2047; const float pr = (float)(tp >> 6), pc = (float)(tp & 63);
#pragma unroll
                for (int ii = 0; ii < 4; ++ii) v[ii] = *(const f32x4*)(xp + ii * 256);
#pragma unroll
                for (int j = 0; j < 4; ++j) {
                    const float om = exp2f(-13.287712379549449f * (float)(lane * 4 + j) * (1.0f / 256.0f));
                    const float ar = pr * om, ac = pc * om;
                    v[0][j] += sinf(ar); v[1][j] += cosf(ar); v[2][j] += sinf(ac); v[3][j] += cosf(ac);
                }
            } else {
                const float* xp = a.in[I_CTX] + (size_t)(row - NLAT) * 1024 + lane * 4;
#pragma unroll
                for (int ii = 0; ii < 4; ++ii) v[ii] = *(const f32x4*)(xp + ii * 256);
            }
        } else {
            f32x4 ys[4]; slot_sum(Y, row, lane, ys);
            const float* gate = MOD + ((size_t)(l - 1) * 17 + s) * 6144 + 5 * 1024 + lane * 4;
#pragma unroll
            for (int ii = 0; ii < 4; ++ii) { const f32x4 xv = xrow_ld(X + (size_t)row * 1024 + ii * 256 + lane * 4), gv = *(const f32x4*)(gate + ii * 256); v[ii] = xv + gv * ys[ii]; }
        }
#pragma unroll
        for (int ii = 0; ii < 4; ++ii) xrow_st(X + (size_t)row * 1024 + ii * 256 + lane * 4, v[ii]);
        const float* m = MOD + ((size_t)l * 17 + s) * 6144;
        norm_mod_store(v, a.in[I_N1G] + l * 1024, m, m + 1024, XA + (size_t)row * 1024, lane);
    }
}
__device__ __forceinline__ void phase_n2(const Args& a, int l, int T) {
    const int tid = opaque_tid(), wid = tid >> 6, lane = tid & 63;
    const bf16_t* X = (const bf16_t*)(a.ws + WS_X); bf16_t* XA = (bf16_t*)(a.ws + WS_XA); const float* MOD = (const float*)(a.ws + WS_MOD);
    for (int row = blockIdx.x * 8 + wid; row < T; row += gridDim.x * 8) {
        const int s = sample_of(row);
        f32x4 v[4];
#pragma unroll
        for (int ii = 0; ii < 4; ++ii) v[ii] = xrow_ld(X + (size_t)row * 1024 + ii * 256 + lane * 4);
        const float* m = MOD + ((size_t)l * 17 + s) * 6144;
        norm_mod_store(v, a.in[I_N2G] + l * 1024, m + 3 * 1024, m + 4 * 1024, XA + (size_t)row * 1024, lane);
    }
}
__device__ __forceinline__ void phase_fin(const Args& a) {
    const int tid = opaque_tid(), wid = tid >> 6, lane = tid & 63;
    const bf16_t* X = (const bf16_t*)(a.ws + WS_X); const float* MOD = (const float*)(a.ws + WS_MOD); const bf16_t* Y = (const bf16_t*)(a.ws + WS_R1);
    for (int row = blockIdx.x * 8 + wid; row < NLAT; row += gridDim.x * 8) {
        const int s = sample_of(row);
        f32x4 ys[4], v[4]; slot_sum(Y, row, lane, ys);
        const float* gate = MOD + ((size_t)17 + s) * 6144 + 5 * 1024 + lane * 4;
        float ss = 0.f;
#pragma unroll
        for (int ii = 0; ii < 4; ++ii) { const f32x4 xv = xrow_ld(X + (size_t)row * 1024 + ii * 256 + lane * 4), gv = *(const f32x4*)(gate + ii * 256); v[ii] = xv + gv * ys[ii];
            ss += v[ii][0] * v[ii][0] + v[ii][1] * v[ii][1] + v[ii][2] * v[ii][2] + v[ii][3] * v[ii][3]; }
        ss = wave_sum(ss);
        const float rstd = rsqrtf(ss * (1.0f / 1024.0f) + EPS);
#pragma unroll
        for (int ii = 0; ii < 4; ++ii) { const f32x4 g = *(const f32x4*)(a.in[I_FNG] + ii * 256 + lane * 4); *(f32x4*)(a.out + (size_t)row * 1024 + ii * 256 + lane * 4) = v[ii] * rstd * g; }
    }
}

namespace pg8 {
#define PG8_LAS __attribute__((address_space(3)))
typedef unsigned short bf16_t;
typedef short bf16x8 __attribute__((ext_vector_type(8)));
typedef float f32x4 __attribute__((ext_vector_type(4)));
typedef unsigned u32x4 __attribute__((ext_vector_type(4)));
constexpr int BM = 256, BK = 64, HALF = 128, HTB = HALF * BK * 2  , STAGE_BYTES = 8 * HTB, NXCD = 8, WGM = 8;

__host__ __device__ __forceinline__ int lds_byte(int r, int c) { const int st = (r >> 4) * 2 + (c >> 5), rr = r & 15, cc = c & 31, ob = rr * 64 + cc * 2; return st * 1024 + (ob ^ (((ob >> 9) & 1) << 5)); }
__host__ __device__ __forceinline__ void stage_rc(int b, int& R, int& C) { const int st = b / 1024, sb = b % 1024, swz = sb ^ (((sb >> 9) & 1) << 5); R = (st >> 1) * 16 + swz / 64; C = (st & 1) * 32 + (swz % 64) / 2; }
__host__ __device__ __forceinline__ int perm32(int rho) { const int n = rho >> 4, i = rho & 15; return 8 * (i >> 2) + 4 * n + (i & 3); }

struct Unit { int pm, pn; };
struct Gemm { const bf16_t* A; const bf16_t* Bt; int M, N, K; };

struct StaticOrder {
    int nM, nN, nwg, G, c;
    __host__ __device__ void init(int M, int N, int G_, int c_) { nM = M / BM; nN = N / BM; nwg = nM * nN; G = G_; c = c_; }
    __host__ __device__ bool next(int i, Unit& u) const {
        const long L = (long)i * G + c; if (L >= nwg) return false;
        int wgid = (int)L; { const int q = nwg / NXCD, r = nwg % NXCD, xcd = wgid % NXCD, off = wgid / NXCD; wgid = (xcd < r ? xcd * (q + 1) : r * (q + 1) + (xcd - r) * q) + off; }
        const int nig = WGM * nN, gid = wgid / nig, fm = gid * WGM, gsz = (nM - fm) < WGM ? (nM - fm) : WGM;
        u.pm = fm + ((wgid % nig) % gsz); u.pn = (wgid % nig) / gsz; return true;
    }
    __device__ __forceinline__ void a_ready(const Unit&) const {}
    __device__ __forceinline__ void done(const Unit&) const {}
};
template <class Epi, class Sched, bool STAMP = false>
__device__ __forceinline__ void gemm_phase(PG8_LAS unsigned char* lds, const Gemm g, const Sched& S, const Epi& E, unsigned long long* stamps) {
    const int tid = opaque_tid(), wid = __builtin_amdgcn_readfirstlane(tid >> 6), lane = tid & 63, wr = wid >> 2, wc = wid & 3, fr = lane & 15, fq = lane >> 4;
    const int K = g.K, nt = K / BK;
    int ts_lo = 0, ts_hi = 0, nts = 0; const unsigned long long rt_entry = STAMP ? (unsigned long long)wall_clock64() : 0ull;
#define PG8_STAMP() do { if (STAMP && wid == 0 && nts < 64) { const unsigned long long _c = (unsigned long long)clock64(); \
        ts_lo = (lane == nts) ? (int)(unsigned)_c : ts_lo; ts_hi = (lane == nts) ? (int)(unsigned)(_c >> 32) : ts_hi; ++nts; } } while (0)
    PG8_STAMP();
    unsigned voffA[2], voffB[2];
#pragma unroll
    for (int i = 0; i < 2; ++i) { int R, C; stage_rc(tid * 16 + i * 8192, R, C); const int Rb = Epi::PERM ? ((R & ~31) + perm32(R & 31)) : R;
        voffA[i] = (unsigned)(R * K + C) * 2u; voffB[i] = (unsigned)(Rb * K + C) * 2u; }
    const size_t kstep = (size_t)(BK * 2);
    const size_t hstep = (size_t)HALF * K * 2;
    const size_t tstep = 2 * hstep;
    const unsigned ldsw = (unsigned)wid * 1024u;
    const int aoff = lds_byte(wr * 64 + fr, fq * 8), boff = lds_byte(wc * 32 + fr, fq * 8);
#define PG8_SA(b, h) (((b) * 2 + (h)) * HTB)
#define PG8_SB(b, h) ((4 + (b) * 2 + (h)) * HTB)
#define PG8_STAGE(bufoff, gbase, voff) do { _Pragma("unroll") for (int _i = 0; _i < 2; ++_i) \
        __builtin_amdgcn_global_load_lds((const unsigned*)((const char*)(gbase) + (voff)[_i]), (PG8_LAS unsigned*)(lds + (bufoff) + ldsw + _i * 8192), 16, 0, 0); } while (0)
#define PG8_LDA(dst, b, h) do { _Pragma("unroll") for (int m = 0; m < 4; ++m) _Pragma("unroll") for (int k = 0; k < 2; ++k) dst[m][k] = *(const PG8_LAS bf16x8*)(lds + PG8_SA(b, h) + aoff + m * 2048 + k * 1024); } while (0)
#define PG8_LDB(dst, b, h) do { _Pragma("unroll") for (int n = 0; n < 2; ++n) _Pragma("unroll") for (int k = 0; k < 2; ++k) dst[n][k] = *(const PG8_LAS bf16x8*)(lds + PG8_SB(b, h) + boff + n * 2048 + k * 1024); } while (0)
#define PG8_MMA(ai, bj, At, Bt) do { __builtin_amdgcn_s_setprio(1); _Pragma("unroll") for (int m = 0; m < 4; ++m) _Pragma("unroll") for (int n = 0; n < 2; ++n) _Pragma("unroll") for (int k = 0; k < 2; ++k) \
        acc[ai][bj][m][n] = __builtin_amdgcn_mfma_f32_16x16x32_bf16(Bt[n][k], At[m][k], acc[ai][bj][m][n], 0, 0, 0); __builtin_amdgcn_s_setprio(0); } while (0)
#define PG8_WAIT_V(n) asm volatile("s_waitcnt vmcnt(" #n ")" ::: "memory")
#define PG8_WAIT_L(n) asm volatile("s_waitcnt lgkmcnt(" #n ")" ::: "memory")
#define PG8_BAR __builtin_amdgcn_s_barrier()
#define PG8_SCHED __builtin_amdgcn_sched_barrier(0)
    Unit cur, nxt; int ui = 0;
    if (!S.next(0, cur)) return;
    f32x4 acc[2][2][4][2];
#pragma unroll
    for (int a = 0; a < 2; ++a)
#pragma unroll
        for (int b = 0; b < 2; ++b)
#pragma unroll
            for (int m = 0; m < 4; ++m)
#pragma unroll
                for (int n = 0; n < 2; ++n) acc[a][b][m][n] = (f32x4){0.f, 0.f, 0.f, 0.f};
    bf16x8 At[4][2], B0[2][2], B1[2][2];
    const char* cA = (const char*)g.A + (size_t)cur.pm * tstep; const char* cB = (const char*)g.Bt + (size_t)cur.pn * tstep;
    S.a_ready(cur);
    PG8_STAGE(PG8_SB(0, 0), cB, voffB); PG8_STAGE(PG8_SA(0, 0), cA, voffA); PG8_STAGE(PG8_SB(0, 1), cB + hstep, voffB); PG8_STAGE(PG8_SA(0, 1), cA + hstep, voffA);
    if (wr == 1) PG8_BAR;
    PG8_WAIT_V(4); PG8_BAR;
    PG8_STAGE(PG8_SB(1, 0), cB + kstep, voffB); PG8_STAGE(PG8_SA(1, 0), cA + kstep, voffA); PG8_STAGE(PG8_SB(1, 1), cB + hstep + kstep, voffB);
    PG8_WAIT_V(6); PG8_BAR;
    PG8_STAMP();
    for (;;) {
        const bool has_next = S.next(ui + 1, nxt);
        const char* nA = has_next ? (const char*)g.A + (size_t)nxt.pm * tstep : cA; const char* nB = has_next ? (const char*)g.Bt + (size_t)nxt.pn * tstep : cB;
        for (int t = 0; t < nt; t += 2) {
            const bool last = (t == nt - 2);
            const char* a1 = cA + (size_t)(t + 1) * kstep;
            const char* a2 = last ? nA : cA + (size_t)(t + 2) * kstep; const char* b2 = last ? nB : cB + (size_t)(t + 2) * kstep;
            const char* a3 = a2 + kstep; const char* b3 = b2 + kstep;
            if (last && has_next) S.a_ready(nxt);
            PG8_LDB(B0, 0, 0); PG8_SCHED; PG8_LDA(At, 0, 0); PG8_STAGE(PG8_SA(1, 1), a1 + hstep, voffA);
            PG8_WAIT_L(8); PG8_BAR; PG8_WAIT_L(0); PG8_MMA(0, 0, At, B0); PG8_BAR; PG8_SCHED;
            PG8_LDB(B1, 0, 1); PG8_STAGE(PG8_SB(0, 0), b2, voffB);
            PG8_BAR; PG8_WAIT_L(0); PG8_MMA(0, 1, At, B1); PG8_BAR;
            PG8_LDA(At, 0, 1); PG8_STAGE(PG8_SA(0, 0), a2, voffA);
            PG8_BAR; PG8_WAIT_L(0); PG8_MMA(1, 0, At, B0); PG8_BAR; PG8_SCHED;
            PG8_STAGE(PG8_SB(0, 1), b2 + hstep, voffB);
            PG8_WAIT_V(6); PG8_BAR; PG8_MMA(1, 1, At, B1); PG8_BAR;
            PG8_LDB(B0, 1, 0); PG8_SCHED; PG8_LDA(At, 1, 0); PG8_STAGE(PG8_SA(0, 1), a2 + hstep, voffA);
            PG8_WAIT_L(8); PG8_BAR; PG8_WAIT_L(0); PG8_MMA(0, 0, At, B0); PG8_BAR; PG8_SCHED;
            PG8_LDB(B1, 1, 1); PG8_STAGE(PG8_SB(1, 0), b3, voffB);
            PG8_BAR; PG8_WAIT_L(0); PG8_MMA(0, 1, At, B1); PG8_BAR;
            PG8_LDA(At, 1, 1); PG8_STAGE(PG8_SA(1, 0), a3, voffA);
            PG8_BAR; PG8_WAIT_L(0); PG8_MMA(1, 0, At, B0); PG8_BAR; PG8_SCHED;
            PG8_STAGE(PG8_SB(1, 1), b3 + hstep, voffB);
            PG8_WAIT_V(6); PG8_BAR; PG8_MMA(1, 1, At, B1); PG8_BAR;
        }
        PG8_STAMP();
        if constexpr (!Epi::AFTER_DRAIN) { E(acc, cur, wr, wc, fr, fq); S.done(cur); }
        PG8_STAMP();
        if (!has_next) break;
#pragma unroll
        for (int a = 0; a < 2; ++a)
#pragma unroll
            for (int b = 0; b < 2; ++b)
#pragma unroll
                for (int m = 0; m < 4; ++m)
#pragma unroll
                    for (int n = 0; n < 2; ++n) acc[a][b][m][n] = (f32x4){0.f, 0.f, 0.f, 0.f};
        cur = nxt; cA = nA; cB = nB; ++ui;
    }
    PG8_WAIT_V(0);
    if (wr == 0) PG8_BAR;
    PG8_BAR;
    if constexpr (Epi::AFTER_DRAIN) { E.fused(acc, cur, wr, wc, fr, fq, lds, wid, lane); S.done(cur); }
    PG8_STAMP();
    if (STAMP && wid == 0) { stamps[lane] = lane < nts ? (((unsigned long long)(unsigned)ts_hi << 32) | (unsigned)ts_lo) : 0ull;
        if (lane == 62) stamps[62] = rt_entry; if (lane == 63) stamps[63] = (unsigned long long)wall_clock64(); }
#undef PG8_STAMP
#undef PG8_SA
#undef PG8_SB
#undef PG8_STAGE
#undef PG8_LDA
#undef PG8_LDB
#undef PG8_MMA
#undef PG8_WAIT_V
#undef PG8_WAIT_L
#undef PG8_BAR
#undef PG8_SCHED
}
}

struct EpiG1 {
    static constexpr bool PERM = true, AFTER_DRAIN = false;
    bf16_t* P; float* GATES;
    __device__ __forceinline__ void operator()(const f32x4 (&acc)[2][2][4][2], const pg8::Unit& u, int wr, int wc, int fr, int fq) const {
        const int row0 = u.pm * 256 + wr * 64 + fr;
#pragma unroll
        for (int bj = 0; bj < 2; ++bj) {
            const int cb = u.pn * 256 + bj * 128 + wc * 32;
            if (cb >= DIN) continue;
            if (cb >= PW) {
                if (fq < 2) {
#pragma unroll
                    for (int ai = 0; ai < 2; ++ai)
#pragma unroll
                        for (int m = 0; m < 4; ++m) { float* gp = GATES + (size_t)(row0 + ai * 128 + m * 16) * 16 + fq * 8; *(f32x4*)gp = acc[ai][bj][m][0]; *(f32x4*)(gp + 4) = acc[ai][bj][m][1]; }
                }
            } else {
                const bool g = (cb >= PC_RG && cb < PC_Q) || cb >= PC_CU;
                const float sc = (cb >= PC_K && cb < PC_V) ? 0.10206207261596575f : 1.0f;
#pragma unroll
                for (int ai = 0; ai < 2; ++ai)
#pragma unroll
                    for (int m = 0; m < 4; ++m) {
                        f32x4 v0 = acc[ai][bj][m][0], v1 = acc[ai][bj][m][1];
                        if (g) { v0[0] = gelu_tanh(v0[0]); v0[1] = gelu_tanh(v0[1]); v0[2] = gelu_tanh(v0[2]); v0[3] = gelu_tanh(v0[3]); v1[0] = gelu_tanh(v1[0]); v1[1] = gelu_tanh(v1[1]); v1[2] = gelu_tanh(v1[2]); v1[3] = gelu_tanh(v1[3]); }
                        else { v0 = v0 * sc; v1 = v1 * sc; }
                        u32x4 w; w.x = cvt_pk_bf16(v0[0], v0[1]); w.y = cvt_pk_bf16(v0[2], v0[3]); w.z = cvt_pk_bf16(v1[0], v1[1]); w.w = cvt_pk_bf16(v1[2], v1[3]);
                        *(u32x4*)(P + (size_t)(row0 + ai * 128 + m * 16) * PW + cb + fq * 8) = w;
                    }
            }
        }
    }
};
__device__ __forceinline__ void phase_g1(const Args& a, LAS unsigned char* lds, int l) {
    pg8::Gemm g{(const bf16_t*)(a.ws + WS_XA), (const bf16_t*)(a.ws + WS_WIN) + (size_t)l * NIN * 1024, TOK, NIN, 1024};
    pg8::StaticOrder S; S.init(TOK, NIN, (int)gridDim.x, (int)blockIdx.x);
    EpiG1 E{(bf16_t*)(a.ws + WS_P), (float*)(a.ws + WS_GATES)};
    pg8::gemm_phase<EpiG1, pg8::StaticOrder>(lds, g, S, E, nullptr);
}
struct EpiG2 {
    static constexpr bool PERM = true, AFTER_DRAIN = false;
    bf16_t* X; const float* MODl;
    __device__ __forceinline__ void operator()(const f32x4 (&acc)[2][2][4][2], const pg8::Unit& u, int wr, int wc, int fr, int fq) const {
        const int row0 = u.pm * 256 + wr * 64 + fr; const float* gate = MODl + (size_t)sample_of(u.pm * 256) * 6144 + 2 * 1024;
#pragma unroll
        for (int bj = 0; bj < 2; ++bj) {
            const int col = u.pn * 256 + bj * 128 + wc * 32 + fq * 8; const f32x4 g0 = *(const f32x4*)(gate + col), g1 = *(const f32x4*)(gate + col + 4);
#pragma unroll
            for (int ai = 0; ai < 2; ++ai)
#pragma unroll
                for (int m = 0; m < 4; ++m) { bf16_t* xp = X + (size_t)(row0 + ai * 128 + m * 16) * 1024 + col;
                    const u32x4 w = *(const u32x4*)xp; const f32x4 a0 = acc[ai][bj][m][0], a1 = acc[ai][bj][m][1]; u32x4 o;
                    o.x = cvt_pk_bf16(__uint_as_float(w.x << 16) + g0[0] * a0[0], __uint_as_float(w.x & 0xffff0000u) + g0[1] * a0[1]);
                    o.y = cvt_pk_bf16(__uint_as_float(w.y << 16) + g0[2] * a0[2], __uint_as_float(w.y & 0xffff0000u) + g0[3] * a0[3]);
                    o.z = cvt_pk_bf16(__uint_as_float(w.z << 16) + g1[0] * a1[0], __uint_as_float(w.z & 0xffff0000u) + g1[1] * a1[1]);
                    o.w = cvt_pk_bf16(__uint_as_float(w.w << 16) + g1[2] * a1[2], __uint_as_float(w.w & 0xffff0000u) + g1[3] * a1[3]);
                    *(u32x4*)xp = o; }
        }
    }
};
__device__ __forceinline__ void phase_g2(const Args& a, LAS unsigned char* lds, int l, int T) {
    pg8::Gemm g{(const bf16_t*)(a.ws + WS_MIX), (const bf16_t*)(a.ws + WS_WOUT) + (size_t)l * 1024 * 1024, T, 1024, 1024};
    pg8::StaticOrder S; S.init(T, 1024, (int)gridDim.x, (int)blockIdx.x);
    EpiG2 E{(bf16_t*)(a.ws + WS_X), (const float*)(a.ws + WS_MOD) + (size_t)l * 17 * 6144};
    pg8::gemm_phase<EpiG2, pg8::StaticOrder>(lds, g, S, E, nullptr);
}
struct EpiRT {
    static constexpr bool PERM = false, AFTER_DRAIN = false;
    float* LG;
    __device__ __forceinline__ void operator()(const f32x4 (&acc)[2][2][4][2], const pg8::Unit& u, int wr, int wc, int fr, int fq) const {
        const int row0 = u.pm * 256 + wr * 64 + fr;
#pragma unroll
        for (int bj = 0; bj < 2; ++bj)
#pragma unroll
            for (int n = 0; n < 2; ++n)
#pragma unroll
                for (int ai = 0; ai < 2; ++ai)
#pragma unroll
                    for (int m = 0; m < 4; ++m) *(f32x4*)(LG + (size_t)(row0 + ai * 128 + m * 16) * 256 + bj * 128 + wc * 32 + n * 16 + fq * 4) = acc[ai][bj][m][n];
    }
};
__device__ __forceinline__ void phase_rt(const Args& a, LAS unsigned char* lds, int l, int T) {
    pg8::Gemm g{(const bf16_t*)(a.ws + WS_XA), (const bf16_t*)(a.ws + WS_ROUT) + (size_t)l * 256 * 1024, T, 256, 1024};
    pg8::StaticOrder S; S.init(T, 256, (int)gridDim.x, (int)blockIdx.x);
    EpiRT E{(float*)(a.ws + WS_LOGITS)};
    pg8::gemm_phase<EpiRT, pg8::StaticOrder>(lds, g, S, E, nullptr);
}

template <int CTRL> __device__ __forceinline__ float dppf(float old, float src) { return __int_as_float(__builtin_amdgcn_update_dpp(__float_as_int(old), __float_as_int(src), CTRL, 0xF, 0xF, false)); }
constexpr int TK_MAXTOK = 512;
__device__ __forceinline__ void phase_tk(const Args& a, LAS unsigned char* lds, int l, int T) {
    const int tid = opaque_tid(), wid = tid >> 6, lane = tid & 63;
    const float* LG = (const float*)(a.ws + WS_LOGITS); const float* rb = a.in[I_RB] + l * 256;
    unsigned* CNT = (unsigned*)(a.ws + WS_CTL + CTL_CNT) + (size_t)l * 256 * CNT_STRIDE; int* LS = (int*)(a.ws + WS_LSLOT); float* LWt = (float*)(a.ws + WS_LW);
    LAS unsigned* lcnt = (LAS unsigned*)lds; LAS unsigned* lbase = lcnt + 256; LAS unsigned* ent = lbase + 256; LAS float* entw = (LAS float*)(ent + TK_MAXTOK * 8);
    const f32x4 bias = *(const f32x4*)(rb + lane * 4);
    const float NEG = -__builtin_huge_valf();
    const int per = (T + (int)gridDim.x - 1) / (int)gridDim.x;
    for (int base0 = blockIdx.x * per; base0 < (int)(blockIdx.x + 1) * per && base0 < T; base0 += TK_MAXTOK) {
        int ntok = (int)(blockIdx.x + 1) * per - base0; if (ntok > TK_MAXTOK) ntok = TK_MAXTOK; if (ntok > T - base0) ntok = T - base0;
        __syncthreads();
        if (tid < 256) lcnt[tid] = 0u;
        __syncthreads();
        for (int tl = wid; tl < ntok; tl += 8) {
            const int t = base0 + tl;
            const f32x4 lg = *(const f32x4*)(LG + (size_t)t * 256 + lane * 4);
            float sc[4], sel[4];
#pragma unroll
            for (int j = 0; j < 4; ++j) { sc[j] = 1.0f / (1.0f + expf(-lg[j])); sel[j] = sc[j] + bias[j]; }
            float a1 = fmaxf(sel[0], sel[1]), a2 = fminf(sel[0], sel[1]);
#pragma unroll
            for (int j = 2; j < 4; ++j) { const float v = sel[j]; a2 = fmaxf(a2, fminf(a1, v)); a1 = fmaxf(a1, v); }
#define TK_MERGE(CTRL) { const float b1 = dppf<CTRL>(a1, a1), b2 = dppf<CTRL>(a2, a2); const float n1 = fmaxf(a1, b1), n2 = fmaxf(fminf(a1, b1), fmaxf(a2, b2)); a1 = n1; a2 = n2; }
            TK_MERGE(0xB1) TK_MERGE(0x4E) TK_MERGE(0x141)
#undef TK_MERGE
            const float gs = a1 + a2; const int g = lane >> 3; int rank = 0;
#pragma unroll
            for (int g2 = 0; g2 < 8; ++g2) { const float s2 = __int_as_float(__builtin_amdgcn_readlane(__float_as_int(gs), g2 * 8)); rank += (s2 > gs || (s2 == gs && g2 < g)) ? 1 : 0; }
            float ms[4];
#pragma unroll
            for (int j = 0; j < 4; ++j) ms[j] = rank < 4 ? sel[j] : NEG;
            int my_e = 0; float my_s = 0.f, ssum = 0.f;
#pragma unroll
            for (int k = 0; k < 8; ++k) {
                float mx = fmaxf(fmaxf(ms[0], ms[1]), fmaxf(ms[2], ms[3]));
                mx = fmaxf(mx, dppf<0x111>(NEG, mx)); mx = fmaxf(mx, dppf<0x112>(NEG, mx)); mx = fmaxf(mx, dppf<0x114>(NEG, mx)); mx = fmaxf(mx, dppf<0x118>(NEG, mx));
                const float gmax = fmaxf(fmaxf(__int_as_float(__builtin_amdgcn_readlane(__float_as_int(mx), 15)), __int_as_float(__builtin_amdgcn_readlane(__float_as_int(mx), 31))),
                                         fmaxf(__int_as_float(__builtin_amdgcn_readlane(__float_as_int(mx), 47)), __int_as_float(__builtin_amdgcn_readlane(__float_as_int(mx), 63))));
                const int cand = ms[0] == gmax ? 0 : ms[1] == gmax ? 1 : ms[2] == gmax ? 2 : ms[3] == gmax ? 3 : -1;
                const unsigned long long bal = __ballot(cand >= 0);
                const int wl = __builtin_amdgcn_readfirstlane(__ffsll((unsigned long long)bal) - 1);
                const int jj = __builtin_amdgcn_readlane(cand, wl), bi = wl * 4 + jj;
                const float mysc = jj == 0 ? sc[0] : jj == 1 ? sc[1] : jj == 2 ? sc[2] : sc[3];
                const float sk = __int_as_float(__builtin_amdgcn_readlane(__float_as_int(mysc), wl));
#pragma unroll
                for (int j = 0; j < 4; ++j) if (lane == wl && j == jj) ms[j] = NEG;
                if (lane == k) { my_e = bi; my_s = sk; }
                ssum += sk;
            }
            if (lane < 8) {
                const unsigned r = __hip_atomic_fetch_add(&lcnt[my_e], 1u, __ATOMIC_RELAXED, __HIP_MEMORY_SCOPE_WORKGROUP);
                ent[tl * 8 + lane] = ((unsigned)my_e << 16) | r; entw[tl * 8 + lane] = my_s / ssum * 2.5f;
            }
        }
        __syncthreads();
        if (tid < 256) { const unsigned c = lcnt[tid]; lbase[tid] = c ? atomicAdd(&CNT[tid * CNT_STRIDE], c) : 0u; }
        __syncthreads();
        for (int i = tid; i < ntok * 8; i += NTHREADS) {
            const unsigned v = ent[i]; const int e = (int)(v >> 16); const unsigned pos = lbase[e] + (v & 0xffffu);
            LS[(size_t)e * LCAP + pos] = (base0 + (i >> 3)) * NSLOT + (i & 7); LWt[(size_t)e * LCAP + pos] = entw[i];
        }
    }
}

__device__ __forceinline__ void moe_tables(const Args& a, LAS unsigned char* lds, int l, int T) {
    LAS int* cntE = (LAS int*)(lds + LDS_TAB); LAS int* blkoff = cntE + 264;
    const int tid = opaque_tid(); const unsigned* CNT = (const unsigned*)(a.ws + WS_CTL + CTL_CNT) + (size_t)l * 256 * CNT_STRIDE;
    if (tid < 256) cntE[tid] = (int)CNT[tid * CNT_STRIDE]; else if (tid == 256) cntE[256] = T;
    __syncthreads();
    if (tid < 258) { int s = 0; for (int e = 0; e < tid && e < 257; ++e) s += (cntE[e] + 255) >> 8; blkoff[tid] = s; }
    __syncthreads();
}
__device__ __forceinline__ int moe_find(const LAS int* blkoff, int mbg) { int lo = 0, hi = 257; while (hi - lo > 1) { const int mid = (lo + hi) >> 1; if (blkoff[mid] <= mbg) lo = mid; else hi = mid; } return lo; }

#define PV_LOAD32(dst, ptr) asm volatile("global_load_dword %0, %1, off" : "=&v"(dst) : "v"(ptr))
struct E1Prov {
    const Args& a; LAS unsigned char* lds; int l, nunit, R0, R1, C0, C1, wr, wc, fr, fq; int q0, q1; bool sh;
    __device__ __forceinline__ void decode(int i, int& mbg, int& nt, int& e, int& mb, int& cnt) const {
        const LAS int* cntE = (const LAS int*)(lds + LDS_TAB); const LAS int* blkoff = cntE + 264;
        const int u = blockIdx.x + i * gridDim.x; mbg = u / 3; nt = u - mbg * 3; e = moe_find(blkoff, mbg); mb = mbg - blkoff[e]; cnt = cntE[e];
    }
    __device__ __forceinline__ bool seg(int i, RSeg& d) {
        if ((int)(blockIdx.x + i * gridDim.x) >= nunit) return false;
        int mbg, nt, e, mb, cnt; decode(i, mbg, nt, e, mb, cnt);
        const int* LS = (const int*)(a.ws + WS_LSLOT) + (e < 256 ? (size_t)e * LCAP : 0);
        const int p0 = mb * 256 + R0, p1 = mb * 256 + R1; sh = e >= 256; q0 = p0 < cnt ? p0 : -1; q1 = p1 < cnt ? p1 : -1;
        const int* a0 = LS + (q0 >= 0 && !sh ? q0 : 0); const int* a1 = LS + (q1 >= 0 && !sh ? q1 : 0);
        PV_LOAD32(d.aoff[0], a0); PV_LOAD32(d.aoff[1], a1);
        d.Ab = (const unsigned char*)(a.ws + WS_XA);
        d.B0 = (e < 256 ? a.in[I_EG] + ((size_t)l * 256 + e) * 1024 * FF : a.in[I_SG] + (size_t)l * 1024 * FF) + nt * 96;
        d.B1 = (e < 256 ? a.in[I_EU] + ((size_t)l * 256 + e) * 1024 * FF : a.in[I_SU] + (size_t)l * 1024 * FF) + nt * 96;
        return true;
    }
    __device__ __forceinline__ void finish(RSeg& d, bool first) const {
        if (first) asm volatile("s_waitcnt vmcnt(0)" ::: "memory"); else asm volatile("s_waitcnt vmcnt(16)" ::: "memory");
        __builtin_amdgcn_sched_barrier(0); asm volatile("" : "+v"(d.aoff[0]), "+v"(d.aoff[1]));
        const int t0 = q0 < 0 ? 0 : sh ? q0 : (int)d.aoff[0] / NSLOT, t1 = q1 < 0 ? 0 : sh ? q1 : (int)d.aoff[1] / NSLOT;
        d.aoff[0] = (unsigned)t0 * 2048u + (unsigned)C0 * 2u; d.aoff[1] = (unsigned)t1 * 2048u + (unsigned)C1 * 2u;
    }
    __device__ __forceinline__ void epi(int i, f32x4 (&acc)[4][6]) const {
        int mbg, nt, e, mb, cnt; decode(i, mbg, nt, e, mb, cnt);
        bf16_t* HB = (bf16_t*)(a.ws + WS_HB);
#pragma unroll
        for (int m = 0; m < 4; ++m) {
            bf16_t* hp = HB + (size_t)(mbg * 256 + wr * 64 + m * 16 + fr) * FF + nt * 96 + wc * 48 + fq * 4;
#pragma unroll
            for (int n = 0; n < 3; ++n) {
                const f32x4 g = acc[m][n], uu = acc[m][n + 3];
                u32x2 w; w.x = cvt_pk_bf16(siluf_(g[0]) * uu[0], siluf_(g[1]) * uu[1]); w.y = cvt_pk_bf16(siluf_(g[2]) * uu[2], siluf_(g[3]) * uu[3]);
                *(u32x2*)(hp + n * 16) = w;
            }
        }
    }
};
__device__ __forceinline__ void ring_piece_rc(int wid, int lane, int k, int& R, int& C) { const int sb = lane * 16, swz = sb ^ (((sb >> 9) & 1) << 5); R = (wid + 8 * k) * 16 + (swz >> 6); C = (swz & 63) >> 1; }
__device__ __forceinline__ void phase_e1(const Args& a, LAS unsigned char* lds, int l, int T) {
    const int tid = opaque_tid(), wid = __builtin_amdgcn_readfirstlane(tid >> 6), lane = tid & 63;
    moe_tables(a, lds, l, T);
    const LAS int* blkoff = (const LAS int*)(lds + LDS_TAB) + 264;
    int R0, C0, R1, C1; ring_piece_rc(wid, lane, 0, R0, C0); ring_piece_rc(wid, lane, 1, R1, C1);
    E1Prov pv{a, lds, l, blkoff[257] * 3, R0, R1, C0, C1, wid >> 1, wid & 1, lane & 15, lane >> 4, -1, -1, false};
    ring_gemm<192, 2, true, true, 2, E1Prov>(lds, pv, 32, FF, 0u, 0u);
}

struct E2Prov {
    const Args& a; LAS unsigned char* lds; int l, nunit, tid; int pslot; float pw; int pidx, ppos; bool psh;
    __device__ __forceinline__ void decode(int i, int& mbg, int& pn, int& e, int& mb, int& cnt) const {
        const LAS int* cntE = (const LAS int*)(lds + LDS_TAB); const LAS int* blkoff = cntE + 264;
        const int u = blockIdx.x + i * gridDim.x; mbg = u >> 2; pn = u & 3; e = moe_find(blkoff, mbg); mb = mbg - blkoff[e]; cnt = cntE[e];
    }
    __device__ __forceinline__ bool seg(int i, RSeg& d) {
        if ((int)(blockIdx.x + i * gridDim.x) >= nunit) return false;
        int mbg, pn, e, mb, cnt; decode(i, mbg, pn, e, mb, cnt);
        const int pos = mb * 256 + (tid & 255); psh = e >= 256; ppos = (tid < 256 && pos < cnt) ? pos : -1; pidx = i;
        const size_t idx = (ppos >= 0 && !psh) ? (size_t)e * LCAP + pos : 0;
        const int* sp = (const int*)(a.ws + WS_LSLOT) + idx; const float* wp = (const float*)(a.ws + WS_LW) + idx;
        PV_LOAD32(pslot, sp); PV_LOAD32(pw, wp);
        d.Ab = (const unsigned char*)(a.ws + WS_HB) + (size_t)mbg * 256 * FF * 2;
        d.B0 = (e < 256 ? a.in[I_ED] + ((size_t)l * 256 + e) * FF * 1024 : a.in[I_SD] + (size_t)l * FF * 1024) + pn * 256; d.B1 = d.B0;
        return true;
    }
    __device__ __forceinline__ void finish(RSeg&, bool first) {
        if (first) asm volatile("s_waitcnt vmcnt(0)" ::: "memory"); else asm volatile("s_waitcnt vmcnt(16)" ::: "memory");
        __builtin_amdgcn_sched_barrier(0); asm volatile("" : "+v"(pslot), "+v"(pw));
        LAS int* tab = (LAS int*)(lds + LDS_TAB) + 528 + (pidx & 1) * 512;
        if (tid < 256) { tab[tid] = ppos < 0 ? -1 : psh ? ppos * NSLOT + 8 : pslot; ((LAS float*)tab)[256 + tid] = psh ? 1.0f : pw; }
    }
    __device__ __forceinline__ void epi(int i, f32x4 (&acc)[8][4]) const {
        int mbg, pn, e, mb, cnt; decode(i, mbg, pn, e, mb, cnt);
        const LAS int* tab = (const LAS int*)(lds + LDS_TAB) + 528 + (i & 1) * 512; bf16_t* Y = (bf16_t*)(a.ws + WS_R1);
        const int wr = tid >> 8, wc = (tid >> 6) & 3, fr = tid & 15, fq = (tid >> 4) & 3;
#pragma unroll
        for (int m = 0; m < 8; ++m) {
            const int r = wr * 128 + m * 16 + fr, slot = tab[r];
            if (slot >= 0) {
                const float w = ((const LAS float*)tab)[256 + r]; bf16_t* yp = Y + (size_t)slot * 1024 + pn * 256 + wc * 64 + fq * 16;
                const f32x4 v0 = acc[m][0] * w, v1 = acc[m][1] * w, v2 = acc[m][2] * w, v3 = acc[m][3] * w;
                u32x4 o0, o1; o0.x = cvt_pk_bf16(v0[0], v0[1]); o0.y = cvt_pk_bf16(v0[2], v0[3]); o0.z = cvt_pk_bf16(v1[0], v1[1]); o0.w = cvt_pk_bf16(v1[2], v1[3]);
                o1.x = cvt_pk_bf16(v2[0], v2[1]); o1.y = cvt_pk_bf16(v2[2], v2[3]); o1.z = cvt_pk_bf16(v3[0], v3[1]); o1.w = cvt_pk_bf16(v3[2], v3[3]);
                *(u32x4*)yp = o0; *(u32x4*)(yp + 8) = o1;
            }
        }
    }
};
__device__ __forceinline__ void phase_e2(const Args& a, LAS unsigned char* lds, int l, int T) {
    const int tid = opaque_tid(), wid = __builtin_amdgcn_readfirstlane(tid >> 6), lane = tid & 63;
    moe_tables(a, lds, l, T);
    const LAS int* blkoff = (const LAS int*)(lds + LDS_TAB) + 264;
    int R0, C0, R1, C1; ring_piece_rc(wid, lane, 0, R0, C0); ring_piece_rc(wid, lane, 1, R1, C1);
    E2Prov pv{a, lds, l, blkoff[257] * 4, tid, -1, 0.f, -1, -1, false};
    ring_gemm<256, 4, false, false, 1, E2Prov>(lds, pv, 9, 1024, (unsigned)(R0 * FF * 2 + C0 * 2), (unsigned)(R1 * FF * 2 + C1 * 2));
}

__device__ __forceinline__ float logsigmoidf_(float x) { return fminf(x, 0.f) - log1pf(expf(-fabsf(x))); }

__device__ __forceinline__ void mlstm_gates(const float* GATES, int row0, int rstep, int gcol, float bi, float bfg, float m, LAS float* colterm, LAS float* Marr, LAS float* bcarr, int lane) {
    const int p0 = 2 * lane;
    const float* g0 = GATES + (size_t)(row0 + rstep * p0) * 16 + gcol; const float* g1 = g0 + rstep * 16;
    const float gi0 = g0[0] + bi, gi1 = g1[0] + bi, lf0 = logsigmoidf_(g0[4] + bfg), lf1 = logsigmoidf_(g1[4] + bfg);
    float s = lf0 + lf1;
#pragma unroll
    for (int o = 1; o < 64; o <<= 1) { const float t = __shfl_up(s, o); if (lane >= o) s += t; }
    const float bc1 = s, bc0 = s - lf1, ct0 = gi0 - bc0, ct1 = gi1 - bc1;
    float pm = fmaxf(ct0, ct1);
#pragma unroll
    for (int o = 1; o < 64; o <<= 1) { const float t = __shfl_up(pm, o); if (lane >= o) pm = fmaxf(pm, t); }
    float prev = __shfl_up(pm, 1); if (lane == 0) prev = -__builtin_huge_valf();
    const float pm0 = fmaxf(prev, ct0);
    colterm[p0] = ct0; colterm[p0 + 1] = ct1; bcarr[p0] = bc0; bcarr[p0 + 1] = bc1; Marr[p0] = fmaxf(m, pm0); Marr[p0 + 1] = fmaxf(m, pm);
}

__device__ __forceinline__ void ms_unit(const Args& a, LAS unsigned char* lds, int l, int b, int h, int d) {
    const int tid = opaque_tid(), wid = __builtin_amdgcn_readfirstlane(tid >> 6), lane = tid & 63, fr = lane & 15, fq = lane >> 4;
    LAS bf16_t* Ks = (LAS bf16_t*)(lds);
    LAS bf16_t* Vp = (LAS bf16_t*)(lds + 26624);
    LAS float* colterm = (LAS float*)(lds + 57344); LAS float* Marr = colterm + 128; LAS float* bcarr = Marr + 128;
    const bf16_t* P = (const bf16_t*)(a.ws + WS_P); const float* GATES = (const float*)(a.ws + WS_GATES);
    const int seq = (b * 4 + h) * 2 + d;
    bf16_t* CTG = (bf16_t*)(a.ws + WS_CTG) + (size_t)seq * 18 * (112 * 96); float* MST = (float*)(a.ws + WS_MST) + seq * 18;
    const float bi = a.in[I_MGB][((l * 2 + d) * 2 + 0) * 4 + h], bfg = a.in[I_MGB][((l * 2 + d) * 2 + 1) * 4 + h];
    const int rstep = d ? -1 : 1, gcol = d * 8 + h;
    int pp[3], pch[3];
#pragma unroll
    for (int i = 0; i < 3; ++i) { const int rem = tid + 512 * i; pp[i] = rem / 12; pch[i] = rem - pp[i] * 12; }
#define MS_ROW0(step) (((step) < 2 ? NLAT + b * CTXL : b * SEQ) + (d ? ((step) < 2 ? CTXL : SEQ) - 1 - ((step) < 2 ? (step) : (step) - 2) * 128 : ((step) < 2 ? (step) : (step) - 2) * 128))
    u32x4 kv[6]; float gq[4];
#define MS_FETCH(step) do { const int _r0 = MS_ROW0(step); \
        _Pragma("unroll") for (int i = 0; i < 6; ++i) kv[i] = *(const u32x4*)(P + (size_t)(_r0 + rstep * pp[i % 3]) * PW + (i < 3 ? PC_K : PC_V) + h * 96 + pch[i % 3] * 8); \
        { const float* g0 = GATES + (size_t)(_r0 + rstep * 2 * lane) * 16 + gcol; gq[0] = g0[0]; gq[1] = g0[4]; gq[2] = g0[rstep * 16]; gq[3] = g0[rstep * 16 + 4]; } } while (0)
    __syncthreads();
    for (int i = tid; i < 128 * 3; i += NTHREADS) { const int p = i / 3, q = i - p * 3; u32x4 v = (u32x4){0u, 0u, 0u, 0u}; if (q == 0) v.x = 0x3F80u; *(LAS u32x4*)(Vp + p * 120 + 96 + q * 8) = v; }
    f32x4 Cst[7];
#pragma unroll
    for (int cb = 0; cb < 7; ++cb) Cst[cb] = (f32x4){0.f, 0.f, 0.f, 0.f};
    float m = 0.f;
    MS_FETCH(0);
    for (int step = 0; step < 18; ++step) {
        const bool do_out = step >= 2 || l == 0;
        if (wid == 0) {
            const int p0 = 2 * lane;
            const float gi0 = gq[0] + bi, gi1 = gq[2] + bi, lf0 = logsigmoidf_(gq[1] + bfg), lf1 = logsigmoidf_(gq[3] + bfg);
            float s = lf0 + lf1;
#pragma unroll
            for (int o = 1; o < 64; o <<= 1) { const float t = __shfl_up(s, o); if (lane >= o) s += t; }
            const float bc1 = s, bc0 = s - lf1, ct0 = gi0 - bc0, ct1 = gi1 - bc1;
            float pm = fmaxf(ct0, ct1);
#pragma unroll
            for (int o = 1; o < 64; o <<= 1) { const float t = __shfl_up(pm, o); if (lane >= o) pm = fmaxf(pm, t); }
            float prev = __shfl_up(pm, 1); if (lane == 0) prev = -__builtin_huge_valf();
            const float pm0 = fmaxf(prev, ct0);
            colterm[p0] = ct0; colterm[p0 + 1] = ct1; bcarr[p0] = bc0; bcarr[p0 + 1] = bc1; Marr[p0] = fmaxf(m, pm0); Marr[p0 + 1] = fmaxf(m, pm);
        }
        if (do_out) {
            if (tid == 0) MST[step] = m;
            if (wid < 6) {
                bf16_t* cg = CTG + (size_t)step * (112 * 96) + wid * 16 + fr;
#pragma unroll
                for (int cb = 0; cb < 7; ++cb)
#pragma unroll
                    for (int j = 0; j < 4; ++j) cg[(cb * 16 + fq * 4 + j) * 96] = f2bf(Cst[cb][j]);
            }
        }
        __syncthreads();
        const float Mend = Marr[127], gsum = bcarr[127];
#pragma unroll
        for (int i = 0; i < 6; ++i) {
            const int p = pp[i % 3], ch = pch[i % 3];
            u32x4 v = kv[i];
            if (i < 3) {
                const float w = __expf(colterm[p] - Mend);
                v.x = cvt_pk_bf16(__uint_as_float(v.x << 16) * w, __uint_as_float(v.x & 0xffff0000u) * w); v.y = cvt_pk_bf16(__uint_as_float(v.y << 16) * w, __uint_as_float(v.y & 0xffff0000u) * w);
                v.z = cvt_pk_bf16(__uint_as_float(v.z << 16) * w, __uint_as_float(v.z & 0xffff0000u) * w); v.w = cvt_pk_bf16(__uint_as_float(v.w << 16) * w, __uint_as_float(v.w & 0xffff0000u) * w);
                *(LAS u32x4*)(Ks + p * 104 + ch * 8) = v;
            } else *(LAS u32x4*)(Vp + p * 120 + ch * 8) = v;
        }
        if (step + 1 < 18) MS_FETCH(step + 1);
        __syncthreads();
        const float decay = __expf(m - Mend);
        if (wid < 6) {
#pragma unroll
            for (int cb = 0; cb < 7; ++cb) Cst[cb] = Cst[cb] * decay;
#pragma unroll
            for (int ks = 0; ks < 4; ++ks) {
                const bf16x8 bk = trfrag(Ks, 104, ks * 32, wid * 16, fr, fq);
#pragma unroll
                for (int cb = 0; cb < 7; ++cb) Cst[cb] = MFMA(trfrag(Vp, 120, ks * 32, cb * 16, fr, fq), bk, Cst[cb]);
            }
        }
        m = gsum + Mend;
        __syncthreads();
    }
#undef MS_FETCH
#undef MS_ROW0
}

__device__ __forceinline__ void mo_unit(const Args& a, LAS unsigned char* lds, int l, int b, int h, int cidx) {
    const int tid = opaque_tid(), wid = __builtin_amdgcn_readfirstlane(tid >> 6), lane = tid & 63, fr = lane & 15, fq = lane >> 4;
    LAS bf16_t* Qi = (LAS bf16_t*)(lds);
    LAS bf16_t* Ki = (LAS bf16_t*)(lds + 26624);
    LAS bf16_t* Si = (LAS bf16_t*)(lds);
    LAS bf16_t* Vp = (LAS bf16_t*)(lds + 53248);
    LAS float* Hs = (LAS float*)(lds + 83968);
    LAS float* colterm = (LAS float*)(lds + 135168); LAS float* Marr = colterm + 128; LAS float* bcarr = Marr + 128;
    const bf16_t* P = (const bf16_t*)(a.ws + WS_P); const float* GATES = (const float*)(a.ws + WS_GATES); bf16_t* MIX = (bf16_t*)(a.ws + WS_MIX);
    const bool isctx = cidx >= 16; const int n = isctx ? cidx - 16 : cidx, nc = isctx ? 2 : 16, rowbase = (isctx ? NLAT + b * CTXL : b * SEQ) + n * 128;
    __syncthreads();
    for (int i = tid; i < 128 * 3; i += NTHREADS) { const int p = i / 3, q = i - p * 3; u32x4 v = (u32x4){0u, 0u, 0u, 0u}; if (q == 0) v.x = 0x3F80u; *(LAS u32x4*)(Vp + p * 120 + 96 + q * 8) = v; }
    for (int d = 0; d < 2; ++d) {
        const int seq = (b * 4 + h) * 2 + d, np = d ? nc - 1 - n : n, step = isctx ? np : 2 + np;
        const float m = ((const float*)(a.ws + WS_MST))[seq * 18 + step];
        const bf16_t* CT = (const bf16_t*)(a.ws + WS_CTG) + ((size_t)seq * 18 + step) * (112 * 96);
        const float bi = a.in[I_MGB][((l * 2 + d) * 2 + 0) * 4 + h], bfg = a.in[I_MGB][((l * 2 + d) * 2 + 1) * 4 + h];
        const int row0 = rowbase + (d ? 127 : 0), rstep = d ? -1 : 1;
        if (wid == 0) mlstm_gates(GATES, row0, rstep, d * 8 + h, bi, bfg, m, colterm, Marr, bcarr, lane);
#pragma unroll
        for (int i = 0; i < 9; ++i) {
            const int rem = tid + 512 * (i % 3), p = rem / 12, ch = rem - p * 12;
            const u32x4 v = *(const u32x4*)(P + (size_t)(row0 + rstep * p) * PW + PC_Q + (i / 3) * 384 + h * 96 + ch * 8);
            if (i < 3) *(LAS u32x4*)(Qi + p * 104 + ch * 8) = v; else if (i < 6) *(LAS u32x4*)(Ki + p * 104 + ch * 8) = v; else *(LAS u32x4*)(Vp + p * 120 + ch * 8) = v;
        }
        __syncthreads();
        f32x4 num[7], sacc[8];
        const int t = wid * 16 + fr; const float Mt = Marr[t];
#pragma unroll
        for (int cb = 0; cb < 7; ++cb) num[cb] = (f32x4){0.f, 0.f, 0.f, 0.f};
#pragma unroll
        for (int ks = 0; ks < 3; ++ks) {
            const bf16x8 bq = ldfrag(Qi, 104, wid * 16, ks * 32, fr, fq);
#pragma unroll
            for (int cb = 0; cb < 7; ++cb) num[cb] = MFMA(*(const bf16x8*)(CT + (cb * 16 + fr) * 96 + ks * 32 + fq * 8), bq, num[cb]);
#pragma unroll
            for (int sb = 0; sb < 8; ++sb) if (sb <= wid) { if (ks == 0) sacc[sb] = (f32x4){0.f, 0.f, 0.f, 0.f}; sacc[sb] = MFMA(ldfrag(Ki, 104, sb * 16, ks * 32, fr, fq), bq, sacc[sb]); }
        }
        { const float ei = __expf(m - Mt);
#pragma unroll
          for (int cb = 0; cb < 7; ++cb) num[cb] = num[cb] * ei; }
        __syncthreads();
#pragma unroll
        for (int sb = 0; sb < 8; ++sb) {
            u32x2 w; w.x = 0u; w.y = 0u;
            if (sb <= wid) {
                const f32x4 ct = *(const LAS f32x4*)(colterm + sb * 16 + fq * 4); float e[4];
#pragma unroll
                for (int j = 0; j < 4; ++j) { const int s = sb * 16 + fq * 4 + j; e[j] = (s <= t) ? sacc[sb][j] * __expf(ct[j] - Mt) : 0.f; }
                w.x = cvt_pk_bf16(e[0], e[1]); w.y = cvt_pk_bf16(e[2], e[3]);
            }
            *(LAS u32x2*)(Si + t * 136 + sb * 16 + fq * 4) = w;
        }
        __syncthreads();
#pragma unroll
        for (int ks = 0; ks < 4; ++ks) {
            const bf16x8 bs = ldfrag(Si, 136, wid * 16, ks * 32, fr, fq);
#pragma unroll
            for (int cb = 0; cb < 7; ++cb) num[cb] = MFMA(trfrag(Vp, 120, ks * 32, cb * 16, fr, fq), bs, num[cb]);
        }
        const float den = __shfl(num[6][0], fr);
        const float inv = 1.0f / fmaxf(fabsf(den), __expf(-(bcarr[t] + Mt)));
        LAS float* hp = Hs + (d ? 127 - t : t) * 100 + fq * 4;
#pragma unroll
        for (int cb = 0; cb < 6; ++cb) { f32x4 hv = num[cb] * inv; if (d) hv = hv + *(const LAS f32x4*)(hp + cb * 16); *(LAS f32x4*)(hp + cb * 16) = hv; }
        __syncthreads();
    }
    {
        const int tau = wid * 16 + (lane >> 2), c0 = (lane & 3) * 24;
        float hv[24], ss = 0.f;
#pragma unroll
        for (int i = 0; i < 6; ++i) { const f32x4 x = *(const LAS f32x4*)(Hs + tau * 100 + c0 + i * 4); hv[4 * i] = x[0]; hv[4 * i + 1] = x[1]; hv[4 * i + 2] = x[2]; hv[4 * i + 3] = x[3]; ss += x[0] * x[0] + x[1] * x[1] + x[2] * x[2] + x[3] * x[3]; }
        ss += __shfl_xor(ss, 1); ss += __shfl_xor(ss, 2);
        const float rstd = rsqrtf(ss * (1.0f / 96.0f) + EPS);
        const bf16_t* op = P + (size_t)(rowbase + tau) * PW + PC_O + h * 96 + c0; const float* ng = a.in[I_MNG] + l * 384 + h * 96 + c0;
        bf16_t* mp = MIX + (size_t)(rowbase + tau) * 1024 + 384 + h * 96 + c0;
#pragma unroll
        for (int i = 0; i < 3; ++i) {
            const u32x4 ow = *(const u32x4*)(op + i * 8); const unsigned oo[4] = {ow.x, ow.y, ow.z, ow.w}; unsigned r[4];
#pragma unroll
            for (int j = 0; j < 4; ++j) { const int c = i * 8 + 2 * j; r[j] = cvt_pk_bf16(sigmoidf_(__uint_as_float(oo[j] << 16)) * hv[c] * rstd * ng[c], sigmoidf_(__uint_as_float(oo[j] & 0xffff0000u)) * hv[c + 1] * rstd * ng[c + 1]); }
            *(u32x4*)(mp + i * 8) = (u32x4){r[0], r[1], r[2], r[3]};
        }
    }
}

template <int D> __device__ __forceinline__ void scan16(float& A, float& U) {
#define RG_STEP(o) { const float Ao = dppf<(D ? 0x100 : 0x110) | (o)>(1.0f, A), Uo = dppf<(D ? 0x100 : 0x110) | (o)>(0.0f, U); U = fmaf(A, Uo, U); A *= Ao; }
    RG_STEP(1) RG_STEP(2) RG_STEP(4) RG_STEP(8)
#undef RG_STEP
}
template <bool FINAL>
__device__ __forceinline__ void rg_unit(const Args& a, LAS unsigned char* lds, int l, int b, int hd, int cidx) {
    const int tid = opaque_tid(), wid = __builtin_amdgcn_readfirstlane(tid >> 6), lane = tid & 63, fr = lane & 15, fq = lane >> 4;
    LAS bf16_t* zi = (LAS bf16_t*)lds;
    LAS bf16_t* Wi = (LAS bf16_t*)(lds + 18432);
    LAS float* zf = (LAS float*)(lds + 55296);
    LAS float* cst = (LAS float*)(lds + 88064);
    LAS float* wagg = (LAS float*)(lds + 89600);
    LAS float* hin = (LAS float*)(lds + 97792);
    const bf16_t* P = (const bf16_t*)(a.ws + WS_P); bf16_t* MIX = (bf16_t*)(a.ws + WS_MIX);
    float* AGG = (float*)(a.ws + WS_RGAGG);
    const bool isctx = cidx >= 16; const int n = isctx ? cidx - 16 : cidx, nc = isctx ? 2 : 16, Tseg = isctx ? CTXL : SEQ, segbase = isctx ? NLAT + b * CTXL : b * SEQ, base = n * 128;
    const int c = lane, ch = hd * 64 + c;
    __syncthreads();
    { const bf16_t* wt = (const bf16_t*)(a.ws + WS_RGWT) + (size_t)((l * 2) * 6 + hd) * 8192;
#pragma unroll
      for (int i = 0; i < 4; ++i) { const int idx = tid + 512 * i, dd = idx >> 10, r = (idx >> 3) & 127, k8 = idx & 7; *(LAS u32x4*)(Wi + (dd * 128 + r) * 72 + k8 * 8) = *(const u32x4*)(wt + (size_t)dd * 6 * 8192 + r * 64 + k8 * 8); } }
    if (tid < 128) { const int dd = tid >> 6, cc = tid & 63;
        cst[(dd * 3 + 0) * 64 + cc] = -1.4426950408889634f * a.in[I_RGGB][((l * 2 + dd) * 2 + 0) * 384 + hd * 64 + cc]; cst[(dd * 3 + 1) * 64 + cc] = -1.4426950408889634f * a.in[I_RGGB][((l * 2 + dd) * 2 + 1) * 384 + hd * 64 + cc];
        cst[(dd * 3 + 2) * 64 + cc] = -8.0f * 1.4426950408889634f * log1pf(expf(-a.in[I_RGLAM][(l * 2 + dd) * 384 + hd * 64 + cc]));
        if (FINAL) {
            const int np = dd ? nc - 1 - n : n, step = isctx ? np : 2 + np; const float* ag = AGG + (size_t)((b * 6 + hd) * 2 + dd) * 18 * 128 + cc;
            float Av[17], Uv[17];
#pragma unroll
            for (int s2 = 0; s2 < 17; ++s2) { Av[s2] = 1.f; Uv[s2] = 0.f; if (s2 < step) { Av[s2] = ag[s2 * 128]; Uv[s2] = ag[s2 * 128 + 64]; } }
            float hv = 0.f;
#pragma unroll
            for (int s2 = 0; s2 < 17; ++s2) hv = Av[s2] * hv + Uv[s2];
            hin[dd * 64 + cc] = hv;
        } }
    {
        const float cw0 = a.in[I_RGCW][(l * 4 + 0) * 384 + ch], cw1 = a.in[I_RGCW][(l * 4 + 1) * 384 + ch], cw2 = a.in[I_RGCW][(l * 4 + 2) * 384 + ch], cw3 = a.in[I_RGCW][(l * 4 + 3) * 384 + ch], cbias = a.in[I_RGCB][l * 384 + ch];
        const int tl0 = wid * 16; const bf16_t* pp = P + (size_t)segbase * PW + PC_RX + ch;
#define RG_LD(pos) (((pos) >= 0 && (pos) < Tseg) ? bf2f(pp[(size_t)(pos) * PW]) : 0.f)
        float xv[19];
#pragma unroll
        for (int i = 0; i < 19; ++i) xv[i] = RG_LD(base + tl0 - 2 + i);
#pragma unroll
        for (int i = 0; i < 16; ++i) { const float z = cw0 * xv[i] + cw1 * xv[i + 1] + cw2 * xv[i + 2] + cw3 * xv[i + 3] + cbias; zf[(tl0 + i) * 64 + c] = z; zi[(tl0 + i) * 72 + c] = f2bf(z); }
#undef RG_LD
    }
    __syncthreads();
    const int tl = wid * 16 + fr;
    f32x4 ysum[4];
#pragma unroll
    for (int nb = 0; nb < 4; ++nb) ysum[nb] = (f32x4){0.f, 0.f, 0.f, 0.f};
    f32x4 Ad[2][4], Ud[2][4];
#pragma unroll
    for (int d = 0; d < 2; ++d) {
        f32x4 acc[8];
#pragma unroll
        for (int nb = 0; nb < 8; ++nb) acc[nb] = (f32x4){0.f, 0.f, 0.f, 0.f};
#pragma unroll
        for (int ks = 0; ks < 2; ++ks) {
            const bf16x8 bz = ldfrag(zi, 72, wid * 16, ks * 32, fr, fq);
#pragma unroll
            for (int nb = 0; nb < 8; ++nb) acc[nb] = MFMA(ldfrag(Wi + d * 128 * 72, 72, nb * 16, ks * 32, fr, fq), bz, acc[nb]);
        }
#pragma unroll
        for (int nb = 0; nb < 4; ++nb) {
            const int j0 = nb * 16 + fq * 4;
            const f32x4 z4 = *(const LAS f32x4*)(zf + tl * 64 + j0), br = *(const LAS f32x4*)(cst + (d * 3 + 0) * 64 + j0), bi4 = *(const LAS f32x4*)(cst + (d * 3 + 1) * 64 + j0), sp = *(const LAS f32x4*)(cst + (d * 3 + 2) * 64 + j0);
#pragma unroll
            for (int j = 0; j < 4; ++j) {
                const float rg = __builtin_amdgcn_rcpf(1.0f + __builtin_amdgcn_exp2f(fmaf(acc[nb][j], -1.4426950408889634f, br[j])));
                const float ig = __builtin_amdgcn_rcpf(1.0f + __builtin_amdgcn_exp2f(fmaf(acc[nb + 4][j], -1.4426950408889634f, bi4[j])));
                const float av = __builtin_amdgcn_exp2f(rg * sp[j]);
                Ad[d][nb][j] = av; Ud[d][nb][j] = __builtin_amdgcn_sqrtf(fmaxf(fmaf(-av, av, 1.0f), 0.f)) * (ig * z4[j]);
            }
        }
#pragma unroll
        for (int nb = 0; nb < 4; ++nb)
#pragma unroll
            for (int j = 0; j < 4; ++j) { float A = Ad[d][nb][j], U = Ud[d][nb][j]; if (d == 0) scan16<0>(A, U); else scan16<1>(A, U); Ad[d][nb][j] = A; Ud[d][nb][j] = U; }
        if (fr == (d ? 0 : 15)) {
#pragma unroll
            for (int nb = 0; nb < 4; ++nb) { *(LAS f32x4*)(wagg + ((d * 8 + wid) * 2 + 0) * 64 + nb * 16 + fq * 4) = Ad[d][nb]; *(LAS f32x4*)(wagg + ((d * 8 + wid) * 2 + 1) * 64 + nb * 16 + fq * 4) = Ud[d][nb]; }
        }
    }
    __syncthreads();
    {
        bf16_t* PF = (bf16_t*)(a.ws + WS_RGPF) + ((size_t)(segbase + base + tl) * 384 + hd * 64) * 4;
#pragma unroll
        for (int nb = 0; nb < 4; ++nb) {
            const int j0 = nb * 16 + fq * 4;
            f32x4 Ap[2], Up[2];
#pragma unroll
            for (int d = 0; d < 2; ++d) {
                f32x4 Aw = (f32x4){1.f, 1.f, 1.f, 1.f}, Uw = (f32x4){0.f, 0.f, 0.f, 0.f};
                for (int w2 = 0; w2 < 7; ++w2) { const int w = d ? 7 - w2 : w2; if (d ? (w > wid) : (w < wid)) { const f32x4 aw = *(const LAS f32x4*)(wagg + ((d * 8 + w) * 2 + 0) * 64 + j0), uw = *(const LAS f32x4*)(wagg + ((d * 8 + w) * 2 + 1) * 64 + j0); Uw = aw * Uw + uw; Aw = Aw * aw; } }
                Ap[d] = Aw * Ad[d][nb]; Up[d] = Ad[d][nb] * Uw + Ud[d][nb];
            }
            u32x4 w0, w1;
            w0.x = cvt_pk_bf16(Ap[0][0], Up[0][0]); w0.y = cvt_pk_bf16(Ap[1][0], Up[1][0]); w0.z = cvt_pk_bf16(Ap[0][1], Up[0][1]); w0.w = cvt_pk_bf16(Ap[1][1], Up[1][1]);
            w1.x = cvt_pk_bf16(Ap[0][2], Up[0][2]); w1.y = cvt_pk_bf16(Ap[1][2], Up[1][2]); w1.z = cvt_pk_bf16(Ap[0][3], Up[0][3]); w1.w = cvt_pk_bf16(Ap[1][3], Up[1][3]);
            *(u32x4*)(PF + j0 * 4) = w0; *(u32x4*)(PF + j0 * 4 + 8) = w1;
        }
        if (tid < 128) { const int dd = tid >> 6, cc = tid & 63; float A = 1.f, U = 0.f;
#pragma unroll
            for (int w2 = 0; w2 < 8; ++w2) { const int w = dd ? 7 - w2 : w2; const float aw = wagg[((dd * 8 + w) * 2 + 0) * 64 + cc], uw = wagg[((dd * 8 + w) * 2 + 1) * 64 + cc]; U = aw * U + uw; A *= aw; }
            const int np = dd ? nc - 1 - n : n, step = isctx ? np : 2 + np; float* ag = AGG + ((size_t)((b * 6 + hd) * 2 + dd) * 18 + step) * 128 + cc;
            ag[0] = A; ag[64] = U; }
    }
}

__device__ __forceinline__ void rgc_unit(const Args& a, LAS unsigned char* lds, int l, int b, int hd, int cidx) {
    const int tid = opaque_tid();
    LAS float* hin = (LAS float*)lds;
    const bf16_t* P = (const bf16_t*)(a.ws + WS_P); bf16_t* MIX = (bf16_t*)(a.ws + WS_MIX); const float* AGG = (const float*)(a.ws + WS_RGAGG);
    const bool isctx = cidx >= 16; const int n = isctx ? cidx - 16 : cidx, nc = isctx ? 2 : 16, rowbase = (isctx ? NLAT + b * CTXL : b * SEQ) + n * 128;
    __syncthreads();
    if (tid < 128) { const int dd = tid >> 6, cc = tid & 63;
        const int np = dd ? nc - 1 - n : n, step = isctx ? np : 2 + np; const float* ag = AGG + (size_t)((b * 6 + hd) * 2 + dd) * 18 * 128 + cc;
        float Av[17], Uv[17];
#pragma unroll
        for (int s2 = 0; s2 < 17; ++s2) { Av[s2] = 1.f; Uv[s2] = 0.f; if (s2 < step) { Av[s2] = ag[s2 * 128]; Uv[s2] = ag[s2 * 128 + 64]; } }
        float hv = 0.f;
#pragma unroll
        for (int s2 = 0; s2 < 17; ++s2) hv = Av[s2] * hv + Uv[s2];
        hin[dd * 64 + cc] = hv; }
    __syncthreads();
    const int c4 = (tid & 15) * 4;
    const f32x4 hf = *(const LAS f32x4*)(hin + c4), hb = *(const LAS f32x4*)(hin + 64 + c4);
#pragma unroll
    for (int i = 0; i < 4; ++i) {
        const size_t row = (size_t)rowbase + (tid >> 4) + 32 * i;
        const bf16_t* pf = (const bf16_t*)(a.ws + WS_RGPF) + (row * 384 + hd * 64 + c4) * 4;
        const u32x4 w0 = *(const u32x4*)pf, w1 = *(const u32x4*)(pf + 8);
        const u32x2 gw = *(const u32x2*)(P + row * PW + PC_RG + hd * 64 + c4);
        const unsigned ww[8] = {w0.x, w0.y, w0.z, w0.w, w1.x, w1.y, w1.z, w1.w};
        float y[4];
#pragma unroll
        for (int j = 0; j < 4; ++j) y[j] = __uint_as_float(ww[2 * j] << 16) * hf[j] + __uint_as_float(ww[2 * j] & 0xffff0000u) + __uint_as_float(ww[2 * j + 1] << 16) * hb[j] + __uint_as_float(ww[2 * j + 1] & 0xffff0000u);
        u32x2 o; o.x = cvt_pk_bf16(__uint_as_float(gw.x << 16) * y[0], __uint_as_float(gw.x & 0xffff0000u) * y[1]); o.y = cvt_pk_bf16(__uint_as_float(gw.y << 16) * y[2], __uint_as_float(gw.y & 0xffff0000u) * y[3]);
        *(u32x2*)(MIX + row * 1024 + hd * 64 + c4) = o;
    }
}

__device__ __forceinline__ void gmlp_unit(const Args& a, LAS unsigned char* lds, int l, int chunk) {
    const int tid = opaque_tid(), wid = __builtin_amdgcn_readfirstlane(tid >> 6), lane = tid & 63, fr = lane & 15, fq = lane >> 4;
    LAS bf16_t* vn = (LAS bf16_t*)lds;
    const bf16_t* P = (const bf16_t*)(a.ws + WS_P); bf16_t* MIX = (bf16_t*)(a.ws + WS_MIX);
    const int row0 = chunk * 128;
    __syncthreads();
    {
        const f32x4 g = *(const f32x4*)(a.in[I_CMNG] + l * 256 + lane * 4);
        u32x2 wv[16];
#pragma unroll
        for (int i = 0; i < 16; ++i) wv[i] = *(const u32x2*)(P + (size_t)(row0 + wid * 16 + i) * PW + PC_CV + lane * 4);
#pragma unroll
        for (int i = 0; i < 16; ++i) {
            const int s = wid * 16 + i;
            const u32x2 w = wv[i];
            const float v0 = __uint_as_float(w.x << 16), v1 = __uint_as_float(w.x & 0xffff0000u), v2 = __uint_as_float(w.y << 16), v3 = __uint_as_float(w.y & 0xffff0000u);
            const float ss = wave_sum(v0 * v0 + v1 * v1 + v2 * v2 + v3 * v3);
            const float rstd = rsqrtf(ss * (1.0f / 256.0f) + EPS);
            u32x2 o; o.x = cvt_pk_bf16(v0 * rstd * g[0], v1 * rstd * g[1]); o.y = cvt_pk_bf16(v2 * rstd * g[2], v3 * rstd * g[3]);
            *(LAS u32x2*)(vn + s * 264 + lane * 4) = o;
        }
    }
    __syncthreads();
    const int g = wid >> 1, th = wid & 1;
    const float* ws = a.in[I_CMW] + ((size_t)(l * 4 + g) * 128) * 128;
    f32x4 acc[4][4];
#pragma unroll
    for (int m = 0; m < 4; ++m)
#pragma unroll
        for (int n = 0; n < 4; ++n) acc[m][n] = (f32x4){0.f, 0.f, 0.f, 0.f};
#pragma unroll
    for (int ks = 0; ks < 4; ++ks) {
        bf16x8 bw[4];
#pragma unroll
        for (int m = 0; m < 4; ++m) {
            const float* wp = ws + (size_t)(th * 64 + m * 16 + fr) * 128 + ks * 32 + fq * 8;
            const f32x4 w0 = *(const f32x4*)wp, w1 = *(const f32x4*)(wp + 4);
            u32x4 pk; pk.x = cvt_pk_bf16(w0[0], w0[1]); pk.y = cvt_pk_bf16(w0[2], w0[3]); pk.z = cvt_pk_bf16(w1[0], w1[1]); pk.w = cvt_pk_bf16(w1[2], w1[3]);
            bw[m] = __builtin_bit_cast(bf16x8, pk);
        }
#pragma unroll
        for (int n = 0; n < 4; ++n) {
            const bf16x8 av = trfrag(vn, 264, ks * 32, g * 64 + n * 16, fr, fq);
#pragma unroll
            for (int m = 0; m < 4; ++m) acc[m][n] = MFMA(av, bw[m], acc[m][n]);
        }
    }
#pragma unroll
    for (int m = 0; m < 4; ++m) {
        const int t = th * 64 + m * 16 + fr; const float bsv = a.in[I_CMB][(l * 4 + g) * 128 + t];
#pragma unroll
        for (int n = 0; n < 4; ++n) {
            const int cc = g * 64 + n * 16 + fq * 4;
            const u32x2 uw = *(const u32x2*)(P + (size_t)(row0 + t) * PW + PC_CU + cc);
            const float u0 = __uint_as_float(uw.x << 16), u1 = __uint_as_float(uw.x & 0xffff0000u), u2 = __uint_as_float(uw.y << 16), u3 = __uint_as_float(uw.y & 0xffff0000u);
            u32x2 o; o.x = cvt_pk_bf16(u0 * (acc[m][n][0] + bsv), u1 * (acc[m][n][1] + bsv)); o.y = cvt_pk_bf16(u2 * (acc[m][n][2] + bsv), u3 * (acc[m][n][3] + bsv));
            *(u32x2*)(MIX + (size_t)(row0 + t) * 1024 + 768 + cc) = o;
        }
    }
}

#define MX_NEXT(head) ({ __syncthreads(); if (tid == 0) *qv = (int)atomicAdd(q + (head) * 64, 1u); __syncthreads(); *qv; })
__device__ __forceinline__ void phase_mxa(const Args& a, LAS unsigned char* lds, int l) {
    unsigned* q = (unsigned*)(a.ws + WS_CTL + CTL_QUEUE) + l * 8 * 64; LAS int* qv = (LAS int*)(lds + LDS_BARW - 16); const int tid = opaque_tid();
    const int nch = (l == 0) ? 18 : 18;
    for (;;) { const int u = MX_NEXT(0); if (u >= 128) break; ms_unit(a, lds, l, u >> 3, (u >> 1) & 3, u & 1); }
    for (;;) { const int u = MX_NEXT(1); if (u >= 16 * 6 * nch) break; rg_unit<false>(a, lds, l, u / (6 * nch), (u / nch) % 6, u % nch); }
    const int ngm = (l == 0 ? TOK : NLAT) / 128;
    for (;;) { const int u = MX_NEXT(2); if (u >= ngm) break; gmlp_unit(a, lds, l, u); }
}
__device__ __forceinline__ void phase_mxc(const Args& a, LAS unsigned char* lds, int l) {
    unsigned* q = (unsigned*)(a.ws + WS_CTL + CTL_QUEUE) + l * 8 * 64; LAS int* qv = (LAS int*)(lds + LDS_BARW - 16); const int tid = opaque_tid();
    const int nch = (l == 0) ? 18 : 16;
    for (;;) { const int u = MX_NEXT(3); if (u >= 16 * 4 * nch) break; mo_unit(a, lds, l, u / (4 * nch), (u / nch) & 3, u % nch); }
    for (;;) { const int u = MX_NEXT(4); if (u >= 16 * 6 * nch) break; rgc_unit(a, lds, l, u / (6 * nch), (u / nch) % 6, u % nch); }
}
#undef MX_NEXT

constexpr int N_PHASES = 22;
__global__ void __launch_bounds__(NTHREADS, 2) fwd_kernel(Args a) {
    extern __shared__ __attribute__((aligned(16))) unsigned char lds_raw[];
    LAS unsigned char* lds = (LAS unsigned char*)lds_raw;
    const int lo = a.ph_lo, hi = a.ph_hi;
    XcdBarrier bar; bar.bar = (unsigned*)(a.ws + WS_CTL); bar.x = 0; bar.st = (volatile LAS unsigned*)(lds + LDS_BARW);
    if (hi - lo > 1) {
        if (threadIdx.x == 0) { *(LAS u32x4*)(lds + LDS_BARW) = (u32x4){0u, 0u, 0u, 0u}; }
        __syncthreads();
        bar = xcd_barrier_post((unsigned*)(a.ws + WS_CTL), (volatile LAS unsigned*)(lds + LDS_BARW));
    }
#ifndef PHSEL
#define PHSEL 0xFFF
#endif
#define SELJ(j) (((PHSEL) >> (j)) & 1)
#define IN(k) (lo <= (k) && (k) < hi)
#ifndef PROBE_MASK
#define PROBE_MASK 0u
#endif
    unsigned long long t_ph = PROBE_MASK ? __builtin_amdgcn_s_memrealtime() : 0ull;
#define SEAM(k) do { if (IN(k) && IN((k) + 1)) xcd_barrier(bar); \
    if (PROBE_MASK) { if (((PROBE_MASK) >> (k)) & 1u) { const unsigned long long t1 = __builtin_amdgcn_s_memrealtime(); while (__builtin_amdgcn_s_memrealtime() < t1 + (t1 - t_ph)) __builtin_amdgcn_s_sleep(4); } \
        __syncthreads(); t_ph = __builtin_amdgcn_s_memrealtime(); } } while (0)
    if (SELJ(10) && IN(0)) { p0_mod(a, lds); p0_conv(a, lds); }
    SEAM(0);
    for (int l = 0; l < 2; ++l) {
        const int pb = 1 + 10 * l, T = (l == 0) ? TOK : NLAT;
        if (SELJ(0) && IN(pb + 0)) phase_n1(a, l);
        SEAM(pb + 0);
        if (SELJ(1) && IN(pb + 1)) phase_g1(a, lds, l);
        SEAM(pb + 1);
        if (SELJ(2) && IN(pb + 2)) phase_mxa(a, lds, l);
        SEAM(pb + 2);
        if (SELJ(3) && IN(pb + 3)) phase_mxc(a, lds, l);
        SEAM(pb + 3);
        if (SELJ(4) && IN(pb + 4)) phase_g2(a, lds, l, T);
        SEAM(pb + 4);
        if (SELJ(5) && IN(pb + 5)) phase_n2(a, l, T);
        SEAM(pb + 5);
        if (SELJ(6) && IN(pb + 6)) phase_rt(a, lds, l, T);
        SEAM(pb + 6);
        if (SELJ(7) && IN(pb + 7)) phase_tk(a, lds, l, T);
        SEAM(pb + 7);
        if (SELJ(8) && IN(pb + 8)) phase_e1(a, lds, l, T);
        SEAM(pb + 8);
        if (SELJ(9) && IN(pb + 9)) phase_e2(a, lds, l, T);
        SEAM(pb + 9);
    }
    if (SELJ(11) && IN(21)) phase_fin(a);
#undef IN
#undef SEAM
}

extern "C" void kernel_launch(void* const* d_in, const int* in_sizes, int n_in, void* d_out, int out_size, void* d_ws, size_t ws_size, hipStream_t stream) {
    static int grid = 0;
    if (grid == 0) {
        if (n_in != 29 || out_size != NLAT * D || ws_size < WS_END) { fprintf(stderr, "kernel_launch: unexpected shapes (n_in %d, out %d, ws %zu, need %zu)\n", n_in, out_size, ws_size, (size_t)WS_END); grid = -1; return; }
        int dev = 0, cus = 0, per_cu = 0;
        if (hipGetDevice(&dev) != hipSuccess || hipDeviceGetAttribute(&cus, hipDeviceAttributeMultiprocessorCount, dev) != hipSuccess) { grid = -1; return; }
        if (hipFuncSetAttribute((const void*)fwd_kernel, hipFuncAttributeMaxDynamicSharedMemorySize, LDS_BYTES) != hipSuccess) { fprintf(stderr, "kernel_launch: hipFuncSetAttribute failed\n"); grid = -1; return; }
        if (hipOccupancyMaxActiveBlocksPerMultiprocessor(&per_cu, (const void*)fwd_kernel, NTHREADS, LDS_BYTES) != hipSuccess || per_cu < 1) { fprintf(stderr, "kernel_launch: occupancy query says %d\n", per_cu); (void)hipGetLastError(); grid = -1; return; }
        grid = cus;
    }
    if (grid < 0) return;
    (void)hipMemsetAsync((char*)d_ws + WS_CTL, 0, CTL_BYTES, stream);
    Args a{};
    for (int i = 0; i < 29; ++i) a.in[i] = (const float*)d_in[i];
    a.out = (float*)d_out; a.ws = (unsigned char*)d_ws;
#if MK_PER_PHASE
    for (int p = 0; p < N_PHASES; ++p) { a.ph_lo = p; a.ph_hi = p + 1; hipLaunchKernelGGL(fwd_kernel, dim3(grid), dim3(NTHREADS), LDS_BYTES, stream, a); }
#else
    a.ph_lo = 0; a.ph_hi = N_PHASES;
    hipLaunchKernelGGL(fwd_kernel, dim3(grid), dim3(NTHREADS), LDS_BYTES, stream, a);
#endif
}
```

```cpp
#include <hip/hip_runtime.h>
#include <cstdio>
#include <cstdint>

#ifndef MK_PER_PHASE
#define MK_PER_PHASE 0
#endif

#define LAS __attribute__((address_space(3)))
typedef unsigned short bf16_t;
typedef short bf16x8 __attribute__((ext_vector_type(8)));
typedef float f32x4 __attribute__((ext_vector_type(4)));
typedef float f32x2 __attribute__((ext_vector_type(2)));
typedef unsigned u32x4 __attribute__((ext_vector_type(4)));
typedef unsigned u32x2 __attribute__((ext_vector_type(2)));

constexpr int D = 1024, NBATCH = 16, SEQ = 2048, CTXL = 256;
constexpr int NLAT = NBATCH * SEQ, NCTX = NBATCH * CTXL, TOK = NLAT + NCTX;
constexpr int DIN = 2832, PW = 2816, NIN = 3072;
constexpr int NE = 256, FF = 288, NSLOT = 9, LCAP = TOK;
constexpr int NTHREADS = 512;
constexpr int LDS_BYTES = 147456;
constexpr int LDS_TAB = 139264;
constexpr int LDS_BARW = LDS_BYTES - 16;
constexpr float EPS = 1e-6f;

constexpr int PC_RX = 0, PC_RG = 384, PC_Q = 768, PC_K = 1152, PC_V = 1536, PC_O = 1920, PC_CU = 2304, PC_CV = 2560;

constexpr size_t WS_CTL = 0, CTL_BYTES = 131072;
constexpr size_t CTL_QUEUE = 16384, CTL_CNT = 32768;
constexpr int CNT_STRIDE = 32;
constexpr size_t WS_MOD = 131072;
constexpr size_t WS_X = WS_MOD + 1048576;
constexpr size_t WS_XA = WS_X + (size_t)TOK * D * 4;
constexpr size_t WS_R1 = WS_XA + (size_t)TOK * D * 2;
constexpr size_t R1_BYTES = (size_t)TOK * NSLOT * D * 2;
constexpr size_t WS_P = WS_R1;
constexpr size_t WS_MIX = WS_P + (size_t)TOK * PW * 2;
constexpr size_t WS_CTG = WS_MIX + (size_t)TOK * D * 2;
constexpr size_t WS_MST = WS_CTG + (size_t)128 * 18 * 112 * 96 * 2;
constexpr size_t WS_RGAGG = WS_MST + 16384;
constexpr size_t WS_RGPF = WS_RGAGG + (size_t)192 * 18 * 128 * 4;
static_assert(WS_RGPF + (size_t)TOK * 384 * 4 * 2 <= WS_R1 + R1_BYTES, "aliases");
constexpr int HB_ROWS = (TOK * 8 / 256 + 256 + TOK / 256) * 256;
constexpr size_t WS_HB = WS_R1 + R1_BYTES;
constexpr size_t WS_GATES = WS_HB + (size_t)HB_ROWS * FF * 2 + 256;
constexpr size_t WS_LOGITS = WS_GATES + (size_t)TOK * 16 * 4;
constexpr size_t WS_LSLOT = WS_LOGITS + (size_t)TOK * 256 * 4;
constexpr size_t WS_LW = WS_LSLOT + (size_t)NE * LCAP * 4;
constexpr size_t WS_WIN = WS_LW + (size_t)NE * LCAP * 4;
constexpr size_t WS_WOUT = WS_WIN + (size_t)2 * NIN * D * 2;
constexpr size_t WS_ROUT = WS_WOUT + (size_t)2 * D * D * 2;
constexpr size_t WS_RGWT = WS_ROUT + (size_t)2 * NE * D * 2;
constexpr size_t WS_END = WS_RGWT + (size_t)2 * 2 * 6 * 128 * 64 * 2;

__device__ __forceinline__ float bf2f(bf16_t b) { return __uint_as_float(((unsigned)b) << 16); }
__device__ __forceinline__ unsigned cvt_pk_bf16(float lo, float hi) { unsigned r; asm volatile("v_cvt_pk_bf16_f32 %0, %1, %2" : "=v"(r) : "v"(lo), "v"(hi)); return r; }
__device__ __forceinline__ bf16_t f2bf(float f) { return (bf16_t)(cvt_pk_bf16(f, 0.f) & 0xffffu); }
__device__ __forceinline__ float sigmoidf_(float x) { return __builtin_amdgcn_rcpf(1.0f + __expf(-x)); }
__device__ __forceinline__ float siluf_(float x) { return x * __builtin_amdgcn_rcpf(1.0f + __expf(-x)); }
__device__ __forceinline__ float gelu_tanh(float x) { const float u = 1.5957691216057308f * (x + 0.044715f * x * x * x); return x * __builtin_amdgcn_rcpf(1.0f + __expf(-u)); }
__device__ __forceinline__ float wave_sum(float v) {
#pragma unroll
    for (int o = 32; o >= 1; o >>= 1) v += __shfl_xor(v, o);
    return v;
}
__device__ __forceinline__ int opaque_tid() { int t = threadIdx.x; asm volatile("" : "+v"(t)); return t; }
#define WAIT_VM0() asm volatile("s_waitcnt vmcnt(0)" ::: "memory")

#define XB_TMO      128
#define XB_XCNT(j)  (256  + 64 * (j))
#define XB_XSUB(j)  (1280 + 64 * (j))
#define XB_XGEN(j)  (2304 + 64 * (j))
#define XB_TOP      3328
#define XB_TOPGEN   3392
#define XCD_BAR_WORDS 3456
#define XB_SPIN_CAP (1u << 18)

__device__ __forceinline__ unsigned xb_ld(unsigned* p)              { return __hip_atomic_load(p, __ATOMIC_RELAXED, __HIP_MEMORY_SCOPE_AGENT); }
__device__ __forceinline__ unsigned xb_add(unsigned* p, unsigned v) { return __hip_atomic_fetch_add(p, v, __ATOMIC_RELAXED, __HIP_MEMORY_SCOPE_AGENT); }
__device__ __forceinline__ unsigned xb_xcc_id() { return (unsigned)__builtin_amdgcn_s_getreg((3 << 11) | 20) & 0xFu; }
#define XB_SPIN(cond, bar) do { unsigned _sp = 0; while (cond) { __builtin_amdgcn_s_sleep(1); \
    if ((++_sp & 255u) == 0u) { if (xb_ld(&(bar)[XB_TMO])) break; if (_sp > XB_SPIN_CAP) { atomicAdd(&(bar)[XB_TMO], 1u); break; } } } } while (0)

struct XcdBarrier { unsigned* bar; unsigned x; volatile LAS unsigned* st; };

__device__ __forceinline__ XcdBarrier xcd_barrier_post(unsigned* bar, volatile LAS unsigned* st) {
    XcdBarrier b; b.bar = bar; b.x = xb_xcc_id(); b.st = st;
    if (threadIdx.x == 0) (void)xb_add(&bar[XB_XCNT(b.x)], 1u);
    return b;
}
__device__ __forceinline__ void xcd_barrier_complete(unsigned* bar, unsigned x, unsigned& nloc, unsigned& nx) {
    const unsigned G = gridDim.x * gridDim.y * gridDim.z;
    unsigned sum, cnt, mine, sp = 0u;
    for (;;) {
        sum = 0u; cnt = 0u; mine = 0u;
#pragma unroll
        for (unsigned j = 0; j < 16; ++j) { const unsigned c = xb_ld(&bar[XB_XCNT(j)]); sum += c; cnt += (c > 0u) ? 1u : 0u; mine = (j == x) ? c : mine; }
        if (sum == G) break;
        __builtin_amdgcn_s_sleep(1);
        if ((++sp & 255u) == 0u) { if (xb_ld(&bar[XB_TMO])) break; if (sp > XB_SPIN_CAP) { atomicAdd(&bar[XB_TMO], 1u); break; } }
    }
    nloc = mine > 0u ? mine : 1u; nx = cnt > 0u ? cnt : 1u;
}
__device__ __forceinline__ void xcd_barrier(const XcdBarrier& b) {
    asm volatile("s_waitcnt vmcnt(0)" ::: "memory");
    __syncthreads();
    if (threadIdx.x == 0) {
        unsigned* bar = b.bar;
        __builtin_amdgcn_s_waitcnt(0);
        unsigned nloc = b.st[0], nx = b.st[1];
        if (nloc == 0u) { xcd_barrier_complete(bar, b.x, nloc, nx); b.st[0] = nloc; b.st[1] = nx; }
        const unsigned old = xb_add(&bar[XB_XSUB(b.x)], 1u);
        const unsigned gen = old / nloc;
        if (old + 1u == (gen + 1u) * nloc) {
            __builtin_amdgcn_fence(__ATOMIC_RELEASE, "agent");
            asm volatile("s_waitcnt vmcnt(0)" ::: "memory");
            const unsigned og = xb_add(&bar[XB_TOP], 1u);
            const unsigned tg = og / nx;
            if (og + 1u == (tg + 1u) * nx) xb_add(&bar[XB_TOPGEN], 1u);
            else XB_SPIN(xb_ld(&bar[XB_TOPGEN]) == tg, bar);
            __builtin_amdgcn_fence(__ATOMIC_ACQUIRE, "agent");
            xb_add(&bar[XB_XGEN(b.x)], 1u);
            asm volatile("s_waitcnt vmcnt(0)" ::: "memory");
        } else {
            XB_SPIN(xb_ld(&bar[XB_XGEN(b.x)]) == gen, bar);
            __builtin_amdgcn_fence(__ATOMIC_ACQUIRE, "agent");
            asm volatile("s_waitcnt vmcnt(0)" ::: "memory");
        }
    }
    __syncthreads();
}

struct Args { const float* in[29]; float* out; unsigned char* ws; int ph_lo, ph_hi; };
enum { I_X = 0, I_C, I_CTX, I_CCTX, I_N1G, I_N2G, I_WMOD, I_BMOD, I_WIN, I_RGCW, I_RGCB, I_RGGW, I_RGGB, I_RGLAM, I_MGB, I_MNG, I_CMNG, I_CMW, I_CMB,
       I_WOUT, I_RW, I_RB, I_EG, I_EU, I_ED, I_SG, I_SU, I_SD, I_FNG };

__device__ __forceinline__ int lds_byte(int r, int c) { const int st = (r >> 4) * 2 + (c >> 5), ob = (r & 15) * 64 + (c & 31) * 2; return st * 1024 + (ob ^ (((ob >> 9) & 1) << 5)); }
__device__ __forceinline__ void stage_rc(int b, int& R, int& C) { const int st = b >> 10, sb = b & 1023, swz = sb ^ (((sb >> 9) & 1) << 5); R = (st >> 1) * 16 + (swz >> 6); C = (st & 1) * 32 + ((swz & 63) >> 1); }

template <int BN, int WC> struct GT { static constexpr int WR = 8 / WC, MF = 256 / WR / 16, NF = BN / WC / 16, BP = BN / 64; };

typedef short s16x4 __attribute__((ext_vector_type(4)));
__device__ __forceinline__ bf16x8 trfrag(const LAS bf16_t* img, int pitch, int k0, int n0, int fr, int fq) {
    const LAS bf16_t* p = img + (k0 + 8 * fq + (fr >> 2)) * pitch + n0 + 4 * (fr & 3);
    const s16x4 lo = __builtin_amdgcn_ds_read_tr16_b64_v4i16((LAS s16x4*)p), hi = __builtin_amdgcn_ds_read_tr16_b64_v4i16((LAS s16x4*)(p + 4 * pitch));
    return __builtin_shufflevector(lo, hi, 0, 1, 2, 3, 4, 5, 6, 7);
}

constexpr int RS_SLOT = 34816, RS_BOFF = 16384;
struct RSeg { const unsigned char* Ab; unsigned aoff[2]; const float* B0; const float* B1; };
template <int BN, int WC, bool DUAL, bool GATHER, int NSET, class PV>
__device__ __forceinline__ void ring_gemm(LAS unsigned char* lds, PV& pv, const int ns, const int ldb, const unsigned ca0, const unsigned ca1) {
    constexpr int MF = GT<BN, WC>::MF, NF = GT<BN, WC>::NF, PITCH = BN == 192 ? 200 : 280, LPS = BN / 64, VPR = BN / 4;
    const int tid = opaque_tid(), wid = __builtin_amdgcn_readfirstlane(tid >> 6), lane = tid & 63, fr = lane & 15, fq = lane >> 4;
    const int wr = wid / WC, wc = wid % WC;
    const int obA = fr * 64 + fq * 16;
    const int aro = (wr * MF) * 1024 + (obA ^ (((obA >> 9) & 1) << 5));
    const unsigned ldsb = (unsigned)(size_t)lds + (unsigned)(RS_BOFF + ((8 * fq + (fr >> 2)) * PITCH + (DUAL ? 4 * (fr & 3) + wc * 48 : 16 * (fr & 3) + wc * (NF * 16))) * 2);
    constexpr int NTB = DUAL ? LPS : 1;
    unsigned bsoff_[NTB]; unsigned bdst_[NTB];
    bool bsel_[NTB];
#pragma unroll
    for (int i = 0; i < NTB; ++i) { const int e = tid + 512 * i, row = e / VPR, c4 = e % VPR; bsel_[i] = DUAL && c4 >= 24; bsoff_[i] = (unsigned)(row * ldb + 4 * (DUAL ? c4 % 24 : c4));
        bdst_[i] = (unsigned)(size_t)lds + (unsigned)(RS_BOFF + (row * PITCH + 4 * c4) * 2); }
#define bsoff(i) (DUAL ? bsoff_[DUAL ? (i) : 0] : bsoff_[0] + (unsigned)(8 * (i) * ldb))
#define bdst(i) (DUAL ? bdst_[DUAL ? (i) : 0] : bdst_[0] + (unsigned)(8 * (i) * PITCH * 2))
#define bsel(i) (DUAL ? bsel_[DUAL ? (i) : 0] : false)
    f32x4 acc[MF][NF];
#pragma unroll
    for (int m = 0; m < MF; ++m)
#pragma unroll
        for (int n = 0; n < NF; ++n) acc[m][n] = (f32x4){0.f, 0.f, 0.f, 0.f};
    RSeg ss, nx; int si = 0, sj = 0;
    bool have = pv.seg(0, ss); if (!have) return;
    pv.finish(ss, true);
    bool have_nx = pv.seg(1, nx);
    int staged = 0, g = 0, ci = 0, cj = 0;
    f32x4 r0[LPS], r1[NSET == 2 ? LPS : 1];
#define RS_STAGEA() do { _Pragma("unroll") for (int _i = 0; _i < 2; ++_i) __builtin_amdgcn_global_load_lds((const unsigned*)(ss.Ab + (GATHER ? ss.aoff[_i] : (_i ? ca1 : ca0)) + (size_t)sj * 64), (LAS unsigned*)(lds + (staged & 3) * RS_SLOT + (wid + 8 * _i) * 1024), 16, 0, 0); } while (0)
#define RS_LOADB(rr) do { if (DUAL) { _Pragma("unroll") for (int _i = 0; _i < LPS; ++_i) { const float* _p = (bsel(_i) ? ss.B1 : ss.B0) + bsoff(_i) + (size_t)(sj * 32) * ldb; \
            asm volatile("global_load_dwordx4 %0, %1, off" : "=&v"(rr[_i]) : "v"(_p)); } } \
        else { const float* _sb = ss.B0 + (size_t)(sj * 32) * ldb; _Pragma("unroll") for (int _i = 0; _i < LPS; ++_i) { const unsigned _o = bsoff(_i) * 4u; \
            asm volatile("global_load_dwordx4 %0, %1, %2" : "=&v"(rr[_i]) : "v"(_o), "s"(_sb)); } } } while (0)
#define RS_WAITB(rr, steady) do { if (steady) { if (NSET == 1) asm volatile("s_waitcnt vmcnt(2)" ::: "memory"); else if (LPS == 3) asm volatile("s_waitcnt vmcnt(7)" ::: "memory"); else asm volatile("s_waitcnt vmcnt(8)" ::: "memory"); } else asm volatile("s_waitcnt vmcnt(0)" ::: "memory"); \
        __builtin_amdgcn_sched_barrier(0);        \
        if (LPS == 3) asm volatile("" : "+v"(rr[0]), "+v"(rr[1]), "+v"(rr[2])); else asm volatile("" : "+v"(rr[0]), "+v"(rr[1]), "+v"(rr[2]), "+v"(rr[LPS > 3 ? 3 : 0])); } while (0)
#define RS_WRITEB(rr, slot) do { _Pragma("unroll") for (int _i = 0; _i < LPS; ++_i) { u32x2 _w; _w.x = cvt_pk_bf16(rr[_i][0], rr[_i][1]); _w.y = cvt_pk_bf16(rr[_i][2], rr[_i][3]); \
        asm volatile("ds_write_b64 %0, %1" :: "v"(bdst(_i) + (unsigned)((slot) * RS_SLOT)), "v"(_w) : "memory"); } } while (0)
#define RS_ADVANCE() do { ++staged; if (++sj == ns) { sj = 0; ++si; if (have_nx) pv.finish(nx, false); ss = nx; have = have_nx; have_nx = have ? pv.seg(si + 1, nx) : false; } } while (0)
#define RS_TR(dst, slot, off) asm volatile("ds_read_b64_tr_b16 %0, %1 offset:%2" : "=v"(dst) : "v"(ldsb + (unsigned)((slot) * RS_SLOT)), "n"(off))
#define RS_KSTEP(slot) do { bf16x8 At[MF], Bf[NF]; s16x4 _lo[NF], _hi[NF]; \
        _Pragma("unroll") for (int n = 0; n < NF; ++n) { \
            if (DUAL) { if (n < 3) { RS_TR(_lo[n], slot, (16 * (n % 3)) * 2); RS_TR(_hi[n], slot, (16 * (n % 3) + 4 * PITCH) * 2); } else { RS_TR(_lo[n], slot, (96 + 16 * (n % 3)) * 2); RS_TR(_hi[n], slot, (96 + 16 * (n % 3) + 4 * PITCH) * 2); } } \
            else { RS_TR(_lo[n], slot, (4 * n) * 2); RS_TR(_hi[n], slot, (4 * n + 4 * PITCH) * 2); } } \
        _Pragma("unroll") for (int m = 0; m < MF; ++m) At[m] = *(const LAS bf16x8*)(lds + (slot) * RS_SLOT + aro + m * 1024); \
        if (NF == 6) asm volatile("s_waitcnt lgkmcnt(0)" : "+v"(_lo[0]), "+v"(_hi[0]), "+v"(_lo[1]), "+v"(_hi[1]), "+v"(_lo[2]), "+v"(_hi[2]), "+v"(_lo[3]), "+v"(_hi[3]), "+v"(_lo[NF > 4 ? 4 : 0]), "+v"(_hi[NF > 4 ? 4 : 0]), "+v"(_lo[NF > 5 ? 5 : 1]), "+v"(_hi[NF > 5 ? 5 : 1])); \
        else asm volatile("s_waitcnt lgkmcnt(0)" : "+v"(_lo[0]), "+v"(_hi[0]), "+v"(_lo[1]), "+v"(_hi[1]), "+v"(_lo[2]), "+v"(_hi[2]), "+v"(_lo[3]), "+v"(_hi[3])); \
        _Pragma("unroll") for (int n = 0; n < NF; ++n) Bf[n] = __builtin_shufflevector(_lo[n], _hi[n], 0, 1, 2, 3, 4, 5, 6, 7); \
        _Pragma("unroll") for (int m = 0; m < MF; ++m) _Pragma("unroll") for (int n = 0; n < NF; ++n) acc[m][n] = __builtin_amdgcn_mfma_f32_16x16x32_bf16(Bf[n], At[m], acc[m][n], 0, 0, 0); __builtin_amdgcn_sched_barrier(0); } while (0)
#define RS_BARRIER() do { asm volatile("s_waitcnt lgkmcnt(0)" ::: "memory"); __builtin_amdgcn_s_barrier(); asm volatile("" ::: "memory"); } while (0)
    if (NSET == 2) {
        RS_STAGEA(); RS_LOADB(r0); RS_WAITB(r0, false); RS_WRITEB(r0, 0); RS_ADVANCE();
        if (have) { RS_STAGEA(); RS_LOADB(r1); RS_ADVANCE(); }
        if (have) { RS_STAGEA(); RS_LOADB(r0); RS_ADVANCE(); }
    } else {
        RS_STAGEA(); RS_LOADB(r0); RS_WAITB(r0, false); RS_WRITEB(r0, 0); RS_ADVANCE();
        if (have) { RS_STAGEA(); RS_LOADB(r0); RS_ADVANCE(); }
    }
    WAIT_VM0(); RS_BARRIER();
#define RS_ITER(rw, STEADY) do { \
        const bool st = have; \
        if (st) RS_STAGEA(); \
        RS_KSTEP(g & 3); \
        if (++cj == ns) { pv.epi(ci, acc); _Pragma("unroll") for (int m = 0; m < MF; ++m) _Pragma("unroll") for (int n = 0; n < NF; ++n) acc[m][n] = (f32x4){0.f, 0.f, 0.f, 0.f}; cj = 0; ++ci; } \
        if (g + 1 < staged) { RS_WAITB(rw, STEADY); RS_WRITEB(rw, (g + 1) & 3); } \
        if (st) { RS_LOADB(rw); RS_ADVANCE(); } \
        st_prev = st; ++g; RS_BARRIER(); } while (0)
    bool st_prev = true;
    if (NSET == 2) {
        for (;;) {
            RS_ITER(r1, st && st_prev); if (g >= staged) break;
            RS_ITER(r0, st && st_prev); if (g >= staged) break;
        }
    } else {
        for (;;) { RS_ITER(r0, st); if (g >= staged) break; }
    }
    WAIT_VM0(); __syncthreads();
#undef RS_STAGEA
#undef RS_LOADB
#undef RS_WAITB
#undef RS_WRITEB
#undef RS_ADVANCE
#undef RS_TR
#undef RS_KSTEP
#undef RS_BARRIER
#undef RS_ITER
#undef bsoff
#undef bdst
#undef bsel
}

__device__ __forceinline__ bf16x8 ldfrag(const LAS bf16_t* img, int pitch, int row0, int k0, int fr, int fq) { return *(const LAS bf16x8*)(img + (row0 + fr) * pitch + k0 + fq * 8); }
#define MFMA(a, b, c) __builtin_amdgcn_mfma_f32_16x16x32_bf16(a, b, c, 0, 0, 0)

__device__ __forceinline__ void p0_mod(const Args& a, LAS unsigned char* lds) {
    { bf16_t* wt = (bf16_t*)(a.ws + WS_RGWT);
      for (int idx = blockIdx.x * NTHREADS + threadIdx.x; idx < 2 * 2 * 2 * 6 * 4096; idx += gridDim.x * NTHREADS) { const int j = idx & 63, i = (idx >> 6) & 63, hd = (idx >> 12) % 6, g = ((idx >> 12) / 6) & 1, ld = (idx >> 12) / 12;
          wt[((size_t)(ld * 6 + hd) * 128 + g * 64 + j) * 64 + i] = f2bf(a.in[I_RGGW][idx]); } }
    LAS float* sc = (LAS float*)lds;
    LAS float* red = (LAS float*)(lds + 69632);
    const int tid = opaque_tid();
    for (int i = tid; i < 17 * 1024; i += NTHREADS) { const int s = i >> 10, k = i & 1023; const float v = s < 16 ? a.in[I_C][s * 1024 + k] : a.in[I_CCTX][k]; sc[i] = siluf_(v); }
    __syncthreads();
    float* MOD = (float*)(a.ws + WS_MOD);
    for (int u = blockIdx.x; u < 192; u += gridDim.x) {
        const int l = u / 96, cb = (u % 96) * 64, col = tid & 63, ks = tid >> 6;
        const float* w = a.in[I_WMOD] + (size_t)l * 1024 * 6144 + cb + col;
        float acc[17];
#pragma unroll
        for (int s = 0; s < 17; ++s) acc[s] = 0.f;
#pragma unroll 4
        for (int k = ks * 128; k < ks * 128 + 128; ++k) {
            const float wv = w[(size_t)k * 6144];
#pragma unroll
            for (int s = 0; s < 17; ++s) acc[s] += sc[s * 1024 + k] * wv;
        }
#pragma unroll
        for (int s = 0; s < 17; ++s) red[(ks * 17 + s) * 64 + col] = acc[s];
        __syncthreads();
        for (int i = tid; i < 17 * 64; i += NTHREADS) {
            const int s = i >> 6, c = i & 63; float v = 0.f;
#pragma unroll
            for (int k2 = 0; k2 < 8; ++k2) v += red[(k2 * 17 + s) * 64 + c];
            MOD[((size_t)l * 17 + s) * 6144 + cb + c] = v + a.in[I_BMOD][l * 6144 + cb + c];
        }
        __syncthreads();
    }
}

template <int KT>
__device__ __forceinline__ void conv_tile(LAS float* tile, const float* p0, const float* p1, const float* p2, const float* p3, int ldn, int k0, bf16_t* dst, int K) {
    const int tid = opaque_tid(), r = tid >> 4, c4 = tid & 15, grp = c4 >> 2, within = (c4 & 3) * 4;
    const float* p = grp == 0 ? p0 : grp == 1 ? p1 : grp == 2 ? p2 : p3;
#pragma unroll
    for (int i = 0; i < KT / 32; ++i) {
        const int k = r + 32 * i; f32x4 v = (f32x4){0.f, 0.f, 0.f, 0.f};
        if (p) v = *(const f32x4*)(p + (size_t)(k0 + k) * ldn + within);
        tile[k * 65 + c4 * 4 + 0] = v[0]; tile[k * 65 + c4 * 4 + 1] = v[1]; tile[k * 65 + c4 * 4 + 2] = v[2]; tile[k * 65 + c4 * 4 + 3] = v[3];
    }
    __syncthreads();
    constexpr int CPR = KT / 16;
    const int row = tid / CPR, ch = tid % CPR;
    if (row < 64) {
        float v[16];
#pragma unroll
        for (int j = 0; j < 16; ++j) v[j] = tile[(ch * 16 + j) * 65 + row];
        u32x4 w0, w1;
        w0.x = cvt_pk_bf16(v[0], v[1]); w0.y = cvt_pk_bf16(v[2], v[3]); w0.z = cvt_pk_bf16(v[4], v[5]); w0.w = cvt_pk_bf16(v[6], v[7]);
        w1.x = cvt_pk_bf16(v[8], v[9]); w1.y = cvt_pk_bf16(v[10], v[11]); w1.z = cvt_pk_bf16(v[12], v[13]); w1.w = cvt_pk_bf16(v[14], v[15]);
        bf16_t* dp = dst + (size_t)row * K + k0 + ch * 16;
        *(u32x4*)dp = w0; *(u32x4*)(dp + 8) = w1;
    }
    __syncthreads();
}

constexpr int CV_WIN = 384, CV_WOUT = 128, CV_ROUT = 32, CV_LAYER = CV_WIN + CV_WOUT + CV_ROUT;
__device__ __forceinline__ void p0_conv(const Args& a, LAS unsigned char* lds) {
    LAS float* tile = (LAS float*)lds;
    for (int u = blockIdx.x; u < 2 * CV_LAYER; u += gridDim.x) {
        const int l = u / CV_LAYER; int j = u % CV_LAYER;
        if (j < CV_WIN) {
            const int rho0 = (j >> 3) * 64, kt = j & 7; const float* src = a.in[I_WIN] + (size_t)l * 1024 * DIN; const float* p[4];
#pragma unroll
            for (int g = 0; g < 4; ++g) { const int rho = rho0 + 16 * g; const int col = rho < 2304 ? rho : rho < 2816 ? rho + 16 : rho < 2832 ? rho - 512 : -1; p[g] = col >= 0 ? src + col : nullptr; }
            conv_tile<128>(tile, p[0], p[1], p[2], p[3], DIN, kt * 128, (bf16_t*)(a.ws + WS_WIN) + ((size_t)l * NIN + rho0) * 1024, 1024);
            continue;
        }
        j -= CV_WIN;
        if (j < CV_WOUT) {
            const int rho0 = (j >> 3) * 64, kt = j & 7; const float* src = a.in[I_WOUT] + (size_t)l * 1024 * 1024 + rho0;
            conv_tile<128>(tile, src, src + 16, src + 32, src + 48, 1024, kt * 128, (bf16_t*)(a.ws + WS_WOUT) + ((size_t)l * 1024 + rho0) * 1024, 1024);
            continue;
        }
        j -= CV_WOUT;
        if (j < CV_ROUT) {
            const int rho0 = (j >> 3) * 64, kt = j & 7; const float* src = a.in[I_RW] + (size_t)l * 1024 * 256 + rho0;
            conv_tile<128>(tile, src, src + 16, src + 32, src + 48, 256, kt * 128, (bf16_t*)(a.ws + WS_ROUT) + ((size_t)l * 256 + rho0) * 1024, 1024);
            continue;
        }
    }
}

__device__ __forceinline__ int sample_of(int row) { return row < NLAT ? (row >> 11) : 16; }

constexpr float SLOT_SCALE = 16.0f, SLOT_CLAMP = 240.0f;
typedef float f32x2 __attribute__((ext_vector_type(2)));
__device__ __forceinline__ void slot_sum(const unsigned char* Y8, int row, int lane, f32x4 (&s)[4]) {
#pragma unroll
    for (int ii = 0; ii < 4; ++ii) s[ii] = (f32x4){0.f, 0.f, 0.f, 0.f};
    u32x4 w[NSLOT];
#pragma unroll
    for (int k = 0; k < NSLOT; ++k) w[k] = *(const u32x4*)(Y8 + ((size_t)row * NSLOT + k) * 1024 + lane * 16);
#pragma unroll
    for (int k = 0; k < NSLOT; ++k) {
        const unsigned ww[4] = {w[k].x, w[k].y, w[k].z, w[k].w};
#pragma unroll
        for (int ii = 0; ii < 4; ++ii) { const f32x2 lo = __builtin_amdgcn_cvt_pk_f32_fp8((int)ww[ii], false), hi = __builtin_amdgcn_cvt_pk_f32_fp8((int)ww[ii], true); s[ii][0] += lo[0]; s[ii][1] += lo[1]; s[ii][2] += hi[0]; s[ii][3] += hi[1]; }
    }
#pragma unroll
    for (int ii = 0; ii < 4; ++ii) s[ii] = s[ii] * (1.0f / SLOT_SCALE);
}
__device__ __forceinline__ void xrow_ld(const bf16_t* p, f32x4 (&v)[4]) {
    const u32x4 w0 = *(const u32x4*)p, w1 = *(const u32x4*)(p + 8);
    v[0] = (f32x4){__uint_as_float(w0.x << 16), __uint_as_float(w0.x & 0xffff0000u), __uint_as_float(w0.y << 16), __uint_as_float(w0.y & 0xffff0000u)};
    v[1] = (f32x4){__uint_as_float(w0.z << 16), __uint_as_float(w0.z & 0xffff0000u), __uint_as_float(w0.w << 16), __uint_as_float(w0.w & 0xffff0000u)};
    v[2] = (f32x4){__uint_as_float(w1.x << 16), __uint_as_float(w1.x & 0xffff0000u), __uint_as_float(w1.y << 16), __uint_as_float(w1.y & 0xffff0000u)};
    v[3] = (f32x4){__uint_as_float(w1.z << 16), __uint_as_float(w1.z & 0xffff0000u), __uint_as_float(w1.w << 16), __uint_as_float(w1.w & 0xffff0000u)};
}
__device__ __forceinline__ void xrow_st(bf16_t* p, const f32x4 (&v)[4]) {
    u32x4 w0, w1;
    w0.x = cvt_pk_bf16(v[0][0], v[0][1]); w0.y = cvt_pk_bf16(v[0][2], v[0][3]); w0.z = cvt_pk_bf16(v[1][0], v[1][1]); w0.w = cvt_pk_bf16(v[1][2], v[1][3]);
    w1.x = cvt_pk_bf16(v[2][0], v[2][1]); w1.y = cvt_pk_bf16(v[2][2], v[2][3]); w1.z = cvt_pk_bf16(v[3][0], v[3][1]); w1.w = cvt_pk_bf16(v[3][2], v[3][3]);
    *(u32x4*)p = w0; *(u32x4*)(p + 8) = w1;
}
__device__ __forceinline__ void norm_mod_store(const f32x4 (&v)[4], const float* g, const float* shift, const float* scale, bf16_t* dst, int lane) {
    float ss = 0.f;
#pragma unroll
    for (int ii = 0; ii < 4; ++ii) ss += v[ii][0] * v[ii][0] + v[ii][1] * v[ii][1] + v[ii][2] * v[ii][2] + v[ii][3] * v[ii][3];
    ss = wave_sum(ss);
    const float rstd = rsqrtf(ss * (1.0f / 1024.0f) + EPS);
    f32x4 y[4];
#pragma unroll
    for (int ii = 0; ii < 4; ++ii) {
        const int c = lane * 16 + ii * 4;
        const f32x4 gg = *(const f32x4*)(g + c), sh = *(const f32x4*)(shift + c), sc = *(const f32x4*)(scale + c);
#pragma unroll
        for (int j = 0; j < 4; ++j) y[ii][j] = v[ii][j] * rstd * gg[j] * (1.0f + sc[j]) + sh[j];
    }
    xrow_st(dst + lane * 16, y);
}

__device__ __forceinline__ void phase_n1(const Args& a, int l) {
    const int tid = opaque_tid(), wid = tid >> 6, lane = tid & 63;
    bf16_t* X = (bf16_t*)(a.ws + WS_X); bf16_t* XA = (bf16_t*)(a.ws + WS_XA); const float* MOD = (const float*)(a.ws + WS_MOD); const unsigned char* Y8 = (const unsigned char*)(a.ws + WS_R1);
    for (int row = blockIdx.x * 8 + wid; row < TOK; row += gridDim.x * 8) {
        const int s = sample_of(row);
        f32x4 v[4];
        if (l == 0) {
            if (row < NLAT) {
                const float* xp = a.in[I_X] + (size_t)row * 1024 + lane * 16;
                const int tp = row & 2047; const int seg = lane >> 4; const float pos = (seg & 2) ? (float)(tp & 63) : (float)(tp >> 6);
#pragma unroll
                for (int ii = 0; ii < 4; ++ii) v[ii] = *(const f32x4*)(xp + ii * 4);
#pragma unroll
                for (int ii = 0; ii < 4; ++ii)
#pragma unroll
                    for (int j = 0; j < 4; ++j) {
                        const float om = exp2f(-13.287712379549449f * (float)((lane & 15) * 16 + ii * 4 + j) * (1.0f / 256.0f));
                        const float ang = pos * om;
                        v[ii][j] += (seg & 1) ? cosf(ang) : sinf(ang);
                    }
            } else {
                const float* xp = a.in[I_CTX] + (size_t)(row - NLAT) * 1024 + lane * 16;
#pragma unroll
                for (int ii = 0; ii < 4; ++ii) v[ii] = *(const f32x4*)(xp + ii * 4);
            }
        } else {
            f32x4 ys[4], xv[4]; slot_sum(Y8, row, lane, ys); xrow_ld(X + (size_t)row * 1024 + lane * 16, xv);
            const float* gate = MOD + ((size_t)(l - 1) * 17 + s) * 6144 + 5 * 1024 + lane * 16;
#pragma unroll
            for (int ii = 0; ii < 4; ++ii) { const f32x4 gv = *(const f32x4*)(gate + ii * 4); v[ii] = xv[ii] + gv * ys[ii]; }
        }
        xrow_st(X + (size_t)row * 1024 + lane * 16, v);
        const float* m = MOD + ((size_t)l * 17 + s) * 6144;
        norm_mod_store(v, a.in[I_N1G] + l * 1024, m, m + 1024, XA + (size_t)row * 1024, lane);
    }
}
__device__ __forceinline__ void phase_n2(const Args& a, int l, int T) {
    const int tid = opaque_tid(), wid = tid >> 6, lane = tid & 63;
    const bf16_t* X = (const bf16_t*)(a.ws + WS_X); bf16_t* XA = (bf16_t*)(a.ws + WS_XA); const float* MOD = (const float*)(a.ws + WS_MOD);
    for (int row = blockIdx.x * 8 + wid; row < T; row += gridDim.x * 8) {
        const int s = sample_of(row);
        f32x4 v[4]; xrow_ld(X + (size_t)row * 1024 + lane * 16, v);
        const float* m = MOD + ((size_t)l * 17 + s) * 6144;
        norm_mod_store(v, a.in[I_N2G] + l * 1024, m + 3 * 1024, m + 4 * 1024, XA + (size_t)row * 1024, lane);
    }
}
__device__ __forceinline__ void phase_fin(const Args& a) {
    const int tid = opaque_tid(), wid = tid >> 6, lane = tid & 63;
    const bf16_t* X = (const bf16_t*)(a.ws + WS_X); const float* MOD = (const float*)(a.ws + WS_MOD); const unsigned char* Y8 = (const unsigned char*)(a.ws + WS_R1);
    for (int row = blockIdx.x * 8 + wid; row < NLAT; row += gridDim.x * 8) {
        const int s = sample_of(row);
        f32x4 ys[4], xv[4], v[4]; slot_sum(Y8, row, lane, ys); xrow_ld(X + (size_t)row * 1024 + lane * 16, xv);
        const float* gate = MOD + ((size_t)17 + s) * 6144 + 5 * 1024 + lane * 16;
        float ss = 0.f;
#pragma unroll
        for (int ii = 0; ii < 4; ++ii) { const f32x4 gv = *(const f32x4*)(gate + ii * 4); v[ii] = xv[ii] + gv * ys[ii];
            ss += v[ii][0] * v[ii][0] + v[ii][1] * v[ii][1] + v[ii][2] * v[ii][2] + v[ii][3] * v[ii][3]; }
        ss = wave_sum(ss);
        const float rstd = rsqrtf(ss * (1.0f / 1024.0f) + EPS);
#pragma unroll
        for (int ii = 0; ii < 4; ++ii) { const f32x4 g = *(const f32x4*)(a.in[I_FNG] + lane * 16 + ii * 4); *(f32x4*)(a.out + (size_t)row * 1024 + lane * 16 + ii * 4) = v[ii] * rstd * g; }
    }
}

namespace pg8 {
#define PG8_LAS __attribute__((address_space(3)))
typedef unsigned short bf16_t;
typedef short bf16x8 __attribute__((ext_vector_type(8)));
typedef float f32x4 __attribute__((ext_vector_type(4)));
typedef unsigned u32x4 __attribute__((ext_vector_type(4)));
constexpr int BM = 256, BK = 64, HALF = 128, HTB = HALF * BK * 2  , STAGE_BYTES = 8 * HTB, NXCD = 8, WGM = 8;

__host__ __device__ __forceinline__ int lds_byte(int r, int c) { const int st = (r >> 4) * 2 + (c >> 5), rr = r & 15, cc = c & 31, ob = rr * 64 + cc * 2; return st * 1024 + (ob ^ (((ob >> 9) & 1) << 5)); }
__host__ __device__ __forceinline__ void stage_rc(int b, int& R, int& C) { const int st = b / 1024, sb = b % 1024, swz = sb ^ (((sb >> 9) & 1) << 5); R = (st >> 1) * 16 + swz / 64; C = (st & 1) * 32 + (swz % 64) / 2; }
__host__ __device__ __forceinline__ int perm32(int rho) { const int n = rho >> 4, i = rho & 15; return 8 * (i >> 2) + 4 * n + (i & 3); }

struct Unit { int pm, pn; };
struct Gemm { const bf16_t* A; const bf16_t* Bt; int M, N, K; };

struct StaticOrder {
    int nM, nN, nwg, G, c;
    __host__ __device__ void init(int M, int N, int G_, int c_) { nM = M / BM; nN = N / BM; nwg = nM * nN; G = G_; c = c_; }
    __host__ __device__ bool next(int i, Unit& u) const {
        const long L = (long)i * G + c; if (L >= nwg) return false;
        int wgid = (int)L; { const int q = nwg / NXCD, r = nwg % NXCD, xcd = wgid % NXCD, off = wgid / NXCD; wgid = (xcd < r ? xcd * (q + 1) : r * (q + 1) + (xcd - r) * q) + off; }
        const int nig = WGM * nN, gid = wgid / nig, fm = gid * WGM, gsz = (nM - fm) < WGM ? (nM - fm) : WGM;
        u.pm = fm + ((wgid % nig) % gsz); u.pn = (wgid % nig) / gsz; return true;
    }
    __device__ __forceinline__ void a_ready(const Unit&) const {}
    __device__ __forceinline__ void done(const Unit&) const {}
};
template <class Epi, class Sched, bool STAMP = false>
__device__ __forceinline__ void gemm_phase(PG8_LAS unsigned char* lds, const Gemm g, const Sched& S, const Epi& E, unsigned long long* stamps) {
    const int tid = opaque_tid(), wid = __builtin_amdgcn_readfirstlane(tid >> 6), lane = tid & 63, wr = wid >> 2, wc = wid & 3, fr = lane & 15, fq = lane >> 4;
    const int K = g.K, nt = K / BK;
    int ts_lo = 0, ts_hi = 0, nts = 0; const unsigned long long rt_entry = STAMP ? (unsigned long long)wall_clock64() : 0ull;
#define PG8_STAMP() do { if (STAMP && wid == 0 && nts < 64) { const unsigned long long _c = (unsigned long long)clock64(); \
        ts_lo = (lane == nts) ? (int)(unsigned)_c : ts_lo; ts_hi = (lane == nts) ? (int)(unsigned)(_c >> 32) : ts_hi; ++nts; } } while (0)
    PG8_STAMP();
    unsigned voffA[2], voffB[2];
#pragma unroll
    for (int i = 0; i < 2; ++i) { int R, C; stage_rc(tid * 16 + i * 8192, R, C); const int Rb = Epi::PERM ? ((R & ~31) + perm32(R & 31)) : R;
        voffA[i] = (unsigned)(R * K + C) * 2u; voffB[i] = (unsigned)(Rb * K + C) * 2u; }
    const size_t kstep = (size_t)(BK * 2);
    const size_t hstep = (size_t)HALF * K * 2;
    const size_t tstep = 2 * hstep;
    const unsigned ldsw = (unsigned)wid * 1024u;
    const int aoff = lds_byte(wr * 64 + fr, fq * 8), boff = lds_byte(wc * 32 + fr, fq * 8);
#define PG8_SA(b, h) (((b) * 2 + (h)) * HTB)
#define PG8_SB(b, h) ((4 + (b) * 2 + (h)) * HTB)
#define PG8_STAGE(bufoff, gbase, voff) do { _Pragma("unroll") for (int _i = 0; _i < 2; ++_i) \
        __builtin_amdgcn_global_load_lds((const unsigned*)((const char*)(gbase) + (voff)[_i]), (PG8_LAS unsigned*)(lds + (bufoff) + ldsw + _i * 8192), 16, 0, 0); } while (0)
#define PG8_LDA(dst, b, h) do { _Pragma("unroll") for (int m = 0; m < 4; ++m) _Pragma("unroll") for (int k = 0; k < 2; ++k) dst[m][k] = *(const PG8_LAS bf16x8*)(lds + PG8_SA(b, h) + aoff + m * 2048 + k * 1024); } while (0)
#define PG8_LDB(dst, b, h) do { _Pragma("unroll") for (int n = 0; n < 2; ++n) _Pragma("unroll") for (int k = 0; k < 2; ++k) dst[n][k] = *(const PG8_LAS bf16x8*)(lds + PG8_SB(b, h) + boff + n * 2048 + k * 1024); } while (0)
#define PG8_MMA(ai, bj, At, Bt) do { __builtin_amdgcn_s_setprio(1); _Pragma("unroll") for (int m = 0; m < 4; ++m) _Pragma("unroll") for (int n = 0; n < 2; ++n) _Pragma("unroll") for (int k = 0; k < 2; ++k) \
        acc[ai][bj][m][n] = __builtin_amdgcn_mfma_f32_16x16x32_bf16(Bt[n][k], At[m][k], acc[ai][bj][m][n], 0, 0, 0); __builtin_amdgcn_s_setprio(0); } while (0)
#define PG8_WAIT_V(n) asm volatile("s_waitcnt vmcnt(" #n ")" ::: "memory")
#define PG8_WAIT_L(n) asm volatile("s_waitcnt lgkmcnt(" #n ")" ::: "memory")
#define PG8_BAR __builtin_amdgcn_s_barrier()
#define PG8_SCHED __builtin_amdgcn_sched_barrier(0)
    Unit cur, nxt; int ui = 0;
    if (!S.next(0, cur)) return;
    f32x4 acc[2][2][4][2];
#pragma unroll
    for (int a = 0; a < 2; ++a)
#pragma unroll
        for (int b = 0; b < 2; ++b)
#pragma unroll
            for (int m = 0; m < 4; ++m)
#pragma unroll
                for (int n = 0; n < 2; ++n) acc[a][b][m][n] = (f32x4){0.f, 0.f, 0.f, 0.f};
    bf16x8 At[4][2], B0[2][2], B1[2][2];
    const char* cA = (const char*)g.A + (size_t)cur.pm * tstep; const char* cB = (const char*)g.Bt + (size_t)cur.pn * tstep;
    S.a_ready(cur);
    PG8_STAGE(PG8_SB(0, 0), cB, voffB); PG8_STAGE(PG8_SA(0, 0), cA, voffA); PG8_STAGE(PG8_SB(0, 1), cB + hstep, voffB); PG8_STAGE(PG8_SA(0, 1), cA + hstep, voffA);
    if (wr == 1) PG8_BAR;
    PG8_WAIT_V(4); PG8_BAR;
    PG8_STAGE(PG8_SB(1, 0), cB + kstep, voffB); PG8_STAGE(PG8_SA(1, 0), cA + kstep, voffA); PG8_STAGE(PG8_SB(1, 1), cB + hstep + kstep, voffB);
    PG8_WAIT_V(6); PG8_BAR;
    PG8_STAMP();
    for (;;) {
        const bool has_next = S.next(ui + 1, nxt);
        const char* nA = has_next ? (const char*)g.A + (size_t)nxt.pm * tstep : cA; const char* nB = has_next ? (const char*)g.Bt + (size_t)nxt.pn * tstep : cB;
        for (int t = 0; t < nt; t += 2) {
            const bool last = (t == nt - 2);
            const char* a1 = cA + (size_t)(t + 1) * kstep;
            const char* a2 = last ? nA : cA + (size_t)(t + 2) * kstep; const char* b2 = last ? nB : cB + (size_t)(t + 2) * kstep;
            const char* a3 = a2 + kstep; const char* b3 = b2 + kstep;
            if (last && has_next) S.a_ready(nxt);
            PG8_LDB(B0, 0, 0); PG8_SCHED; PG8_LDA(At, 0, 0); PG8_STAGE(PG8_SA(1, 1), a1 + hstep, voffA);
            PG8_WAIT_L(8); PG8_BAR; PG8_WAIT_L(0); PG8_MMA(0, 0, At, B0); PG8_BAR; PG8_SCHED;
            PG8_LDB(B1, 0, 1); PG8_STAGE(PG8_SB(0, 0), b2, voffB);
            PG8_BAR; PG8_WAIT_L(0); PG8_MMA(0, 1, At, B1); PG8_BAR;
            PG8_LDA(At, 0, 1); PG8_STAGE(PG8_SA(0, 0), a2, voffA);
            PG8_BAR; PG8_WAIT_L(0); PG8_MMA(1, 0, At, B0); PG8_BAR; PG8_SCHED;
            PG8_STAGE(PG8_SB(0, 1), b2 + hstep, voffB);
            PG8_WAIT_V(6); PG8_BAR; PG8_MMA(1, 1, At, B1); PG8_BAR;
            PG8_LDB(B0, 1, 0); PG8_SCHED; PG8_LDA(At, 1, 0); PG8_STAGE(PG8_SA(0, 1), a2 + hstep, voffA);
            PG8_WAIT_L(8); PG8_BAR; PG8_WAIT_L(0); PG8_MMA(0, 0, At, B0); PG8_BAR; PG8_SCHED;
            PG8_LDB(B1, 1, 1); PG8_STAGE(PG8_SB(1, 0), b3, voffB);
            PG8_BAR; PG8_WAIT_L(0); PG8_MMA(0, 1, At, B1); PG8_BAR;
            PG8_LDA(At, 1, 1); PG8_STAGE(PG8_SA(1, 0), a3, voffA);
            PG8_BAR; PG8_WAIT_L(0); PG8_MMA(1, 0, At, B0); PG8_BAR; PG8_SCHED;
            PG8_STAGE(PG8_SB(1, 1), b3 + hstep, voffB);
            PG8_WAIT_V(6); PG8_BAR; PG8_MMA(1, 1, At, B1); PG8_BAR;
        }
        PG8_STAMP();
        if constexpr (!Epi::AFTER_DRAIN) { E(acc, cur, wr, wc, fr, fq); S.done(cur); }
        PG8_STAMP();
        if (!has_next) break;
#pragma unroll
        for (int a = 0; a < 2; ++a)
#pragma unroll
            for (int b = 0; b < 2; ++b)
#pragma unroll
                for (int m = 0; m < 4; ++m)
#pragma unroll
                    for (int n = 0; n < 2; ++n) acc[a][b][m][n] = (f32x4){0.f, 0.f, 0.f, 0.f};
        cur = nxt; cA = nA; cB = nB; ++ui;
    }
    PG8_WAIT_V(0);
    if (wr == 0) PG8_BAR;
    PG8_BAR;
    if constexpr (Epi::AFTER_DRAIN) { E.fused(acc, cur, wr, wc, fr, fq, lds, wid, lane); S.done(cur); }
    PG8_STAMP();
    if (STAMP && wid == 0) { stamps[lane] = lane < nts ? (((unsigned long long)(unsigned)ts_hi << 32) | (unsigned)ts_lo) : 0ull;
        if (lane == 62) stamps[62] = rt_entry; if (lane == 63) stamps[63] = (unsigned long long)wall_clock64(); }
#undef PG8_STAMP
#undef PG8_SA
#undef PG8_SB
#undef PG8_STAGE
#undef PG8_LDA
#undef PG8_LDB
#undef PG8_MMA
#undef PG8_WAIT_V
#undef PG8_WAIT_L
#undef PG8_BAR
#undef PG8_SCHED
}
}

struct EpiG1 {
    static constexpr bool PERM = true, AFTER_DRAIN = false;
    bf16_t* P; float* GATES;
    __device__ __forceinline__ void operator()(const f32x4 (&acc)[2][2][4][2], const pg8::Unit& u, int wr, int wc, int fr, int fq) const {
        const int row0 = u.pm * 256 + wr * 64 + fr;
#pragma unroll
        for (int bj = 0; bj < 2; ++bj) {
            const int cb = u.pn * 256 + bj * 128 + wc * 32;
            if (cb >= DIN) continue;
            if (cb >= PW) {
                if (fq < 2) {
#pragma unroll
                    for (int ai = 0; ai < 2; ++ai)
#pragma unroll
                        for (int m = 0; m < 4; ++m) { float* gp = GATES + (size_t)(row0 + ai * 128 + m * 16) * 16 + fq * 8; *(f32x4*)gp = acc[ai][bj][m][0]; *(f32x4*)(gp + 4) = acc[ai][bj][m][1]; }
                }
            } else {
                const bool g = (cb >= PC_RG && cb < PC_Q) || cb >= PC_CU;
                const float sc = (cb >= PC_K && cb < PC_V) ? 0.10206207261596575f : 1.0f;
#pragma unroll
                for (int ai = 0; ai < 2; ++ai)
#pragma unroll
                    for (int m = 0; m < 4; ++m) {
                        f32x4 v0 = acc[ai][bj][m][0], v1 = acc[ai][bj][m][1];
                        if (g) { v0[0] = gelu_tanh(v0[0]); v0[1] = gelu_tanh(v0[1]); v0[2] = gelu_tanh(v0[2]); v0[3] = gelu_tanh(v0[3]); v1[0] = gelu_tanh(v1[0]); v1[1] = gelu_tanh(v1[1]); v1[2] = gelu_tanh(v1[2]); v1[3] = gelu_tanh(v1[3]); }
                        else { v0 = v0 * sc; v1 = v1 * sc; }
                        u32x4 w; w.x = cvt_pk_bf16(v0[0], v0[1]); w.y = cvt_pk_bf16(v0[2], v0[3]); w.z = cvt_pk_bf16(v1[0], v1[1]); w.w = cvt_pk_bf16(v1[2], v1[3]);
                        *(u32x4*)(P + (size_t)(row0 + ai * 128 + m * 16) * PW + cb + fq * 8) = w;
                    }
            }
        }
    }
};
__device__ __forceinline__ void phase_g1(const Args& a, LAS unsigned char* lds, int l) {
    pg8::Gemm g{(const bf16_t*)(a.ws + WS_XA), (const bf16_t*)(a.ws + WS_WIN) + (size_t)l * NIN * 1024, TOK, NIN, 1024};
    pg8::StaticOrder S; S.init(TOK, NIN, (int)gridDim.x, (int)blockIdx.x);
    EpiG1 E{(bf16_t*)(a.ws + WS_P), (float*)(a.ws + WS_GATES)};
    pg8::gemm_phase<EpiG1, pg8::StaticOrder>(lds, g, S, E, nullptr);
}
struct EpiG2 {
    static constexpr bool PERM = true, AFTER_DRAIN = false;
    bf16_t* X; const float* MODl;
    __device__ __forceinline__ void operator()(const f32x4 (&acc)[2][2][4][2], const pg8::Unit& u, int wr, int wc, int fr, int fq) const {
        const int row0 = u.pm * 256 + wr * 64 + fr; const float* gate = MODl + (size_t)sample_of(u.pm * 256) * 6144 + 2 * 1024;
#pragma unroll
        for (int bj = 0; bj < 2; ++bj) {
            const int col = u.pn * 256 + bj * 128 + wc * 32 + fq * 8; const f32x4 g0 = *(const f32x4*)(gate + col), g1 = *(const f32x4*)(gate + col + 4);
#pragma unroll
            for (int ai = 0; ai < 2; ++ai)
#pragma unroll
                for (int m = 0; m < 4; ++m) { bf16_t* xp = X + (size_t)(row0 + ai * 128 + m * 16) * 1024 + col;
                    const u32x4 w = *(const u32x4*)xp; const f32x4 a0 = acc[ai][bj][m][0], a1 = acc[ai][bj][m][1]; u32x4 o;
                    o.x = cvt_pk_bf16(__uint_as_float(w.x << 16) + g0[0] * a0[0], __uint_as_float(w.x & 0xffff0000u) + g0[1] * a0[1]);
                    o.y = cvt_pk_bf16(__uint_as_float(w.y << 16) + g0[2] * a0[2], __uint_as_float(w.y & 0xffff0000u) + g0[3] * a0[3]);
                    o.z = cvt_pk_bf16(__uint_as_float(w.z << 16) + g1[0] * a1[0], __uint_as_float(w.z & 0xffff0000u) + g1[1] * a1[1]);
                    o.w = cvt_pk_bf16(__uint_as_float(w.w << 16) + g1[2] * a1[2], __uint_as_float(w.w & 0xffff0000u) + g1[3] * a1[3]);
                    *(u32x4*)xp = o; }
        }
    }
};
__device__ __forceinline__ void phase_g2(const Args& a, LAS unsigned char* lds, int l, int T) {
    pg8::Gemm g{(const bf16_t*)(a.ws + WS_MIX), (const bf16_t*)(a.ws + WS_WOUT) + (size_t)l * 1024 * 1024, T, 1024, 1024};
    pg8::StaticOrder S; S.init(T, 1024, (int)gridDim.x, (int)blockIdx.x);
    EpiG2 E{(bf16_t*)(a.ws + WS_X), (const float*)(a.ws + WS_MOD) + (size_t)l * 17 * 6144};
    pg8::gemm_phase<EpiG2, pg8::StaticOrder>(lds, g, S, E, nullptr);
}
struct EpiRT {
    static constexpr bool PERM = false, AFTER_DRAIN = false;
    float* LG;
    __device__ __forceinline__ void operator()(const f32x4 (&acc)[2][2][4][2], const pg8::Unit& u, int wr, int wc, int fr, int fq) const {
        const int row0 = u.pm * 256 + wr * 64 + fr;
#pragma unroll
        for (int bj = 0; bj < 2; ++bj)
#pragma unroll
            for (int n = 0; n < 2; ++n)
#pragma unroll
                for (int ai = 0; ai < 2; ++ai)
#pragma unroll
                    for (int m = 0; m < 4; ++m) *(f32x4*)(LG + (size_t)(row0 + ai * 128 + m * 16) * 256 + bj * 128 + wc * 32 + n * 16 + fq * 4) = acc[ai][bj][m][n];
    }
};
__device__ __forceinline__ void phase_rt(const Args& a, LAS unsigned char* lds, int l, int T) {
    pg8::Gemm g{(const bf16_t*)(a.ws + WS_XA), (const bf16_t*)(a.ws + WS_ROUT) + (size_t)l * 256 * 1024, T, 256, 1024};
    pg8::StaticOrder S; S.init(T, 256, (int)gridDim.x, (int)blockIdx.x);
    EpiRT E{(float*)(a.ws + WS_LOGITS)};
    pg8::gemm_phase<EpiRT, pg8::StaticOrder>(lds, g, S, E, nullptr);
}

template <int CTRL> __device__ __forceinline__ float dppf(float old, float src) { return __int_as_float(__builtin_amdgcn_update_dpp(__float_as_int(old), __float_as_int(src), CTRL, 0xF, 0xF, false)); }
constexpr int TK_MAXTOK = 512;
__device__ __forceinline__ void phase_tk(const Args& a, LAS unsigned char* lds, int l, int T) {
    const int tid = opaque_tid(), wid = tid >> 6, lane = tid & 63;
    const float* LG = (const float*)(a.ws + WS_LOGITS); const float* rb = a.in[I_RB] + l * 256;
    unsigned* CNT = (unsigned*)(a.ws + WS_CTL + CTL_CNT) + (size_t)l * 256 * CNT_STRIDE; int* LS = (int*)(a.ws + WS_LSLOT); float* LWt = (float*)(a.ws + WS_LW);
    LAS unsigned* lcnt = (LAS unsigned*)lds; LAS unsigned* lbase = lcnt + 256; LAS unsigned* ent = lbase + 256; LAS float* entw = (LAS float*)(ent + TK_MAXTOK * 8);
    const f32x4 bias = *(const f32x4*)(rb + lane * 4);
    const float NEG = -__builtin_huge_valf();
    const int per = (T + (int)gridDim.x - 1) / (int)gridDim.x;
    for (int base0 = blockIdx.x * per; base0 < (int)(blockIdx.x + 1) * per && base0 < T; base0 += TK_MAXTOK) {
        int ntok = (int)(blockIdx.x + 1) * per - base0; if (ntok > TK_MAXTOK) ntok = TK_MAXTOK; if (ntok > T - base0) ntok = T - base0;
        __syncthreads();
        if (tid < 256) lcnt[tid] = 0u;
        __syncthreads();
        for (int tl = wid; tl < ntok; tl += 8) {
            const int t = base0 + tl;
            const f32x4 lg = *(const f32x4*)(LG + (size_t)t * 256 + lane * 4);
            float sc[4], sel[4];
#pragma unroll
            for (int j = 0; j < 4; ++j) { sc[j] = 1.0f / (1.0f + expf(-lg[j])); sel[j] = sc[j] + bias[j]; }
            float a1 = fmaxf(sel[0], sel[1]), a2 = fminf(sel[0], sel[1]);
#pragma unroll
            for (int j = 2; j < 4; ++j) { const float v = sel[j]; a2 = fmaxf(a2, fminf(a1, v)); a1 = fmaxf(a1, v); }
#define TK_MERGE(CTRL) { const float b1 = dppf<CTRL>(a1, a1), b2 = dppf<CTRL>(a2, a2); const float n1 = fmaxf(a1, b1), n2 = fmaxf(fminf(a1, b1), fmaxf(a2, b2)); a1 = n1; a2 = n2; }
            TK_MERGE(0xB1) TK_MERGE(0x4E) TK_MERGE(0x141)
#undef TK_MERGE
            const float gs = a1 + a2; const int g = lane >> 3; int rank = 0;
#pragma unroll
            for (int g2 = 0; g2 < 8; ++g2) { const float s2 = __int_as_float(__builtin_amdgcn_readlane(__float_as_int(gs), g2 * 8)); rank += (s2 > gs || (s2 == gs && g2 < g)) ? 1 : 0; }
            float ms[4];
#pragma unroll
            for (int j = 0; j < 4; ++j) ms[j] = rank < 4 ? sel[j] : NEG;
            int my_e = 0; float my_s = 0.f, ssum = 0.f;
#pragma unroll
            for (int k = 0; k < 8; ++k) {
                float mx = fmaxf(fmaxf(ms[0], ms[1]), fmaxf(ms[2], ms[3]));
                mx = fmaxf(mx, dppf<0x111>(NEG, mx)); mx = fmaxf(mx, dppf<0x112>(NEG, mx)); mx = fmaxf(mx, dppf<0x114>(NEG, mx)); mx = fmaxf(mx, dppf<0x118>(NEG, mx));
                const float gmax = fmaxf(fmaxf(__int_as_float(__builtin_amdgcn_readlane(__float_as_int(mx), 15)), __int_as_float(__builtin_amdgcn_readlane(__float_as_int(mx), 31))),
                                         fmaxf(__int_as_float(__builtin_amdgcn_readlane(__float_as_int(mx), 47)), __int_as_float(__builtin_amdgcn_readlane(__float_as_int(mx), 63))));
                const int cand = ms[0] == gmax ? 0 : ms[1] == gmax ? 1 : ms[2] == gmax ? 2 : ms[3] == gmax ? 3 : -1;
                const unsigned long long bal = __ballot(cand >= 0);
                const int wl = __builtin_amdgcn_readfirstlane(__ffsll((unsigned long long)bal) - 1);
                const int jj = __builtin_amdgcn_readlane(cand, wl), bi = wl * 4 + jj;
                const float mysc = jj == 0 ? sc[0] : jj == 1 ? sc[1] : jj == 2 ? sc[2] : sc[3];
                const float sk = __int_as_float(__builtin_amdgcn_readlane(__float_as_int(mysc), wl));
#pragma unroll
                for (int j = 0; j < 4; ++j) if (lane == wl && j == jj) ms[j] = NEG;
                if (lane == k) { my_e = bi; my_s = sk; }
                ssum += sk;
            }
            if (lane < 8) {
                const unsigned r = __hip_atomic_fetch_add(&lcnt[my_e], 1u, __ATOMIC_RELAXED, __HIP_MEMORY_SCOPE_WORKGROUP);
                ent[tl * 8 + lane] = ((unsigned)my_e << 16) | r; entw[tl * 8 + lane] = my_s / ssum * 2.5f;
            }
        }
        __syncthreads();
        if (tid < 256) { const unsigned c = lcnt[tid]; lbase[tid] = c ? atomicAdd(&CNT[tid * CNT_STRIDE], c) : 0u; }
        __syncthreads();
        for (int i = tid; i < ntok * 8; i += NTHREADS) {
            const unsigned v = ent[i]; const int e = (int)(v >> 16); const unsigned pos = lbase[e] + (v & 0xffffu);
            LS[(size_t)e * LCAP + pos] = (base0 + (i >> 3)) * NSLOT + (i & 7); LWt[(size_t)e * LCAP + pos] = entw[i];
        }
    }
}

__device__ __forceinline__ void moe_tables(const Args& a, LAS unsigned char* lds, int l, int T) {
    LAS int* cntE = (LAS int*)(lds + LDS_TAB); LAS int* blkoff = cntE + 264;
    const int tid = opaque_tid(); const unsigned* CNT = (const unsigned*)(a.ws + WS_CTL + CTL_CNT) + (size_t)l * 256 * CNT_STRIDE;
    if (tid < 256) cntE[tid] = (int)CNT[tid * CNT_STRIDE]; else if (tid == 256) cntE[256] = T;
    __syncthreads();
    if (tid < 258) { int s = 0; for (int e = 0; e < tid && e < 257; ++e) s += (cntE[e] + 255) >> 8; blkoff[tid] = s; }
    __syncthreads();
}
__device__ __forceinline__ int moe_find(const LAS int* blkoff, int mbg) { int lo = 0, hi = 257; while (hi - lo > 1) { const int mid = (lo + hi) >> 1; if (blkoff[mid] <= mbg) lo = mid; else hi = mid; } return lo; }

#define PV_LOAD32(dst, ptr) asm volatile("global_load_dword %0, %1, off" : "=&v"(dst) : "v"(ptr))
struct E1Prov {
    const Args& a; LAS unsigned char* lds; int l, nunit, R0, R1, C0, C1, wr, wc, fr, fq; int q0, q1; bool sh;
    __device__ __forceinline__ void decode(int i, int& mbg, int& nt, int& e, int& mb, int& cnt) const {
        const LAS int* cntE = (const LAS int*)(lds + LDS_TAB); const LAS int* blkoff = cntE + 264;
        const int u = blockIdx.x + i * gridDim.x; mbg = u / 3; nt = u - mbg * 3; e = moe_find(blkoff, mbg); mb = mbg - blkoff[e]; cnt = cntE[e];
    }
    __device__ __forceinline__ bool seg(int i, RSeg& d) {
        if ((int)(blockIdx.x + i * gridDim.x) >= nunit) return false;
        int mbg, nt, e, mb, cnt; decode(i, mbg, nt, e, mb, cnt);
        const int* LS = (const int*)(a.ws + WS_LSLOT) + (e < 256 ? (size_t)e * LCAP : 0);
        const int p0 = mb * 256 + R0, p1 = mb * 256 + R1; sh = e >= 256; q0 = p0 < cnt ? p0 : -1; q1 = p1 < cnt ? p1 : -1;
        const int* a0 = LS + (q0 >= 0 && !sh ? q0 : 0); const int* a1 = LS + (q1 >= 0 && !sh ? q1 : 0);
        PV_LOAD32(d.aoff[0], a0); PV_LOAD32(d.aoff[1], a1);
        d.Ab = (const unsigned char*)(a.ws + WS_XA);
        d.B0 = (e < 256 ? a.in[I_EG] + ((size_t)l * 256 + e) * 1024 * FF : a.in[I_SG] + (size_t)l * 1024 * FF) + nt * 96;
        d.B1 = (e < 256 ? a.in[I_EU] + ((size_t)l * 256 + e) * 1024 * FF : a.in[I_SU] + (size_t)l * 1024 * FF) + nt * 96;
        return true;
    }
    __device__ __forceinline__ void finish(RSeg& d, bool first) const {
        if (first) asm volatile("s_waitcnt vmcnt(0)" ::: "memory"); else asm volatile("s_waitcnt vmcnt(16)" ::: "memory");
        __builtin_amdgcn_sched_barrier(0); asm volatile("" : "+v"(d.aoff[0]), "+v"(d.aoff[1]));
        const int t0 = q0 < 0 ? 0 : sh ? q0 : (int)d.aoff[0] / NSLOT, t1 = q1 < 0 ? 0 : sh ? q1 : (int)d.aoff[1] / NSLOT;
        d.aoff[0] = (unsigned)t0 * 2048u + (unsigned)C0 * 2u; d.aoff[1] = (unsigned)t1 * 2048u + (unsigned)C1 * 2u;
    }
    __device__ __forceinline__ void epi(int i, f32x4 (&acc)[4][6]) const {
        int mbg, nt, e, mb, cnt; decode(i, mbg, nt, e, mb, cnt);
        bf16_t* HB = (bf16_t*)(a.ws + WS_HB);
#pragma unroll
        for (int m = 0; m < 4; ++m) {
            bf16_t* hp = HB + (size_t)(mbg * 256 + wr * 64 + m * 16 + fr) * FF + nt * 96 + wc * 48 + fq * 4;
#pragma unroll
            for (int n = 0; n < 3; ++n) {
                const f32x4 g = acc[m][n], uu = acc[m][n + 3];
                u32x2 w; w.x = cvt_pk_bf16(siluf_(g[0]) * uu[0], siluf_(g[1]) * uu[1]); w.y = cvt_pk_bf16(siluf_(g[2]) * uu[2], siluf_(g[3]) * uu[3]);
                *(u32x2*)(hp + n * 16) = w;
            }
        }
    }
};
__device__ __forceinline__ void ring_piece_rc(int wid, int lane, int k, int& R, int& C) { const int sb = lane * 16, swz = sb ^ (((sb >> 9) & 1) << 5); R = (wid + 8 * k) * 16 + (swz >> 6); C = (swz & 63) >> 1; }
__device__ __forceinline__ void phase_e1(const Args& a, LAS unsigned char* lds, int l, int T) {
    const int tid = opaque_tid(), wid = __builtin_amdgcn_readfirstlane(tid >> 6), lane = tid & 63;
    moe_tables(a, lds, l, T);
    const LAS int* blkoff = (const LAS int*)(lds + LDS_TAB) + 264;
    int R0, C0, R1, C1; ring_piece_rc(wid, lane, 0, R0, C0); ring_piece_rc(wid, lane, 1, R1, C1);
    E1Prov pv{a, lds, l, blkoff[257] * 3, R0, R1, C0, C1, wid >> 1, wid & 1, lane & 15, lane >> 4, -1, -1, false};
    ring_gemm<192, 2, true, true, 2, E1Prov>(lds, pv, 32, FF, 0u, 0u);
}

struct E2Prov {
    const Args& a; LAS unsigned char* lds; int l, nunit, tid; int pslot; float pw; int pidx, ppos; bool psh;
    __device__ __forceinline__ void decode(int i, int& mbg, int& pn, int& e, int& mb, int& cnt) const {
        const LAS int* cntE = (const LAS int*)(lds + LDS_TAB); const LAS int* blkoff = cntE + 264;
        const int u = blockIdx.x + i * gridDim.x; mbg = u >> 2; pn = u & 3; e = moe_find(blkoff, mbg); mb = mbg - blkoff[e]; cnt = cntE[e];
    }
    __device__ __forceinline__ bool seg(int i, RSeg& d) {
        if ((int)(blockIdx.x + i * gridDim.x) >= nunit) return false;
        int mbg, pn, e, mb, cnt; decode(i, mbg, pn, e, mb, cnt);
        const int pos = mb * 256 + (tid & 255); psh = e >= 256; ppos = (tid < 256 && pos < cnt) ? pos : -1; pidx = i;
        const size_t idx = (ppos >= 0 && !psh) ? (size_t)e * LCAP + pos : 0;
        const int* sp = (const int*)(a.ws + WS_LSLOT) + idx; const float* wp = (const float*)(a.ws + WS_LW) + idx;
        PV_LOAD32(pslot, sp); PV_LOAD32(pw, wp);
        d.Ab = (const unsigned char*)(a.ws + WS_HB) + (size_t)mbg * 256 * FF * 2;
        d.B0 = (e < 256 ? a.in[I_ED] + ((size_t)l * 256 + e) * FF * 1024 : a.in[I_SD] + (size_t)l * FF * 1024) + pn * 256; d.B1 = d.B0;
        return true;
    }
    __device__ __forceinline__ void finish(RSeg&, bool first) {
        if (first) asm volatile("s_waitcnt vmcnt(0)" ::: "memory"); else asm volatile("s_waitcnt vmcnt(16)" ::: "memory");
        __builtin_amdgcn_sched_barrier(0); asm volatile("" : "+v"(pslot), "+v"(pw));
        LAS int* tab = (LAS int*)(lds + LDS_TAB) + 528 + (pidx & 1) * 512;
        if (tid < 256) { tab[tid] = ppos < 0 ? -1 : psh ? ppos * NSLOT + 8 : pslot; ((LAS float*)tab)[256 + tid] = psh ? 1.0f : pw; }
    }
    __device__ __forceinline__ void epi(int i, f32x4 (&acc)[8][4]) const {
        int mbg, pn, e, mb, cnt; decode(i, mbg, pn, e, mb, cnt);
        const LAS int* tab = (const LAS int*)(lds + LDS_TAB) + 528 + (i & 1) * 512; unsigned char* Y8 = (unsigned char*)(a.ws + WS_R1);
        const int wr = tid >> 8, wc = (tid >> 6) & 3, fr = tid & 15, fq = (tid >> 4) & 3;
#pragma unroll
        for (int m = 0; m < 8; ++m) {
            const int r = wr * 128 + m * 16 + fr, slot = tab[r];
            if (slot >= 0) {
                const float w = ((const LAS float*)tab)[256 + r] * SLOT_SCALE; unsigned char* yp = Y8 + (size_t)slot * 1024 + pn * 256 + wc * 64 + fq * 16;
                u32x4 o; unsigned ow[4];
#pragma unroll
                for (int n = 0; n < 4; ++n) {
                    const f32x4 v = acc[m][n] * w;
                    const float c0 = __builtin_amdgcn_fmed3f(v[0], -SLOT_CLAMP, SLOT_CLAMP), c1 = __builtin_amdgcn_fmed3f(v[1], -SLOT_CLAMP, SLOT_CLAMP), c2 = __builtin_amdgcn_fmed3f(v[2], -SLOT_CLAMP, SLOT_CLAMP), c3 = __builtin_amdgcn_fmed3f(v[3], -SLOT_CLAMP, SLOT_CLAMP);
                    ow[n] = (unsigned)__builtin_amdgcn_cvt_pk_fp8_f32(c2, c3, __builtin_amdgcn_cvt_pk_fp8_f32(c0, c1, 0, false), true);
                }
                o.x = ow[0]; o.y = ow[1]; o.z = ow[2]; o.w = ow[3];
                *(u32x4*)yp = o;
            }
        }
    }
};
__device__ __forceinline__ void phase_e2(const Args& a, LAS unsigned char* lds, int l, int T) {
    const int tid = opaque_tid(), wid = __builtin_amdgcn_readfirstlane(tid >> 6), lane = tid & 63;
    moe_tables(a, lds, l, T);
    const LAS int* blkoff = (const LAS int*)(lds + LDS_TAB) + 264;
    int R0, C0, R1, C1; ring_piece_rc(wid, lane, 0, R0, C0); ring_piece_rc(wid, lane, 1, R1, C1);
    E2Prov pv{a, lds, l, blkoff[257] * 4, tid, -1, 0.f, -1, -1, false};
    ring_gemm<256, 4, false, false, 1, E2Prov>(lds, pv, 9, 1024, (unsigned)(R0 * FF * 2 + C0 * 2), (unsigned)(R1 * FF * 2 + C1 * 2));
}

__device__ __forceinline__ float logsigmoidf_(float x) { return fminf(x, 0.f) - log1pf(expf(-fabsf(x))); }

__device__ __forceinline__ void mlstm_gates(const float* GATES, int row0, int rstep, int gcol, float bi, float bfg, float m, LAS float* colterm, LAS float* Marr, LAS float* bcarr, int lane) {
    const int p0 = 2 * lane;
    const float* g0 = GATES + (size_t)(row0 + rstep * p0) * 16 + gcol; const float* g1 = g0 + rstep * 16;
    const float gi0 = g0[0] + bi, gi1 = g1[0] + bi, lf0 = logsigmoidf_(g0[4] + bfg), lf1 = logsigmoidf_(g1[4] + bfg);
    float s = lf0 + lf1;
#pragma unroll
    for (int o = 1; o < 64; o <<= 1) { const float t = __shfl_up(s, o); if (lane >= o) s += t; }
    const float bc1 = s, bc0 = s - lf1, ct0 = gi0 - bc0, ct1 = gi1 - bc1;
    float pm = fmaxf(ct0, ct1);
#pragma unroll
    for (int o = 1; o < 64; o <<= 1) { const float t = __shfl_up(pm, o); if (lane >= o) pm = fmaxf(pm, t); }
    float prev = __shfl_up(pm, 1); if (lane == 0) prev = -__builtin_huge_valf();
    const float pm0 = fmaxf(prev, ct0);
    colterm[p0] = ct0; colterm[p0 + 1] = ct1; bcarr[p0] = bc0; bcarr[p0 + 1] = bc1; Marr[p0] = fmaxf(m, pm0); Marr[p0 + 1] = fmaxf(m, pm);
}

__device__ __forceinline__ void ms_unit(const Args& a, LAS unsigned char* lds, int l, int b, int h, int d) {
    const int tid = opaque_tid(), wid = __builtin_amdgcn_readfirstlane(tid >> 6), lane = tid & 63, fr = lane & 15, fq = lane >> 4;
    LAS bf16_t* Ks = (LAS bf16_t*)(lds);
    LAS bf16_t* Vp = (LAS bf16_t*)(lds + 26624);
    LAS float* colterm = (LAS float*)(lds + 57344); LAS float* Marr = colterm + 128; LAS float* bcarr = Marr + 128;
    const bf16_t* P = (const bf16_t*)(a.ws + WS_P); const float* GATES = (const float*)(a.ws + WS_GATES);
    const int seq = (b * 4 + h) * 2 + d;
    bf16_t* CTG = (bf16_t*)(a.ws + WS_CTG) + (size_t)seq * 18 * (112 * 96); float* MST = (float*)(a.ws + WS_MST) + seq * 18;
    const float bi = a.in[I_MGB][((l * 2 + d) * 2 + 0) * 4 + h], bfg = a.in[I_MGB][((l * 2 + d) * 2 + 1) * 4 + h];
    const int rstep = d ? -1 : 1, gcol = d * 8 + h;
    int pp[3], pch[3];
#pragma unroll
    for (int i = 0; i < 3; ++i) { const int rem = tid + 512 * i; pp[i] = rem / 12; pch[i] = rem - pp[i] * 12; }
#define MS_ROW0(step) (((step) < 2 ? NLAT + b * CTXL : b * SEQ) + (d ? ((step) < 2 ? CTXL : SEQ) - 1 - ((step) < 2 ? (step) : (step) - 2) * 128 : ((step) < 2 ? (step) : (step) - 2) * 128))
    u32x4 kv[6]; float gq[4];
#define MS_FETCH(step) do { const int _r0 = MS_ROW0(step); \
        _Pragma("unroll") for (int i = 0; i < 6; ++i) kv[i] = *(const u32x4*)(P + (size_t)(_r0 + rstep * pp[i % 3]) * PW + (i < 3 ? PC_K : PC_V) + h * 96 + pch[i % 3] * 8); \
        { const float* g0 = GATES + (size_t)(_r0 + rstep * 2 * lane) * 16 + gcol; gq[0] = g0[0]; gq[1] = g0[4]; gq[2] = g0[rstep * 16]; gq[3] = g0[rstep * 16 + 4]; } } while (0)
    __syncthreads();
    for (int i = tid; i < 128 * 3; i += NTHREADS) { const int p = i / 3, q = i - p * 3; u32x4 v = (u32x4){0u, 0u, 0u, 0u}; if (q == 0) v.x = 0x3F80u; *(LAS u32x4*)(Vp + p * 120 + 96 + q * 8) = v; }
    f32x4 Cst[7];
#pragma unroll
    for (int cb = 0; cb < 7; ++cb) Cst[cb] = (f32x4){0.f, 0.f, 0.f, 0.f};
    float m = 0.f;
    MS_FETCH(0);
    for (int step = 0; step < 18; ++step) {
        const bool do_out = step >= 2 || l == 0;
        if (wid == 0) {
            const int p0 = 2 * lane;
            const float gi0 = gq[0] + bi, gi1 = gq[2] + bi, lf0 = logsigmoidf_(gq[1] + bfg), lf1 = logsigmoidf_(gq[3] + bfg);
            float s = lf0 + lf1;
#pragma unroll
            for (int o = 1; o < 64; o <<= 1) { const float t = __shfl_up(s, o); if (lane >= o) s += t; }
            const float bc1 = s, bc0 = s - lf1, ct0 = gi0 - bc0, ct1 = gi1 - bc1;
            float pm = fmaxf(ct0, ct1);
#pragma unroll
            for (int o = 1; o < 64; o <<= 1) { const float t = __shfl_up(pm, o); if (lane >= o) pm = fmaxf(pm, t); }
            float prev = __shfl_up(pm, 1); if (lane == 0) prev = -__builtin_huge_valf();
            const float pm0 = fmaxf(prev, ct0);
            colterm[p0] = ct0; colterm[p0 + 1] = ct1; bcarr[p0] = bc0; bcarr[p0 + 1] = bc1; Marr[p0] = fmaxf(m, pm0); Marr[p0 + 1] = fmaxf(m, pm);
        }
        if (do_out) {
            if (tid == 0) MST[step] = m;
            if (wid < 6) {
                bf16_t* cg = CTG + (size_t)step * (112 * 96) + wid * 16 + fr;
#pragma unroll
                for (int cb = 0; cb < 7; ++cb)
#pragma unroll
                    for (int j = 0; j < 4; ++j) cg[(cb * 16 + fq * 4 + j) * 96] = f2bf(Cst[cb][j]);
            }
        }
        __syncthreads();
        const float Mend = Marr[127], gsum = bcarr[127];
#pragma unroll
        for (int i = 0; i < 6; ++i) {
            const int p = pp[i % 3], ch = pch[i % 3];
            u32x4 v = kv[i];
            if (i < 3) {
                const float w = __expf(colterm[p] - Mend);
                v.x = cvt_pk_bf16(__uint_as_float(v.x << 16) * w, __uint_as_float(v.x & 0xffff0000u) * w); v.y = cvt_pk_bf16(__uint_as_float(v.y << 16) * w, __uint_as_float(v.y & 0xffff0000u) * w);
                v.z = cvt_pk_bf16(__uint_as_float(v.z << 16) * w, __uint_as_float(v.z & 0xffff0000u) * w); v.w = cvt_pk_bf16(__uint_as_float(v.w << 16) * w, __uint_as_float(v.w & 0xffff0000u) * w);
                *(LAS u32x4*)(Ks + p * 104 + ch * 8) = v;
            } else *(LAS u32x4*)(Vp + p * 120 + ch * 8) = v;
        }
        if (step + 1 < 18) MS_FETCH(step + 1);
        __syncthreads();
        const float decay = __expf(m - Mend);
        if (wid < 6) {
#pragma unroll
            for (int cb = 0; cb < 7; ++cb) Cst[cb] = Cst[cb] * decay;
#pragma unroll
            for (int ks = 0; ks < 4; ++ks) {
                const bf16x8 bk = trfrag(Ks, 104, ks * 32, wid * 16, fr, fq);
#pragma unroll
                for (int cb = 0; cb < 7; ++cb) Cst[cb] = MFMA(trfrag(Vp, 120, ks * 32, cb * 16, fr, fq), bk, Cst[cb]);
            }
        }
        m = gsum + Mend;
        __syncthreads();
    }
#undef MS_FETCH
#undef MS_ROW0
}

__device__ __forceinline__ void mo_unit(const Args& a, LAS unsigned char* lds, int l, int b, int h, int cidx) {
    const int tid = opaque_tid(), wid = __builtin_amdgcn_readfirstlane(tid >> 6), lane = tid & 63, fr = lane & 15, fq = lane >> 4;
    LAS bf16_t* Qi = (LAS bf16_t*)(lds);
    LAS bf16_t* Ki = (LAS bf16_t*)(lds + 26624);
    LAS bf16_t* Si = (LAS bf16_t*)(lds);
    LAS bf16_t* Vp = (LAS bf16_t*)(lds + 53248);
    LAS float* Hs = (LAS float*)(lds + 83968);
    LAS float* colterm = (LAS float*)(lds + 135168); LAS float* Marr = colterm + 128; LAS float* bcarr = Marr + 128;
    const bf16_t* P = (const bf16_t*)(a.ws + WS_P); const float* GATES = (const float*)(a.ws + WS_GATES); bf16_t* MIX = (bf16_t*)(a.ws + WS_MIX);
    const bool isctx = cidx >= 16; const int n = isctx ? cidx - 16 : cidx, nc = isctx ? 2 : 16, rowbase = (isctx ? NLAT + b * CTXL : b * SEQ) + n * 128;
    __syncthreads();
    for (int i = tid; i < 128 * 3; i += NTHREADS) { const int p = i / 3, q = i - p * 3; u32x4 v = (u32x4){0u, 0u, 0u, 0u}; if (q == 0) v.x = 0x3F80u; *(LAS u32x4*)(Vp + p * 120 + 96 + q * 8) = v; }
    for (int d = 0; d < 2; ++d) {
        const int seq = (b * 4 + h) * 2 + d, np = d ? nc - 1 - n : n, step = isctx ? np : 2 + np;
        const float m = ((const float*)(a.ws + WS_MST))[seq * 18 + step];
        const bf16_t* CT = (const bf16_t*)(a.ws + WS_CTG) + ((size_t)seq * 18 + step) * (112 * 96);
        const float bi = a.in[I_MGB][((l * 2 + d) * 2 + 0) * 4 + h], bfg = a.in[I_MGB][((l * 2 + d) * 2 + 1) * 4 + h];
        const int row0 = rowbase + (d ? 127 : 0), rstep = d ? -1 : 1;
        if (wid == 0) mlstm_gates(GATES, row0, rstep, d * 8 + h, bi, bfg, m, colterm, Marr, bcarr, lane);
#pragma unroll
        for (int i = 0; i < 9; ++i) {
            const int rem = tid + 512 * (i % 3), p = rem / 12, ch = rem - p * 12;
            const u32x4 v = *(const u32x4*)(P + (size_t)(row0 + rstep * p) * PW + PC_Q + (i / 3) * 384 + h * 96 + ch * 8);
            if (i < 3) *(LAS u32x4*)(Qi + p * 104 + ch * 8) = v; else if (i < 6) *(LAS u32x4*)(Ki + p * 104 + ch * 8) = v; else *(LAS u32x4*)(Vp + p * 120 + ch * 8) = v;
        }
        __syncthreads();
        f32x4 num[7], sacc[8];
        const int t = wid * 16 + fr; const float Mt = Marr[t];
#pragma unroll
        for (int cb = 0; cb < 7; ++cb) num[cb] = (f32x4){0.f, 0.f, 0.f, 0.f};
#pragma unroll
        for (int ks = 0; ks < 3; ++ks) {
            const bf16x8 bq = ldfrag(Qi, 104, wid * 16, ks * 32, fr, fq);
#pragma unroll
            for (int cb = 0; cb < 7; ++cb) num[cb] = MFMA(*(const bf16x8*)(CT + (cb * 16 + fr) * 96 + ks * 32 + fq * 8), bq, num[cb]);
#pragma unroll
            for (int sb = 0; sb < 8; ++sb) if (sb <= wid) { if (ks == 0) sacc[sb] = (f32x4){0.f, 0.f, 0.f, 0.f}; sacc[sb] = MFMA(ldfrag(Ki, 104, sb * 16, ks * 32, fr, fq), bq, sacc[sb]); }
        }
        { const float ei = __expf(m - Mt);
#pragma unroll
          for (int cb = 0; cb < 7; ++cb) num[cb] = num[cb] * ei; }
        __syncthreads();
#pragma unroll
        for (int sb = 0; sb < 8; ++sb) {
            u32x2 w; w.x = 0u; w.y = 0u;
            if (sb <= wid) {
                const f32x4 ct = *(const LAS f32x4*)(colterm + sb * 16 + fq * 4); float e[4];
#pragma unroll
                for (int j = 0; j < 4; ++j) { const int s = sb * 16 + fq * 4 + j; e[j] = (s <= t) ? sacc[sb][j] * __expf(ct[j] - Mt) : 0.f; }
                w.x = cvt_pk_bf16(e[0], e[1]); w.y = cvt_pk_bf16(e[2], e[3]);
            }
            *(LAS u32x2*)(Si + t * 136 + sb * 16 + fq * 4) = w;
        }
        __syncthreads();
#pragma unroll
        for (int ks = 0; ks < 4; ++ks) {
            const bf16x8 bs = ldfrag(Si, 136, wid * 16, ks * 32, fr, fq);
#pragma unroll
            for (int cb = 0; cb < 7; ++cb) num[cb] = MFMA(trfrag(Vp, 120, ks * 32, cb * 16, fr, fq), bs, num[cb]);
        }
        const float den = __shfl(num[6][0], fr);
        const float inv = 1.0f / fmaxf(fabsf(den), __expf(-(bcarr[t] + Mt)));
        LAS float* hp = Hs + (d ? 127 - t : t) * 100 + fq * 4;
#pragma unroll
        for (int cb = 0; cb < 6; ++cb) { f32x4 hv = num[cb] * inv; if (d) hv = hv + *(const LAS f32x4*)(hp + cb * 16); *(LAS f32x4*)(hp + cb * 16) = hv; }
        __syncthreads();
    }
    {
        const int tau = wid * 16 + (lane >> 2), c0 = (lane & 3) * 24;
        float hv[24], ss = 0.f;
#pragma unroll
        for (int i = 0; i < 6; ++i) { const f32x4 x = *(const LAS f32x4*)(Hs + tau * 100 + c0 + i * 4); hv[4 * i] = x[0]; hv[4 * i + 1] = x[1]; hv[4 * i + 2] = x[2]; hv[4 * i + 3] = x[3]; ss += x[0] * x[0] + x[1] * x[1] + x[2] * x[2] + x[3] * x[3]; }
        ss += __shfl_xor(ss, 1); ss += __shfl_xor(ss, 2);
        const float rstd = rsqrtf(ss * (1.0f / 96.0f) + EPS);
        const bf16_t* op = P + (size_t)(rowbase + tau) * PW + PC_O + h * 96 + c0; const float* ng = a.in[I_MNG] + l * 384 + h * 96 + c0;
        bf16_t* mp = MIX + (size_t)(rowbase + tau) * 1024 + 384 + h * 96 + c0;
#pragma unroll
        for (int i = 0; i < 3; ++i) {
            const u32x4 ow = *(const u32x4*)(op + i * 8); const unsigned oo[4] = {ow.x, ow.y, ow.z, ow.w}; unsigned r[4];
#pragma unroll
            for (int j = 0; j < 4; ++j) { const int c = i * 8 + 2 * j; r[j] = cvt_pk_bf16(sigmoidf_(__uint_as_float(oo[j] << 16)) * hv[c] * rstd * ng[c], sigmoidf_(__uint_as_float(oo[j] & 0xffff0000u)) * hv[c + 1] * rstd * ng[c + 1]); }
            *(u32x4*)(mp + i * 8) = (u32x4){r[0], r[1], r[2], r[3]};
        }
    }
}

template <int D> __device__ __forceinline__ void scan16(float& A, float& U) {
#define RG_STEP(o) { const float Ao = dppf<(D ? 0x100 : 0x110) | (o)>(1.0f, A), Uo = dppf<(D ? 0x100 : 0x110) | (o)>(0.0f, U); U = fmaf(A, Uo, U); A *= Ao; }
    RG_STEP(1) RG_STEP(2) RG_STEP(4) RG_STEP(8)
#undef RG_STEP
}
template <bool FINAL>
__device__ __forceinline__ void rg_unit(const Args& a, LAS unsigned char* lds, int l, int b, int hd, int cidx) {
    const int tid = opaque_tid(), wid = __builtin_amdgcn_readfirstlane(tid >> 6), lane = tid & 63, fr = lane & 15, fq = lane >> 4;
    LAS bf16_t* zi = (LAS bf16_t*)lds;
    LAS bf16_t* Wi = (LAS bf16_t*)(lds + 18432);
    LAS float* zf = (LAS float*)(lds + 55296);
    LAS float* cst = (LAS float*)(lds + 88064);
    LAS float* wagg = (LAS float*)(lds + 89600);
    LAS float* hin = (LAS float*)(lds + 97792);
    const bf16_t* P = (const bf16_t*)(a.ws + WS_P); bf16_t* MIX = (bf16_t*)(a.ws + WS_MIX);
    float* AGG = (float*)(a.ws + WS_RGAGG);
    const bool isctx = cidx >= 16; const int n = isctx ? cidx - 16 : cidx, nc = isctx ? 2 : 16, Tseg = isctx ? CTXL : SEQ, segbase = isctx ? NLAT + b * CTXL : b * SEQ, base = n * 128;
    const int c = lane, ch = hd * 64 + c;
    __syncthreads();
    { const bf16_t* wt = (const bf16_t*)(a.ws + WS_RGWT) + (size_t)((l * 2) * 6 + hd) * 8192;
#pragma unroll
      for (int i = 0; i < 4; ++i) { const int idx = tid + 512 * i, dd = idx >> 10, r = (idx >> 3) & 127, k8 = idx & 7; *(LAS u32x4*)(Wi + (dd * 128 + r) * 72 + k8 * 8) = *(const u32x4*)(wt + (size_t)dd * 6 * 8192 + r * 64 + k8 * 8); } }
    if (tid < 128) { const int dd = tid >> 6, cc = tid & 63;
        cst[(dd * 3 + 0) * 64 + cc] = -1.4426950408889634f * a.in[I_RGGB][((l * 2 + dd) * 2 + 0) * 384 + hd * 64 + cc]; cst[(dd * 3 + 1) * 64 + cc] = -1.4426950408889634f * a.in[I_RGGB][((l * 2 + dd) * 2 + 1) * 384 + hd * 64 + cc];
        cst[(dd * 3 + 2) * 64 + cc] = -8.0f * 1.4426950408889634f * log1pf(expf(-a.in[I_RGLAM][(l * 2 + dd) * 384 + hd * 64 + cc]));
        if (FINAL) {
            const int np = dd ? nc - 1 - n : n, step = isctx ? np : 2 + np; const float* ag = AGG + (size_t)((b * 6 + hd) * 2 + dd) * 18 * 128 + cc;
            float Av[17], Uv[17];
#pragma unroll
            for (int s2 = 0; s2 < 17; ++s2) { Av[s2] = 1.f; Uv[s2] = 0.f; if (s2 < step) { Av[s2] = ag[s2 * 128]; Uv[s2] = ag[s2 * 128 + 64]; } }
            float hv = 0.f;
#pragma unroll
            for (int s2 = 0; s2 < 17; ++s2) hv = Av[s2] * hv + Uv[s2];
            hin[dd * 64 + cc] = hv;
        } }
    {
        const float cw0 = a.in[I_RGCW][(l * 4 + 0) * 384 + ch], cw1 = a.in[I_RGCW][(l * 4 + 1) * 384 + ch], cw2 = a.in[I_RGCW][(l * 4 + 2) * 384 + ch], cw3 = a.in[I_RGCW][(l * 4 + 3) * 384 + ch], cbias = a.in[I_RGCB][l * 384 + ch];
        const int tl0 = wid * 16; const bf16_t* pp = P + (size_t)segbase * PW + PC_RX + ch;
#define RG_LD(pos) (((pos) >= 0 && (pos) < Tseg) ? bf2f(pp[(size_t)(pos) * PW]) : 0.f)
        float xv[19];
#pragma unroll
        for (int i = 0; i < 19; ++i) xv[i] = RG_LD(base + tl0 - 2 + i);
#pragma unroll
        for (int i = 0; i < 16; ++i) { const float z = cw0 * xv[i] + cw1 * xv[i + 1] + cw2 * xv[i + 2] + cw3 * xv[i + 3] + cbias; zf[(tl0 + i) * 64 + c] = z; zi[(tl0 + i) * 72 + c] = f2bf(z); }
#undef RG_LD
    }
    __syncthreads();
    const int tl = wid * 16 + fr;
    f32x4 ysum[4];
#pragma unroll
    for (int nb = 0; nb < 4; ++nb) ysum[nb] = (f32x4){0.f, 0.f, 0.f, 0.f};
    f32x4 Ad[2][4], Ud[2][4];
#pragma unroll
    for (int d = 0; d < 2; ++d) {
        f32x4 acc[8];
#pragma unroll
        for (int nb = 0; nb < 8; ++nb) acc[nb] = (f32x4){0.f, 0.f, 0.f, 0.f};
#pragma unroll
        for (int ks = 0; ks < 2; ++ks) {
            const bf16x8 bz = ldfrag(zi, 72, wid * 16, ks * 32, fr, fq);
#pragma unroll
            for (int nb = 0; nb < 8; ++nb) acc[nb] = MFMA(ldfrag(Wi + d * 128 * 72, 72, nb * 16, ks * 32, fr, fq), bz, acc[nb]);
        }
#pragma unroll
        for (int nb = 0; nb < 4; ++nb) {
            const int j0 = nb * 16 + fq * 4;
            const f32x4 z4 = *(const LAS f32x4*)(zf + tl * 64 + j0), br = *(const LAS f32x4*)(cst + (d * 3 + 0) * 64 + j0), bi4 = *(const LAS f32x4*)(cst + (d * 3 + 1) * 64 + j0), sp = *(const LAS f32x4*)(cst + (d * 3 + 2) * 64 + j0);
#pragma unroll
            for (int j = 0; j < 4; ++j) {
                const float rg = __builtin_amdgcn_rcpf(1.0f + __builtin_amdgcn_exp2f(fmaf(acc[nb][j], -1.4426950408889634f, br[j])));
                const float ig = __builtin_amdgcn_rcpf(1.0f + __builtin_amdgcn_exp2f(fmaf(acc[nb + 4][j], -1.4426950408889634f, bi4[j])));
                const float av = __builtin_amdgcn_exp2f(rg * sp[j]);
                Ad[d][nb][j] = av; Ud[d][nb][j] = __builtin_amdgcn_sqrtf(fmaxf(fmaf(-av, av, 1.0f), 0.f)) * (ig * z4[j]);
            }
        }
#pragma unroll
        for (int nb = 0; nb < 4; ++nb)
#pragma unroll
            for (int j = 0; j < 4; ++j) { float A = Ad[d][nb][j], U = Ud[d][nb][j]; if (d == 0) scan16<0>(A, U); else scan16<1>(A, U); Ad[d][nb][j] = A; Ud[d][nb][j] = U; }
        if (fr == (d ? 0 : 15)) {
#pragma unroll
            for (int nb = 0; nb < 4; ++nb) { *(LAS f32x4*)(wagg + ((d * 8 + wid) * 2 + 0) * 64 + nb * 16 + fq * 4) = Ad[d][nb]; *(LAS f32x4*)(wagg + ((d * 8 + wid) * 2 + 1) * 64 + nb * 16 + fq * 4) = Ud[d][nb]; }
        }
    }
    __syncthreads();
    {
        bf16_t* PF = (bf16_t*)(a.ws + WS_RGPF) + ((size_t)(segbase + base + tl) * 384 + hd * 64) * 4;
#pragma unroll
        for (int nb = 0; nb < 4; ++nb) {
            const int j0 = nb * 16 + fq * 4;
            f32x4 Ap[2], Up[2];
#pragma unroll
            for (int d = 0; d < 2; ++d) {
                f32x4 Aw = (f32x4){1.f, 1.f, 1.f, 1.f}, Uw = (f32x4){0.f, 0.f, 0.f, 0.f};
                for (int w2 = 0; w2 < 7; ++w2) { const int w = d ? 7 - w2 : w2; if (d ? (w > wid) : (w < wid)) { const f32x4 aw = *(const LAS f32x4*)(wagg + ((d * 8 + w) * 2 + 0) * 64 + j0), uw = *(const LAS f32x4*)(wagg + ((d * 8 + w) * 2 + 1) * 64 + j0); Uw = aw * Uw + uw; Aw = Aw * aw; } }
                Ap[d] = Aw * Ad[d][nb]; Up[d] = Ad[d][nb] * Uw + Ud[d][nb];
            }
            u32x4 w0, w1;
            w0.x = cvt_pk_bf16(Ap[0][0], Up[0][0]); w0.y = cvt_pk_bf16(Ap[1][0], Up[1][0]); w0.z = cvt_pk_bf16(Ap[0][1], Up[0][1]); w0.w = cvt_pk_bf16(Ap[1][1], Up[1][1]);
            w1.x = cvt_pk_bf16(Ap[0][2], Up[0][2]); w1.y = cvt_pk_bf16(Ap[1][2], Up[1][2]); w1.z = cvt_pk_bf16(Ap[0][3], Up[0][3]); w1.w = cvt_pk_bf16(Ap[1][3], Up[1][3]);
            *(u32x4*)(PF + j0 * 4) = w0; *(u32x4*)(PF + j0 * 4 + 8) = w1;
        }
        if (tid < 128) { const int dd = tid >> 6, cc = tid & 63; float A = 1.f, U = 0.f;
#pragma unroll
            for (int w2 = 0; w2 < 8; ++w2) { const int w = dd ? 7 - w2 : w2; const float aw = wagg[((dd * 8 + w) * 2 + 0) * 64 + cc], uw = wagg[((dd * 8 + w) * 2 + 1) * 64 + cc]; U = aw * U + uw; A *= aw; }
            const int np = dd ? nc - 1 - n : n, step = isctx ? np : 2 + np; float* ag = AGG + ((size_t)((b * 6 + hd) * 2 + dd) * 18 + step) * 128 + cc;
            ag[0] = A; ag[64] = U; }
    }
}

__device__ __forceinline__ void rgc_unit(const Args& a, LAS unsigned char* lds, int l, int b, int hd, int cidx) {
    const int tid = opaque_tid();
    LAS float* hin = (LAS float*)lds;
    const bf16_t* P = (const bf16_t*)(a.ws + WS_P); bf16_t* MIX = (bf16_t*)(a.ws + WS_MIX); const float* AGG = (const float*)(a.ws + WS_RGAGG);
    const bool isctx = cidx >= 16; const int n = isctx ? cidx - 16 : cidx, nc = isctx ? 2 : 16, rowbase = (isctx ? NLAT + b * CTXL : b * SEQ) + n * 128;
    __syncthreads();
    if (tid < 128) { const int dd = tid >> 6, cc = tid & 63;
        const int np = dd ? nc - 1 - n : n, step = isctx ? np : 2 + np; const float* ag = AGG + (size_t)((b * 6 + hd) * 2 + dd) * 18 * 128 + cc;
        float Av[17], Uv[17];
#pragma unroll
        for (int s2 = 0; s2 < 17; ++s2) { Av[s2] = 1.f; Uv[s2] = 0.f; if (s2 < step) { Av[s2] = ag[s2 * 128]; Uv[s2] = ag[s2 * 128 + 64]; } }
        float hv = 0.f;
#pragma unroll
        for (int s2 = 0; s2 < 17; ++s2) hv = Av[s2] * hv + Uv[s2];
        hin[dd * 64 + cc] = hv; }
    __syncthreads();
    const int c4 = (tid & 15) * 4;
    const f32x4 hf = *(const LAS f32x4*)(hin + c4), hb = *(const LAS f32x4*)(hin + 64 + c4);
#pragma unroll
    for (int i = 0; i < 4; ++i) {
        const size_t row = (size_t)rowbase + (tid >> 4) + 32 * i;
        const bf16_t* pf = (const bf16_t*)(a.ws + WS_RGPF) + (row * 384 + hd * 64 + c4) * 4;
        const u32x4 w0 = *(const u32x4*)pf, w1 = *(const u32x4*)(pf + 8);
        const u32x2 gw = *(const u32x2*)(P + row * PW + PC_RG + hd * 64 + c4);
        const unsigned ww[8] = {w0.x, w0.y, w0.z, w0.w, w1.x, w1.y, w1.z, w1.w};
        float y[4];
#pragma unroll
        for (int j = 0; j < 4; ++j) y[j] = __uint_as_float(ww[2 * j] << 16) * hf[j] + __uint_as_float(ww[2 * j] & 0xffff0000u) + __uint_as_float(ww[2 * j + 1] << 16) * hb[j] + __uint_as_float(ww[2 * j + 1] & 0xffff0000u);
        u32x2 o; o.x = cvt_pk_bf16(__uint_as_float(gw.x << 16) * y[0], __uint_as_float(gw.x & 0xffff0000u) * y[1]); o.y = cvt_pk_bf16(__uint_as_float(gw.y << 16) * y[2], __uint_as_float(gw.y & 0xffff0000u) * y[3]);
        *(u32x2*)(MIX + row * 1024 + hd * 64 + c4) = o;
    }
}

__device__ __forceinline__ void gmlp_unit(const Args& a, LAS unsigned char* lds, int l, int chunk) {
    const int tid = opaque_tid(), wid = __builtin_amdgcn_readfirstlane(tid >> 6), lane = tid & 63, fr = lane & 15, fq = lane >> 4;
    LAS bf16_t* vn = (LAS bf16_t*)lds;
    const bf16_t* P = (const bf16_t*)(a.ws + WS_P); bf16_t* MIX = (bf16_t*)(a.ws + WS_MIX);
    const int row0 = chunk * 128;
    __syncthreads();
    {
        const f32x4 g = *(const f32x4*)(a.in[I_CMNG] + l * 256 + lane * 4);
        u32x2 wv[16];
#pragma unroll
        for (int i = 0; i < 16; ++i) wv[i] = *(const u32x2*)(P + (size_t)(row0 + wid * 16 + i) * PW + PC_CV + lane * 4);
#pragma unroll
        for (int i = 0; i < 16; ++i) {
            const int s = wid * 16 + i;
            const u32x2 w = wv[i];
            const float v0 = __uint_as_float(w.x << 16), v1 = __uint_as_float(w.x & 0xffff0000u), v2 = __uint_as_float(w.y << 16), v3 = __uint_as_float(w.y & 0xffff0000u);
            const float ss = wave_sum(v0 * v0 + v1 * v1 + v2 * v2 + v3 * v3);
            const float rstd = rsqrtf(ss * (1.0f / 256.0f) + EPS);
            u32x2 o; o.x = cvt_pk_bf16(v0 * rstd * g[0], v1 * rstd * g[1]); o.y = cvt_pk_bf16(v2 * rstd * g[2], v3 * rstd * g[3]);
            *(LAS u32x2*)(vn + s * 264 + lane * 4) = o;
        }
    }
    __syncthreads();
    const int g = wid >> 1, th = wid & 1;
    const float* ws = a.in[I_CMW] + ((size_t)(l * 4 + g) * 128) * 128;
    f32x4 acc[4][4];
#pragma unroll
    for (int m = 0; m < 4; ++m)
#pragma unroll
        for (int n = 0; n < 4; ++n) acc[m][n] = (f32x4){0.f, 0.f, 0.f, 0.f};
#pragma unroll
    for (int ks = 0; ks < 4; ++ks) {
        bf16x8 bw[4];
#pragma unroll
        for (int m = 0; m < 4; ++m) {
            const float* wp = ws + (size_t)(th * 64 + m * 16 + fr) * 128 + ks * 32 + fq * 8;
            const f32x4 w0 = *(const f32x4*)wp, w1 = *(const f32x4*)(wp + 4);
            u32x4 pk; pk.x = cvt_pk_bf16(w0[0], w0[1]); pk.y = cvt_pk_bf16(w0[2], w0[3]); pk.z = cvt_pk_bf16(w1[0], w1[1]); pk.w = cvt_pk_bf16(w1[2], w1[3]);
            bw[m] = __builtin_bit_cast(bf16x8, pk);
        }
#pragma unroll
        for (int n = 0; n < 4; ++n) {
            const bf16x8 av = trfrag(vn, 264, ks * 32, g * 64 + n * 16, fr, fq);
#pragma unroll
            for (int m = 0; m < 4; ++m) acc[m][n] = MFMA(av, bw[m], acc[m][n]);
        }
    }
#pragma unroll
    for (int m = 0; m < 4; ++m) {
        const int t = th * 64 + m * 16 + fr; const float bsv = a.in[I_CMB][(l * 4 + g) * 128 + t];
#pragma unroll
        for (int n = 0; n < 4; ++n) {
            const int cc = g * 64 + n * 16 + fq * 4;
            const u32x2 uw = *(const u32x2*)(P + (size_t)(row0 + t) * PW + PC_CU + cc);
            const float u0 = __uint_as_float(uw.x << 16), u1 = __uint_as_float(uw.x & 0xffff0000u), u2 = __uint_as_float(uw.y << 16), u3 = __uint_as_float(uw.y & 0xffff0000u);
            u32x2 o; o.x = cvt_pk_bf16(u0 * (acc[m][n][0] + bsv), u1 * (acc[m][n][1] + bsv)); o.y = cvt_pk_bf16(u2 * (acc[m][n][2] + bsv), u3 * (acc[m][n][3] + bsv));
            *(u32x2*)(MIX + (size_t)(row0 + t) * 1024 + 768 + cc) = o;
        }
    }
}

#define MX_NEXT(head) ({ __syncthreads(); if (tid == 0) *qv = (int)atomicAdd(q + (head) * 64, 1u); __syncthreads(); *qv; })
__device__ __forceinline__ void phase_mxa(const Args& a, LAS unsigned char* lds, int l) {
    unsigned* q = (unsigned*)(a.ws + WS_CTL + CTL_QUEUE) + l * 8 * 64; LAS int* qv = (LAS int*)(lds + LDS_BARW - 16); const int tid = opaque_tid();
    const int nch = (l == 0) ? 18 : 18;
    for (;;) { const int u = MX_NEXT(0); if (u >= 128) break; ms_unit(a, lds, l, u >> 3, (u >> 1) & 3, u & 1); }
    for (;;) { const int u = MX_NEXT(1); if (u >= 16 * 6 * nch) break; rg_unit<false>(a, lds, l, u / (6 * nch), (u / nch) % 6, u % nch); }
    const int ngm = (l == 0 ? TOK : NLAT) / 128;
    for (;;) { const int u = MX_NEXT(2); if (u >= ngm) break; gmlp_unit(a, lds, l, u); }
}
__device__ __forceinline__ void phase_mxc(const Args& a, LAS unsigned char* lds, int l) {
    unsigned* q = (unsigned*)(a.ws + WS_CTL + CTL_QUEUE) + l * 8 * 64; LAS int* qv = (LAS int*)(lds + LDS_BARW - 16); const int tid = opaque_tid();
    const int nch = (l == 0) ? 18 : 16;
    for (;;) { const int u = MX_NEXT(3); if (u >= 16 * 4 * nch) break; mo_unit(a, lds, l, u / (4 * nch), (u / nch) & 3, u % nch); }
    for (;;) { const int u = MX_NEXT(4); if (u >= 16 * 6 * nch) break; rgc_unit(a, lds, l, u / (6 * nch), (u / nch) % 6, u % nch); }
}
#undef MX_NEXT

constexpr int N_PHASES = 22;
__global__ void __launch_bounds__(NTHREADS, 2) fwd_kernel(Args a) {
    extern __shared__ __attribute__((aligned(16))) unsigned char lds_raw[];
    LAS unsigned char* lds = (LAS unsigned char*)lds_raw;
    const int lo = a.ph_lo, hi = a.ph_hi;
    XcdBarrier bar; bar.bar = (unsigned*)(a.ws + WS_CTL); bar.x = 0; bar.st = (volatile LAS unsigned*)(lds + LDS_BARW);
    if (hi - lo > 1) {
        if (threadIdx.x == 0) { *(LAS u32x4*)(lds + LDS_BARW) = (u32x4){0u, 0u, 0u, 0u}; }
        __syncthreads();
        bar = xcd_barrier_post((unsigned*)(a.ws + WS_CTL), (volatile LAS unsigned*)(lds + LDS_BARW));
    }
#ifndef PHSEL
#define PHSEL 0xFFF
#endif
#define SELJ(j) (((PHSEL) >> (j)) & 1)
#define IN(k) (lo <= (k) && (k) < hi)
#ifndef PROBE_MASK
#define PROBE_MASK 0u
#endif
    unsigned long long t_ph = PROBE_MASK ? __builtin_amdgcn_s_memrealtime() : 0ull;
#define SEAM(k) do { if (IN(k) && IN((k) + 1)) xcd_barrier(bar); \
    if (PROBE_MASK) { if (((PROBE_MASK) >> (k)) & 1u) { const unsigned long long t1 = __builtin_amdgcn_s_memrealtime(); while (__builtin_amdgcn_s_memrealtime() < t1 + (t1 - t_ph)) __builtin_amdgcn_s_sleep(4); } \
        __syncthreads(); t_ph = __builtin_amdgcn_s_memrealtime(); } } while (0)
    if (SELJ(10) && IN(0)) { p0_mod(a, lds); p0_conv(a, lds); }
    SEAM(0);
    for (int l = 0; l < 2; ++l) {
        const int pb = 1 + 10 * l, T = (l == 0) ? TOK : NLAT;
        if (SELJ(0) && IN(pb + 0)) phase_n1(a, l);
        SEAM(pb + 0);
        if (SELJ(1) && IN(pb + 1)) phase_g1(a, lds, l);
        SEAM(pb + 1);
        if (SELJ(2) && IN(pb + 2)) phase_mxa(a, lds, l);
        SEAM(pb + 2);
        if (SELJ(3) && IN(pb + 3)) phase_mxc(a, lds, l);
        SEAM(pb + 3);
        if (SELJ(4) && IN(pb + 4)) phase_g2(a, lds, l, T);
        SEAM(pb + 4);
        if (SELJ(5) && IN(pb + 5)) phase_n2(a, l, T);
        SEAM(pb + 5);
        if (SELJ(6) && IN(pb + 6)) phase_rt(a, lds, l, T);
        SEAM(pb + 6);
        if (SELJ(7) && IN(pb + 7)) phase_tk(a, lds, l, T);
        SEAM(pb + 7);
        if (SELJ(8) && IN(pb + 8)) phase_e1(a, lds, l, T);
        SEAM(pb + 8);
        if (SELJ(9) && IN(pb + 9)) phase_e2(a, lds, l, T);
        SEAM(pb + 9);
    }
    if (SELJ(11) && IN(21)) phase_fin(a);
#undef IN
#undef SEAM
}

extern "C" void kernel_launch(void* const* d_in, const int* in_sizes, int n_in, void* d_out, int out_size, void* d_ws, size_t ws_size, hipStream_t stream) {
    static int grid = 0;
    if (grid == 0) {
        if (n_in != 29 || out_size != NLAT * D || ws_size < WS_END) { fprintf(stderr, "kernel_launch: unexpected shapes (n_in %d, out %d, ws %zu, need %zu)\n", n_in, out_size, ws_size, (size_t)WS_END); grid = -1; return; }
        int dev = 0, cus = 0, per_cu = 0;
        if (hipGetDevice(&dev) != hipSuccess || hipDeviceGetAttribute(&cus, hipDeviceAttributeMultiprocessorCount, dev) != hipSuccess) { grid = -1; return; }
        if (hipFuncSetAttribute((const void*)fwd_kernel, hipFuncAttributeMaxDynamicSharedMemorySize, LDS_BYTES) != hipSuccess) { fprintf(stderr, "kernel_launch: hipFuncSetAttribute failed\n"); grid = -1; return; }
        if (hipOccupancyMaxActiveBlocksPerMultiprocessor(&per_cu, (const void*)fwd_kernel, NTHREADS, LDS_BYTES) != hipSuccess || per_cu < 1) { fprintf(stderr, "kernel_launch: occupancy query says %d\n", per_cu); (void)hipGetLastError(); grid = -1; return; }
        grid = cus;
    }
    if (grid < 0) return;
    (void)hipMemsetAsync((char*)d_ws + WS_CTL, 0, CTL_BYTES, stream);
    Args a{};
    for (int i = 0; i < 29; ++i) a.in[i] = (const float*)d_in[i];
    a.out = (float*)d_out; a.ws = (unsigned char*)d_ws;
#if MK_PER_PHASE
    for (int p = 0; p < N_PHASES; ++p) { a.ph_lo = p; a.ph_hi = p + 1; hipLaunchKernelGGL(fwd_kernel, dim3(grid), dim3(NTHREADS), LDS_BYTES, stream, a); }
#else
    a.ph_lo = 0; a.ph_hi = N_PHASES;
    hipLaunchKernelGGL(fwd_kernel, dim3(grid), dim3(NTHREADS), LDS_BYTES, stream, a);
#endif
}
```

```cpp
#include <hip/hip_runtime.h>
#include <cstdio>
#include <cstdint>

#ifndef MK_PER_PHASE
#define MK_PER_PHASE 0
#endif

#define LAS __attribute__((address_space(3)))
typedef unsigned short bf16_t;
typedef short bf16x8 __attribute__((ext_vector_type(8)));
typedef float f32x4 __attribute__((ext_vector_type(4)));
typedef float f32x2 __attribute__((ext_vector_type(2)));
typedef unsigned u32x4 __attribute__((ext_vector_type(4)));
typedef unsigned u32x2 __attribute__((ext_vector_type(2)));

constexpr int D = 1024, NBATCH = 16, SEQ = 2048, CTXL = 256;
constexpr int NLAT = NBATCH * SEQ, NCTX = NBATCH * CTXL, TOK = NLAT + NCTX;
constexpr int DIN = 2832, PW = 2816, NIN = 3072;
constexpr int NE = 256, FF = 288, NSLOT = 9, LCAP = TOK;
constexpr int NTHREADS = 512;
constexpr int LDS_BYTES = 147456;
constexpr int LDS_TAB = 139264;
constexpr int LDS_BARW = LDS_BYTES - 16;
constexpr float EPS = 1e-6f;

constexpr int PC_RX = 0, PC_RG = 384, PC_Q = 768, PC_K = 1152, PC_V = 1536, PC_O = 1920, PC_CU = 2304, PC_CV = 2560;

constexpr size_t WS_CTL = 0, CTL_BYTES = 131072;
constexpr size_t CTL_QUEUE = 16384, CTL_CNT = 32768;
constexpr int CNT_STRIDE = 32;
constexpr size_t WS_MOD = 131072;
constexpr size_t WS_X = WS_MOD + 1048576;
constexpr size_t WS_XA = WS_X + (size_t)TOK * D * 4;
constexpr size_t WS_R1 = WS_XA + (size_t)TOK * D * 2;
constexpr size_t R1_BYTES = (size_t)TOK * NSLOT * D * 2;
constexpr size_t WS_P = WS_R1;
constexpr size_t WS_MIX = WS_P + (size_t)TOK * PW * 2;
constexpr size_t WS_CTG = WS_MIX + (size_t)TOK * D * 2;
constexpr size_t WS_MST = WS_CTG + (size_t)128 * 18 * 112 * 96 * 2;
constexpr size_t WS_RGAGG = WS_MST + 16384;
constexpr size_t WS_RGPF = WS_RGAGG + (size_t)192 * 18 * 128 * 4;
static_assert(WS_RGPF + (size_t)TOK * 384 * 4 * 2 <= WS_R1 + R1_BYTES, "aliases");
constexpr int HB_ROWS = (TOK * 8 / 256 + 256 + TOK / 256) * 256;
constexpr size_t WS_HB = WS_R1 + R1_BYTES;
constexpr size_t WS_GATES = WS_HB + (size_t)HB_ROWS * FF * 2 + 256;
constexpr size_t WS_LOGITS = WS_GATES + (size_t)TOK * 16 * 4;
constexpr size_t WS_LSLOT = WS_LOGITS + (size_t)TOK * 256 * 4;
constexpr size_t WS_LW = WS_LSLOT + (size_t)NE * LCAP * 4;
constexpr size_t WS_WIN = WS_LW + (size_t)NE * LCAP * 4;
constexpr size_t WS_WOUT = WS_WIN + (size_t)2 * NIN * D * 2;
constexpr size_t WS_ROUT = WS_WOUT + (size_t)2 * D * D * 2;
constexpr size_t WS_RGWT = WS_ROUT + (size_t)2 * NE * D * 2;
constexpr size_t WS_END = WS_RGWT + (size_t)2 * 2 * 6 * 128 * 64 * 2;

__device__ __forceinline__ float bf2f(bf16_t b) { return __uint_as_float(((unsigned)b) << 16); }
__device__ __forceinline__ unsigned cvt_pk_bf16(float lo, float hi) { unsigned r; asm volatile("v_cvt_pk_bf16_f32 %0, %1, %2" : "=v"(r) : "v"(lo), "v"(hi)); return r; }
__device__ __forceinline__ bf16_t f2bf(float f) { return (bf16_t)(cvt_pk_bf16(f, 0.f) & 0xffffu); }
__device__ __forceinline__ float sigmoidf_(float x) { return __builtin_amdgcn_rcpf(1.0f + __expf(-x)); }
__device__ __forceinline__ float siluf_(float x) { return x * __builtin_amdgcn_rcpf(1.0f + __expf(-x)); }
__device__ __forceinline__ float gelu_tanh(float x) { const float u = 1.5957691216057308f * (x + 0.044715f * x * x * x); return x * __builtin_amdgcn_rcpf(1.0f + __expf(-u)); }
__device__ __forceinline__ float wave_sum(float v) {
#pragma unroll
    for (int o = 32; o >= 1; o >>= 1) v += __shfl_xor(v, o);
    return v;
}
__device__ __forceinline__ int opaque_tid() { int t = threadIdx.x; asm volatile("" : "+v"(t)); return t; }
#define WAIT_VM0() asm volatile("s_waitcnt vmcnt(0)" ::: "memory")

#define XB_TMO      128
#define XB_XCNT(j)  (256  + 64 * (j))
#define XB_XSUB(j)  (1280 + 64 * (j))
#define XB_XGEN(j)  (2304 + 64 * (j))
#define XB_TOP      3328
#define XB_TOPGEN   3392
#define XCD_BAR_WORDS 3456
#define XB_SPIN_CAP (1u << 18)

__device__ __forceinline__ unsigned xb_ld(unsigned* p)              { return __hip_atomic_load(p, __ATOMIC_RELAXED, __HIP_MEMORY_SCOPE_AGENT); }
__device__ __forceinline__ unsigned xb_add(unsigned* p, unsigned v) { return __hip_atomic_fetch_add(p, v, __ATOMIC_RELAXED, __HIP_MEMORY_SCOPE_AGENT); }
__device__ __forceinline__ unsigned xb_xcc_id() { return (unsigned)__builtin_amdgcn_s_getreg((3 << 11) | 20) & 0xFu; }
#define XB_SPIN(cond, bar) do { unsigned _sp = 0; while (cond) { __builtin_amdgcn_s_sleep(1); \
    if ((++_sp & 255u) == 0u) { if (xb_ld(&(bar)[XB_TMO])) break; if (_sp > XB_SPIN_CAP) { atomicAdd(&(bar)[XB_TMO], 1u); break; } } } } while (0)

struct XcdBarrier { unsigned* bar; unsigned x; volatile LAS unsigned* st; };

__device__ __forceinline__ XcdBarrier xcd_barrier_post(unsigned* bar, volatile LAS unsigned* st) {
    XcdBarrier b; b.bar = bar; b.x = xb_xcc_id(); b.st = st;
    if (threadIdx.x == 0) (void)xb_add(&bar[XB_XCNT(b.x)], 1u);
    return b;
}
__device__ __forceinline__ void xcd_barrier_complete(unsigned* bar, unsigned x, unsigned& nloc, unsigned& nx) {
    const unsigned G = gridDim.x * gridDim.y * gridDim.z;
    unsigned sum, cnt, mine, sp = 0u;
    for (;;) {
        sum = 0u; cnt = 0u; mine = 0u;
#pragma unroll
        for (unsigned j = 0; j < 16; ++j) { const unsigned c = xb_ld(&bar[XB_XCNT(j)]); sum += c; cnt += (c > 0u) ? 1u : 0u; mine = (j == x) ? c : mine; }
        if (sum == G) break;
        __builtin_amdgcn_s_sleep(1);
        if ((++sp & 255u) == 0u) { if (xb_ld(&bar[XB_TMO])) break; if (sp > XB_SPIN_CAP) { atomicAdd(&bar[XB_TMO], 1u); break; } }
    }
    nloc = mine > 0u ? mine : 1u; nx = cnt > 0u ? cnt : 1u;
}
__device__ __forceinline__ void xcd_barrier(const XcdBarrier& b) {
    asm volatile("s_waitcnt vmcnt(0)" ::: "memory");
    __syncthreads();
    if (threadIdx.x == 0) {
        unsigned* bar = b.bar;
        __builtin_amdgcn_s_waitcnt(0);
        unsigned nloc = b.st[0], nx = b.st[1];
        if (nloc == 0u) { xcd_barrier_complete(bar, b.x, nloc, nx); b.st[0] = nloc; b.st[1] = nx; }
        const unsigned old = xb_add(&bar[XB_XSUB(b.x)], 1u);
        const unsigned gen = old / nloc;
        if (old + 1u == (gen + 1u) * nloc) {
            __builtin_amdgcn_fence(__ATOMIC_RELEASE, "agent");
            asm volatile("s_waitcnt vmcnt(0)" ::: "memory");
            const unsigned og = xb_add(&bar[XB_TOP], 1u);
            const unsigned tg = og / nx;
            if (og + 1u == (tg + 1u) * nx) xb_add(&bar[XB_TOPGEN], 1u);
            else XB_SPIN(xb_ld(&bar[XB_TOPGEN]) == tg, bar);
            __builtin_amdgcn_fence(__ATOMIC_ACQUIRE, "agent");
            xb_add(&bar[XB_XGEN(b.x)], 1u);
            asm volatile("s_waitcnt vmcnt(0)" ::: "memory");
        } else {
            XB_SPIN(xb_ld(&bar[XB_XGEN(b.x)]) == gen, bar);
            __builtin_amdgcn_fence(__ATOMIC_ACQUIRE, "agent");
            asm volatile("s_waitcnt vmcnt(0)" ::: "memory");
        }
    }
    __syncthreads();
}

struct Args { const float* in[29]; float* out; unsigned char* ws; int ph_lo, ph_hi; };
enum { I_X = 0, I_C, I_CTX, I_CCTX, I_N1G, I_N2G, I_WMOD, I_BMOD, I_WIN, I_RGCW, I_RGCB, I_RGGW, I_RGGB, I_RGLAM, I_MGB, I_MNG, I_CMNG, I_CMW, I_CMB,
       I_WOUT, I_RW, I_RB, I_EG, I_EU, I_ED, I_SG, I_SU, I_SD, I_FNG };

__device__ __forceinline__ int lds_byte(int r, int c) { const int st = (r >> 4) * 2 + (c >> 5), ob = (r & 15) * 64 + (c & 31) * 2; return st * 1024 + (ob ^ (((ob >> 9) & 1) << 5)); }
__device__ __forceinline__ void stage_rc(int b, int& R, int& C) { const int st = b >> 10, sb = b & 1023, swz = sb ^ (((sb >> 9) & 1) << 5); R = (st >> 1) * 16 + (swz >> 6); C = (st & 1) * 32 + ((swz & 63) >> 1); }

template <int BN, int WC> struct GT { static constexpr int WR = 8 / WC, MF = 256 / WR / 16, NF = BN / WC / 16, BP = BN / 64; };

typedef short s16x4 __attribute__((ext_vector_type(4)));
__device__ __forceinline__ bf16x8 trfrag(const LAS bf16_t* img, int pitch, int k0, int n0, int fr, int fq) {
    const LAS bf16_t* p = img + (k0 + 8 * fq + (fr >> 2)) * pitch + n0 + 4 * (fr & 3);
    const s16x4 lo = __builtin_amdgcn_ds_read_tr16_b64_v4i16((LAS s16x4*)p), hi = __builtin_amdgcn_ds_read_tr16_b64_v4i16((LAS s16x4*)(p + 4 * pitch));
    return __builtin_shufflevector(lo, hi, 0, 1, 2, 3, 4, 5, 6, 7);
}

constexpr int RS_SLOT = 34816, RS_BOFF = 16384;
struct RSeg { const unsigned char* Ab; unsigned aoff[2]; const float* B0; const float* B1; };
template <int BN, int WC, bool DUAL, bool GATHER, int NSET, class PV>
__device__ __forceinline__ void ring_gemm(LAS unsigned char* lds, PV& pv, const int ns, const int ldb, const unsigned ca0, const unsigned ca1) {
    constexpr int MF = GT<BN, WC>::MF, NF = GT<BN, WC>::NF, PITCH = BN == 192 ? 200 : 280, LPS = BN / 64, VPR = BN / 4;
    const int tid = opaque_tid(), wid = __builtin_amdgcn_readfirstlane(tid >> 6), lane = tid & 63, fr = lane & 15, fq = lane >> 4;
    const int wr = wid / WC, wc = wid % WC;
    const int obA = fr * 64 + fq * 16;
    const int aro = (wr * MF) * 1024 + (obA ^ (((obA >> 9) & 1) << 5));
    const unsigned ldsb = (unsigned)(size_t)lds + (unsigned)(RS_BOFF + ((8 * fq + (fr >> 2)) * PITCH + (DUAL ? 4 * (fr & 3) + wc * 48 : 16 * (fr & 3) + wc * (NF * 16))) * 2);
    constexpr int NTB = DUAL ? LPS : 1;
    unsigned bsoff_[NTB]; unsigned bdst_[NTB];
    bool bsel_[NTB];
#pragma unroll
    for (int i = 0; i < NTB; ++i) { const int e = tid + 512 * i, row = e / VPR, c4 = e % VPR; bsel_[i] = DUAL && c4 >= 24; bsoff_[i] = (unsigned)(row * ldb + 4 * (DUAL ? c4 % 24 : c4));
        bdst_[i] = (unsigned)(size_t)lds + (unsigned)(RS_BOFF + (row * PITCH + 4 * c4) * 2); }
#define bsoff(i) (DUAL ? bsoff_[DUAL ? (i) : 0] : bsoff_[0] + (unsigned)(8 * (i) * ldb))
#define bdst(i) (DUAL ? bdst_[DUAL ? (i) : 0] : bdst_[0] + (unsigned)(8 * (i) * PITCH * 2))
#define bsel(i) (DUAL ? bsel_[DUAL ? (i) : 0] : false)
    f32x4 acc[MF][NF];
#pragma unroll
    for (int m = 0; m < MF; ++m)
#pragma unroll
        for (int n = 0; n < NF; ++n) acc[m][n] = (f32x4){0.f, 0.f, 0.f, 0.f};
    RSeg ss, nx; int si = 0, sj = 0;
    bool have = pv.seg(0, ss); if (!have) return;
    pv.finish(ss, true);
    bool have_nx = pv.seg(1, nx);
    int staged = 0, g = 0, ci = 0, cj = 0;
    f32x4 r0[LPS], r1[NSET == 2 ? LPS : 1];
#define RS_STAGEA() do { _Pragma("unroll") for (int _i = 0; _i < 2; ++_i) __builtin_amdgcn_global_load_lds((const unsigned*)(ss.Ab + (GATHER ? ss.aoff[_i] : (_i ? ca1 : ca0)) + (size_t)sj * 64), (LAS unsigned*)(lds + (staged & 3) * RS_SLOT + (wid + 8 * _i) * 1024), 16, 0, 0); } while (0)
#define RS_LOADB(rr) do { if (DUAL) { _Pragma("unroll") for (int _i = 0; _i < LPS; ++_i) { const float* _p = (bsel(_i) ? ss.B1 : ss.B0) + bsoff(_i) + (size_t)(sj * 32) * ldb; \
            asm volatile("global_load_dwordx4 %0, %1, off" : "=&v"(rr[_i]) : "v"(_p)); } } \
        else { const float* _sb = ss.B0 + (size_t)(sj * 32) * ldb; _Pragma("unroll") for (int _i = 0; _i < LPS; ++_i) { const unsigned _o = bsoff(_i) * 4u; \
            asm volatile("global_load_dwordx4 %0, %1, %2" : "=&v"(rr[_i]) : "v"(_o), "s"(_sb)); } } } while (0)
#define RS_WAITB(rr, steady) do { if (steady) { if (NSET == 1) asm volatile("s_waitcnt vmcnt(2)" ::: "memory"); else if (LPS == 3) asm volatile("s_waitcnt vmcnt(7)" ::: "memory"); else asm volatile("s_waitcnt vmcnt(8)" ::: "memory"); } else asm volatile("s_waitcnt vmcnt(0)" ::: "memory"); \
        __builtin_amdgcn_sched_barrier(0);        \
        if (LPS == 3) asm volatile("" : "+v"(rr[0]), "+v"(rr[1]), "+v"(rr[2])); else asm volatile("" : "+v"(rr[0]), "+v"(rr[1]), "+v"(rr[2]), "+v"(rr[LPS > 3 ? 3 : 0])); } while (0)
#define RS_WRITEB(rr, slot) do { _Pragma("unroll") for (int _i = 0; _i < LPS; ++_i) { u32x2 _w; _w.x = cvt_pk_bf16(rr[_i][0], rr[_i][1]); _w.y = cvt_pk_bf16(rr[_i][2], rr[_i][3]); \
        asm volatile("ds_write_b64 %0, %1" :: "v"(bdst(_i) + (unsigned)((slot) * RS_SLOT)), "v"(_w) : "memory"); } } while (0)
#define RS_ADVANCE() do { ++staged; if (++sj == ns) { sj = 0; ++si; if (have_nx) pv.finish(nx, false); ss = nx; have = have_nx; have_nx = have ? pv.seg(si + 1, nx) : false; } } while (0)
#define RS_TR(dst, slot, off) asm volatile("ds_read_b64_tr_b16 %0, %1 offset:%2" : "=v"(dst) : "v"(ldsb + (unsigned)((slot) * RS_SLOT)), "n"(off))
#define RS_KSTEP(slot) do { bf16x8 At[MF], Bf[NF]; s16x4 _lo[NF], _hi[NF]; \
        _Pragma("unroll") for (int n = 0; n < NF; ++n) { \
            if (DUAL) { if (n < 3) { RS_TR(_lo[n], slot, (16 * (n % 3)) * 2); RS_TR(_hi[n], slot, (16 * (n % 3) + 4 * PITCH) * 2); } else { RS_TR(_lo[n], slot, (96 + 16 * (n % 3)) * 2); RS_TR(_hi[n], slot, (96 + 16 * (n % 3) + 4 * PITCH) * 2); } } \
            else { RS_TR(_lo[n], slot, (4 * n) * 2); RS_TR(_hi[n], slot, (4 * n + 4 * PITCH) * 2); } } \
        _Pragma("unroll") for (int m = 0; m < MF; ++m) At[m] = *(const LAS bf16x8*)(lds + (slot) * RS_SLOT + aro + m * 1024); \
        if (NF == 6) asm volatile("s_waitcnt lgkmcnt(0)" : "+v"(_lo[0]), "+v"(_hi[0]), "+v"(_lo[1]), "+v"(_hi[1]), "+v"(_lo[2]), "+v"(_hi[2]), "+v"(_lo[3]), "+v"(_hi[3]), "+v"(_lo[NF > 4 ? 4 : 0]), "+v"(_hi[NF > 4 ? 4 : 0]), "+v"(_lo[NF > 5 ? 5 : 1]), "+v"(_hi[NF > 5 ? 5 : 1])); \
        else asm volatile("s_waitcnt lgkmcnt(0)" : "+v"(_lo[0]), "+v"(_hi[0]), "+v"(_lo[1]), "+v"(_hi[1]), "+v"(_lo[2]), "+v"(_hi[2]), "+v"(_lo[3]), "+v"(_hi[3])); \
        _Pragma("unroll") for (int n = 0; n < NF; ++n) Bf[n] = __builtin_shufflevector(_lo[n], _hi[n], 0, 1, 2, 3, 4, 5, 6, 7); \
        _Pragma("unroll") for (int m = 0; m < MF; ++m) _Pragma("unroll") for (int n = 0; n < NF; ++n) acc[m][n] = __builtin_amdgcn_mfma_f32_16x16x32_bf16(Bf[n], At[m], acc[m][n], 0, 0, 0); __builtin_amdgcn_sched_barrier(0); } while (0)
#define RS_BARRIER() do { asm volatile("s_waitcnt lgkmcnt(0)" ::: "memory"); __builtin_amdgcn_s_barrier(); asm volatile("" ::: "memory"); } while (0)
    if (NSET == 2) {
        RS_STAGEA(); RS_LOADB(r0); RS_WAITB(r0, false); RS_WRITEB(r0, 0); RS_ADVANCE();
        if (have) { RS_STAGEA(); RS_LOADB(r1); RS_ADVANCE(); }
        if (have) { RS_STAGEA(); RS_LOADB(r0); RS_ADVANCE(); }
    } else {
        RS_STAGEA(); RS_LOADB(r0); RS_WAITB(r0, false); RS_WRITEB(r0, 0); RS_ADVANCE();
        if (have) { RS_STAGEA(); RS_LOADB(r0); RS_ADVANCE(); }
    }
    WAIT_VM0(); RS_BARRIER();
#define RS_ITER(rw, STEADY) do { \
        const bool st = have; \
        if (st) RS_STAGEA(); \
        RS_KSTEP(g & 3); \
        if (++cj == ns) { pv.epi(ci, acc); _Pragma("unroll") for (int m = 0; m < MF; ++m) _Pragma("unroll") for (int n = 0; n < NF; ++n) acc[m][n] = (f32x4){0.f, 0.f, 0.f, 0.f}; cj = 0; ++ci; } \
        if (g + 1 < staged) { RS_WAITB(rw, STEADY); RS_WRITEB(rw, (g + 1) & 3); } \
        if (st) { RS_LOADB(rw); RS_ADVANCE(); } \
        st_prev = st; ++g; RS_BARRIER(); } while (0)
    bool st_prev = true;
    if (NSET == 2) {
        for (;;) {
            RS_ITER(r1, st && st_prev); if (g >= staged) break;
            RS_ITER(r0, st && st_prev); if (g >= staged) break;
        }
    } else {
        for (;;) { RS_ITER(r0, st); if (g >= staged) break; }
    }
    WAIT_VM0(); __syncthreads();
#undef RS_STAGEA
#undef RS_LOADB
#undef RS_WAITB
#undef RS_WRITEB
#undef RS_ADVANCE
#undef RS_TR
#undef RS_KSTEP
#undef RS_BARRIER
#undef RS_ITER
#undef bsoff
#undef bdst
#undef bsel
}

__device__ __forceinline__ bf16x8 ldfrag(const LAS bf16_t* img, int pitch, int row0, int k0, int fr, int fq) { return *(const LAS bf16x8*)(img + (row0 + fr) * pitch + k0 + fq * 8); }
#define MFMA(a, b, c) __builtin_amdgcn_mfma_f32_16x16x32_bf16(a, b, c, 0, 0, 0)

__device__ __forceinline__ void p0_mod(const Args& a, LAS unsigned char* lds) {
    { bf16_t* wt = (bf16_t*)(a.ws + WS_RGWT);
      for (int idx = blockIdx.x * NTHREADS + threadIdx.x; idx < 2 * 2 * 2 * 6 * 4096; idx += gridDim.x * NTHREADS) { const int j = idx & 63, i = (idx >> 6) & 63, hd = (idx >> 12) % 6, g = ((idx >> 12) / 6) & 1, ld = (idx >> 12) / 12;
          wt[((size_t)(ld * 6 + hd) * 128 + g * 64 + j) * 64 + i] = f2bf(a.in[I_RGGW][idx]); } }
    LAS float* sc = (LAS float*)lds;
    LAS float* red = (LAS float*)(lds + 69632);
    const int tid = opaque_tid();
    for (int i = tid; i < 17 * 1024; i += NTHREADS) { const int s = i >> 10, k = i & 1023; const float v = s < 16 ? a.in[I_C][s * 1024 + k] : a.in[I_CCTX][k]; sc[i] = siluf_(v); }
    __syncthreads();
    float* MOD = (float*)(a.ws + WS_MOD);
    for (int u = blockIdx.x; u < 192; u += gridDim.x) {
        const int l = u / 96, cb = (u % 96) * 64, col = tid & 63, ks = tid >> 6;
        const float* w = a.in[I_WMOD] + (size_t)l * 1024 * 6144 + cb + col;
        float acc[17];
#pragma unroll
        for (int s = 0; s < 17; ++s) acc[s] = 0.f;
#pragma unroll 4
        for (int k = ks * 128; k < ks * 128 + 128; ++k) {
            const float wv = w[(size_t)k * 6144];
#pragma unroll
            for (int s = 0; s < 17; ++s) acc[s] += sc[s * 1024 + k] * wv;
        }
#pragma unroll
        for (int s = 0; s < 17; ++s) red[(ks * 17 + s) * 64 + col] = acc[s];
        __syncthreads();
        for (int i = tid; i < 17 * 64; i += NTHREADS) {
            const int s = i >> 6, c = i & 63; float v = 0.f;
#pragma unroll
            for (int k2 = 0; k2 < 8; ++k2) v += red[(k2 * 17 + s) * 64 + c];
            MOD[((size_t)l * 17 + s) * 6144 + cb + c] = v + a.in[I_BMOD][l * 6144 + cb + c];
        }
        __syncthreads();
    }
}

template <int KT>
__device__ __forceinline__ void conv_tile(LAS float* tile, const float* p0, const float* p1, const float* p2, const float* p3, int ldn, int k0, bf16_t* dst, int K) {
    const int tid = opaque_tid(), r = tid >> 4, c4 = tid & 15, grp = c4 >> 2, within = (c4 & 3) * 4;
    const float* p = grp == 0 ? p0 : grp == 1 ? p1 : grp == 2 ? p2 : p3;
#pragma unroll
    for (int i = 0; i < KT / 32; ++i) {
        const int k = r + 32 * i; f32x4 v = (f32x4){0.f, 0.f, 0.f, 0.f};
        if (p) v = *(const f32x4*)(p + (size_t)(k0 + k) * ldn + within);
        tile[k * 65 + c4 * 4 + 0] = v[0]; tile[k * 65 + c4 * 4 + 1] = v[1]; tile[k * 65 + c4 * 4 + 2] = v[2]; tile[k * 65 + c4 * 4 + 3] = v[3];
    }
    __syncthreads();
    constexpr int CPR = KT / 16;
    const int row = tid / CPR, ch = tid % CPR;
    if (row < 64) {
        float v[16];
#pragma unroll
        for (int j = 0; j < 16; ++j) v[j] = tile[(ch * 16 + j) * 65 + row];
        u32x4 w0, w1;
        w0.x = cvt_pk_bf16(v[0], v[1]); w0.y = cvt_pk_bf16(v[2], v[3]); w0.z = cvt_pk_bf16(v[4], v[5]); w0.w = cvt_pk_bf16(v[6], v[7]);
        w1.x = cvt_pk_bf16(v[8], v[9]); w1.y = cvt_pk_bf16(v[10], v[11]); w1.z = cvt_pk_bf16(v[12], v[13]); w1.w = cvt_pk_bf16(v[14], v[15]);
        bf16_t* dp = dst + (size_t)row * K + k0 + ch * 16;
        *(u32x4*)dp = w0; *(u32x4*)(dp + 8) = w1;
    }
    __syncthreads();
}

constexpr int CV_WIN = 384, CV_WOUT = 128, CV_ROUT = 32, CV_LAYER = CV_WIN + CV_WOUT + CV_ROUT;
__device__ __forceinline__ void p0_conv(const Args& a, LAS unsigned char* lds) {
    LAS float* tile = (LAS float*)lds;
    for (int u = blockIdx.x; u < 2 * CV_LAYER; u += gridDim.x) {
        const int l = u / CV_LAYER; int j = u % CV_LAYER;
        if (j < CV_WIN) {
            const int rho0 = (j >> 3) * 64, kt = j & 7; const float* src = a.in[I_WIN] + (size_t)l * 1024 * DIN; const float* p[4];
#pragma unroll
            for (int g = 0; g < 4; ++g) { const int rho = rho0 + 16 * g; const int col = rho < 2304 ? rho : rho < 2816 ? rho + 16 : rho < 2832 ? rho - 512 : -1; p[g] = col >= 0 ? src + col : nullptr; }
            conv_tile<128>(tile, p[0], p[1], p[2], p[3], DIN, kt * 128, (bf16_t*)(a.ws + WS_WIN) + ((size_t)l * NIN + rho0) * 1024, 1024);
            continue;
        }
        j -= CV_WIN;
        if (j < CV_WOUT) {
            const int rho0 = (j >> 3) * 64, kt = j & 7; const float* src = a.in[I_WOUT] + (size_t)l * 1024 * 1024 + rho0;
            conv_tile<128>(tile, src, src + 16, src + 32, src + 48, 1024, kt * 128, (bf16_t*)(a.ws + WS_WOUT) + ((size_t)l * 1024 + rho0) * 1024, 1024);
            continue;
        }
        j -= CV_WOUT;
        if (j < CV_ROUT) {
            const int rho0 = (j >> 3) * 64, kt = j & 7; const float* src = a.in[I_RW] + (size_t)l * 1024 * 256 + rho0;
            conv_tile<128>(tile, src, src + 16, src + 32, src + 48, 256, kt * 128, (bf16_t*)(a.ws + WS_ROUT) + ((size_t)l * 256 + rho0) * 1024, 1024);
            continue;
        }
    }
}

__device__ __forceinline__ int sample_of(int row) { return row < NLAT ? (row >> 11) : 16; }

constexpr float SLOT_SCALE = 16.0f, SLOT_CLAMP = 240.0f;
typedef float f32x2 __attribute__((ext_vector_type(2)));
__device__ __forceinline__ void slot_sum(const unsigned char* Y8, int row, int lane, f32x4 (&s)[4]) {
#pragma unroll
    for (int ii = 0; ii < 4; ++ii) s[ii] = (f32x4){0.f, 0.f, 0.f, 0.f};
    u32x4 w[NSLOT];
#pragma unroll
    for (int k = 0; k < NSLOT; ++k) w[k] = *(const u32x4*)(Y8 + ((size_t)row * NSLOT + k) * 1024 + lane * 16);
#pragma unroll
    for (int k = 0; k < NSLOT; ++k) {
        const unsigned ww[4] = {w[k].x, w[k].y, w[k].z, w[k].w};
#pragma unroll
        for (int ii = 0; ii < 4; ++ii) { const f32x2 lo = __builtin_amdgcn_cvt_pk_f32_fp8((int)ww[ii], false), hi = __builtin_amdgcn_cvt_pk_f32_fp8((int)ww[ii], true); s[ii][0] += lo[0]; s[ii][1] += lo[1]; s[ii][2] += hi[0]; s[ii][3] += hi[1]; }
    }
#pragma unroll
    for (int ii = 0; ii < 4; ++ii) s[ii] = s[ii] * (1.0f / SLOT_SCALE);
}
__device__ __forceinline__ void xrow_ld(const bf16_t* p, f32x4 (&v)[4]) {
    const u32x4 w0 = *(const u32x4*)p, w1 = *(const u32x4*)(p + 8);
    v[0] = (f32x4){__uint_as_float(w0.x << 16), __uint_as_float(w0.x & 0xffff0000u), __uint_as_float(w0.y << 16), __uint_as_float(w0.y & 0xffff0000u)};
    v[1] = (f32x4){__uint_as_float(w0.z << 16), __uint_as_float(w0.z & 0xffff0000u), __uint_as_float(w0.w << 16), __uint_as_float(w0.w & 0xffff0000u)};
    v[2] = (f32x4){__uint_as_float(w1.x << 16), __uint_as_float(w1.x & 0xffff0000u), __uint_as_float(w1.y << 16), __uint_as_float(w1.y & 0xffff0000u)};
    v[3] = (f32x4){__uint_as_float(w1.z << 16), __uint_as_float(w1.z & 0xffff0000u), __uint_as_float(w1.w << 16), __uint_as_float(w1.w & 0xffff0000u)};
}
__device__ __forceinline__ void xrow_st(bf16_t* p, const f32x4 (&v)[4]) {
    u32x4 w0, w1;
    w0.x = cvt_pk_bf16(v[0][0], v[0][1]); w0.y = cvt_pk_bf16(v[0][2], v[0][3]); w0.z = cvt_pk_bf16(v[1][0], v[1][1]); w0.w = cvt_pk_bf16(v[1][2], v[1][3]);
    w1.x = cvt_pk_bf16(v[2][0], v[2][1]); w1.y = cvt_pk_bf16(v[2][2], v[2][3]); w1.z = cvt_pk_bf16(v[3][0], v[3][1]); w1.w = cvt_pk_bf16(v[3][2], v[3][3]);
    *(u32x4*)p = w0; *(u32x4*)(p + 8) = w1;
}
__device__ __forceinline__ void norm_mod_store(const f32x4 (&v)[4], const float* g, const float* shift, const float* scale, bf16_t* dst, int lane) {
    float ss = 0.f;
#pragma unroll
    for (int ii = 0; ii < 4; ++ii) ss += v[ii][0] * v[ii][0] + v[ii][1] * v[ii][1] + v[ii][2] * v[ii][2] + v[ii][3] * v[ii][3];
    ss = wave_sum(ss);
    const float rstd = rsqrtf(ss * (1.0f / 1024.0f) + EPS);
    f32x4 y[4];
#pragma unroll
    for (int ii = 0; ii < 4; ++ii) {
        const int c = lane * 16 + ii * 4;
        const f32x4 gg = *(const f32x4*)(g + c), sh = *(const f32x4*)(shift + c), sc = *(const f32x4*)(scale + c);
#pragma unroll
        for (int j = 0; j < 4; ++j) y[ii][j] = v[ii][j] * rstd * gg[j] * (1.0f + sc[j]) + sh[j];
    }
    xrow_st(dst + lane * 16, y);
}

__device__ __forceinline__ void phase_n1(const Args& a, int l) {
    const int tid = opaque_tid(), wid = tid >> 6, lane = tid & 63;
    bf16_t* X = (bf16_t*)(a.ws + WS_X); bf16_t* XA = (bf16_t*)(a.ws + WS_XA); const float* MOD = (const float*)(a.ws + WS_MOD); const unsigned char* Y8 = (const unsigned char*)(a.ws + WS_R1);
    for (int row = blockIdx.x * 8 + wid; row < TOK; row += gridDim.x * 8) {
        const int s = sample_of(row);
        f32x4 v[4];
        if (l == 0) {
            if (row < NLAT) {
                const float* xp = a.in[I_X] + (size_t)row * 1024 + lane * 16;
                const int tp = row & 2047; const int seg = lane >> 4; const float pos = (seg & 2) ? (float)(tp & 63) : (float)(tp >> 6);
#pragma unroll
                for (int ii = 0; ii < 4; ++ii) v[ii] = *(const f32x4*)(xp + ii * 4);
#pragma unroll
                for (int ii = 0; ii < 4; ++ii)
#pragma unroll
                    for (int j = 0; j < 4; ++j) {
                        const float om = exp2f(-13.287712379549449f * (float)((lane & 15) * 16 + ii * 4 + j) * (1.0f / 256.0f));
                        const float ang = pos * om;
                        v[ii][j] += (seg & 1) ? cosf(ang) : sinf(ang);
                    }
            } else {
                const float* xp = a.in[I_CTX] + (size_t)(row - NLAT) * 1024 + lane * 16;
#pragma unroll
                for (int ii = 0; ii < 4; ++ii) v[ii] = *(const f32x4*)(xp + ii * 4);
            }
        } else {
            f32x4 ys[4], xv[4]; slot_sum(Y8, row, lane, ys); xrow_ld(X + (size_t)row * 1024 + lane * 16, xv);
            const float* gate = MOD + ((size_t)(l - 1) * 17 + s) * 6144 + 5 * 1024 + lane * 16;
#pragma unroll
            for (int ii = 0; ii < 4; ++ii) { const f32x4 gv = *(const f32x4*)(gate + ii * 4); v[ii] = xv[ii] + gv * ys[ii]; }
        }
        xrow_st(X + (size_t)row * 1024 + lane * 16, v);
        const float* m = MOD + ((size_t)l * 17 + s) * 6144;
        norm_mod_store(v, a.in[I_N1G] + l * 1024, m, m + 1024, XA + (size_t)row * 1024, lane);
    }
}
__device__ __forceinline__ void phase_n2(const Args& a, int l, int T) {
    const int tid = opaque_tid(), wid = tid >> 6, lane = tid & 63;
    const bf16_t* X = (const bf16_t*)(a.ws + WS_X); bf16_t* XA = (bf16_t*)(a.ws + WS_XA); const float* MOD = (const float*)(a.ws + WS_MOD);
    for (int row = blockIdx.x * 8 + wid; row < T; row += gridDim.x * 8) {
        const int s = sample_of(row);
        f32x4 v[4]; xrow_ld(X + (size_t)row * 1024 + lane * 16, v);
        const float* m = MOD + ((size_t)l * 17 + s) * 6144;
        norm_mod_store(v, a.in[I_N2G] + l * 1024, m + 3 * 1024, m + 4 * 1024, XA + (size_t)row * 1024, lane);
    }
}
__device__ __forceinline__ void phase_fin(const Args& a) {
    const int tid = opaque_tid(), wid = tid >> 6, lane = tid & 63;
    const bf16_t* X = (const bf16_t*)(a.ws + WS_X); const float* MOD = (const float*)(a.ws + WS_MOD); const unsigned char* Y8 = (const unsigned char*)(a.ws + WS_R1);
    for (int row = blockIdx.x * 8 + wid; row < NLAT; row += gridDim.x * 8) {
        const int s = sample_of(row);
        f32x4 ys[4], xv[4], v[4]; slot_sum(Y8, row, lane, ys); xrow_ld(X + (size_t)row * 1024 + lane * 16, xv);
        const float* gate = MOD + ((size_t)17 + s) * 6144 + 5 * 1024 + lane * 16;
        float ss = 0.f;
#pragma unroll
        for (int ii = 0; ii < 4; ++ii) { const f32x4 gv = *(const f32x4*)(gate + ii * 4); v[ii] = xv[ii] + gv * ys[ii];
            ss += v[ii][0] * v[ii][0] + v[ii][1] * v[ii][1] + v[ii][2] * v[ii][2] + v[ii][3] * v[ii][3]; }
        ss = wave_sum(ss);
        const float rstd = rsqrtf(ss * (1.0f / 1024.0f) + EPS);
#pragma unroll
        for (int ii = 0; ii < 4; ++ii) { const f32x4 g = *(const f32x4*)(a.in[I_FNG] + lane * 16 + ii * 4); *(f32x4*)(a.out + (size_t)row * 1024 + lane * 16 + ii * 4) = v[ii] * rstd * g; }
    }
}

namespace pg8 {
#define PG8_LAS __attribute__((address_space(3)))
typedef unsigned short bf16_t;
typedef short bf16x8 __attribute__((ext_vector_type(8)));
typedef float f32x4 __attribute__((ext_vector_type(4)));
typedef unsigned u32x4 __attribute__((ext_vector_type(4)));
constexpr int BM = 256, BK = 64, HALF = 128, HTB = HALF * BK * 2  , STAGE_BYTES = 8 * HTB, NXCD = 8, WGM = 8;

__host__ __device__ __forceinline__ int lds_byte(int r, int c) { const int st = (r >> 4) * 2 + (c >> 5), rr = r & 15, cc = c & 31, ob = rr * 64 + cc * 2; return st * 1024 + (ob ^ (((ob >> 9) & 1) << 5)); }
__host__ __device__ __forceinline__ void stage_rc(int b, int& R, int& C) { const int st = b / 1024, sb = b % 1024, swz = sb ^ (((sb >> 9) & 1) << 5); R = (st >> 1) * 16 + swz / 64; C = (st & 1) * 32 + (swz % 64) / 2; }
__host__ __device__ __forceinline__ int perm32(int rho) { const int n = rho >> 4, i = rho & 15; return 8 * (i >> 2) + 4 * n + (i & 3); }

struct Unit { int pm, pn; };
struct Gemm { const bf16_t* A; const bf16_t* Bt; int M, N, K; };

struct StaticOrder {
    int nM, nN, nwg, G, c;
    __host__ __device__ void init(int M, int N, int G_, int c_) { nM = M / BM; nN = N / BM; nwg = nM * nN; G = G_; c = c_; }
    __host__ __device__ bool next(int i, Unit& u) const {
        const long L = (long)i * G + c; if (L >= nwg) return false;
        int wgid = (int)L; { const int q = nwg / NXCD, r = nwg % NXCD, xcd = wgid % NXCD, off = wgid / NXCD; wgid = (xcd < r ? xcd * (q + 1) : r * (q + 1) + (xcd - r) * q) + off; }
        const int nig = WGM * nN, gid = wgid / nig, fm = gid * WGM, gsz = (nM - fm) < WGM ? (nM - fm) : WGM;
        u.pm = fm + ((wgid % nig) % gsz); u.pn = (wgid % nig) / gsz; return true;
    }
    __device__ __forceinline__ void a_ready(const Unit&) const {}
    __device__ __forceinline__ void done(const Unit&) const {}
};
template <class Epi, class Sched, bool STAMP = false>
__device__ __forceinline__ void gemm_phase(PG8_LAS unsigned char* lds, const Gemm g, const Sched& S, const Epi& E, unsigned long long* stamps) {
    const int tid = opaque_tid(), wid = __builtin_amdgcn_readfirstlane(tid >> 6), lane = tid & 63, wr = wid >> 2, wc = wid & 3, fr = lane & 15, fq = lane >> 4;
    const int K = g.K, nt = K / BK;
    int ts_lo = 0, ts_hi = 0, nts = 0; const unsigned long long rt_entry = STAMP ? (unsigned long long)wall_clock64() : 0ull;
#define PG8_STAMP() do { if (STAMP && wid == 0 && nts < 64) { const unsigned long long _c = (unsigned long long)clock64(); \
        ts_lo = (lane == nts) ? (int)(unsigned)_c : ts_lo; ts_hi = (lane == nts) ? (int)(unsigned)(_c >> 32) : ts_hi; ++nts; } } while (0)
    PG8_STAMP();
    unsigned voffA[2], voffB[2];
#pragma unroll
    for (int i = 0; i < 2; ++i) { int R, C; stage_rc(tid * 16 + i * 8192, R, C); const int Rb = Epi::PERM ? ((R & ~31) + perm32(R & 31)) : R;
        voffA[i] = (unsigned)(R * K + C) * 2u; voffB[i] = (unsigned)(Rb * K + C) * 2u; }
    const size_t kstep = (size_t)(BK * 2);
    const size_t hstep = (size_t)HALF * K * 2;
    const size_t tstep = 2 * hstep;
    const unsigned ldsw = (unsigned)wid * 1024u;
    const int aoff = lds_byte(wr * 64 + fr, fq * 8), boff = lds_byte(wc * 32 + fr, fq * 8);
#define PG8_SA(b, h) (((b) * 2 + (h)) * HTB)
#define PG8_SB(b, h) ((4 + (b) * 2 + (h)) * HTB)
#define PG8_STAGE(bufoff, gbase, voff) do { _Pragma("unroll") for (int _i = 0; _i < 2; ++_i) \
        __builtin_amdgcn_global_load_lds((const unsigned*)((const char*)(gbase) + (voff)[_i]), (PG8_LAS unsigned*)(lds + (bufoff) + ldsw + _i * 8192), 16, 0, 0); } while (0)
#define PG8_LDA(dst, b, h) do { _Pragma("unroll") for (int m = 0; m < 4; ++m) _Pragma("unroll") for (int k = 0; k < 2; ++k) dst[m][k] = *(const PG8_LAS bf16x8*)(lds + PG8_SA(b, h) + aoff + m * 2048 + k * 1024); } while (0)
#define PG8_LDB(dst, b, h) do { _Pragma("unroll") for (int n = 0; n < 2; ++n) _Pragma("unroll") for (int k = 0; k < 2; ++k) dst[n][k] = *(const PG8_LAS bf16x8*)(lds + PG8_SB(b, h) + boff + n * 2048 + k * 1024); } while (0)
#define PG8_MMA(ai, bj, At, Bt) do { __builtin_amdgcn_s_setprio(1); _Pragma("unroll") for (int m = 0; m < 4; ++m) _Pragma("unroll") for (int n = 0; n < 2; ++n) _Pragma("unroll") for (int k = 0; k < 2; ++k) \
        acc[ai][bj][m][n] = __builtin_amdgcn_mfma_f32_16x16x32_bf16(Bt[n][k], At[m][k], acc[ai][bj][m][n], 0, 0, 0); __builtin_amdgcn_s_setprio(0); } while (0)
#define PG8_WAIT_V(n) asm volatile("s_waitcnt vmcnt(" #n ")" ::: "memory")
#define PG8_WAIT_L(n) asm volatile("s_waitcnt lgkmcnt(" #n ")" ::: "memory")
#define PG8_BAR __builtin_amdgcn_s_barrier()
#define PG8_SCHED __builtin_amdgcn_sched_barrier(0)
    Unit cur, nxt; int ui = 0;
    if (!S.next(0, cur)) return;
    f32x4 acc[2][2][4][2];
#pragma unroll
    for (int a = 0; a < 2; ++a)
#pragma unroll
        for (int b = 0; b < 2; ++b)
#pragma unroll
            for (int m = 0; m < 4; ++m)
#pragma unroll
                for (int n = 0; n < 2; ++n) acc[a][b][m][n] = (f32x4){0.f, 0.f, 0.f, 0.f};
    bf16x8 At[4][2], B0[2][2], B1[2][2];
    const char* cA = (const char*)g.A + (size_t)cur.pm * tstep; const char* cB = (const char*)g.Bt + (size_t)cur.pn * tstep;
    S.a_ready(cur);
    PG8_STAGE(PG8_SB(0, 0), cB, voffB); PG8_STAGE(PG8_SA(0, 0), cA, voffA); PG8_STAGE(PG8_SB(0, 1), cB + hstep, voffB); PG8_STAGE(PG8_SA(0, 1), cA + hstep, voffA);
    if (wr == 1) PG8_BAR;
    PG8_WAIT_V(4); PG8_BAR;
    PG8_STAGE(PG8_SB(1, 0), cB + kstep, voffB); PG8_STAGE(PG8_SA(1, 0), cA + kstep, voffA); PG8_STAGE(PG8_SB(1, 1), cB + hstep + kstep, voffB);
    PG8_WAIT_V(6); PG8_BAR;
    PG8_STAMP();
    for (;;) {
        const bool has_next = S.next(ui + 1, nxt);
        const char* nA = has_next ? (const char*)g.A + (size_t)nxt.pm * tstep : cA; const char* nB = has_next ? (const char*)g.Bt + (size_t)nxt.pn * tstep : cB;
        for (int t = 0; t < nt; t += 2) {
            const bool last = (t == nt - 2);
            const char* a1 = cA + (size_t)(t + 1) * kstep;
            const char* a2 = last ? nA : cA + (size_t)(t + 2) * kstep; const char* b2 = last ? nB : cB + (size_t)(t + 2) * kstep;
            const char* a3 = a2 + kstep; const char* b3 = b2 + kstep;
            if (last && has_next) S.a_ready(nxt);
            PG8_LDB(B0, 0, 0); PG8_SCHED; PG8_LDA(At, 0, 0); PG8_STAGE(PG8_SA(1, 1), a1 + hstep, voffA);
            PG8_WAIT_L(8); PG8_BAR; PG8_WAIT_L(0); PG8_MMA(0, 0, At, B0); PG8_BAR; PG8_SCHED;
            PG8_LDB(B1, 0, 1); PG8_STAGE(PG8_SB(0, 0), b2, voffB);
            PG8_BAR; PG8_WAIT_L(0); PG8_MMA(0, 1, At, B1); PG8_BAR;
            PG8_LDA(At, 0, 1); PG8_STAGE(PG8_SA(0, 0), a2, voffA);
            PG8_BAR; PG8_WAIT_L(0); PG8_MMA(1, 0, At, B0); PG8_BAR; PG8_SCHED;
            PG8_STAGE(PG8_SB(0, 1), b2 + hstep, voffB);
            PG8_WAIT_V(6); PG8_BAR; PG8_MMA(1, 1, At, B1); PG8_BAR;
            PG8_LDB(B0, 1, 0); PG8_SCHED; PG8_LDA(At, 1, 0); PG8_STAGE(PG8_SA(0, 1), a2 + hstep, voffA);
            PG8_WAIT_L(8); PG8_BAR; PG8_WAIT_L(0); PG8_MMA(0, 0, At, B0); PG8_BAR; PG8_SCHED;
            PG8_LDB(B1, 1, 1); PG8_STAGE(PG8_SB(1, 0), b3, voffB);
            PG8_BAR; PG8_WAIT_L(0); PG8_MMA(0, 1, At, B1); PG8_BAR;
            PG8_LDA(At, 1, 1); PG8_STAGE(PG8_SA(1, 0), a3, voffA);
            PG8_BAR; PG8_WAIT_L(0); PG8_MMA(1, 0, At, B0); PG8_BAR; PG8_SCHED;
            PG8_STAGE(PG8_SB(1, 1), b3 + hstep, voffB);
            PG8_WAIT_V(6); PG8_BAR; PG8_MMA(1, 1, At, B1); PG8_BAR;
        }
        PG8_STAMP();
        if constexpr (!Epi::AFTER_DRAIN) { E(acc, cur, wr, wc, fr, fq); S.done(cur); }
        PG8_STAMP();
        if (!has_next) break;
#pragma unroll
        for (int a = 0; a < 2; ++a)
#pragma unroll
            for (int b = 0; b < 2; ++b)
#pragma unroll
                for (int m = 0; m < 4; ++m)
#pragma unroll
                    for (int n = 0; n < 2; ++n) acc[a][b][m][n] = (f32x4){0.f, 0.f, 0.f, 0.f};
        cur = nxt; cA = nA; cB = nB; ++ui;
    }
    PG8_WAIT_V(0);
    if (wr == 0) PG8_BAR;
    PG8_BAR;
    if constexpr (Epi::AFTER_DRAIN) { E.fused(acc, cur, wr, wc, fr, fq, lds, wid, lane); S.done(cur); }
    PG8_STAMP();
    if (STAMP && wid == 0) { stamps[lane] = lane < nts ? (((unsigned long long)(unsigned)ts_hi << 32) | (unsigned)ts_lo) : 0ull;
        if (lane == 62) stamps[62] = rt_entry; if (lane == 63) stamps[63] = (unsigned long long)wall_clock64(); }
#undef PG8_STAMP
#undef PG8_SA
#undef PG8_SB
#undef PG8_STAGE
#undef PG8_LDA
#undef PG8_LDB
#undef PG8_MMA
#undef PG8_WAIT_V
#undef PG8_WAIT_L
#undef PG8_BAR
#undef PG8_SCHED
}
}

struct EpiG1 {
    static constexpr bool PERM = true, AFTER_DRAIN = false;
    bf16_t* P; float* GATES;
    __device__ __forceinline__ void operator()(const f32x4 (&acc)[2][2][4][2], const pg8::Unit& u, int wr, int wc, int fr, int fq) const {
        const int row0 = u.pm * 256 + wr * 64 + fr;
#pragma unroll
        for (int bj = 0; bj < 2; ++bj) {
            const int cb = u.pn * 256 + bj * 128 + wc * 32;
            if (cb >= DIN) continue;
            if (cb >= PW) {
                if (fq < 2) {
#pragma unroll
                    for (int ai = 0; ai < 2; ++ai)
#pragma unroll
                        for (int m = 0; m < 4; ++m) { float* gp = GATES + (size_t)(row0 + ai * 128 + m * 16) * 16 + fq * 8; *(f32x4*)gp = acc[ai][bj][m][0]; *(f32x4*)(gp + 4) = acc[ai][bj][m][1]; }
                }
            } else {
                const bool g = (cb >= PC_RG && cb < PC_Q) || cb >= PC_CU;
                const float sc = (cb >= PC_K && cb < PC_V) ? 0.10206207261596575f : 1.0f;
#pragma unroll
                for (int ai = 0; ai < 2; ++ai)
#pragma unroll
                    for (int m = 0; m < 4; ++m) {
                        f32x4 v0 = acc[ai][bj][m][0], v1 = acc[ai][bj][m][1];
                        if (g) { v0[0] = gelu_tanh(v0[0]); v0[1] = gelu_tanh(v0[1]); v0[2] = gelu_tanh(v0[2]); v0[3] = gelu_tanh(v0[3]); v1[0] = gelu_tanh(v1[0]); v1[1] = gelu_tanh(v1[1]); v1[2] = gelu_tanh(v1[2]); v1[3] = gelu_tanh(v1[3]); }
                        else { v0 = v0 * sc; v1 = v1 * sc; }
                        u32x4 w; w.x = cvt_pk_bf16(v0[0], v0[1]); w.y = cvt_pk_bf16(v0[2], v0[3]); w.z = cvt_pk_bf16(v1[0], v1[1]); w.w = cvt_pk_bf16(v1[2], v1[3]);
                        *(u32x4*)(P + (size_t)(row0 + ai * 128 + m * 16) * PW + cb + fq * 8) = w;
                    }
            }
        }
    }
};
__device__ __forceinline__ void phase_g1(const Args& a, LAS unsigned char* lds, int l) {
    pg8::Gemm g{(const bf16_t*)(a.ws + WS_XA), (const bf16_t*)(a.ws + WS_WIN) + (size_t)l * NIN * 1024, TOK, NIN, 1024};
    pg8::StaticOrder S; S.init(TOK, NIN, (int)gridDim.x, (int)blockIdx.x);
    EpiG1 E{(bf16_t*)(a.ws + WS_P), (float*)(a.ws + WS_GATES)};
    pg8::gemm_phase<EpiG1, pg8::StaticOrder>(lds, g, S, E, nullptr);
}
struct EpiG2 {
    static constexpr bool PERM = true, AFTER_DRAIN = false;
    bf16_t* X; const float* MODl;
    __device__ __forceinline__ void operator()(const f32x4 (&acc)[2][2][4][2], const pg8::Unit& u, int wr, int wc, int fr, int fq) const {
        const int row0 = u.pm * 256 + wr * 64 + fr; const float* gate = MODl + (size_t)sample_of(u.pm * 256) * 6144 + 2 * 1024;
#pragma unroll
        for (int bj = 0; bj < 2; ++bj) {
            const int col = u.pn * 256 + bj * 128 + wc * 32 + fq * 8; const f32x4 g0 = *(const f32x4*)(gate + col), g1 = *(const f32x4*)(gate + col + 4);
#pragma unroll
            for (int ai = 0; ai < 2; ++ai)
#pragma unroll
                for (int m = 0; m < 4; ++m) { bf16_t* xp = X + (size_t)(row0 + ai * 128 + m * 16) * 1024 + col;
                    const u32x4 w = *(const u32x4*)xp; const f32x4 a0 = acc[ai][bj][m][0], a1 = acc[ai][bj][m][1]; u32x4 o;
                    o.x = cvt_pk_bf16(__uint_as_float(w.x << 16) + g0[0] * a0[0], __uint_as_float(w.x & 0xffff0000u) + g0[1] * a0[1]);
                    o.y = cvt_pk_bf16(__uint_as_float(w.y << 16) + g0[2] * a0[2], __uint_as_float(w.y & 0xffff0000u) + g0[3] * a0[3]);
                    o.z = cvt_pk_bf16(__uint_as_float(w.z << 16) + g1[0] * a1[0], __uint_as_float(w.z & 0xffff0000u) + g1[1] * a1[1]);
                    o.w = cvt_pk_bf16(__uint_as_float(w.w << 16) + g1[2] * a1[2], __uint_as_float(w.w & 0xffff0000u) + g1[3] * a1[3]);
                    *(u32x4*)xp = o; }
        }
    }
};
__device__ __forceinline__ void phase_g2(const Args& a, LAS unsigned char* lds, int l, int T) {
    pg8::Gemm g{(const bf16_t*)(a.ws + WS_MIX), (const bf16_t*)(a.ws + WS_WOUT) + (size_t)l * 1024 * 1024, T, 1024, 1024};
    pg8::StaticOrder S; S.init(T, 1024, (int)gridDim.x, (int)blockIdx.x);
    EpiG2 E{(bf16_t*)(a.ws + WS_X), (const float*)(a.ws + WS_MOD) + (size_t)l * 17 * 6144};
    pg8::gemm_phase<EpiG2, pg8::StaticOrder>(lds, g, S, E, nullptr);
}
struct EpiRT {
    static constexpr bool PERM = false, AFTER_DRAIN = false;
    float* LG;
    __device__ __forceinline__ void operator()(const f32x4 (&acc)[2][2][4][2], const pg8::Unit& u, int wr, int wc, int fr, int fq) const {
        const int row0 = u.pm * 256 + wr * 64 + fr;
#pragma unroll
        for (int bj = 0; bj < 2; ++bj)
#pragma unroll
            for (int n = 0; n < 2; ++n)
#pragma unroll
                for (int ai = 0; ai < 2; ++ai)
#pragma unroll
                    for (int m = 0; m < 4; ++m) *(f32x4*)(LG + (size_t)(row0 + ai * 128 + m * 16) * 256 + bj * 128 + wc * 32 + n * 16 + fq * 4) = acc[ai][bj][m][n];
    }
};
__device__ __forceinline__ void phase_rt(const Args& a, LAS unsigned char* lds, int l, int T) {
    pg8::Gemm g{(const bf16_t*)(a.ws + WS_XA), (const bf16_t*)(a.ws + WS_ROUT) + (size_t)l * 256 * 1024, T, 256, 1024};
    pg8::StaticOrder S; S.init(T, 256, (int)gridDim.x, (int)blockIdx.x);
    EpiRT E{(float*)(a.ws + WS_LOGITS)};
    pg8::gemm_phase<EpiRT, pg8::StaticOrder>(lds, g, S, E, nullptr);
}

template <int CTRL> __device__ __forceinline__ float dppf(float old, float src) { return __int_as_float(__builtin_amdgcn_update_dpp(__float_as_int(old), __float_as_int(src), CTRL, 0xF, 0xF, false)); }
constexpr int TK_MAXTOK = 512;
__device__ __forceinline__ void phase_tk(const Args& a, LAS unsigned char* lds, int l, int T) {
    const int tid = opaque_tid(), wid = tid >> 6, lane = tid & 63;
    const float* LG = (const float*)(a.ws + WS_LOGITS); const float* rb = a.in[I_RB] + l * 256;
    unsigned* CNT = (unsigned*)(a.ws + WS_CTL + CTL_CNT) + (size_t)l * 256 * CNT_STRIDE; int* LS = (int*)(a.ws + WS_LSLOT); float* LWt = (float*)(a.ws + WS_LW);
    LAS unsigned* lcnt = (LAS unsigned*)lds; LAS unsigned* lbase = lcnt + 256; LAS unsigned* ent = lbase + 256; LAS float* entw = (LAS float*)(ent + TK_MAXTOK * 8);
    const f32x4 bias = *(const f32x4*)(rb + lane * 4);
    const float NEG = -__builtin_huge_valf();
    const int per = (T + (int)gridDim.x - 1) / (int)gridDim.x;
    for (int base0 = blockIdx.x * per; base0 < (int)(blockIdx.x + 1) * per && base0 < T; base0 += TK_MAXTOK) {
        int ntok = (int)(blockIdx.x + 1) * per - base0; if (ntok > TK_MAXTOK) ntok = TK_MAXTOK; if (ntok > T - base0) ntok = T - base0;
        __syncthreads();
        if (tid < 256) lcnt[tid] = 0u;
        __syncthreads();
        for (int tl = wid; tl < ntok; tl += 8) {
            const int t = base0 + tl;
            const f32x4 lg = *(const f32x4*)(LG + (size_t)t * 256 + lane * 4);
            float sc[4], sel[4];
#pragma unroll
            for (int j = 0; j < 4; ++j) { sc[j] = 1.0f / (1.0f + expf(-lg[j])); sel[j] = sc[j] + bias[j]; }
            float a1 = fmaxf(sel[0], sel[1]), a2 = fminf(sel[0], sel[1]);
#pragma unroll
            for (int j = 2; j < 4; ++j) { const float v = sel[j]; a2 = fmaxf(a2, fminf(a1, v)); a1 = fmaxf(a1, v); }
#define TK_MERGE(CTRL) { const float b1 = dppf<CTRL>(a1, a1), b2 = dppf<CTRL>(a2, a2); const float n1 = fmaxf(a1, b1), n2 = fmaxf(fminf(a1, b1), fmaxf(a2, b2)); a1 = n1; a2 = n2; }
            TK_MERGE(0xB1) TK_MERGE(0x4E) TK_MERGE(0x141)
#undef TK_MERGE
            const float gs = a1 + a2; const int g = lane >> 3; int rank = 0;
#pragma unroll
            for (int g2 = 0; g2 < 8; ++g2) { const float s2 = __int_as_float(__builtin_amdgcn_readlane(__float_as_int(gs), g2 * 8)); rank += (s2 > gs || (s2 == gs && g2 < g)) ? 1 : 0; }
            float ms[4];
#pragma unroll
            for (int j = 0; j < 4; ++j) ms[j] = rank < 4 ? sel[j] : NEG;
            int my_e = 0; float my_s = 0.f, ssum = 0.f;
#pragma unroll
            for (int k = 0; k < 8; ++k) {
                float mx = fmaxf(fmaxf(ms[0], ms[1]), fmaxf(ms[2], ms[3]));
                mx = fmaxf(mx, dppf<0x111>(NEG, mx)); mx = fmaxf(mx, dppf<0x112>(NEG, mx)); mx = fmaxf(mx, dppf<0x114>(NEG, mx)); mx = fmaxf(mx, dppf<0x118>(NEG, mx));
                const float gmax = fmaxf(fmaxf(__int_as_float(__builtin_amdgcn_readlane(__float_as_int(mx), 15)), __int_as_float(__builtin_amdgcn_readlane(__float_as_int(mx), 31))),
                                         fmaxf(__int_as_float(__builtin_amdgcn_readlane(__float_as_int(mx), 47)), __int_as_float(__builtin_amdgcn_readlane(__float_as_int(mx), 63))));
                const int cand = ms[0] == gmax ? 0 : ms[1] == gmax ? 1 : ms[2] == gmax ? 2 : ms[3] == gmax ? 3 : -1;
                const unsigned long long bal = __ballot(cand >= 0);
                const int wl = __builtin_amdgcn_readfirstlane(__ffsll((unsigned long long)bal) - 1);
                const int jj = __builtin_amdgcn_readlane(cand, wl), bi = wl * 4 + jj;
                const float mysc = jj == 0 ? sc[0] : jj == 1 ? sc[1] : jj == 2 ? sc[2] : sc[3];
                const float sk = __int_as_float(__builtin_amdgcn_readlane(__float_as_int(mysc), wl));
#pragma unroll
                for (int j = 0; j < 4; ++j) if (lane == wl && j == jj) ms[j] = NEG;
                if (lane == k) { my_e = bi; my_s = sk; }
                ssum += sk;
            }
            if (lane < 8) {
                const unsigned r = __hip_atomic_fetch_add(&lcnt[my_e], 1u, __ATOMIC_RELAXED, __HIP_MEMORY_SCOPE_WORKGROUP);
                ent[tl * 8 + lane] = ((unsigned)my_e << 16) | r; entw[tl * 8 + lane] = my_s / ssum * 2.5f;
            }
        }
        __syncthreads();
        if (tid < 256) { const unsigned c = lcnt[tid]; lbase[tid] = c ? atomicAdd(&CNT[tid * CNT_STRIDE], c) : 0u; }
        __syncthreads();
        for (int i = tid; i < ntok * 8; i += NTHREADS) {
            const unsigned v = ent[i]; const int e = (int)(v >> 16); const unsigned pos = lbase[e] + (v & 0xffffu);
            LS[(size_t)e * LCAP + pos] = (base0 + (i >> 3)) * NSLOT + (i & 7); LWt[(size_t)e * LCAP + pos] = entw[i];
        }
    }
}

__device__ __forceinline__ void moe_tables(const Args& a, LAS unsigned char* lds, int l, int T) {
    LAS int* cntE = (LAS int*)(lds + LDS_TAB); LAS int* blkoff = cntE + 264;
    const int tid = opaque_tid(); const unsigned* CNT = (const unsigned*)(a.ws + WS_CTL + CTL_CNT) + (size_t)l * 256 * CNT_STRIDE;
    if (tid < 256) cntE[tid] = (int)CNT[tid * CNT_STRIDE]; else if (tid == 256) cntE[256] = T;
    __syncthreads();
    if (tid < 258) { int s = 0; for (int e = 0; e < tid && e < 257; ++e) s += (cntE[e] + 255) >> 8; blkoff[tid] = s; }
    __syncthreads();
}
__device__ __forceinline__ int moe_find(const LAS int* blkoff, int mbg) { int lo = 0, hi = 257; while (hi - lo > 1) { const int mid = (lo + hi) >> 1; if (blkoff[mid] <= mbg) lo = mid; else hi = mid; } return lo; }

#define PV_LOAD32(dst, ptr) asm volatile("global_load_dword %0, %1, off" : "=&v"(dst) : "v"(ptr))
__device__ __forceinline__ bool xcd_unit(int i, int ntile, int nmb, int& mbg, int& nt) {
    const int x = blockIdx.x & 7, j = blockIdx.x >> 3, vnr = ((int)gridDim.x - x + 7) >> 3, s = j + vnr * i, mbl = s / ntile;
    nt = s - mbl * ntile; mbg = x + 8 * mbl; return mbg < nmb;
}
struct E1Prov {
    const Args& a; LAS unsigned char* lds; int l, nunit, R0, R1, C0, C1, wr, wc, fr, fq; int q0, q1; bool sh;
    __device__ __forceinline__ void decode(int i, int& mbg, int& nt, int& e, int& mb, int& cnt) const {
        const LAS int* cntE = (const LAS int*)(lds + LDS_TAB); const LAS int* blkoff = cntE + 264;
        (void)xcd_unit(i, 3, nunit, mbg, nt); e = moe_find(blkoff, mbg); mb = mbg - blkoff[e]; cnt = cntE[e];
    }
    __device__ __forceinline__ bool seg(int i, RSeg& d) {
        { int m0, n0; if (!xcd_unit(i, 3, nunit, m0, n0)) return false; }
        int mbg, nt, e, mb, cnt; decode(i, mbg, nt, e, mb, cnt);
        const int* LS = (const int*)(a.ws + WS_LSLOT) + (e < 256 ? (size_t)e * LCAP : 0);
        const int p0 = mb * 256 + R0, p1 = mb * 256 + R1; sh = e >= 256; q0 = p0 < cnt ? p0 : -1; q1 = p1 < cnt ? p1 : -1;
        const int* a0 = LS + (q0 >= 0 && !sh ? q0 : 0); const int* a1 = LS + (q1 >= 0 && !sh ? q1 : 0);
        PV_LOAD32(d.aoff[0], a0); PV_LOAD32(d.aoff[1], a1);
        d.Ab = (const unsigned char*)(a.ws + WS_XA);
        d.B0 = (e < 256 ? a.in[I_EG] + ((size_t)l * 256 + e) * 1024 * FF : a.in[I_SG] + (size_t)l * 1024 * FF) + nt * 96;
        d.B1 = (e < 256 ? a.in[I_EU] + ((size_t)l * 256 + e) * 1024 * FF : a.in[I_SU] + (size_t)l * 1024 * FF) + nt * 96;
        return true;
    }
    __device__ __forceinline__ void finish(RSeg& d, bool first) const {
        if (first) asm volatile("s_waitcnt vmcnt(0)" ::: "memory"); else asm volatile("s_waitcnt vmcnt(16)" ::: "memory");
        __builtin_amdgcn_sched_barrier(0); asm volatile("" : "+v"(d.aoff[0]), "+v"(d.aoff[1]));
        const int t0 = q0 < 0 ? 0 : sh ? q0 : (int)d.aoff[0] / NSLOT, t1 = q1 < 0 ? 0 : sh ? q1 : (int)d.aoff[1] / NSLOT;
        d.aoff[0] = (unsigned)t0 * 2048u + (unsigned)C0 * 2u; d.aoff[1] = (unsigned)t1 * 2048u + (unsigned)C1 * 2u;
    }
    __device__ __forceinline__ void epi(int i, f32x4 (&acc)[4][6]) const {
        int mbg, nt, e, mb, cnt; decode(i, mbg, nt, e, mb, cnt);
        bf16_t* HB = (bf16_t*)(a.ws + WS_HB);
#pragma unroll
        for (int m = 0; m < 4; ++m) {
            bf16_t* hp = HB + (size_t)(mbg * 256 + wr * 64 + m * 16 + fr) * FF + nt * 96 + wc * 48 + fq * 4;
#pragma unroll
            for (int n = 0; n < 3; ++n) {
                const f32x4 g = acc[m][n], uu = acc[m][n + 3];
                u32x2 w; w.x = cvt_pk_bf16(siluf_(g[0]) * uu[0], siluf_(g[1]) * uu[1]); w.y = cvt_pk_bf16(siluf_(g[2]) * uu[2], siluf_(g[3]) * uu[3]);
                *(u32x2*)(hp + n * 16) = w;
            }
        }
    }
};
__device__ __forceinline__ void ring_piece_rc(int wid, int lane, int k, int& R, int& C) { const int sb = lane * 16, swz = sb ^ (((sb >> 9) & 1) << 5); R = (wid + 8 * k) * 16 + (swz >> 6); C = (swz & 63) >> 1; }
__device__ __forceinline__ void phase_e1(const Args& a, LAS unsigned char* lds, int l, int T) {
    const int tid = opaque_tid(), wid = __builtin_amdgcn_readfirstlane(tid >> 6), lane = tid & 63;
    moe_tables(a, lds, l, T);
    const LAS int* blkoff = (const LAS int*)(lds + LDS_TAB) + 264;
    int R0, C0, R1, C1; ring_piece_rc(wid, lane, 0, R0, C0); ring_piece_rc(wid, lane, 1, R1, C1);
    E1Prov pv{a, lds, l, blkoff[257], R0, R1, C0, C1, wid >> 1, wid & 1, lane & 15, lane >> 4, -1, -1, false};
    ring_gemm<192, 2, true, true, 2, E1Prov>(lds, pv, 32, FF, 0u, 0u);
}

struct E2Prov {
    const Args& a; LAS unsigned char* lds; int l, nunit, tid; int pslot; float pw; int pidx, ppos; bool psh;
    __device__ __forceinline__ void decode(int i, int& mbg, int& pn, int& e, int& mb, int& cnt) const {
        const LAS int* cntE = (const LAS int*)(lds + LDS_TAB); const LAS int* blkoff = cntE + 264;
        (void)xcd_unit(i, 4, nunit, mbg, pn); e = moe_find(blkoff, mbg); mb = mbg - blkoff[e]; cnt = cntE[e];
    }
    __device__ __forceinline__ bool seg(int i, RSeg& d) {
        { int m0, n0; if (!xcd_unit(i, 4, nunit, m0, n0)) return false; }
        int mbg, pn, e, mb, cnt; decode(i, mbg, pn, e, mb, cnt);
        const int pos = mb * 256 + (tid & 255); psh = e >= 256; ppos = (tid < 256 && pos < cnt) ? pos : -1; pidx = i;
        const size_t idx = (ppos >= 0 && !psh) ? (size_t)e * LCAP + pos : 0;
        const int* sp = (const int*)(a.ws + WS_LSLOT) + idx; const float* wp = (const float*)(a.ws + WS_LW) + idx;
        PV_LOAD32(pslot, sp); PV_LOAD32(pw, wp);
        d.Ab = (const unsigned char*)(a.ws + WS_HB) + (size_t)mbg * 256 * FF * 2;
        d.B0 = (e < 256 ? a.in[I_ED] + ((size_t)l * 256 + e) * FF * 1024 : a.in[I_SD] + (size_t)l * FF * 1024) + pn * 256; d.B1 = d.B0;
        return true;
    }
    __device__ __forceinline__ void finish(RSeg&, bool first) {
        if (first) asm volatile("s_waitcnt vmcnt(0)" ::: "memory"); else asm volatile("s_waitcnt vmcnt(16)" ::: "memory");
        __builtin_amdgcn_sched_barrier(0); asm volatile("" : "+v"(pslot), "+v"(pw));
        LAS int* tab = (LAS int*)(lds + LDS_TAB) + 528 + (pidx & 1) * 512;
        if (tid < 256) { tab[tid] = ppos < 0 ? -1 : psh ? ppos * NSLOT + 8 : pslot; ((LAS float*)tab)[256 + tid] = psh ? 1.0f : pw; }
    }
    __device__ __forceinline__ void epi(int i, f32x4 (&acc)[8][4]) const {
        int mbg, pn, e, mb, cnt; decode(i, mbg, pn, e, mb, cnt);
        const LAS int* tab = (const LAS int*)(lds + LDS_TAB) + 528 + (i & 1) * 512; unsigned char* Y8 = (unsigned char*)(a.ws + WS_R1);
        const int wr = tid >> 8, wc = (tid >> 6) & 3, fr = tid & 15, fq = (tid >> 4) & 3;
#pragma unroll
        for (int m = 0; m < 8; ++m) {
            const int r = wr * 128 + m * 16 + fr, slot = tab[r];
            if (slot >= 0) {
                const float w = ((const LAS float*)tab)[256 + r] * SLOT_SCALE; unsigned char* yp = Y8 + (size_t)slot * 1024 + pn * 256 + wc * 64 + fq * 16;
                u32x4 o; unsigned ow[4];
#pragma unroll
                for (int n = 0; n < 4; ++n) {
                    const f32x4 v = acc[m][n] * w;
                    const float c0 = __builtin_amdgcn_fmed3f(v[0], -SLOT_CLAMP, SLOT_CLAMP), c1 = __builtin_amdgcn_fmed3f(v[1], -SLOT_CLAMP, SLOT_CLAMP), c2 = __builtin_amdgcn_fmed3f(v[2], -SLOT_CLAMP, SLOT_CLAMP), c3 = __builtin_amdgcn_fmed3f(v[3], -SLOT_CLAMP, SLOT_CLAMP);
                    ow[n] = (unsigned)__builtin_amdgcn_cvt_pk_fp8_f32(c2, c3, __builtin_amdgcn_cvt_pk_fp8_f32(c0, c1, 0, false), true);
                }
                o.x = ow[0]; o.y = ow[1]; o.z = ow[2]; o.w = ow[3];
                *(u32x4*)yp = o;
            }
        }
    }
};
__device__ __forceinline__ void phase_e2(const Args& a, LAS unsigned char* lds, int l, int T) {
    const int tid = opaque_tid(), wid = __builtin_amdgcn_readfirstlane(tid >> 6), lane = tid & 63;
    moe_tables(a, lds, l, T);
    const LAS int* blkoff = (const LAS int*)(lds + LDS_TAB) + 264;
    int R0, C0, R1, C1; ring_piece_rc(wid, lane, 0, R0, C0); ring_piece_rc(wid, lane, 1, R1, C1);
    E2Prov pv{a, lds, l, blkoff[257], tid, -1, 0.f, -1, -1, false};
    ring_gemm<256, 4, false, false, 1, E2Prov>(lds, pv, 9, 1024, (unsigned)(R0 * FF * 2 + C0 * 2), (unsigned)(R1 * FF * 2 + C1 * 2));
}

__device__ __forceinline__ float logsigmoidf_(float x) { return fminf(x, 0.f) - log1pf(expf(-fabsf(x))); }

__device__ __forceinline__ void mlstm_gates(const float* GATES, int row0, int rstep, int gcol, float bi, float bfg, float m, LAS float* colterm, LAS float* Marr, LAS float* bcarr, int lane) {
    const int p0 = 2 * lane;
    const float* g0 = GATES + (size_t)(row0 + rstep * p0) * 16 + gcol; const float* g1 = g0 + rstep * 16;
    const float gi0 = g0[0] + bi, gi1 = g1[0] + bi, lf0 = logsigmoidf_(g0[4] + bfg), lf1 = logsigmoidf_(g1[4] + bfg);
    float s = lf0 + lf1;
#pragma unroll
    for (int o = 1; o < 64; o <<= 1) { const float t = __shfl_up(s, o); if (lane >= o) s += t; }
    const float bc1 = s, bc0 = s - lf1, ct0 = gi0 - bc0, ct1 = gi1 - bc1;
    float pm = fmaxf(ct0, ct1);
#pragma unroll
    for (int o = 1; o < 64; o <<= 1) { const float t = __shfl_up(pm, o); if (lane >= o) pm = fmaxf(pm, t); }
    float prev = __shfl_up(pm, 1); if (lane == 0) prev = -__builtin_huge_valf();
    const float pm0 = fmaxf(prev, ct0);
    colterm[p0] = ct0; colterm[p0 + 1] = ct1; bcarr[p0] = bc0; bcarr[p0 + 1] = bc1; Marr[p0] = fmaxf(m, pm0); Marr[p0 + 1] = fmaxf(m, pm);
}

__device__ __forceinline__ void ms_unit(const Args& a, LAS unsigned char* lds, int l, int b, int h, int d) {
    const int tid = opaque_tid(), wid = __builtin_amdgcn_readfirstlane(tid >> 6), lane = tid & 63, fr = lane & 15, fq = lane >> 4;
    LAS bf16_t* Ks = (LAS bf16_t*)(lds);
    LAS bf16_t* Vp = (LAS bf16_t*)(lds + 26624);
    LAS float* colterm = (LAS float*)(lds + 57344); LAS float* Marr = colterm + 128; LAS float* bcarr = Marr + 128;
    const bf16_t* P = (const bf16_t*)(a.ws + WS_P); const float* GATES = (const float*)(a.ws + WS_GATES);
    const int seq = (b * 4 + h) * 2 + d;
    bf16_t* CTG = (bf16_t*)(a.ws + WS_CTG) + (size_t)seq * 18 * (112 * 96); float* MST = (float*)(a.ws + WS_MST) + seq * 18;
    const float bi = a.in[I_MGB][((l * 2 + d) * 2 + 0) * 4 + h], bfg = a.in[I_MGB][((l * 2 + d) * 2 + 1) * 4 + h];
    const int rstep = d ? -1 : 1, gcol = d * 8 + h;
    int pp[3], pch[3];
#pragma unroll
    for (int i = 0; i < 3; ++i) { const int rem = tid + 512 * i; pp[i] = rem / 12; pch[i] = rem - pp[i] * 12; }
#define MS_ROW0(step) (((step) < 2 ? NLAT + b * CTXL : b * SEQ) + (d ? ((step) < 2 ? CTXL : SEQ) - 1 - ((step) < 2 ? (step) : (step) - 2) * 128 : ((step) < 2 ? (step) : (step) - 2) * 128))
    u32x4 kv[6]; float gq[4];
#define MS_FETCH(step) do { const int _r0 = MS_ROW0(step); \
        _Pragma("unroll") for (int i = 0; i < 6; ++i) kv[i] = *(const u32x4*)(P + (size_t)(_r0 + rstep * pp[i % 3]) * PW + (i < 3 ? PC_K : PC_V) + h * 96 + pch[i % 3] * 8); \
        { const float* g0 = GATES + (size_t)(_r0 + rstep * 2 * lane) * 16 + gcol; gq[0] = g0[0]; gq[1] = g0[4]; gq[2] = g0[rstep * 16]; gq[3] = g0[rstep * 16 + 4]; } } while (0)
    __syncthreads();
    for (int i = tid; i < 128 * 3; i += NTHREADS) { const int p = i / 3, q = i - p * 3; u32x4 v = (u32x4){0u, 0u, 0u, 0u}; if (q == 0) v.x = 0x3F80u; *(LAS u32x4*)(Vp + p * 120 + 96 + q * 8) = v; }
    f32x4 Cst[7];
#pragma unroll
    for (int cb = 0; cb < 7; ++cb) Cst[cb] = (f32x4){0.f, 0.f, 0.f, 0.f};
    float m = 0.f;
    MS_FETCH(0);
    for (int step = 0; step < 18; ++step) {
        const bool do_out = step >= 2 || l == 0;
        if (wid == 0) {
            const int p0 = 2 * lane;
            const float gi0 = gq[0] + bi, gi1 = gq[2] + bi, lf0 = logsigmoidf_(gq[1] + bfg), lf1 = logsigmoidf_(gq[3] + bfg);
            float s = lf0 + lf1;
#pragma unroll
            for (int o = 1; o < 64; o <<= 1) { const float t = __shfl_up(s, o); if (lane >= o) s += t; }
            const float bc1 = s, bc0 = s - lf1, ct0 = gi0 - bc0, ct1 = gi1 - bc1;
            float pm = fmaxf(ct0, ct1);
#pragma unroll
            for (int o = 1; o < 64; o <<= 1) { const float t = __shfl_up(pm, o); if (lane >= o) pm = fmaxf(pm, t); }
            float prev = __shfl_up(pm, 1); if (lane == 0) prev = -__builtin_huge_valf();
            const float pm0 = fmaxf(prev, ct0);
            colterm[p0] = ct0; colterm[p0 + 1] = ct1; bcarr[p0] = bc0; bcarr[p0 + 1] = bc1; Marr[p0] = fmaxf(m, pm0); Marr[p0 + 1] = fmaxf(m, pm);
        }
        if (do_out) {
            if (tid == 0) MST[step] = m;
            if (wid < 6) {
                bf16_t* cg = CTG + (size_t)step * (112 * 96) + wid * 16 + fr;
#pragma unroll
                for (int cb = 0; cb < 7; ++cb)
#pragma unroll
                    for (int j = 0; j < 4; ++j) cg[(cb * 16 + fq * 4 + j) * 96] = f2bf(Cst[cb][j]);
            }
        }
        __syncthreads();
        const float Mend = Marr[127], gsum = bcarr[127];
#pragma unroll
        for (int i = 0; i < 6; ++i) {
            const int p = pp[i % 3], ch = pch[i % 3];
            u32x4 v = kv[i];
            if (i < 3) {
                const float w = __expf(colterm[p] - Mend);
                v.x = cvt_pk_bf16(__uint_as_float(v.x << 16) * w, __uint_as_float(v.x & 0xffff0000u) * w); v.y = cvt_pk_bf16(__uint_as_float(v.y << 16) * w, __uint_as_float(v.y & 0xffff0000u) * w);
                v.z = cvt_pk_bf16(__uint_as_float(v.z << 16) * w, __uint_as_float(v.z & 0xffff0000u) * w); v.w = cvt_pk_bf16(__uint_as_float(v.w << 16) * w, __uint_as_float(v.w & 0xffff0000u) * w);
                *(LAS u32x4*)(Ks + p * 104 + ch * 8) = v;
            } else *(LAS u32x4*)(Vp + p * 120 + ch * 8) = v;
        }
        if (step + 1 < 18) MS_FETCH(step + 1);
        __syncthreads();
        const float decay = __expf(m - Mend);
        if (wid < 6) {
#pragma unroll
            for (int cb = 0; cb < 7; ++cb) Cst[cb] = Cst[cb] * decay;
#pragma unroll
            for (int ks = 0; ks < 4; ++ks) {
                const bf16x8 bk = trfrag(Ks, 104, ks * 32, wid * 16, fr, fq);
#pragma unroll
                for (int cb = 0; cb < 7; ++cb) Cst[cb] = MFMA(trfrag(Vp, 120, ks * 32, cb * 16, fr, fq), bk, Cst[cb]);
            }
        }
        m = gsum + Mend;
        __syncthreads();
    }
#undef MS_FETCH
#undef MS_ROW0
}

__device__ __forceinline__ void mo_unit(const Args& a, LAS unsigned char* lds, int l, int b, int h, int cidx) {
    const int tid = opaque_tid(), wid = __builtin_amdgcn_readfirstlane(tid >> 6), lane = tid & 63, fr = lane & 15, fq = lane >> 4;
    LAS bf16_t* Qi = (LAS bf16_t*)(lds);
    LAS bf16_t* Ki = (LAS bf16_t*)(lds + 26624);
    LAS bf16_t* Si = (LAS bf16_t*)(lds);
    LAS bf16_t* Vp = (LAS bf16_t*)(lds + 53248);
    LAS float* Hs = (LAS float*)(lds + 83968);
    LAS float* colterm = (LAS float*)(lds + 135168); LAS float* Marr = colterm + 128; LAS float* bcarr = Marr + 128;
    const bf16_t* P = (const bf16_t*)(a.ws + WS_P); const float* GATES = (const float*)(a.ws + WS_GATES); bf16_t* MIX = (bf16_t*)(a.ws + WS_MIX);
    const bool isctx = cidx >= 16; const int n = isctx ? cidx - 16 : cidx, nc = isctx ? 2 : 16, rowbase = (isctx ? NLAT + b * CTXL : b * SEQ) + n * 128;
    __syncthreads();
    for (int i = tid; i < 128 * 3; i += NTHREADS) { const int p = i / 3, q = i - p * 3; u32x4 v = (u32x4){0u, 0u, 0u, 0u}; if (q == 0) v.x = 0x3F80u; *(LAS u32x4*)(Vp + p * 120 + 96 + q * 8) = v; }
    for (int d = 0; d < 2; ++d) {
        const int seq = (b * 4 + h) * 2 + d, np = d ? nc - 1 - n : n, step = isctx ? np : 2 + np;
        const float m = ((const float*)(a.ws + WS_MST))[seq * 18 + step];
        const bf16_t* CT = (const bf16_t*)(a.ws + WS_CTG) + ((size_t)seq * 18 + step) * (112 * 96);
        const float bi = a.in[I_MGB][((l * 2 + d) * 2 + 0) * 4 + h], bfg = a.in[I_MGB][((l * 2 + d) * 2 + 1) * 4 + h];
        const int row0 = rowbase + (d ? 127 : 0), rstep = d ? -1 : 1;
        if (wid == 0) mlstm_gates(GATES, row0, rstep, d * 8 + h, bi, bfg, m, colterm, Marr, bcarr, lane);
#pragma unroll
        for (int i = 0; i < 9; ++i) {
            const int rem = tid + 512 * (i % 3), p = rem / 12, ch = rem - p * 12;
            const u32x4 v = *(const u32x4*)(P + (size_t)(row0 + rstep * p) * PW + PC_Q + (i / 3) * 384 + h * 96 + ch * 8);
            if (i < 3) *(LAS u32x4*)(Qi + p * 104 + ch * 8) = v; else if (i < 6) *(LAS u32x4*)(Ki + p * 104 + ch * 8) = v; else *(LAS u32x4*)(Vp + p * 120 + ch * 8) = v;
        }
        __syncthreads();
        f32x4 num[7], sacc[8];
        const int t = wid * 16 + fr; const float Mt = Marr[t];
#pragma unroll
        for (int cb = 0; cb < 7; ++cb) num[cb] = (f32x4){0.f, 0.f, 0.f, 0.f};
#pragma unroll
        for (int ks = 0; ks < 3; ++ks) {
            const bf16x8 bq = ldfrag(Qi, 104, wid * 16, ks * 32, fr, fq);
#pragma unroll
            for (int cb = 0; cb < 7; ++cb) num[cb] = MFMA(*(const bf16x8*)(CT + (cb * 16 + fr) * 96 + ks * 32 + fq * 8), bq, num[cb]);
#pragma unroll
            for (int sb = 0; sb < 8; ++sb) if (sb <= wid) { if (ks == 0) sacc[sb] = (f32x4){0.f, 0.f, 0.f, 0.f}; sacc[sb] = MFMA(ldfrag(Ki, 104, sb * 16, ks * 32, fr, fq), bq, sacc[sb]); }
        }
        { const float ei = __expf(m - Mt);
#pragma unroll
          for (int cb = 0; cb < 7; ++cb) num[cb] = num[cb] * ei; }
        __syncthreads();
#pragma unroll
        for (int sb = 0; sb < 8; ++sb) {
            u32x2 w; w.x = 0u; w.y = 0u;
            if (sb <= wid) {
                const f32x4 ct = *(const LAS f32x4*)(colterm + sb * 16 + fq * 4); float e[4];
#pragma unroll
                for (int j = 0; j < 4; ++j) { const int s = sb * 16 + fq * 4 + j; e[j] = (s <= t) ? sacc[sb][j] * __expf(ct[j] - Mt) : 0.f; }
                w.x = cvt_pk_bf16(e[0], e[1]); w.y = cvt_pk_bf16(e[2], e[3]);
            }
            *(LAS u32x2*)(Si + t * 136 + sb * 16 + fq * 4) = w;
        }
        __syncthreads();
#pragma unroll
        for (int ks = 0; ks < 4; ++ks) {
            const bf16x8 bs = ldfrag(Si, 136, wid * 16, ks * 32, fr, fq);
#pragma unroll
            for (int cb = 0; cb < 7; ++cb) num[cb] = MFMA(trfrag(Vp, 120, ks * 32, cb * 16, fr, fq), bs, num[cb]);
        }
        const float den = __shfl(num[6][0], fr);
        const float inv = 1.0f / fmaxf(fabsf(den), __expf(-(bcarr[t] + Mt)));
        LAS float* hp = Hs + (d ? 127 - t : t) * 100 + fq * 4;
#pragma unroll
        for (int cb = 0; cb < 6; ++cb) { f32x4 hv = num[cb] * inv; if (d) hv = hv + *(const LAS f32x4*)(hp + cb * 16); *(LAS f32x4*)(hp + cb * 16) = hv; }
        __syncthreads();
    }
    {
        const int tau = wid * 16 + (lane >> 2), c0 = (lane & 3) * 24;
        float hv[24], ss = 0.f;
#pragma unroll
        for (int i = 0; i < 6; ++i) { const f32x4 x = *(const LAS f32x4*)(Hs + tau * 100 + c0 + i * 4); hv[4 * i] = x[0]; hv[4 * i + 1] = x[1]; hv[4 * i + 2] = x[2]; hv[4 * i + 3] = x[3]; ss += x[0] * x[0] + x[1] * x[1] + x[2] * x[2] + x[3] * x[3]; }
        ss += __shfl_xor(ss, 1); ss += __shfl_xor(ss, 2);
        const float rstd = rsqrtf(ss * (1.0f / 96.0f) + EPS);
        const bf16_t* op = P + (size_t)(rowbase + tau) * PW + PC_O + h * 96 + c0; const float* ng = a.in[I_MNG] + l * 384 + h * 96 + c0;
        bf16_t* mp = MIX + (size_t)(rowbase + tau) * 1024 + 384 + h * 96 + c0;
#pragma unroll
        for (int i = 0; i < 3; ++i) {
            const u32x4 ow = *(const u32x4*)(op + i * 8); const unsigned oo[4] = {ow.x, ow.y, ow.z, ow.w}; unsigned r[4];
#pragma unroll
            for (int j = 0; j < 4; ++j) { const int c = i * 8 + 2 * j; r[j] = cvt_pk_bf16(sigmoidf_(__uint_as_float(oo[j] << 16)) * hv[c] * rstd * ng[c], sigmoidf_(__uint_as_float(oo[j] & 0xffff0000u)) * hv[c + 1] * rstd * ng[c + 1]); }
            *(u32x4*)(mp + i * 8) = (u32x4){r[0], r[1], r[2], r[3]};
        }
    }
}

template <int D> __device__ __forceinline__ void scan16(float& A, float& U) {
#define RG_STEP(o) { const float Ao = dppf<(D ? 0x100 : 0x110) | (o)>(1.0f, A), Uo = dppf<(D ? 0x100 : 0x110) | (o)>(0.0f, U); U = fmaf(A, Uo, U); A *= Ao; }
    RG_STEP(1) RG_STEP(2) RG_STEP(4) RG_STEP(8)
#undef RG_STEP
}
template <bool FINAL>
__device__ __forceinline__ void rg_unit(const Args& a, LAS unsigned char* lds, int l, int b, int hd, int cidx) {
    const int tid = opaque_tid(), wid = __builtin_amdgcn_readfirstlane(tid >> 6), lane = tid & 63, fr = lane & 15, fq = lane >> 4;
    LAS bf16_t* zi = (LAS bf16_t*)lds;
    LAS bf16_t* Wi = (LAS bf16_t*)(lds + 18432);
    LAS float* zf = (LAS float*)(lds + 55296);
    LAS float* cst = (LAS float*)(lds + 88064);
    LAS float* wagg = (LAS float*)(lds + 89600);
    LAS float* hin = (LAS float*)(lds + 97792);
    const bf16_t* P = (const bf16_t*)(a.ws + WS_P); bf16_t* MIX = (bf16_t*)(a.ws + WS_MIX);
    float* AGG = (float*)(a.ws + WS_RGAGG);
    const bool isctx = cidx >= 16; const int n = isctx ? cidx - 16 : cidx, nc = isctx ? 2 : 16, Tseg = isctx ? CTXL : SEQ, segbase = isctx ? NLAT + b * CTXL : b * SEQ, base = n * 128;
    const int c = lane, ch = hd * 64 + c;
    __syncthreads();
    { const bf16_t* wt = (const bf16_t*)(a.ws + WS_RGWT) + (size_t)((l * 2) * 6 + hd) * 8192;
#pragma unroll
      for (int i = 0; i < 4; ++i) { const int idx = tid + 512 * i, dd = idx >> 10, r = (idx >> 3) & 127, k8 = idx & 7; *(LAS u32x4*)(Wi + (dd * 128 + r) * 72 + k8 * 8) = *(const u32x4*)(wt + (size_t)dd * 6 * 8192 + r * 64 + k8 * 8); } }
    if (tid < 128) { const int dd = tid >> 6, cc = tid & 63;
        cst[(dd * 3 + 0) * 64 + cc] = -1.4426950408889634f * a.in[I_RGGB][((l * 2 + dd) * 2 + 0) * 384 + hd * 64 + cc]; cst[(dd * 3 + 1) * 64 + cc] = -1.4426950408889634f * a.in[I_RGGB][((l * 2 + dd) * 2 + 1) * 384 + hd * 64 + cc];
        cst[(dd * 3 + 2) * 64 + cc] = -8.0f * 1.4426950408889634f * log1pf(expf(-a.in[I_RGLAM][(l * 2 + dd) * 384 + hd * 64 + cc]));
        if (FINAL) {
            const int np = dd ? nc - 1 - n : n, step = isctx ? np : 2 + np; const float* ag = AGG + (size_t)((b * 6 + hd) * 2 + dd) * 18 * 128 + cc;
            float Av[17], Uv[17];
#pragma unroll
            for (int s2 = 0; s2 < 17; ++s2) { Av[s2] = 1.f; Uv[s2] = 0.f; if (s2 < step) { Av[s2] = ag[s2 * 128]; Uv[s2] = ag[s2 * 128 + 64]; } }
            float hv = 0.f;
#pragma unroll
            for (int s2 = 0; s2 < 17; ++s2) hv = Av[s2] * hv + Uv[s2];
            hin[dd * 64 + cc] = hv;
        } }
    {
        const float cw0 = a.in[I_RGCW][(l * 4 + 0) * 384 + ch], cw1 = a.in[I_RGCW][(l * 4 + 1) * 384 + ch], cw2 = a.in[I_RGCW][(l * 4 + 2) * 384 + ch], cw3 = a.in[I_RGCW][(l * 4 + 3) * 384 + ch], cbias = a.in[I_RGCB][l * 384 + ch];
        const int tl0 = wid * 16; const bf16_t* pp = P + (size_t)segbase * PW + PC_RX + ch;
#define RG_LD(pos) (((pos) >= 0 && (pos) < Tseg) ? bf2f(pp[(size_t)(pos) * PW]) : 0.f)
        float xv[19];
#pragma unroll
        for (int i = 0; i < 19; ++i) xv[i] = RG_LD(base + tl0 - 2 + i);
#pragma unroll
        for (int i = 0; i < 16; ++i) { const float z = cw0 * xv[i] + cw1 * xv[i + 1] + cw2 * xv[i + 2] + cw3 * xv[i + 3] + cbias; zf[(tl0 + i) * 64 + c] = z; zi[(tl0 + i) * 72 + c] = f2bf(z); }
#undef RG_LD
    }
    __syncthreads();
    const int tl = wid * 16 + fr;
    f32x4 ysum[4];
#pragma unroll
    for (int nb = 0; nb < 4; ++nb) ysum[nb] = (f32x4){0.f, 0.f, 0.f, 0.f};
    f32x4 Ad[2][4], Ud[2][4];
#pragma unroll
    for (int d = 0; d < 2; ++d) {
        f32x4 acc[8];
#pragma unroll
        for (int nb = 0; nb < 8; ++nb) acc[nb] = (f32x4){0.f, 0.f, 0.f, 0.f};
#pragma unroll
        for (int ks = 0; ks < 2; ++ks) {
            const bf16x8 bz = ldfrag(zi, 72, wid * 16, ks * 32, fr, fq);
#pragma unroll
            for (int nb = 0; nb < 8; ++nb) acc[nb] = MFMA(ldfrag(Wi + d * 128 * 72, 72, nb * 16, ks * 32, fr, fq), bz, acc[nb]);
        }
#pragma unroll
        for (int nb = 0; nb < 4; ++nb) {
            const int j0 = nb * 16 + fq * 4;
            const f32x4 z4 = *(const LAS f32x4*)(zf + tl * 64 + j0), br = *(const LAS f32x4*)(cst + (d * 3 + 0) * 64 + j0), bi4 = *(const LAS f32x4*)(cst + (d * 3 + 1) * 64 + j0), sp = *(const LAS f32x4*)(cst + (d * 3 + 2) * 64 + j0);
#pragma unroll
            for (int j = 0; j < 4; ++j) {
                const float rg = __builtin_amdgcn_rcpf(1.0f + __builtin_amdgcn_exp2f(fmaf(acc[nb][j], -1.4426950408889634f, br[j])));
                const float ig = __builtin_amdgcn_rcpf(1.0f + __builtin_amdgcn_exp2f(fmaf(acc[nb + 4][j], -1.4426950408889634f, bi4[j])));
                const float av = __builtin_amdgcn_exp2f(rg * sp[j]);
                Ad[d][nb][j] = av; Ud[d][nb][j] = __builtin_amdgcn_sqrtf(fmaxf(fmaf(-av, av, 1.0f), 0.f)) * (ig * z4[j]);
            }
        }
#pragma unroll
        for (int nb = 0; nb < 4; ++nb)
#pragma unroll
            for (int j = 0; j < 4; ++j) { float A = Ad[d][nb][j], U = Ud[d][nb][j]; if (d == 0) scan16<0>(A, U); else scan16<1>(A, U); Ad[d][nb][j] = A; Ud[d][nb][j] = U; }
        if (fr == (d ? 0 : 15)) {
#pragma unroll
            for (int nb = 0; nb < 4; ++nb) { *(LAS f32x4*)(wagg + ((d * 8 + wid) * 2 + 0) * 64 + nb * 16 + fq * 4) = Ad[d][nb]; *(LAS f32x4*)(wagg + ((d * 8 + wid) * 2 + 1) * 64 + nb * 16 + fq * 4) = Ud[d][nb]; }
        }
    }
    __syncthreads();
    {
        bf16_t* PF = (bf16_t*)(a.ws + WS_RGPF) + ((size_t)(segbase + base + tl) * 384 + hd * 64) * 4;
#pragma unroll
        for (int nb = 0; nb < 4; ++nb) {
            const int j0 = nb * 16 + fq * 4;
            f32x4 Ap[2], Up[2];
#pragma unroll
            for (int d = 0; d < 2; ++d) {
                f32x4 Aw = (f32x4){1.f, 1.f, 1.f, 1.f}, Uw = (f32x4){0.f, 0.f, 0.f, 0.f};
                for (int w2 = 0; w2 < 7; ++w2) { const int w = d ? 7 - w2 : w2; if (d ? (w > wid) : (w < wid)) { const f32x4 aw = *(const LAS f32x4*)(wagg + ((d * 8 + w) * 2 + 0) * 64 + j0), uw = *(const LAS f32x4*)(wagg + ((d * 8 + w) * 2 + 1) * 64 + j0); Uw = aw * Uw + uw; Aw = Aw * aw; } }
                Ap[d] = Aw * Ad[d][nb]; Up[d] = Ad[d][nb] * Uw + Ud[d][nb];
            }
            u32x4 w0, w1;
            w0.x = cvt_pk_bf16(Ap[0][0], Up[0][0]); w0.y = cvt_pk_bf16(Ap[1][0], Up[1][0]); w0.z = cvt_pk_bf16(Ap[0][1], Up[0][1]); w0.w = cvt_pk_bf16(Ap[1][1], Up[1][1]);
            w1.x = cvt_pk_bf16(Ap[0][2], Up[0][2]); w1.y = cvt_pk_bf16(Ap[1][2], Up[1][2]); w1.z = cvt_pk_bf16(Ap[0][3], Up[0][3]); w1.w = cvt_pk_bf16(Ap[1][3], Up[1][3]);
            *(u32x4*)(PF + j0 * 4) = w0; *(u32x4*)(PF + j0 * 4 + 8) = w1;
        }
        if (tid < 128) { const int dd = tid >> 6, cc = tid & 63; float A = 1.f, U = 0.f;
#pragma unroll
            for (int w2 = 0; w2 < 8; ++w2) { const int w = dd ? 7 - w2 : w2; const float aw = wagg[((dd * 8 + w) * 2 + 0) * 64 + cc], uw = wagg[((dd * 8 + w) * 2 + 1) * 64 + cc]; U = aw * U + uw; A *= aw; }
            const int np = dd ? nc - 1 - n : n, step = isctx ? np : 2 + np; float* ag = AGG + ((size_t)((b * 6 + hd) * 2 + dd) * 18 + step) * 128 + cc;
            ag[0] = A; ag[64] = U; }
    }
}

__device__ __forceinline__ void rgc_unit(const Args& a, LAS unsigned char* lds, int l, int b, int hd, int cidx) {
    const int tid = opaque_tid();
    LAS float* hin = (LAS float*)lds;
    const bf16_t* P = (const bf16_t*)(a.ws + WS_P); bf16_t* MIX = (bf16_t*)(a.ws + WS_MIX); const float* AGG = (const float*)(a.ws + WS_RGAGG);
    const bool isctx = cidx >= 16; const int n = isctx ? cidx - 16 : cidx, nc = isctx ? 2 : 16, rowbase = (isctx ? NLAT + b * CTXL : b * SEQ) + n * 128;
    __syncthreads();
    if (tid < 128) { const int dd = tid >> 6, cc = tid & 63;
        const int np = dd ? nc - 1 - n : n, step = isctx ? np : 2 + np; const float* ag = AGG + (size_t)((b * 6 + hd) * 2 + dd) * 18 * 128 + cc;
        float Av[17], Uv[17];
#pragma unroll
        for (int s2 = 0; s2 < 17; ++s2) { Av[s2] = 1.f; Uv[s2] = 0.f; if (s2 < step) { Av[s2] = ag[s2 * 128]; Uv[s2] = ag[s2 * 128 + 64]; } }
        float hv = 0.f;
#pragma unroll
        for (int s2 = 0; s2 < 17; ++s2) hv = Av[s2] * hv + Uv[s2];
        hin[dd * 64 + cc] = hv; }
    __syncthreads();
    const int c4 = (tid & 15) * 4;
    const f32x4 hf = *(const LAS f32x4*)(hin + c4), hb = *(const LAS f32x4*)(hin + 64 + c4);
#pragma unroll
    for (int i = 0; i < 4; ++i) {
        const size_t row = (size_t)rowbase + (tid >> 4) + 32 * i;
        const bf16_t* pf = (const bf16_t*)(a.ws + WS_RGPF) + (row * 384 + hd * 64 + c4) * 4;
        const u32x4 w0 = *(const u32x4*)pf, w1 = *(const u32x4*)(pf + 8);
        const u32x2 gw = *(const u32x2*)(P + row * PW + PC_RG + hd * 64 + c4);
        const unsigned ww[8] = {w0.x, w0.y, w0.z, w0.w, w1.x, w1.y, w1.z, w1.w};
        float y[4];
#pragma unroll
        for (int j = 0; j < 4; ++j) y[j] = __uint_as_float(ww[2 * j] << 16) * hf[j] + __uint_as_float(ww[2 * j] & 0xffff0000u) + __uint_as_float(ww[2 * j + 1] << 16) * hb[j] + __uint_as_float(ww[2 * j + 1] & 0xffff0000u);
        u32x2 o; o.x = cvt_pk_bf16(__uint_as_float(gw.x << 16) * y[0], __uint_as_float(gw.x & 0xffff0000u) * y[1]); o.y = cvt_pk_bf16(__uint_as_float(gw.y << 16) * y[2], __uint_as_float(gw.y & 0xffff0000u) * y[3]);
        *(u32x2*)(MIX + row * 1024 + hd * 64 + c4) = o;
    }
}

__device__ __forceinline__ void gmlp_unit(const Args& a, LAS unsigned char* lds, int l, int chunk) {
    const int tid = opaque_tid(), wid = __builtin_amdgcn_readfirstlane(tid >> 6), lane = tid & 63, fr = lane & 15, fq = lane >> 4;
    LAS bf16_t* vn = (LAS bf16_t*)lds;
    const bf16_t* P = (const bf16_t*)(a.ws + WS_P); bf16_t* MIX = (bf16_t*)(a.ws + WS_MIX);
    const int row0 = chunk * 128;
    __syncthreads();
    {
        const f32x4 g = *(const f32x4*)(a.in[I_CMNG] + l * 256 + lane * 4);
        u32x2 wv[16];
#pragma unroll
        for (int i = 0; i < 16; ++i) wv[i] = *(const u32x2*)(P + (size_t)(row0 + wid * 16 + i) * PW + PC_CV + lane * 4);
#pragma unroll
        for (int i = 0; i < 16; ++i) {
            const int s = wid * 16 + i;
            const u32x2 w = wv[i];
            const float v0 = __uint_as_float(w.x << 16), v1 = __uint_as_float(w.x & 0xffff0000u), v2 = __uint_as_float(w.y << 16), v3 = __uint_as_float(w.y & 0xffff0000u);
            const float ss = wave_sum(v0 * v0 + v1 * v1 + v2 * v2 + v3 * v3);
            const float rstd = rsqrtf(ss * (1.0f / 256.0f) + EPS);
            u32x2 o; o.x = cvt_pk_bf16(v0 * rstd * g[0], v1 * rstd * g[1]); o.y = cvt_pk_bf16(v2 * rstd * g[2], v3 * rstd * g[3]);
            *(LAS u32x2*)(vn + s * 264 + lane * 4) = o;
        }
    }
    __syncthreads();
    const int g = wid >> 1, th = wid & 1;
    const float* ws = a.in[I_CMW] + ((size_t)(l * 4 + g) * 128) * 128;
    f32x4 acc[4][4];
#pragma unroll
    for (int m = 0; m < 4; ++m)
#pragma unroll
        for (int n = 0; n < 4; ++n) acc[m][n] = (f32x4){0.f, 0.f, 0.f, 0.f};
#pragma unroll
    for (int ks = 0; ks < 4; ++ks) {
        bf16x8 bw[4];
#pragma unroll
        for (int m = 0; m < 4; ++m) {
            const float* wp = ws + (size_t)(th * 64 + m * 16 + fr) * 128 + ks * 32 + fq * 8;
            const f32x4 w0 = *(const f32x4*)wp, w1 = *(const f32x4*)(wp + 4);
            u32x4 pk; pk.x = cvt_pk_bf16(w0[0], w0[1]); pk.y = cvt_pk_bf16(w0[2], w0[3]); pk.z = cvt_pk_bf16(w1[0], w1[1]); pk.w = cvt_pk_bf16(w1[2], w1[3]);
            bw[m] = __builtin_bit_cast(bf16x8, pk);
        }
#pragma unroll
        for (int n = 0; n < 4; ++n) {
            const bf16x8 av = trfrag(vn, 264, ks * 32, g * 64 + n * 16, fr, fq);
#pragma unroll
            for (int m = 0; m < 4; ++m) acc[m][n] = MFMA(av, bw[m], acc[m][n]);
        }
    }
#pragma unroll
    for (int m = 0; m < 4; ++m) {
        const int t = th * 64 + m * 16 + fr; const float bsv = a.in[I_CMB][(l * 4 + g) * 128 + t];
#pragma unroll
        for (int n = 0; n < 4; ++n) {
            const int cc = g * 64 + n * 16 + fq * 4;
            const u32x2 uw = *(const u32x2*)(P + (size_t)(row0 + t) * PW + PC_CU + cc);
            const float u0 = __uint_as_float(uw.x << 16), u1 = __uint_as_float(uw.x & 0xffff0000u), u2 = __uint_as_float(uw.y << 16), u3 = __uint_as_float(uw.y & 0xffff0000u);
            u32x2 o; o.x = cvt_pk_bf16(u0 * (acc[m][n][0] + bsv), u1 * (acc[m][n][1] + bsv)); o.y = cvt_pk_bf16(u2 * (acc[m][n][2] + bsv), u3 * (acc[m][n][3] + bsv));
            *(u32x2*)(MIX + (size_t)(row0 + t) * 1024 + 768 + cc) = o;
        }
    }
}

#define MX_NEXT(head) ({ __syncthreads(); if (tid == 0) *qv = (int)atomicAdd(q + (head) * 64, 1u); __syncthreads(); *qv; })
__device__ __forceinline__ void phase_mxa(const Args& a, LAS unsigned char* lds, int l) {
    unsigned* q = (unsigned*)(a.ws + WS_CTL + CTL_QUEUE) + l * 8 * 64; LAS int* qv = (LAS int*)(lds + LDS_BARW - 16); const int tid = opaque_tid();
    const int nch = (l == 0) ? 18 : 18;
    for (;;) { const int u = MX_NEXT(0); if (u >= 128) break; ms_unit(a, lds, l, u >> 3, (u >> 1) & 3, u & 1); }
    for (;;) { const int u = MX_NEXT(1); if (u >= 16 * 6 * nch) break; rg_unit<false>(a, lds, l, u / (6 * nch), (u / nch) % 6, u % nch); }
    const int ngm = (l == 0 ? TOK : NLAT) / 128;
    for (;;) { const int u = MX_NEXT(2); if (u >= ngm) break; gmlp_unit(a, lds, l, u); }
}
__device__ __forceinline__ void phase_mxc(const Args& a, LAS unsigned char* lds, int l) {
    unsigned* q = (unsigned*)(a.ws + WS_CTL + CTL_QUEUE) + l * 8 * 64; LAS int* qv = (LAS int*)(lds + LDS_BARW - 16); const int tid = opaque_tid();
    const int nch = (l == 0) ? 18 : 16;
    for (;;) { const int u = MX_NEXT(3); if (u >= 16 * 4 * nch) break; mo_unit(a, lds, l, u / (4 * nch), (u / nch) & 3, u % nch); }
    for (;;) { const int u = MX_NEXT(4); if (u >= 16 * 6 * nch) break; rgc_unit(a, lds, l, u / (6 * nch), (u / nch) % 6, u % nch); }
}
#undef MX_NEXT

constexpr int N_PHASES = 22;
__global__ void __launch_bounds__(NTHREADS, 2) fwd_kernel(Args a) {
    extern __shared__ __attribute__((aligned(16))) unsigned char lds_raw[];
    LAS unsigned char* lds = (LAS unsigned char*)lds_raw;
    const int lo = a.ph_lo, hi = a.ph_hi;
    XcdBarrier bar; bar.bar = (unsigned*)(a.ws + WS_CTL); bar.x = 0; bar.st = (volatile LAS unsigned*)(lds + LDS_BARW);
    if (hi - lo > 1) {
        if (threadIdx.x == 0) { *(LAS u32x4*)(lds + LDS_BARW) = (u32x4){0u, 0u, 0u, 0u}; }
        __syncthreads();
        bar = xcd_barrier_post((unsigned*)(a.ws + WS_CTL), (volatile LAS unsigned*)(lds + LDS_BARW));
    }
#ifndef PHSEL
#define PHSEL 0xFFF
#endif
#define SELJ(j) (((PHSEL) >> (j)) & 1)
#define IN(k) (lo <= (k) && (k) < hi)
#ifndef PROBE_MASK
#define PROBE_MASK 0u
#endif
    unsigned long long t_ph = PROBE_MASK ? __builtin_amdgcn_s_memrealtime() : 0ull;
#define SEAM(k) do { if (IN(k) && IN((k) + 1)) xcd_barrier(bar); \
    if (PROBE_MASK) { if (((PROBE_MASK) >> (k)) & 1u) { const unsigned long long t1 = __builtin_amdgcn_s_memrealtime(); while (__builtin_amdgcn_s_memrealtime() < t1 + (t1 - t_ph)) __builtin_amdgcn_s_sleep(4); } \
        __syncthreads(); t_ph = __builtin_amdgcn_s_memrealtime(); } } while (0)
    if (SELJ(10) && IN(0)) { p0_mod(a, lds); p0_conv(a, lds); }
    SEAM(0);
    for (int l = 0; l < 2; ++l) {
        const int pb = 1 + 10 * l, T = (l == 0) ? TOK : NLAT;
        if (SELJ(0) && IN(pb + 0)) phase_n1(a, l);
        SEAM(pb + 0);
        if (SELJ(1) && IN(pb + 1)) phase_g1(a, lds, l);
        SEAM(pb + 1);
        if (SELJ(2) && IN(pb + 2)) phase_mxa(a, lds, l);
        SEAM(pb + 2);
        if (SELJ(3) && IN(pb + 3)) phase_mxc(a, lds, l);
        SEAM(pb + 3);
        if (SELJ(4) && IN(pb + 4)) phase_g2(a, lds, l, T);
        SEAM(pb + 4);
        if (SELJ(5) && IN(pb + 5)) phase_n2(a, l, T);
        SEAM(pb + 5);
        if (SELJ(6) && IN(pb + 6)) phase_rt(a, lds, l, T);
        SEAM(pb + 6);
        if (SELJ(7) && IN(pb + 7)) phase_tk(a, lds, l, T);
        SEAM(pb + 7);
        if (SELJ(8) && IN(pb + 8)) phase_e1(a, lds, l, T);
        SEAM(pb + 8);
        if (SELJ(9) && IN(pb + 9)) phase_e2(a, lds, l, T);
        SEAM(pb + 9);
    }
    if (SELJ(11) && IN(21)) phase_fin(a);
#undef IN
#undef SEAM
}

extern "C" void kernel_launch(void* const* d_in, const int* in_sizes, int n_in, void* d_out, int out_size, void* d_ws, size_t ws_size, hipStream_t stream) {
    static int grid = 0;
    if (grid == 0) {
        if (n_in != 29 || out_size != NLAT * D || ws_size < WS_END) { fprintf(stderr, "kernel_launch: unexpected shapes (n_in %d, out %d, ws %zu, need %zu)\n", n_in, out_size, ws_size, (size_t)WS_END); grid = -1; return; }
        int dev = 0, cus = 0, per_cu = 0;
        if (hipGetDevice(&dev) != hipSuccess || hipDeviceGetAttribute(&cus, hipDeviceAttributeMultiprocessorCount, dev) != hipSuccess) { grid = -1; return; }
        if (hipFuncSetAttribute((const void*)fwd_kernel, hipFuncAttributeMaxDynamicSharedMemorySize, LDS_BYTES) != hipSuccess) { fprintf(stderr, "kernel_launch: hipFuncSetAttribute failed\n"); grid = -1; return; }
        if (hipOccupancyMaxActiveBlocksPerMultiprocessor(&per_cu, (const void*)fwd_kernel, NTHREADS, LDS_BYTES) != hipSuccess || per_cu < 1) { fprintf(stderr, "kernel_launch: occupancy query says %d\n", per_cu); (void)hipGetLastError(); grid = -1; return; }
        grid = cus;
    }
    if (grid < 0) return;
    (void)hipMemsetAsync((char*)d_ws + WS_CTL, 0, CTL_BYTES, stream);
    Args a{};
    for (int i = 0; i < 29; ++i) a.in[i] = (const float*)d_in[i];
    a.out = (float*)d_out; a.ws = (unsigned char*)d_ws;
#if MK_PER_PHASE
    for (int p = 0; p < N_PHASES; ++p) { a.ph_lo = p; a.ph_hi = p + 1; hipLaunchKernelGGL(fwd_kernel, dim3(grid), dim3(NTHREADS), LDS_BYTES, stream, a); }
#else
    a.ph_lo = 0; a.ph_hi = N_PHASES;
    hipLaunchKernelGGL(fwd_kernel, dim3(grid), dim3(NTHREADS), LDS_BYTES, stream, a);
#endif
}
```

```cpp
#include <hip/hip_runtime.h>
#include <cstdio>
#include <cstdint>

#ifndef MK_PER_PHASE
#define MK_PER_PHASE 0
#endif

#define LAS __attribute__((address_space(3)))
typedef unsigned short bf16_t;
typedef short bf16x8 __attribute__((ext_vector_type(8)));
typedef float f32x4 __attribute__((ext_vector_type(4)));
typedef float f32x2 __attribute__((ext_vector_type(2)));
typedef unsigned u32x4 __attribute__((ext_vector_type(4)));
typedef unsigned u32x2 __attribute__((ext_vector_type(2)));

constexpr int D = 1024, NBATCH = 16, SEQ = 2048, CTXL = 256;
constexpr int NLAT = NBATCH * SEQ, NCTX = NBATCH * CTXL, TOK = NLAT + NCTX;
constexpr int DIN = 2832, PW = 2816, NIN = 3072;
constexpr int NE = 256, FF = 288, NSLOT = 9, LCAP = TOK;
constexpr int NTHREADS = 512;
constexpr int LDS_BYTES = 147456;
constexpr int LDS_TAB = 139264;
constexpr int LDS_BARW = LDS_BYTES - 16;
constexpr float EPS = 1e-6f;

constexpr int PC_RX = 0, PC_RG = 384, PC_Q = 768, PC_K = 1152, PC_V = 1536, PC_O = 1920, PC_CU = 2304, PC_CV = 2560;

constexpr size_t WS_CTL = 0, CTL_BYTES = 131072;
constexpr size_t CTL_QUEUE = 16384, CTL_CNT = 32768;
constexpr int CNT_STRIDE = 32;
constexpr size_t WS_MOD = 131072;
constexpr size_t WS_X = WS_MOD + 1048576;
constexpr size_t WS_XA = WS_X + (size_t)TOK * D * 4;
constexpr size_t WS_R1 = WS_XA + (size_t)TOK * D * 2;
constexpr size_t R1_BYTES = (size_t)TOK * NSLOT * D * 2;
constexpr size_t WS_P = WS_R1;
constexpr size_t WS_MIX = WS_P + (size_t)TOK * PW * 2;
constexpr size_t WS_CTG = WS_MIX + (size_t)TOK * D * 2;
constexpr size_t WS_MST = WS_CTG + (size_t)128 * 18 * 112 * 96 * 2;
constexpr size_t WS_RGAGG = WS_MST + 16384;
constexpr size_t WS_RGPF = WS_RGAGG + (size_t)192 * 18 * 128 * 4;
static_assert(WS_RGPF + (size_t)TOK * 384 * 4 * 2 <= WS_R1 + R1_BYTES, "aliases");
constexpr int HB_ROWS = (TOK * 8 / 256 + 256 + TOK / 256) * 256;
constexpr size_t WS_HB = WS_R1 + R1_BYTES;
constexpr size_t WS_GATES = WS_HB + (size_t)HB_ROWS * FF * 2 + 256;
constexpr size_t WS_LOGITS = WS_GATES + (size_t)TOK * 16 * 4;
constexpr size_t WS_LSLOT = WS_LOGITS + (size_t)TOK * 256 * 4;
constexpr size_t WS_LW = WS_LSLOT + (size_t)NE * LCAP * 4;
constexpr size_t WS_WIN = WS_LW + (size_t)NE * LCAP * 4;
constexpr size_t WS_WOUT = WS_WIN + (size_t)2 * NIN * D * 2;
constexpr size_t WS_ROUT = WS_WOUT + (size_t)2 * D * D * 2;
constexpr size_t WS_RGWT = WS_ROUT + (size_t)2 * NE * D * 2;
constexpr size_t WS_END = WS_RGWT + (size_t)2 * 2 * 6 * 128 * 64 * 2;

__device__ __forceinline__ float bf2f(bf16_t b) { return __uint_as_float(((unsigned)b) << 16); }
__device__ __forceinline__ unsigned cvt_pk_bf16(float lo, float hi) { unsigned r; asm volatile("v_cvt_pk_bf16_f32 %0, %1, %2" : "=v"(r) : "v"(lo), "v"(hi)); return r; }
__device__ __forceinline__ bf16_t f2bf(float f) { return (bf16_t)(cvt_pk_bf16(f, 0.f) & 0xffffu); }
__device__ __forceinline__ float sigmoidf_(float x) { return __builtin_amdgcn_rcpf(1.0f + __expf(-x)); }
__device__ __forceinline__ float siluf_(float x) { return x * __builtin_amdgcn_rcpf(1.0f + __expf(-x)); }
__device__ __forceinline__ float gelu_tanh(float x) { const float u = 1.5957691216057308f * (x + 0.044715f * x * x * x); return x * __builtin_amdgcn_rcpf(1.0f + __expf(-u)); }
__device__ __forceinline__ float wave_sum(float v) {
#pragma unroll
    for (int o = 32; o >= 1; o >>= 1) v += __shfl_xor(v, o);
    return v;
}
__device__ __forceinline__ int opaque_tid() { int t = threadIdx.x; asm volatile("" : "+v"(t)); return t; }
#define WAIT_VM0() asm volatile("s_waitcnt vmcnt(0)" ::: "memory")

#define XB_TMO      128
#define XB_XCNT(j)  (256  + 64 * (j))
#define XB_XSUB(j)  (1280 + 64 * (j))
#define XB_XGEN(j)  (2304 + 64 * (j))
#define XB_TOP      3328
#define XB_TOPGEN   3392
#define XCD_BAR_WORDS 3456
#define XB_SPIN_CAP (1u << 18)

__device__ __forceinline__ unsigned xb_ld(unsigned* p)              { return __hip_atomic_load(p, __ATOMIC_RELAXED, __HIP_MEMORY_SCOPE_AGENT); }
__device__ __forceinline__ unsigned xb_add(unsigned* p, unsigned v) { return __hip_atomic_fetch_add(p, v, __ATOMIC_RELAXED, __HIP_MEMORY_SCOPE_AGENT); }
__device__ __forceinline__ unsigned xb_xcc_id() { return (unsigned)__builtin_amdgcn_s_getreg((3 << 11) | 20) & 0xFu; }
#define XB_SPIN(cond, bar) do { unsigned _sp = 0; while (cond) { __builtin_amdgcn_s_sleep(1); \
    if ((++_sp & 255u) == 0u) { if (xb_ld(&(bar)[XB_TMO])) break; if (_sp > XB_SPIN_CAP) { atomicAdd(&(bar)[XB_TMO], 1u); break; } } } } while (0)

struct XcdBarrier { unsigned* bar; unsigned x; volatile LAS unsigned* st; };

__device__ __forceinline__ XcdBarrier xcd_barrier_post(unsigned* bar, volatile LAS unsigned* st) {
    XcdBarrier b; b.bar = bar; b.x = xb_xcc_id(); b.st = st;
    if (threadIdx.x == 0) (void)xb_add(&bar[XB_XCNT(b.x)], 1u);
    return b;
}
__device__ __forceinline__ void xcd_barrier_complete(unsigned* bar, unsigned x, unsigned& nloc, unsigned& nx) {
    const unsigned G = gridDim.x * gridDim.y * gridDim.z;
    unsigned sum, cnt, mine, sp = 0u;
    for (;;) {
        sum = 0u; cnt = 0u; mine = 0u;
#pragma unroll
        for (unsigned j = 0; j < 16; ++j) { const unsigned c = xb_ld(&bar[XB_XCNT(j)]); sum += c; cnt += (c > 0u) ? 1u : 0u; mine = (j == x) ? c : mine; }
        if (sum == G) break;
        __builtin_amdgcn_s_sleep(1);
        if ((++sp & 255u) == 0u) { if (xb_ld(&bar[XB_TMO])) break; if (sp > XB_SPIN_CAP) { atomicAdd(&bar[XB_TMO], 1u); break; } }
    }
    nloc = mine > 0u ? mine : 1u; nx = cnt > 0u ? cnt : 1u;
}
__device__ __forceinline__ void xcd_barrier(const XcdBarrier& b) {
    asm volatile("s_waitcnt vmcnt(0)" ::: "memory");
    __syncthreads();
    if (threadIdx.x == 0) {
        unsigned* bar = b.bar;
        __builtin_amdgcn_s_waitcnt(0);
        unsigned nloc = b.st[0], nx = b.st[1];
        if (nloc == 0u) { xcd_barrier_complete(bar, b.x, nloc, nx); b.st[0] = nloc; b.st[1] = nx; }
        const unsigned old = xb_add(&bar[XB_XSUB(b.x)], 1u);
        const unsigned gen = old / nloc;
        if (old + 1u == (gen + 1u) * nloc) {
            __builtin_amdgcn_fence(__ATOMIC_RELEASE, "agent");
            asm volatile("s_waitcnt vmcnt(0)" ::: "memory");
            const unsigned og = xb_add(&bar[XB_TOP], 1u);
            const unsigned tg = og / nx;
            if (og + 1u == (tg + 1u) * nx) xb_add(&bar[XB_TOPGEN], 1u);
            else XB_SPIN(xb_ld(&bar[XB_TOPGEN]) == tg, bar);
            __builtin_amdgcn_fence(__ATOMIC_ACQUIRE, "agent");
            xb_add(&bar[XB_XGEN(b.x)], 1u);
            asm volatile("s_waitcnt vmcnt(0)" ::: "memory");
        } else {
            XB_SPIN(xb_ld(&bar[XB_XGEN(b.x)]) == gen, bar);
            __builtin_amdgcn_fence(__ATOMIC_ACQUIRE, "agent");
            asm volatile("s_waitcnt vmcnt(0)" ::: "memory");
        }
    }
    __syncthreads();
}

struct Args { const float* in[29]; float* out; unsigned char* ws; int ph_lo, ph_hi; };
enum { I_X = 0, I_C, I_CTX, I_CCTX, I_N1G, I_N2G, I_WMOD, I_BMOD, I_WIN, I_RGCW, I_RGCB, I_RGGW, I_RGGB, I_RGLAM, I_MGB, I_MNG, I_CMNG, I_CMW, I_CMB,
       I_WOUT, I_RW, I_RB, I_EG, I_EU, I_ED, I_SG, I_SU, I_SD, I_FNG };

__device__ __forceinline__ int lds_byte(int r, int c) { const int st = (r >> 4) * 2 + (c >> 5), ob = (r & 15) * 64 + (c & 31) * 2; return st * 1024 + (ob ^ (((ob >> 9) & 1) << 5)); }
__device__ __forceinline__ void stage_rc(int b, int& R, int& C) { const int st = b >> 10, sb = b & 1023, swz = sb ^ (((sb >> 9) & 1) << 5); R = (st >> 1) * 16 + (swz >> 6); C = (st & 1) * 32 + ((swz & 63) >> 1); }

template <int BN, int WC> struct GT { static constexpr int WR = 8 / WC, MF = 256 / WR / 16, NF = BN / WC / 16, BP = BN / 64; };

typedef short s16x4 __attribute__((ext_vector_type(4)));
__device__ __forceinline__ bf16x8 trfrag(const LAS bf16_t* img, int pitch, int k0, int n0, int fr, int fq) {
    const LAS bf16_t* p = img + (k0 + 8 * fq + (fr >> 2)) * pitch + n0 + 4 * (fr & 3);
    const s16x4 lo = __builtin_amdgcn_ds_read_tr16_b64_v4i16((LAS s16x4*)p), hi = __builtin_amdgcn_ds_read_tr16_b64_v4i16((LAS s16x4*)(p + 4 * pitch));
    return __builtin_shufflevector(lo, hi, 0, 1, 2, 3, 4, 5, 6, 7);
}

constexpr int RS_SLOT = 34816, RS_BOFF = 16384;
struct RSeg { const unsigned char* Ab; unsigned aoff[2]; const float* B0; const float* B1; };
template <int BN, int WC, bool DUAL, bool GATHER, int NSET, class PV>
__device__ __forceinline__ void ring_gemm(LAS unsigned char* lds, PV& pv, const int ns, const int ldb, const unsigned ca0, const unsigned ca1) {
    constexpr int MF = GT<BN, WC>::MF, NF = GT<BN, WC>::NF, PITCH = BN == 192 ? 200 : 280, LPS = BN / 64, VPR = BN / 4;
    const int tid = opaque_tid(), wid = __builtin_amdgcn_readfirstlane(tid >> 6), lane = tid & 63, fr = lane & 15, fq = lane >> 4;
    const int wr = wid / WC, wc = wid % WC;
    const int obA = fr * 64 + fq * 16;
    const int aro = (wr * MF) * 1024 + (obA ^ (((obA >> 9) & 1) << 5));
    const unsigned ldsb = (unsigned)(size_t)lds + (unsigned)(RS_BOFF + ((8 * fq + (fr >> 2)) * PITCH + (DUAL ? 4 * (fr & 3) + wc * 48 : 16 * (fr & 3) + wc * (NF * 16))) * 2);
    constexpr int NTB = DUAL ? LPS : 1;
    unsigned bsoff_[NTB]; unsigned bdst_[NTB];
    bool bsel_[NTB];
#pragma unroll
    for (int i = 0; i < NTB; ++i) { const int e = tid + 512 * i, row = e / VPR, c4 = e % VPR; bsel_[i] = DUAL && c4 >= 24; bsoff_[i] = (unsigned)(row * ldb + 4 * (DUAL ? c4 % 24 : c4));
        bdst_[i] = (unsigned)(size_t)lds + (unsigned)(RS_BOFF + (row * PITCH + 4 * c4) * 2); }
#define bsoff(i) (DUAL ? bsoff_[DUAL ? (i) : 0] : bsoff_[0] + (unsigned)(8 * (i) * ldb))
#define bdst(i) (DUAL ? bdst_[DUAL ? (i) : 0] : bdst_[0] + (unsigned)(8 * (i) * PITCH * 2))
#define bsel(i) (DUAL ? bsel_[DUAL ? (i) : 0] : false)
    f32x4 acc[MF][NF];
#pragma unroll
    for (int m = 0; m < MF; ++m)
#pragma unroll
        for (int n = 0; n < NF; ++n) acc[m][n] = (f32x4){0.f, 0.f, 0.f, 0.f};
    RSeg ss, nx; int si = 0, sj = 0;
    bool have = pv.seg(0, ss); if (!have) return;
    pv.finish(ss, true);
    bool have_nx = pv.seg(1, nx);
    int staged = 0, g = 0, ci = 0, cj = 0;
    f32x4 r0[LPS], r1[NSET == 2 ? LPS : 1];
#define RS_STAGEA() do { _Pragma("unroll") for (int _i = 0; _i < 2; ++_i) __builtin_amdgcn_global_load_lds((const unsigned*)(ss.Ab + (GATHER ? ss.aoff[_i] : (_i ? ca1 : ca0)) + (size_t)sj * 64), (LAS unsigned*)(lds + (staged & 3) * RS_SLOT + (wid + 8 * _i) * 1024), 16, 0, 0); } while (0)
#define RS_LOADB(rr) do { if (DUAL) { _Pragma("unroll") for (int _i = 0; _i < LPS; ++_i) { const float* _p = (bsel(_i) ? ss.B1 : ss.B0) + bsoff(_i) + (size_t)(sj * 32) * ldb; \
            asm volatile("global_load_dwordx4 %0, %1, off" : "=&v"(rr[_i]) : "v"(_p)); } } \
        else { const float* _sb = ss.B0 + (size_t)(sj * 32) * ldb; _Pragma("unroll") for (int _i = 0; _i < LPS; ++_i) { const unsigned _o = bsoff(_i) * 4u; \
            asm volatile("global_load_dwordx4 %0, %1, %2" : "=&v"(rr[_i]) : "v"(_o), "s"(_sb)); } } } while (0)
#define RS_WAITB(rr, steady) do { if (steady) { if (NSET == 1) asm volatile("s_waitcnt vmcnt(2)" ::: "memory"); else if (LPS == 3) asm volatile("s_waitcnt vmcnt(7)" ::: "memory"); else asm volatile("s_waitcnt vmcnt(8)" ::: "memory"); } else asm volatile("s_waitcnt vmcnt(0)" ::: "memory"); \
        __builtin_amdgcn_sched_barrier(0);        \
        if (LPS == 3) asm volatile("" : "+v"(rr[0]), "+v"(rr[1]), "+v"(rr[2])); else asm volatile("" : "+v"(rr[0]), "+v"(rr[1]), "+v"(rr[2]), "+v"(rr[LPS > 3 ? 3 : 0])); } while (0)
#define RS_WRITEB(rr, slot) do { _Pragma("unroll") for (int _i = 0; _i < LPS; ++_i) { u32x2 _w; _w.x = cvt_pk_bf16(rr[_i][0], rr[_i][1]); _w.y = cvt_pk_bf16(rr[_i][2], rr[_i][3]); \
        asm volatile("ds_write_b64 %0, %1" :: "v"(bdst(_i) + (unsigned)((slot) * RS_SLOT)), "v"(_w) : "memory"); } } while (0)
#define RS_ADVANCE() do { ++staged; if (++sj == ns) { sj = 0; ++si; if (have_nx) pv.finish(nx, false); ss = nx; have = have_nx; have_nx = have ? pv.seg(si + 1, nx) : false; } } while (0)
#define RS_TR(dst, slot, off) asm volatile("ds_read_b64_tr_b16 %0, %1 offset:%2" : "=v"(dst) : "v"(ldsb + (unsigned)((slot) * RS_SLOT)), "n"(off))
#define RS_KSTEP(slot) do { bf16x8 At[MF], Bf[NF]; s16x4 _lo[NF], _hi[NF]; \
        _Pragma("unroll") for (int n = 0; n < NF; ++n) { \
            if (DUAL) { if (n < 3) { RS_TR(_lo[n], slot, (16 * (n % 3)) * 2); RS_TR(_hi[n], slot, (16 * (n % 3) + 4 * PITCH) * 2); } else { RS_TR(_lo[n], slot, (96 + 16 * (n % 3)) * 2); RS_TR(_hi[n], slot, (96 + 16 * (n % 3) + 4 * PITCH) * 2); } } \
            else { RS_TR(_lo[n], slot, (4 * n) * 2); RS_TR(_hi[n], slot, (4 * n + 4 * PITCH) * 2); } } \
        _Pragma("unroll") for (int m = 0; m < MF; ++m) At[m] = *(const LAS bf16x8*)(lds + (slot) * RS_SLOT + aro + m * 1024); \
        if (NF == 6) asm volatile("s_waitcnt lgkmcnt(0)" : "+v"(_lo[0]), "+v"(_hi[0]), "+v"(_lo[1]), "+v"(_hi[1]), "+v"(_lo[2]), "+v"(_hi[2]), "+v"(_lo[3]), "+v"(_hi[3]), "+v"(_lo[NF > 4 ? 4 : 0]), "+v"(_hi[NF > 4 ? 4 : 0]), "+v"(_lo[NF > 5 ? 5 : 1]), "+v"(_hi[NF > 5 ? 5 : 1])); \
        else asm volatile("s_waitcnt lgkmcnt(0)" : "+v"(_lo[0]), "+v"(_hi[0]), "+v"(_lo[1]), "+v"(_hi[1]), "+v"(_lo[2]), "+v"(_hi[2]), "+v"(_lo[3]), "+v"(_hi[3])); \
        _Pragma("unroll") for (int n = 0; n < NF; ++n) Bf[n] = __builtin_shufflevector(_lo[n], _hi[n], 0, 1, 2, 3, 4, 5, 6, 7); \
        _Pragma("unroll") for (int m = 0; m < MF; ++m) _Pragma("unroll") for (int n = 0; n < NF; ++n) acc[m][n] = __builtin_amdgcn_mfma_f32_16x16x32_bf16(Bf[n], At[m], acc[m][n], 0, 0, 0); __builtin_amdgcn_sched_barrier(0); } while (0)
#define RS_BARRIER() do { asm volatile("s_waitcnt lgkmcnt(0)" ::: "memory"); __builtin_amdgcn_s_barrier(); asm volatile("" ::: "memory"); } while (0)
    if (NSET == 2) {
        RS_STAGEA(); RS_LOADB(r0); RS_WAITB(r0, false); RS_WRITEB(r0, 0); RS_ADVANCE();
        if (have) { RS_STAGEA(); RS_LOADB(r1); RS_ADVANCE(); }
        if (have) { RS_STAGEA(); RS_LOADB(r0); RS_ADVANCE(); }
    } else {
        RS_STAGEA(); RS_LOADB(r0); RS_WAITB(r0, false); RS_WRITEB(r0, 0); RS_ADVANCE();
        if (have) { RS_STAGEA(); RS_LOADB(r0); RS_ADVANCE(); }
    }
    WAIT_VM0(); RS_BARRIER();
#define RS_ITER(rw, STEADY) do { \
        const bool st = have; \
        if (st) RS_STAGEA(); \
        RS_KSTEP(g & 3); \
        if (++cj == ns) { pv.epi(ci, acc); _Pragma("unroll") for (int m = 0; m < MF; ++m) _Pragma("unroll") for (int n = 0; n < NF; ++n) acc[m][n] = (f32x4){0.f, 0.f, 0.f, 0.f}; cj = 0; ++ci; } \
        if (g + 1 < staged) { RS_WAITB(rw, STEADY); RS_WRITEB(rw, (g + 1) & 3); } \
        if (st) { RS_LOADB(rw); RS_ADVANCE(); } \
        st_prev = st; ++g; RS_BARRIER(); } while (0)
    bool st_prev = true;
    if (NSET == 2) {
        for (;;) {
            RS_ITER(r1, st && st_prev); if (g >= staged) break;
            RS_ITER(r0, st && st_prev); if (g >= staged) break;
        }
    } else {
        for (;;) { RS_ITER(r0, st); if (g >= staged) break; }
    }
    WAIT_VM0(); __syncthreads();
#undef RS_STAGEA
#undef RS_LOADB
#undef RS_WAITB
#undef RS_WRITEB
#undef RS_ADVANCE
#undef RS_TR
#undef RS_KSTEP
#undef RS_BARRIER
#undef RS_ITER
#undef bsoff
#undef bdst
#undef bsel
}

__device__ __forceinline__ bf16x8 ldfrag(const LAS bf16_t* img, int pitch, int row0, int k0, int fr, int fq) { return *(const LAS bf16x8*)(img + (row0 + fr) * pitch + k0 + fq * 8); }
#define MFMA(a, b, c) __builtin_amdgcn_mfma_f32_16x16x32_bf16(a, b, c, 0, 0, 0)

__device__ __forceinline__ void p0_mod(const Args& a, LAS unsigned char* lds) {
    { bf16_t* wt = (bf16_t*)(a.ws + WS_RGWT);
      for (int idx = blockIdx.x * NTHREADS + threadIdx.x; idx < 2 * 2 * 2 * 6 * 4096; idx += gridDim.x * NTHREADS) { const int j = idx & 63, i = (idx >> 6) & 63, hd = (idx >> 12) % 6, g = ((idx >> 12) / 6) & 1, ld = (idx >> 12) / 12;
          wt[((size_t)(ld * 6 + hd) * 128 + g * 64 + j) * 64 + i] = f2bf(a.in[I_RGGW][idx]); } }
    LAS float* sc = (LAS float*)lds;
    LAS float* red = (LAS float*)(lds + 69632);
    const int tid = opaque_tid();
    for (int i = tid; i < 17 * 1024; i += NTHREADS) { const int s = i >> 10, k = i & 1023; const float v = s < 16 ? a.in[I_C][s * 1024 + k] : a.in[I_CCTX][k]; sc[i] = siluf_(v); }
    __syncthreads();
    float* MOD = (float*)(a.ws + WS_MOD);
    for (int u = blockIdx.x; u < 192; u += gridDim.x) {
        const int l = u / 96, cb = (u % 96) * 64, col = tid & 63, ks = tid >> 6;
        const float* w = a.in[I_WMOD] + (size_t)l * 1024 * 6144 + cb + col;
        float acc[17];
#pragma unroll
        for (int s = 0; s < 17; ++s) acc[s] = 0.f;
#pragma unroll 4
        for (int k = ks * 128; k < ks * 128 + 128; ++k) {
            const float wv = w[(size_t)k * 6144];
#pragma unroll
            for (int s = 0; s < 17; ++s) acc[s] += sc[s * 1024 + k] * wv;
        }
#pragma unroll
        for (int s = 0; s < 17; ++s) red[(ks * 17 + s) * 64 + col] = acc[s];
        __syncthreads();
        for (int i = tid; i < 17 * 64; i += NTHREADS) {
            const int s = i >> 6, c = i & 63; float v = 0.f;
#pragma unroll
            for (int k2 = 0; k2 < 8; ++k2) v += red[(k2 * 17 + s) * 64 + c];
            MOD[((size_t)l * 17 + s) * 6144 + cb + c] = v + a.in[I_BMOD][l * 6144 + cb + c];
        }
        __syncthreads();
    }
}

template <int KT>
__device__ __forceinline__ void conv_tile(LAS float* tile, const float* p0, const float* p1, const float* p2, const float* p3, int ldn, int k0, bf16_t* dst, int K) {
    const int tid = opaque_tid(), r = tid >> 4, c4 = tid & 15, grp = c4 >> 2, within = (c4 & 3) * 4;
    const float* p = grp == 0 ? p0 : grp == 1 ? p1 : grp == 2 ? p2 : p3;
#pragma unroll
    for (int i = 0; i < KT / 32; ++i) {
        const int k = r + 32 * i; f32x4 v = (f32x4){0.f, 0.f, 0.f, 0.f};
        if (p) v = *(const f32x4*)(p + (size_t)(k0 + k) * ldn + within);
        tile[k * 65 + c4 * 4 + 0] = v[0]; tile[k * 65 + c4 * 4 + 1] = v[1]; tile[k * 65 + c4 * 4 + 2] = v[2]; tile[k * 65 + c4 * 4 + 3] = v[3];
    }
    __syncthreads();
    constexpr int CPR = KT / 16;
    const int row = tid / CPR, ch = tid % CPR;
    if (row < 64) {
        float v[16];
#pragma unroll
        for (int j = 0; j < 16; ++j) v[j] = tile[(ch * 16 + j) * 65 + row];
        u32x4 w0, w1;
        w0.x = cvt_pk_bf16(v[0], v[1]); w0.y = cvt_pk_bf16(v[2], v[3]); w0.z = cvt_pk_bf16(v[4], v[5]); w0.w = cvt_pk_bf16(v[6], v[7]);
        w1.x = cvt_pk_bf16(v[8], v[9]); w1.y = cvt_pk_bf16(v[10], v[11]); w1.z = cvt_pk_bf16(v[12], v[13]); w1.w = cvt_pk_bf16(v[14], v[15]);
        bf16_t* dp = dst + (size_t)row * K + k0 + ch * 16;
        *(u32x4*)dp = w0; *(u32x4*)(dp + 8) = w1;
    }
    __syncthreads();
}

constexpr int CV_WIN = 384, CV_WOUT = 128, CV_ROUT = 32, CV_LAYER = CV_WIN + CV_WOUT + CV_ROUT;
__device__ __forceinline__ void p0_conv(const Args& a, LAS unsigned char* lds) {
    LAS float* tile = (LAS float*)lds;
    for (int u = blockIdx.x; u < 2 * CV_LAYER; u += gridDim.x) {
        const int l = u / CV_LAYER; int j = u % CV_LAYER;
        if (j < CV_WIN) {
            const int rho0 = (j >> 3) * 64, kt = j & 7; const float* src = a.in[I_WIN] + (size_t)l * 1024 * DIN; const float* p[4];
#pragma unroll
            for (int g = 0; g < 4; ++g) { const int rho = rho0 + 16 * g; const int col = rho < 2304 ? rho : rho < 2816 ? rho + 16 : rho < 2832 ? rho - 512 : -1; p[g] = col >= 0 ? src + col : nullptr; }
            conv_tile<128>(tile, p[0], p[1], p[2], p[3], DIN, kt * 128, (bf16_t*)(a.ws + WS_WIN) + ((size_t)l * NIN + rho0) * 1024, 1024);
            continue;
        }
        j -= CV_WIN;
        if (j < CV_WOUT) {
            const int rho0 = (j >> 3) * 64, kt = j & 7; const float* src = a.in[I_WOUT] + (size_t)l * 1024 * 1024 + rho0;
            conv_tile<128>(tile, src, src + 16, src + 32, src + 48, 1024, kt * 128, (bf16_t*)(a.ws + WS_WOUT) + ((size_t)l * 1024 + rho0) * 1024, 1024);
            continue;
        }
        j -= CV_WOUT;
        if (j < CV_ROUT) {
            const int rho0 = (j >> 3) * 64, kt = j & 7; const float* src = a.in[I_RW] + (size_t)l * 1024 * 256 + rho0;
            conv_tile<128>(tile, src, src + 16, src + 32, src + 48, 256, kt * 128, (bf16_t*)(a.ws + WS_ROUT) + ((size_t)l * 256 + rho0) * 1024, 1024);
            continue;
        }
    }
}

__device__ __forceinline__ int sample_of(int row) { return row < NLAT ? (row >> 11) : 16; }

constexpr float SLOT_SCALE = 16.0f, SLOT_CLAMP = 240.0f;
typedef float f32x2 __attribute__((ext_vector_type(2)));
__device__ __forceinline__ void slot_sum(const unsigned char* Y8, int row, int lane, f32x4 (&s)[4]) {
#pragma unroll
    for (int ii = 0; ii < 4; ++ii) s[ii] = (f32x4){0.f, 0.f, 0.f, 0.f};
    u32x4 w[NSLOT];
#pragma unroll
    for (int k = 0; k < NSLOT; ++k) w[k] = *(const u32x4*)(Y8 + ((size_t)row * NSLOT + k) * 1024 + lane * 16);
#pragma unroll
    for (int k = 0; k < NSLOT; ++k) {
        const unsigned ww[4] = {w[k].x, w[k].y, w[k].z, w[k].w};
#pragma unroll
        for (int ii = 0; ii < 4; ++ii) { const f32x2 lo = __builtin_amdgcn_cvt_pk_f32_fp8((int)ww[ii], false), hi = __builtin_amdgcn_cvt_pk_f32_fp8((int)ww[ii], true); s[ii][0] += lo[0]; s[ii][1] += lo[1]; s[ii][2] += hi[0]; s[ii][3] += hi[1]; }
    }
#pragma unroll
    for (int ii = 0; ii < 4; ++ii) s[ii] = s[ii] * (1.0f / SLOT_SCALE);
}
__device__ __forceinline__ void xrow_ld(const bf16_t* p, f32x4 (&v)[4]) {
    const u32x4 w0 = *(const u32x4*)p, w1 = *(const u32x4*)(p + 8);
    v[0] = (f32x4){__uint_as_float(w0.x << 16), __uint_as_float(w0.x & 0xffff0000u), __uint_as_float(w0.y << 16), __uint_as_float(w0.y & 0xffff0000u)};
    v[1] = (f32x4){__uint_as_float(w0.z << 16), __uint_as_float(w0.z & 0xffff0000u), __uint_as_float(w0.w << 16), __uint_as_float(w0.w & 0xffff0000u)};
    v[2] = (f32x4){__uint_as_float(w1.x << 16), __uint_as_float(w1.x & 0xffff0000u), __uint_as_float(w1.y << 16), __uint_as_float(w1.y & 0xffff0000u)};
    v[3] = (f32x4){__uint_as_float(w1.z << 16), __uint_as_float(w1.z & 0xffff0000u), __uint_as_float(w1.w << 16), __uint_as_float(w1.w & 0xffff0000u)};
}
__device__ __forceinline__ void xrow_st(bf16_t* p, const f32x4 (&v)[4]) {
    u32x4 w0, w1;
    w0.x = cvt_pk_bf16(v[0][0], v[0][1]); w0.y = cvt_pk_bf16(v[0][2], v[0][3]); w0.z = cvt_pk_bf16(v[1][0], v[1][1]); w0.w = cvt_pk_bf16(v[1][2], v[1][3]);
    w1.x = cvt_pk_bf16(v[2][0], v[2][1]); w1.y = cvt_pk_bf16(v[2][2], v[2][3]); w1.z = cvt_pk_bf16(v[3][0], v[3][1]); w1.w = cvt_pk_bf16(v[3][2], v[3][3]);
    *(u32x4*)p = w0; *(u32x4*)(p + 8) = w1;
}
__device__ __forceinline__ void norm_mod_store(const f32x4 (&v)[4], const float* g, const float* shift, const float* scale, bf16_t* dst, int lane) {
    float ss = 0.f;
#pragma unroll
    for (int ii = 0; ii < 4; ++ii) ss += v[ii][0] * v[ii][0] + v[ii][1] * v[ii][1] + v[ii][2] * v[ii][2] + v[ii][3] * v[ii][3];
    ss = wave_sum(ss);
    const float rstd = rsqrtf(ss * (1.0f / 1024.0f) + EPS);
    f32x4 y[4];
#pragma unroll
    for (int ii = 0; ii < 4; ++ii) {
        const int c = lane * 16 + ii * 4;
        const f32x4 gg = *(const f32x4*)(g + c), sh = *(const f32x4*)(shift + c), sc = *(const f32x4*)(scale + c);
#pragma unroll
        for (int j = 0; j < 4; ++j) y[ii][j] = v[ii][j] * rstd * gg[j] * (1.0f + sc[j]) + sh[j];
    }
    xrow_st(dst + lane * 16, y);
}

__device__ __forceinline__ void phase_n1(const Args& a, int l) {
    const int tid = opaque_tid(), wid = tid >> 6, lane = tid & 63;
    bf16_t* X = (bf16_t*)(a.ws + WS_X); bf16_t* XA = (bf16_t*)(a.ws + WS_XA); const float* MOD = (const float*)(a.ws + WS_MOD); const unsigned char* Y8 = (const unsigned char*)(a.ws + WS_R1);
    for (int row = blockIdx.x * 8 + wid; row < TOK; row += gridDim.x * 8) {
        const int s = sample_of(row);
        f32x4 v[4];
        if (l == 0) {
            if (row < NLAT) {
                const float* xp = a.in[I_X] + (size_t)row * 1024 + lane * 16;
                const int tp = row & 2047; const int seg = lane >> 4; const float pos = (seg & 2) ? (float)(tp & 63) : (float)(tp >> 6);
#pragma unroll
                for (int ii = 0; ii < 4; ++ii) v[ii] = *(const f32x4*)(xp + ii * 4);
#pragma unroll
                for (int ii = 0; ii < 4; ++ii)
#pragma unroll
                    for (int j = 0; j < 4; ++j) {
                        const float om = exp2f(-13.287712379549449f * (float)((lane & 15) * 16 + ii * 4 + j) * (1.0f / 256.0f));
                        const float ang = pos * om;
                        v[ii][j] += (seg & 1) ? cosf(ang) : sinf(ang);
                    }
            } else {
                const float* xp = a.in[I_CTX] + (size_t)(row - NLAT) * 1024 + lane * 16;
#pragma unroll
                for (int ii = 0; ii < 4; ++ii) v[ii] = *(const f32x4*)(xp + ii * 4);
            }
        } else {
            f32x4 ys[4], xv[4]; slot_sum(Y8, row, lane, ys); xrow_ld(X + (size_t)row * 1024 + lane * 16, xv);
            const float* gate = MOD + ((size_t)(l - 1) * 17 + s) * 6144 + 5 * 1024 + lane * 16;
#pragma unroll
            for (int ii = 0; ii < 4; ++ii) { const f32x4 gv = *(const f32x4*)(gate + ii * 4); v[ii] = xv[ii] + gv * ys[ii]; }
        }
        xrow_st(X + (size_t)row * 1024 + lane * 16, v);
        const float* m = MOD + ((size_t)l * 17 + s) * 6144;
        norm_mod_store(v, a.in[I_N1G] + l * 1024, m, m + 1024, XA + (size_t)row * 1024, lane);
    }
}
__device__ __forceinline__ void phase_n2(const Args& a, int l, int T) {
    const int tid = opaque_tid(), wid = tid >> 6, lane = tid & 63;
    const bf16_t* X = (const bf16_t*)(a.ws + WS_X); bf16_t* XA = (bf16_t*)(a.ws + WS_XA); const float* MOD = (const float*)(a.ws + WS_MOD);
    for (int row = blockIdx.x * 8 + wid; row < T; row += gridDim.x * 8) {
        const int s = sample_of(row);
        f32x4 v[4]; xrow_ld(X + (size_t)row * 1024 + lane * 16, v);
        const float* m = MOD + ((size_t)l * 17 + s) * 6144;
        norm_mod_store(v, a.in[I_N2G] + l * 1024, m + 3 * 1024, m + 4 * 1024, XA + (size_t)row * 1024, lane);
    }
}
__device__ __forceinline__ void phase_fin(const Args& a) {
    const int tid = opaque_tid(), wid = tid >> 6, lane = tid & 63;
    const bf16_t* X = (const bf16_t*)(a.ws + WS_X); const float* MOD = (const float*)(a.ws + WS_MOD); const unsigned char* Y8 = (const unsigned char*)(a.ws + WS_R1);
    for (int row = blockIdx.x * 8 + wid; row < NLAT; row += gridDim.x * 8) {
        const int s = sample_of(row);
        f32x4 ys[4], xv[4], v[4]; slot_sum(Y8, row, lane, ys); xrow_ld(X + (size_t)row * 1024 + lane * 16, xv);
        const float* gate = MOD + ((size_t)17 + s) * 6144 + 5 * 1024 + lane * 16;
        float ss = 0.f;
#pragma unroll
        for (int ii = 0; ii < 4; ++ii) { const f32x4 gv = *(const f32x4*)(gate + ii * 4); v[ii] = xv[ii] + gv * ys[ii];
            ss += v[ii][0] * v[ii][0] + v[ii][1] * v[ii][1] + v[ii][2] * v[ii][2] + v[ii][3] * v[ii][3]; }
        ss = wave_sum(ss);
        const float rstd = rsqrtf(ss * (1.0f / 1024.0f) + EPS);
#pragma unroll
        for (int ii = 0; ii < 4; ++ii) { const f32x4 g = *(const f32x4*)(a.in[I_FNG] + lane * 16 + ii * 4); *(f32x4*)(a.out + (size_t)row * 1024 + lane * 16 + ii * 4) = v[ii] * rstd * g; }
    }
}

namespace pg8 {
#define PG8_LAS __attribute__((address_space(3)))
typedef unsigned short bf16_t;
typedef short bf16x8 __attribute__((ext_vector_type(8)));
typedef float f32x4 __attribute__((ext_vector_type(4)));
typedef unsigned u32x4 __attribute__((ext_vector_type(4)));
constexpr int BM = 256, BK = 64, HALF = 128, HTB = HALF * BK * 2  , STAGE_BYTES = 8 * HTB, NXCD = 8, WGM = 8;

__host__ __device__ __forceinline__ int lds_byte(int r, int c) { const int st = (r >> 4) * 2 + (c >> 5), rr = r & 15, cc = c & 31, ob = rr * 64 + cc * 2; return st * 1024 + (ob ^ (((ob >> 9) & 1) << 5)); }
__host__ __device__ __forceinline__ void stage_rc(int b, int& R, int& C) { const int st = b / 1024, sb = b % 1024, swz = sb ^ (((sb >> 9) & 1) << 5); R = (st >> 1) * 16 + swz / 64; C = (st & 1) * 32 + (swz % 64) / 2; }
__host__ __device__ __forceinline__ int perm32(int rho) { const int n = rho >> 4, i = rho & 15; return 8 * (i >> 2) + 4 * n + (i & 3); }

struct Unit { int pm, pn; };
struct Gemm { const bf16_t* A; const bf16_t* Bt; int M, N, K; };

struct StaticOrder {
    int nM, nN, nwg, G, c;
    __host__ __device__ void init(int M, int N, int G_, int c_) { nM = M / BM; nN = N / BM; nwg = nM * nN; G = G_; c = c_; }
    __host__ __device__ bool next(int i, Unit& u) const {
        const long L = (long)i * G + c; if (L >= nwg) return false;
        int wgid = (int)L; { const int q = nwg / NXCD, r = nwg % NXCD, xcd = wgid % NXCD, off = wgid / NXCD; wgid = (xcd < r ? xcd * (q + 1) : r * (q + 1) + (xcd - r) * q) + off; }
        const int nig = WGM * nN, gid = wgid / nig, fm = gid * WGM, gsz = (nM - fm) < WGM ? (nM - fm) : WGM;
        u.pm = fm + ((wgid % nig) % gsz); u.pn = (wgid % nig) / gsz; return true;
    }
    __device__ __forceinline__ void a_ready(const Unit&) const {}
    __device__ __forceinline__ void done(const Unit&) const {}
};
template <class Epi, class Sched, bool STAMP = false>
__device__ __forceinline__ void gemm_phase(PG8_LAS unsigned char* lds, const Gemm g, const Sched& S, const Epi& E, unsigned long long* stamps) {
    const int tid = opaque_tid(), wid = __builtin_amdgcn_readfirstlane(tid >> 6), lane = tid & 63, wr = wid >> 2, wc = wid & 3, fr = lane & 15, fq = lane >> 4;
    const int K = g.K, nt = K / BK;
    int ts_lo = 0, ts_hi = 0, nts = 0; const unsigned long long rt_entry = STAMP ? (unsigned long long)wall_clock64() : 0ull;
#define PG8_STAMP() do { if (STAMP && wid == 0 && nts < 64) { const unsigned long long _c = (unsigned long long)clock64(); \
        ts_lo = (lane == nts) ? (int)(unsigned)_c : ts_lo; ts_hi = (lane == nts) ? (int)(unsigned)(_c >> 32) : ts_hi; ++nts; } } while (0)
    PG8_STAMP();
    unsigned voffA[2], voffB[2];
#pragma unroll
    for (int i = 0; i < 2; ++i) { int R, C; stage_rc(tid * 16 + i * 8192, R, C); const int Rb = Epi::PERM ? ((R & ~31) + perm32(R & 31)) : R;
        voffA[i] = (unsigned)(R * K + C) * 2u; voffB[i] = (unsigned)(Rb * K + C) * 2u; }
    const size_t kstep = (size_t)(BK * 2);
    const size_t hstep = (size_t)HALF * K * 2;
    const size_t tstep = 2 * hstep;
    const unsigned ldsw = (unsigned)wid * 1024u;
    const int aoff = lds_byte(wr * 64 + fr, fq * 8), boff = lds_byte(wc * 32 + fr, fq * 8);
#define PG8_SA(b, h) (((b) * 2 + (h)) * HTB)
#define PG8_SB(b, h) ((4 + (b) * 2 + (h)) * HTB)
#define PG8_STAGE(bufoff, gbase, voff) do { _Pragma("unroll") for (int _i = 0; _i < 2; ++_i) \
        __builtin_amdgcn_global_load_lds((const unsigned*)((const char*)(gbase) + (voff)[_i]), (PG8_LAS unsigned*)(lds + (bufoff) + ldsw + _i * 8192), 16, 0, 0); } while (0)
#define PG8_LDA(dst, b, h) do { _Pragma("unroll") for (int m = 0; m < 4; ++m) _Pragma("unroll") for (int k = 0; k < 2; ++k) dst[m][k] = *(const PG8_LAS bf16x8*)(lds + PG8_SA(b, h) + aoff + m * 2048 + k * 1024); } while (0)
#define PG8_LDB(dst, b, h) do { _Pragma("unroll") for (int n = 0; n < 2; ++n) _Pragma("unroll") for (int k = 0; k < 2; ++k) dst[n][k] = *(const PG8_LAS bf16x8*)(lds + PG8_SB(b, h) + boff + n * 2048 + k * 1024); } while (0)
#define PG8_MMA(ai, bj, At, Bt) do { __builtin_amdgcn_s_setprio(1); _Pragma("unroll") for (int m = 0; m < 4; ++m) _Pragma("unroll") for (int n = 0; n < 2; ++n) _Pragma("unroll") for (int k = 0; k < 2; ++k) \
        acc[ai][bj][m][n] = __builtin_amdgcn_mfma_f32_16x16x32_bf16(Bt[n][k], At[m][k], acc[ai][bj][m][n], 0, 0, 0); __builtin_amdgcn_s_setprio(0); } while (0)
#define PG8_WAIT_V(n) asm volatile("s_waitcnt vmcnt(" #n ")" ::: "memory")
#define PG8_WAIT_L(n) asm volatile("s_waitcnt lgkmcnt(" #n ")" ::: "memory")
#define PG8_BAR __builtin_amdgcn_s_barrier()
#define PG8_SCHED __builtin_amdgcn_sched_barrier(0)
    Unit cur, nxt; int ui = 0;
    if (!S.next(0, cur)) return;
    f32x4 acc[2][2][4][2];
#pragma unroll
    for (int a = 0; a < 2; ++a)
#pragma unroll
        for (int b = 0; b < 2; ++b)
#pragma unroll
            for (int m = 0; m < 4; ++m)
#pragma unroll
                for (int n = 0; n < 2; ++n) acc[a][b][m][n] = (f32x4){0.f, 0.f, 0.f, 0.f};
    bf16x8 At[4][2], B0[2][2], B1[2][2];
    const char* cA = (const char*)g.A + (size_t)cur.pm * tstep; const char* cB = (const char*)g.Bt + (size_t)cur.pn * tstep;
    S.a_ready(cur);
    PG8_STAGE(PG8_SB(0, 0), cB, voffB); PG8_STAGE(PG8_SA(0, 0), cA, voffA); PG8_STAGE(PG8_SB(0, 1), cB + hstep, voffB); PG8_STAGE(PG8_SA(0, 1), cA + hstep, voffA);
    if (wr == 1) PG8_BAR;
    PG8_WAIT_V(4); PG8_BAR;
    PG8_STAGE(PG8_SB(1, 0), cB + kstep, voffB); PG8_STAGE(PG8_SA(1, 0), cA + kstep, voffA); PG8_STAGE(PG8_SB(1, 1), cB + hstep + kstep, voffB);
    PG8_WAIT_V(6); PG8_BAR;
    PG8_STAMP();
    for (;;) {
        const bool has_next = S.next(ui + 1, nxt);
        const char* nA = has_next ? (const char*)g.A + (size_t)nxt.pm * tstep : cA; const char* nB = has_next ? (const char*)g.Bt + (size_t)nxt.pn * tstep : cB;
        for (int t = 0; t < nt; t += 2) {
            const bool last = (t == nt - 2);
            const char* a1 = cA + (size_t)(t + 1) * kstep;
            const char* a2 = last ? nA : cA + (size_t)(t + 2) * kstep; const char* b2 = last ? nB : cB + (size_t)(t + 2) * kstep;
            const char* a3 = a2 + kstep; const char* b3 = b2 + kstep;
            if (last && has_next) S.a_ready(nxt);
            PG8_LDB(B0, 0, 0); PG8_SCHED; PG8_LDA(At, 0, 0); PG8_STAGE(PG8_SA(1, 1), a1 + hstep, voffA);
            PG8_WAIT_L(8); PG8_BAR; PG8_WAIT_L(0); PG8_MMA(0, 0, At, B0); PG8_BAR; PG8_SCHED;
            PG8_LDB(B1, 0, 1); PG8_STAGE(PG8_SB(0, 0), b2, voffB);
            PG8_BAR; PG8_WAIT_L(0); PG8_MMA(0, 1, At, B1); PG8_BAR;
            PG8_LDA(At, 0, 1); PG8_STAGE(PG8_SA(0, 0), a2, voffA);
            PG8_BAR; PG8_WAIT_L(0); PG8_MMA(1, 0, At, B0); PG8_BAR; PG8_SCHED;
            PG8_STAGE(PG8_SB(0, 1), b2 + hstep, voffB);
            PG8_WAIT_V(6); PG8_BAR; PG8_MMA(1, 1, At, B1); PG8_BAR;
            PG8_LDB(B0, 1, 0); PG8_SCHED; PG8_LDA(At, 1, 0); PG8_STAGE(PG8_SA(0, 1), a2 + hstep, voffA);
            PG8_WAIT_L(8); PG8_BAR; PG8_WAIT_L(0); PG8_MMA(0, 0, At, B0); PG8_BAR; PG8_SCHED;
            PG8_LDB(B1, 1, 1); PG8_STAGE(PG8_SB(1, 0), b3, voffB);
            PG8_BAR; PG8_WAIT_L(0); PG8_MMA(0, 1, At, B1); PG8_BAR;
            PG8_LDA(At, 1, 1); PG8_STAGE(PG8_SA(1, 0), a3, voffA);
            PG8_BAR; PG8_WAIT_L(0); PG8_MMA(1, 0, At, B0); PG8_BAR; PG8_SCHED;
            PG8_STAGE(PG8_SB(1, 1), b3 + hstep, voffB);
            PG8_WAIT_V(6); PG8_BAR; PG8_MMA(1, 1, At, B1); PG8_BAR;
        }
        PG8_STAMP();
        if constexpr (!Epi::AFTER_DRAIN) { E(acc, cur, wr, wc, fr, fq); S.done(cur); }
        PG8_STAMP();
        if (!has_next) break;
#pragma unroll
        for (int a = 0; a < 2; ++a)
#pragma unroll
            for (int b = 0; b < 2; ++b)
#pragma unroll
                for (int m = 0; m < 4; ++m)
#pragma unroll
                    for (int n = 0; n < 2; ++n) acc[a][b][m][n] = (f32x4){0.f, 0.f, 0.f, 0.f};
        cur = nxt; cA = nA; cB = nB; ++ui;
    }
    PG8_WAIT_V(0);
    if (wr == 0) PG8_BAR;
    PG8_BAR;
    if constexpr (Epi::AFTER_DRAIN) { E.fused(acc, cur, wr, wc, fr, fq, lds, wid, lane); S.done(cur); }
    PG8_STAMP();
    if (STAMP && wid == 0) { stamps[lane] = lane < nts ? (((unsigned long long)(unsigned)ts_hi << 32) | (unsigned)ts_lo) : 0ull;
        if (lane == 62) stamps[62] = rt_entry; if (lane == 63) stamps[63] = (unsigned long long)wall_clock64(); }
#undef PG8_STAMP
#undef PG8_SA
#undef PG8_SB
#undef PG8_STAGE
#undef PG8_LDA
#undef PG8_LDB
#undef PG8_MMA
#undef PG8_WAIT_V
#undef PG8_WAIT_L
#undef PG8_BAR
#undef PG8_SCHED
}
}

struct EpiG1 {
    static constexpr bool PERM = true, AFTER_DRAIN = false;
    bf16_t* P; float* GATES;
    __device__ __forceinline__ void operator()(const f32x4 (&acc)[2][2][4][2], const pg8::Unit& u, int wr, int wc, int fr, int fq) const {
        const int row0 = u.pm * 256 + wr * 64 + fr;
#pragma unroll
        for (int bj = 0; bj < 2; ++bj) {
            const int cb = u.pn * 256 + bj * 128 + wc * 32;
            if (cb >= DIN) continue;
            if (cb >= PW) {
                if (fq < 2) {
#pragma unroll
                    for (int ai = 0; ai < 2; ++ai)
#pragma unroll
                        for (int m = 0; m < 4; ++m) { float* gp = GATES + (size_t)(row0 + ai * 128 + m * 16) * 16 + fq * 8; *(f32x4*)gp = acc[ai][bj][m][0]; *(f32x4*)(gp + 4) = acc[ai][bj][m][1]; }
                }
            } else {
                const bool g = (cb >= PC_RG && cb < PC_Q) || cb >= PC_CU;
                const float sc = (cb >= PC_K && cb < PC_V) ? 0.10206207261596575f : 1.0f;
#pragma unroll
                for (int ai = 0; ai < 2; ++ai)
#pragma unroll
                    for (int m = 0; m < 4; ++m) {
                        f32x4 v0 = acc[ai][bj][m][0], v1 = acc[ai][bj][m][1];
                        if (g) { v0[0] = gelu_tanh(v0[0]); v0[1] = gelu_tanh(v0[1]); v0[2] = gelu_tanh(v0[2]); v0[3] = gelu_tanh(v0[3]); v1[0] = gelu_tanh(v1[0]); v1[1] = gelu_tanh(v1[1]); v1[2] = gelu_tanh(v1[2]); v1[3] = gelu_tanh(v1[3]); }
                        else { v0 = v0 * sc; v1 = v1 * sc; }
                        u32x4 w; w.x = cvt_pk_bf16(v0[0], v0[1]); w.y = cvt_pk_bf16(v0[2], v0[3]); w.z = cvt_pk_bf16(v1[0], v1[1]); w.w = cvt_pk_bf16(v1[2], v1[3]);
                        *(u32x4*)(P + (size_t)(row0 + ai * 128 + m * 16) * PW + cb + fq * 8) = w;
                    }
            }
        }
    }
};
__device__ __forceinline__ void phase_g1(const Args& a, LAS unsigned char* lds, int l) {
    pg8::Gemm g{(const bf16_t*)(a.ws + WS_XA), (const bf16_t*)(a.ws + WS_WIN) + (size_t)l * NIN * 1024, TOK, NIN, 1024};
    pg8::StaticOrder S; S.init(TOK, NIN, (int)gridDim.x, (int)blockIdx.x);
    EpiG1 E{(bf16_t*)(a.ws + WS_P), (float*)(a.ws + WS_GATES)};
    pg8::gemm_phase<EpiG1, pg8::StaticOrder>(lds, g, S, E, nullptr);
}
struct EpiG2 {
    static constexpr bool PERM = true, AFTER_DRAIN = false;
    bf16_t* X; const float* MODl;
    __device__ __forceinline__ void operator()(const f32x4 (&acc)[2][2][4][2], const pg8::Unit& u, int wr, int wc, int fr, int fq) const {
        const int row0 = u.pm * 256 + wr * 64 + fr; const float* gate = MODl + (size_t)sample_of(u.pm * 256) * 6144 + 2 * 1024;
#pragma unroll
        for (int bj = 0; bj < 2; ++bj) {
            const int col = u.pn * 256 + bj * 128 + wc * 32 + fq * 8; const f32x4 g0 = *(const f32x4*)(gate + col), g1 = *(const f32x4*)(gate + col + 4);
#pragma unroll
            for (int ai = 0; ai < 2; ++ai)
#pragma unroll
                for (int m = 0; m < 4; ++m) { bf16_t* xp = X + (size_t)(row0 + ai * 128 + m * 16) * 1024 + col;
                    const u32x4 w = *(const u32x4*)xp; const f32x4 a0 = acc[ai][bj][m][0], a1 = acc[ai][bj][m][1]; u32x4 o;
                    o.x = cvt_pk_bf16(__uint_as_float(w.x << 16) + g0[0] * a0[0], __uint_as_float(w.x & 0xffff0000u) + g0[1] * a0[1]);
                    o.y = cvt_pk_bf16(__uint_as_float(w.y << 16) + g0[2] * a0[2], __uint_as_float(w.y & 0xffff0000u) + g0[3] * a0[3]);
                    o.z = cvt_pk_bf16(__uint_as_float(w.z << 16) + g1[0] * a1[0], __uint_as_float(w.z & 0xffff0000u) + g1[1] * a1[1]);
                    o.w = cvt_pk_bf16(__uint_as_float(w.w << 16) + g1[2] * a1[2], __uint_as_float(w.w & 0xffff0000u) + g1[3] * a1[3]);
                    *(u32x4*)xp = o; }
        }
    }
};
__device__ __forceinline__ void phase_g2(const Args& a, LAS unsigned char* lds, int l, int T) {
    pg8::Gemm g{(const bf16_t*)(a.ws + WS_MIX), (const bf16_t*)(a.ws + WS_WOUT) + (size_t)l * 1024 * 1024, T, 1024, 1024};
    pg8::StaticOrder S; S.init(T, 1024, (int)gridDim.x, (int)blockIdx.x);
    EpiG2 E{(bf16_t*)(a.ws + WS_X), (const float*)(a.ws + WS_MOD) + (size_t)l * 17 * 6144};
    pg8::gemm_phase<EpiG2, pg8::StaticOrder>(lds, g, S, E, nullptr);
}
struct EpiRT {
    static constexpr bool PERM = false, AFTER_DRAIN = false;
    float* LG;
    __device__ __forceinline__ void operator()(const f32x4 (&acc)[2][2][4][2], const pg8::Unit& u, int wr, int wc, int fr, int fq) const {
        const int row0 = u.pm * 256 + wr * 64 + fr;
#pragma unroll
        for (int bj = 0; bj < 2; ++bj)
#pragma unroll
            for (int n = 0; n < 2; ++n)
#pragma unroll
                for (int ai = 0; ai < 2; ++ai)
#pragma unroll
                    for (int m = 0; m < 4; ++m) *(f32x4*)(LG + (size_t)(row0 + ai * 128 + m * 16) * 256 + bj * 128 + wc * 32 + n * 16 + fq * 4) = acc[ai][bj][m][n];
    }
};
__device__ __forceinline__ void phase_rt(const Args& a, LAS unsigned char* lds, int l, int T) {
    pg8::Gemm g{(const bf16_t*)(a.ws + WS_XA), (const bf16_t*)(a.ws + WS_ROUT) + (size_t)l * 256 * 1024, T, 256, 1024};
    pg8::StaticOrder S; S.init(T, 256, (int)gridDim.x, (int)blockIdx.x);
    EpiRT E{(float*)(a.ws + WS_LOGITS)};
    pg8::gemm_phase<EpiRT, pg8::StaticOrder>(lds, g, S, E, nullptr);
}

template <int CTRL> __device__ __forceinline__ float dppf(float old, float src) { return __int_as_float(__builtin_amdgcn_update_dpp(__float_as_int(old), __float_as_int(src), CTRL, 0xF, 0xF, false)); }
constexpr int TK_MAXTOK = 512;
__device__ __forceinline__ void phase_tk(const Args& a, LAS unsigned char* lds, int l, int T) {
    const int tid = opaque_tid(), wid = tid >> 6, lane = tid & 63;
    const float* LG = (const float*)(a.ws + WS_LOGITS); const float* rb = a.in[I_RB] + l * 256;
    unsigned* CNT = (unsigned*)(a.ws + WS_CTL + CTL_CNT) + (size_t)l * 256 * CNT_STRIDE; int* LS = (int*)(a.ws + WS_LSLOT); float* LWt = (float*)(a.ws + WS_LW);
    LAS unsigned* lcnt = (LAS unsigned*)lds; LAS unsigned* lbase = lcnt + 256; LAS unsigned* ent = lbase + 256; LAS float* entw = (LAS float*)(ent + TK_MAXTOK * 8);
    const f32x4 bias = *(const f32x4*)(rb + lane * 4);
    const float NEG = -__builtin_huge_valf();
    const int per = (T + (int)gridDim.x - 1) / (int)gridDim.x;
    for (int base0 = blockIdx.x * per; base0 < (int)(blockIdx.x + 1) * per && base0 < T; base0 += TK_MAXTOK) {
        int ntok = (int)(blockIdx.x + 1) * per - base0; if (ntok > TK_MAXTOK) ntok = TK_MAXTOK; if (ntok > T - base0) ntok = T - base0;
        __syncthreads();
        if (tid < 256) lcnt[tid] = 0u;
        __syncthreads();
        for (int tl = wid; tl < ntok; tl += 8) {
            const int t = base0 + tl;
            const f32x4 lg = *(const f32x4*)(LG + (size_t)t * 256 + lane * 4);
            float sc[4], sel[4];
#pragma unroll
            for (int j = 0; j < 4; ++j) { sc[j] = 1.0f / (1.0f + expf(-lg[j])); sel[j] = sc[j] + bias[j]; }
            float a1 = fmaxf(sel[0], sel[1]), a2 = fminf(sel[0], sel[1]);
#pragma unroll
            for (int j = 2; j < 4; ++j) { const float v = sel[j]; a2 = fmaxf(a2, fminf(a1, v)); a1 = fmaxf(a1, v); }
#define TK_MERGE(CTRL) { const float b1 = dppf<CTRL>(a1, a1), b2 = dppf<CTRL>(a2, a2); const float n1 = fmaxf(a1, b1), n2 = fmaxf(fminf(a1, b1), fmaxf(a2, b2)); a1 = n1; a2 = n2; }
            TK_MERGE(0xB1) TK_MERGE(0x4E) TK_MERGE(0x141)
#undef TK_MERGE
            const float gs = a1 + a2; const int g = lane >> 3; int rank = 0;
#pragma unroll
            for (int g2 = 0; g2 < 8; ++g2) { const float s2 = __int_as_float(__builtin_amdgcn_readlane(__float_as_int(gs), g2 * 8)); rank += (s2 > gs || (s2 == gs && g2 < g)) ? 1 : 0; }
            float ms[4];
#pragma unroll
            for (int j = 0; j < 4; ++j) ms[j] = rank < 4 ? sel[j] : NEG;
            int my_e = 0; float my_s = 0.f, ssum = 0.f;
#pragma unroll
            for (int k = 0; k < 8; ++k) {
                float mx = fmaxf(fmaxf(ms[0], ms[1]), fmaxf(ms[2], ms[3]));
                mx = fmaxf(mx, dppf<0x111>(NEG, mx)); mx = fmaxf(mx, dppf<0x112>(NEG, mx)); mx = fmaxf(mx, dppf<0x114>(NEG, mx)); mx = fmaxf(mx, dppf<0x118>(NEG, mx));
                const float gmax = fmaxf(fmaxf(__int_as_float(__builtin_amdgcn_readlane(__float_as_int(mx), 15)), __int_as_float(__builtin_amdgcn_readlane(__float_as_int(mx), 31))),
                                         fmaxf(__int_as_float(__builtin_amdgcn_readlane(__float_as_int(mx), 47)), __int_as_float(__builtin_amdgcn_readlane(__float_as_int(mx), 63))));
                const int cand = ms[0] == gmax ? 0 : ms[1] == gmax ? 1 : ms[2] == gmax ? 2 : ms[3] == gmax ? 3 : -1;
                const unsigned long long bal = __ballot(cand >= 0);
                const int wl = __builtin_amdgcn_readfirstlane(__ffsll((unsigned long long)bal) - 1);
                const int jj = __builtin_amdgcn_readlane(cand, wl), bi = wl * 4 + jj;
                const float mysc = jj == 0 ? sc[0] : jj == 1 ? sc[1] : jj == 2 ? sc[2] : sc[3];
                const float sk = __int_as_float(__builtin_amdgcn_readlane(__float_as_int(mysc), wl));
#pragma unroll
                for (int j = 0; j < 4; ++j) if (lane == wl && j == jj) ms[j] = NEG;
                if (lane == k) { my_e = bi; my_s = sk; }
                ssum += sk;
            }
            if (lane < 8) {
                const unsigned r = __hip_atomic_fetch_add(&lcnt[my_e], 1u, __ATOMIC_RELAXED, __HIP_MEMORY_SCOPE_WORKGROUP);
                ent[tl * 8 + lane] = ((unsigned)my_e << 16) | r; entw[tl * 8 + lane] = my_s / ssum * 2.5f;
            }
        }
        __syncthreads();
        if (tid < 256) { const unsigned c = lcnt[tid]; lbase[tid] = c ? atomicAdd(&CNT[tid * CNT_STRIDE], c) : 0u; }
        __syncthreads();
        for (int i = tid; i < ntok * 8; i += NTHREADS) {
            const unsigned v = ent[i]; const int e = (int)(v >> 16); const unsigned pos = lbase[e] + (v & 0xffffu);
            LS[(size_t)e * LCAP + pos] = (base0 + (i >> 3)) * NSLOT + (i & 7); LWt[(size_t)e * LCAP + pos] = entw[i];
        }
    }
}

__device__ __forceinline__ void moe_tables(const Args& a, LAS unsigned char* lds, int l, int T) {
    LAS int* cntE = (LAS int*)(lds + LDS_TAB); LAS int* blkoff = cntE + 264;
    const int tid = opaque_tid(); const unsigned* CNT = (const unsigned*)(a.ws + WS_CTL + CTL_CNT) + (size_t)l * 256 * CNT_STRIDE;
    if (tid < 256) cntE[tid] = (int)CNT[tid * CNT_STRIDE]; else if (tid == 256) cntE[256] = T;
    __syncthreads();
    if (tid < 258) { int s = 0; for (int e = 0; e < tid && e < 257; ++e) s += (cntE[e] + 255) >> 8; blkoff[tid] = s; }
    __syncthreads();
}
__device__ __forceinline__ int moe_find(const LAS int* blkoff, int mbg) { int lo = 0, hi = 257; while (hi - lo > 1) { const int mid = (lo + hi) >> 1; if (blkoff[mid] <= mbg) lo = mid; else hi = mid; } return lo; }

#define PV_LOAD32(dst, ptr) asm volatile("global_load_dword %0, %1, off" : "=&v"(dst) : "v"(ptr))
__device__ __forceinline__ bool xcd_unit(int i, int ntile, int nmb, int& mbg, int& nt) {
    const int x = blockIdx.x & 7, j = blockIdx.x >> 3, vnr = ((int)gridDim.x - x + 7) >> 3, s = j + vnr * i, mbl = s / ntile;
    const int lo = (x * nmb) >> 3, hi = ((x + 1) * nmb) >> 3;
    nt = s - mbl * ntile; mbg = lo + mbl; return mbg < hi;
}
struct E1Prov {
    const Args& a; LAS unsigned char* lds; int l, nunit, R0, R1, C0, C1, wr, wc, fr, fq; int q0, q1; bool sh;
    __device__ __forceinline__ void decode(int i, int& mbg, int& nt, int& e, int& mb, int& cnt) const {
        const LAS int* cntE = (const LAS int*)(lds + LDS_TAB); const LAS int* blkoff = cntE + 264;
        (void)xcd_unit(i, 3, nunit, mbg, nt); e = moe_find(blkoff, mbg); mb = mbg - blkoff[e]; cnt = cntE[e];
    }
    __device__ __forceinline__ bool seg(int i, RSeg& d) {
        { int m0, n0; if (!xcd_unit(i, 3, nunit, m0, n0)) return false; }
        int mbg, nt, e, mb, cnt; decode(i, mbg, nt, e, mb, cnt);
        const int* LS = (const int*)(a.ws + WS_LSLOT) + (e < 256 ? (size_t)e * LCAP : 0);
        const int p0 = mb * 256 + R0, p1 = mb * 256 + R1; sh = e >= 256; q0 = p0 < cnt ? p0 : -1; q1 = p1 < cnt ? p1 : -1;
        const int* a0 = LS + (q0 >= 0 && !sh ? q0 : 0); const int* a1 = LS + (q1 >= 0 && !sh ? q1 : 0);
        PV_LOAD32(d.aoff[0], a0); PV_LOAD32(d.aoff[1], a1);
        d.Ab = (const unsigned char*)(a.ws + WS_XA);
        d.B0 = (e < 256 ? a.in[I_EG] + ((size_t)l * 256 + e) * 1024 * FF : a.in[I_SG] + (size_t)l * 1024 * FF) + nt * 96;
        d.B1 = (e < 256 ? a.in[I_EU] + ((size_t)l * 256 + e) * 1024 * FF : a.in[I_SU] + (size_t)l * 1024 * FF) + nt * 96;
        return true;
    }
    __device__ __forceinline__ void finish(RSeg& d, bool first) const {
        if (first) asm volatile("s_waitcnt vmcnt(0)" ::: "memory"); else asm volatile("s_waitcnt vmcnt(16)" ::: "memory");
        __builtin_amdgcn_sched_barrier(0); asm volatile("" : "+v"(d.aoff[0]), "+v"(d.aoff[1]));
        const int t0 = q0 < 0 ? 0 : sh ? q0 : (int)d.aoff[0] / NSLOT, t1 = q1 < 0 ? 0 : sh ? q1 : (int)d.aoff[1] / NSLOT;
        d.aoff[0] = (unsigned)t0 * 2048u + (unsigned)C0 * 2u; d.aoff[1] = (unsigned)t1 * 2048u + (unsigned)C1 * 2u;
    }
    __device__ __forceinline__ void epi(int i, f32x4 (&acc)[4][6]) const {
        int mbg, nt, e, mb, cnt; decode(i, mbg, nt, e, mb, cnt);
        bf16_t* HB = (bf16_t*)(a.ws + WS_HB);
#pragma unroll
        for (int m = 0; m < 4; ++m) {
            bf16_t* hp = HB + (size_t)(mbg * 256 + wr * 64 + m * 16 + fr) * FF + nt * 96 + wc * 48 + fq * 4;
#pragma unroll
            for (int n = 0; n < 3; ++n) {
                const f32x4 g = acc[m][n], uu = acc[m][n + 3];
                u32x2 w; w.x = cvt_pk_bf16(siluf_(g[0]) * uu[0], siluf_(g[1]) * uu[1]); w.y = cvt_pk_bf16(siluf_(g[2]) * uu[2], siluf_(g[3]) * uu[3]);
                *(u32x2*)(hp + n * 16) = w;
            }
        }
    }
};
__device__ __forceinline__ void ring_piece_rc(int wid, int lane, int k, int& R, int& C) { const int sb = lane * 16, swz = sb ^ (((sb >> 9) & 1) << 5); R = (wid + 8 * k) * 16 + (swz >> 6); C = (swz & 63) >> 1; }
__device__ __forceinline__ void phase_e1(const Args& a, LAS unsigned char* lds, int l, int T) {
    const int tid = opaque_tid(), wid = __builtin_amdgcn_readfirstlane(tid >> 6), lane = tid & 63;
    moe_tables(a, lds, l, T);
    const LAS int* blkoff = (const LAS int*)(lds + LDS_TAB) + 264;
    int R0, C0, R1, C1; ring_piece_rc(wid, lane, 0, R0, C0); ring_piece_rc(wid, lane, 1, R1, C1);
    E1Prov pv{a, lds, l, blkoff[257], R0, R1, C0, C1, wid >> 1, wid & 1, lane & 15, lane >> 4, -1, -1, false};
    ring_gemm<192, 2, true, true, 2, E1Prov>(lds, pv, 32, FF, 0u, 0u);
}

struct E2Prov {
    const Args& a; LAS unsigned char* lds; int l, nunit, tid; int pslot; float pw; int pidx, ppos; bool psh;
    __device__ __forceinline__ void decode(int i, int& mbg, int& pn, int& e, int& mb, int& cnt) const {
        const LAS int* cntE = (const LAS int*)(lds + LDS_TAB); const LAS int* blkoff = cntE + 264;
        (void)xcd_unit(i, 4, nunit, mbg, pn); e = moe_find(blkoff, mbg); mb = mbg - blkoff[e]; cnt = cntE[e];
    }
    __device__ __forceinline__ bool seg(int i, RSeg& d) {
        { int m0, n0; if (!xcd_unit(i, 4, nunit, m0, n0)) return false; }
        int mbg, pn, e, mb, cnt; decode(i, mbg, pn, e, mb, cnt);
        const int pos = mb * 256 + (tid & 255); psh = e >= 256; ppos = (tid < 256 && pos < cnt) ? pos : -1; pidx = i;
        const size_t idx = (ppos >= 0 && !psh) ? (size_t)e * LCAP + pos : 0;
        const int* sp = (const int*)(a.ws + WS_LSLOT) + idx; const float* wp = (const float*)(a.ws + WS_LW) + idx;
        PV_LOAD32(pslot, sp); PV_LOAD32(pw, wp);
        d.Ab = (const unsigned char*)(a.ws + WS_HB) + (size_t)mbg * 256 * FF * 2;
        d.B0 = (e < 256 ? a.in[I_ED] + ((size_t)l * 256 + e) * FF * 1024 : a.in[I_SD] + (size_t)l * FF * 1024) + pn * 256; d.B1 = d.B0;
        return true;
    }
    __device__ __forceinline__ void finish(RSeg&, bool first) {
        if (first) asm volatile("s_waitcnt vmcnt(0)" ::: "memory"); else asm volatile("s_waitcnt vmcnt(16)" ::: "memory");
        __builtin_amdgcn_sched_barrier(0); asm volatile("" : "+v"(pslot), "+v"(pw));
        LAS int* tab = (LAS int*)(lds + LDS_TAB) + 528 + (pidx & 1) * 512;
        if (tid < 256) { tab[tid] = ppos < 0 ? -1 : psh ? ppos * NSLOT + 8 : pslot; ((LAS float*)tab)[256 + tid] = psh ? 1.0f : pw; }
    }
    __device__ __forceinline__ void epi(int i, f32x4 (&acc)[8][4]) const {
        int mbg, pn, e, mb, cnt; decode(i, mbg, pn, e, mb, cnt);
        const LAS int* tab = (const LAS int*)(lds + LDS_TAB) + 528 + (i & 1) * 512; unsigned char* Y8 = (unsigned char*)(a.ws + WS_R1);
        const int wr = tid >> 8, wc = (tid >> 6) & 3, fr = tid & 15, fq = (tid >> 4) & 3;
#pragma unroll
        for (int m = 0; m < 8; ++m) {
            const int r = wr * 128 + m * 16 + fr, slot = tab[r];
            if (slot >= 0) {
                const float w = ((const LAS float*)tab)[256 + r] * SLOT_SCALE; unsigned char* yp = Y8 + (size_t)slot * 1024 + pn * 256 + wc * 64 + fq * 16;
                u32x4 o; unsigned ow[4];
#pragma unroll
                for (int n = 0; n < 4; ++n) {
                    const f32x4 v = acc[m][n] * w;
                    const float c0 = __builtin_amdgcn_fmed3f(v[0], -SLOT_CLAMP, SLOT_CLAMP), c1 = __builtin_amdgcn_fmed3f(v[1], -SLOT_CLAMP, SLOT_CLAMP), c2 = __builtin_amdgcn_fmed3f(v[2], -SLOT_CLAMP, SLOT_CLAMP), c3 = __builtin_amdgcn_fmed3f(v[3], -SLOT_CLAMP, SLOT_CLAMP);
                    ow[n] = (unsigned)__builtin_amdgcn_cvt_pk_fp8_f32(c2, c3, __builtin_amdgcn_cvt_pk_fp8_f32(c0, c1, 0, false), true);
                }
                o.x = ow[0]; o.y = ow[1]; o.z = ow[2]; o.w = ow[3];
                *(u32x4*)yp = o;
            }
        }
    }
};
__device__ __forceinline__ void phase_e2(const Args& a, LAS unsigned char* lds, int l, int T) {
    const int tid = opaque_tid(), wid = __builtin_amdgcn_readfirstlane(tid >> 6), lane = tid & 63;
    moe_tables(a, lds, l, T);
    const LAS int* blkoff = (const LAS int*)(lds + LDS_TAB) + 264;
    int R0, C0, R1, C1; ring_piece_rc(wid, lane, 0, R0, C0); ring_piece_rc(wid, lane, 1, R1, C1);
    E2Prov pv{a, lds, l, blkoff[257], tid, -1, 0.f, -1, -1, false};
    ring_gemm<256, 4, false, false, 1, E2Prov>(lds, pv, 9, 1024, (unsigned)(R0 * FF * 2 + C0 * 2), (unsigned)(R1 * FF * 2 + C1 * 2));
}

__device__ __forceinline__ float logsigmoidf_(float x) { return fminf(x, 0.f) - log1pf(expf(-fabsf(x))); }

__device__ __forceinline__ void mlstm_gates(const float* GATES, int row0, int rstep, int gcol, float bi, float bfg, float m, LAS float* colterm, LAS float* Marr, LAS float* bcarr, int lane) {
    const int p0 = 2 * lane;
    const float* g0 = GATES + (size_t)(row0 + rstep * p0) * 16 + gcol; const float* g1 = g0 + rstep * 16;
    const float gi0 = g0[0] + bi, gi1 = g1[0] + bi, lf0 = logsigmoidf_(g0[4] + bfg), lf1 = logsigmoidf_(g1[4] + bfg);
    float s = lf0 + lf1;
#pragma unroll
    for (int o = 1; o < 64; o <<= 1) { const float t = __shfl_up(s, o); if (lane >= o) s += t; }
    const float bc1 = s, bc0 = s - lf1, ct0 = gi0 - bc0, ct1 = gi1 - bc1;
    float pm = fmaxf(ct0, ct1);
#pragma unroll
    for (int o = 1; o < 64; o <<= 1) { const float t = __shfl_up(pm, o); if (lane >= o) pm = fmaxf(pm, t); }
    float prev = __shfl_up(pm, 1); if (lane == 0) prev = -__builtin_huge_valf();
    const float pm0 = fmaxf(prev, ct0);
    colterm[p0] = ct0; colterm[p0 + 1] = ct1; bcarr[p0] = bc0; bcarr[p0 + 1] = bc1; Marr[p0] = fmaxf(m, pm0); Marr[p0 + 1] = fmaxf(m, pm);
}

__device__ __forceinline__ void ms_unit(const Args& a, LAS unsigned char* lds, int l, int b, int h, int d) {
    const int tid = opaque_tid(), wid = __builtin_amdgcn_readfirstlane(tid >> 6), lane = tid & 63, fr = lane & 15, fq = lane >> 4;
    LAS bf16_t* Ks = (LAS bf16_t*)(lds);
    LAS bf16_t* Vp = (LAS bf16_t*)(lds + 26624);
    LAS float* colterm = (LAS float*)(lds + 57344); LAS float* Marr = colterm + 128; LAS float* bcarr = Marr + 128;
    const bf16_t* P = (const bf16_t*)(a.ws + WS_P); const float* GATES = (const float*)(a.ws + WS_GATES);
    const int seq = (b * 4 + h) * 2 + d;
    bf16_t* CTG = (bf16_t*)(a.ws + WS_CTG) + (size_t)seq * 18 * (112 * 96); float* MST = (float*)(a.ws + WS_MST) + seq * 18;
    const float bi = a.in[I_MGB][((l * 2 + d) * 2 + 0) * 4 + h], bfg = a.in[I_MGB][((l * 2 + d) * 2 + 1) * 4 + h];
    const int rstep = d ? -1 : 1, gcol = d * 8 + h;
    int pp[3], pch[3];
#pragma unroll
    for (int i = 0; i < 3; ++i) { const int rem = tid + 512 * i; pp[i] = rem / 12; pch[i] = rem - pp[i] * 12; }
#define MS_ROW0(step) (((step) < 2 ? NLAT + b * CTXL : b * SEQ) + (d ? ((step) < 2 ? CTXL : SEQ) - 1 - ((step) < 2 ? (step) : (step) - 2) * 128 : ((step) < 2 ? (step) : (step) - 2) * 128))
    u32x4 kv[6]; float gq[4];
#define MS_FETCH(step) do { const int _r0 = MS_ROW0(step); \
        _Pragma("unroll") for (int i = 0; i < 6; ++i) kv[i] = *(const u32x4*)(P + (size_t)(_r0 + rstep * pp[i % 3]) * PW + (i < 3 ? PC_K : PC_V) + h * 96 + pch[i % 3] * 8); \
        { const float* g0 = GATES + (size_t)(_r0 + rstep * 2 * lane) * 16 + gcol; gq[0] = g0[0]; gq[1] = g0[4]; gq[2] = g0[rstep * 16]; gq[3] = g0[rstep * 16 + 4]; } } while (0)
    __syncthreads();
    for (int i = tid; i < 128 * 3; i += NTHREADS) { const int p = i / 3, q = i - p * 3; u32x4 v = (u32x4){0u, 0u, 0u, 0u}; if (q == 0) v.x = 0x3F80u; *(LAS u32x4*)(Vp + p * 120 + 96 + q * 8) = v; }
    f32x4 Cst[7];
#pragma unroll
    for (int cb = 0; cb < 7; ++cb) Cst[cb] = (f32x4){0.f, 0.f, 0.f, 0.f};
    float m = 0.f;
    MS_FETCH(0);
    for (int step = 0; step < 18; ++step) {
        const bool do_out = step >= 2 || l == 0;
        if (wid == 0) {
            const int p0 = 2 * lane;
            const float gi0 = gq[0] + bi, gi1 = gq[2] + bi, lf0 = logsigmoidf_(gq[1] + bfg), lf1 = logsigmoidf_(gq[3] + bfg);
            float s = lf0 + lf1;
#pragma unroll
            for (int o = 1; o < 64; o <<= 1) { const float t = __shfl_up(s, o); if (lane >= o) s += t; }
            const float bc1 = s, bc0 = s - lf1, ct0 = gi0 - bc0, ct1 = gi1 - bc1;
            float pm = fmaxf(ct0, ct1);
#pragma unroll
            for (int o = 1; o < 64; o <<= 1) { const float t = __shfl_up(pm, o); if (lane >= o) pm = fmaxf(pm, t); }
            float prev = __shfl_up(pm, 1); if (lane == 0) prev = -__builtin_huge_valf();
            const float pm0 = fmaxf(prev, ct0);
            colterm[p0] = ct0; colterm[p0 + 1] = ct1; bcarr[p0] = bc0; bcarr[p0 + 1] = bc1; Marr[p0] = fmaxf(m, pm0); Marr[p0 + 1] = fmaxf(m, pm);
        }
        if (do_out) {
            if (tid == 0) MST[step] = m;
            if (wid < 6) {
                bf16_t* cg = CTG + (size_t)step * (112 * 96) + wid * 16 + fr;
#pragma unroll
                for (int cb = 0; cb < 7; ++cb)
#pragma unroll
                    for (int j = 0; j < 4; ++j) cg[(cb * 16 + fq * 4 + j) * 96] = f2bf(Cst[cb][j]);
            }
        }
        __syncthreads();
        const float Mend = Marr[127], gsum = bcarr[127];
#pragma unroll
        for (int i = 0; i < 6; ++i) {
            const int p = pp[i % 3], ch = pch[i % 3];
            u32x4 v = kv[i];
            if (i < 3) {
                const float w = __expf(colterm[p] - Mend);
                v.x = cvt_pk_bf16(__uint_as_float(v.x << 16) * w, __uint_as_float(v.x & 0xffff0000u) * w); v.y = cvt_pk_bf16(__uint_as_float(v.y << 16) * w, __uint_as_float(v.y & 0xffff0000u) * w);
                v.z = cvt_pk_bf16(__uint_as_float(v.z << 16) * w, __uint_as_float(v.z & 0xffff0000u) * w); v.w = cvt_pk_bf16(__uint_as_float(v.w << 16) * w, __uint_as_float(v.w & 0xffff0000u) * w);
                *(LAS u32x4*)(Ks + p * 104 + ch * 8) = v;
            } else *(LAS u32x4*)(Vp + p * 120 + ch * 8) = v;
        }
        if (step + 1 < 18) MS_FETCH(step + 1);
        __syncthreads();
        const float decay = __expf(m - Mend);
        if (wid < 6) {
#pragma unroll
            for (int cb = 0; cb < 7; ++cb) Cst[cb] = Cst[cb] * decay;
#pragma unroll
            for (int ks = 0; ks < 4; ++ks) {
                const bf16x8 bk = trfrag(Ks, 104, ks * 32, wid * 16, fr, fq);
#pragma unroll
                for (int cb = 0; cb < 7; ++cb) Cst[cb] = MFMA(trfrag(Vp, 120, ks * 32, cb * 16, fr, fq), bk, Cst[cb]);
            }
        }
        m = gsum + Mend;
        __syncthreads();
    }
#undef MS_FETCH
#undef MS_ROW0
}

__device__ __forceinline__ void mo_unit(const Args& a, LAS unsigned char* lds, int l, int b, int h, int cidx) {
    const int tid = opaque_tid(), wid = __builtin_amdgcn_readfirstlane(tid >> 6), lane = tid & 63, fr = lane & 15, fq = lane >> 4;
    LAS bf16_t* Qi = (LAS bf16_t*)(lds);
    LAS bf16_t* Ki = (LAS bf16_t*)(lds + 26624);
    LAS bf16_t* Si = (LAS bf16_t*)(lds);
    LAS bf16_t* Vp = (LAS bf16_t*)(lds + 53248);
    LAS float* Hs = (LAS float*)(lds + 83968);
    LAS float* colterm = (LAS float*)(lds + 135168); LAS float* Marr = colterm + 128; LAS float* bcarr = Marr + 128;
    const bf16_t* P = (const bf16_t*)(a.ws + WS_P); const float* GATES = (const float*)(a.ws + WS_GATES); bf16_t* MIX = (bf16_t*)(a.ws + WS_MIX);
    const bool isctx = cidx >= 16; const int n = isctx ? cidx - 16 : cidx, nc = isctx ? 2 : 16, rowbase = (isctx ? NLAT + b * CTXL : b * SEQ) + n * 128;
    __syncthreads();
    for (int i = tid; i < 128 * 3; i += NTHREADS) { const int p = i / 3, q = i - p * 3; u32x4 v = (u32x4){0u, 0u, 0u, 0u}; if (q == 0) v.x = 0x3F80u; *(LAS u32x4*)(Vp + p * 120 + 96 + q * 8) = v; }
    for (int d = 0; d < 2; ++d) {
        const int seq = (b * 4 + h) * 2 + d, np = d ? nc - 1 - n : n, step = isctx ? np : 2 + np;
        const float m = ((const float*)(a.ws + WS_MST))[seq * 18 + step];
        const bf16_t* CT = (const bf16_t*)(a.ws + WS_CTG) + ((size_t)seq * 18 + step) * (112 * 96);
        const float bi = a.in[I_MGB][((l * 2 + d) * 2 + 0) * 4 + h], bfg = a.in[I_MGB][((l * 2 + d) * 2 + 1) * 4 + h];
        const int row0 = rowbase + (d ? 127 : 0), rstep = d ? -1 : 1;
        if (wid == 0) mlstm_gates(GATES, row0, rstep, d * 8 + h, bi, bfg, m, colterm, Marr, bcarr, lane);
#pragma unroll
        for (int i = 0; i < 9; ++i) {
            const int rem = tid + 512 * (i % 3), p = rem / 12, ch = rem - p * 12;
            const u32x4 v = *(const u32x4*)(P + (size_t)(row0 + rstep * p) * PW + PC_Q + (i / 3) * 384 + h * 96 + ch * 8);
            if (i < 3) *(LAS u32x4*)(Qi + p * 104 + ch * 8) = v; else if (i < 6) *(LAS u32x4*)(Ki + p * 104 + ch * 8) = v; else *(LAS u32x4*)(Vp + p * 120 + ch * 8) = v;
        }
        __syncthreads();
        f32x4 num[7], sacc[8];
        const int t = wid * 16 + fr; const float Mt = Marr[t];
#pragma unroll
        for (int cb = 0; cb < 7; ++cb) num[cb] = (f32x4){0.f, 0.f, 0.f, 0.f};
#pragma unroll
        for (int ks = 0; ks < 3; ++ks) {
            const bf16x8 bq = ldfrag(Qi, 104, wid * 16, ks * 32, fr, fq);
#pragma unroll
            for (int cb = 0; cb < 7; ++cb) num[cb] = MFMA(*(const bf16x8*)(CT + (cb * 16 + fr) * 96 + ks * 32 + fq * 8), bq, num[cb]);
#pragma unroll
            for (int sb = 0; sb < 8; ++sb) if (sb <= wid) { if (ks == 0) sacc[sb] = (f32x4){0.f, 0.f, 0.f, 0.f}; sacc[sb] = MFMA(ldfrag(Ki, 104, sb * 16, ks * 32, fr, fq), bq, sacc[sb]); }
        }
        { const float ei = __expf(m - Mt);
#pragma unroll
          for (int cb = 0; cb < 7; ++cb) num[cb] = num[cb] * ei; }
        __syncthreads();
#pragma unroll
        for (int sb = 0; sb < 8; ++sb) {
            u32x2 w; w.x = 0u; w.y = 0u;
            if (sb <= wid) {
                const f32x4 ct = *(const LAS f32x4*)(colterm + sb * 16 + fq * 4); float e[4];
#pragma unroll
                for (int j = 0; j < 4; ++j) { const int s = sb * 16 + fq * 4 + j; e[j] = (s <= t) ? sacc[sb][j] * __expf(ct[j] - Mt) : 0.f; }
                w.x = cvt_pk_bf16(e[0], e[1]); w.y = cvt_pk_bf16(e[2], e[3]);
            }
            *(LAS u32x2*)(Si + t * 136 + sb * 16 + fq * 4) = w;
        }
        __syncthreads();
#pragma unroll
        for (int ks = 0; ks < 4; ++ks) {
            const bf16x8 bs = ldfrag(Si, 136, wid * 16, ks * 32, fr, fq);
#pragma unroll
            for (int cb = 0; cb < 7; ++cb) num[cb] = MFMA(trfrag(Vp, 120, ks * 32, cb * 16, fr, fq), bs, num[cb]);
        }
        const float den = __shfl(num[6][0], fr);
        const float inv = 1.0f / fmaxf(fabsf(den), __expf(-(bcarr[t] + Mt)));
        LAS float* hp = Hs + (d ? 127 - t : t) * 100 + fq * 4;
#pragma unroll
        for (int cb = 0; cb < 6; ++cb) { f32x4 hv = num[cb] * inv; if (d) hv = hv + *(const LAS f32x4*)(hp + cb * 16); *(LAS f32x4*)(hp + cb * 16) = hv; }
        __syncthreads();
    }
    {
        const int tau = wid * 16 + (lane >> 2), c0 = (lane & 3) * 24;
        float hv[24], ss = 0.f;
#pragma unroll
        for (int i = 0; i < 6; ++i) { const f32x4 x = *(const LAS f32x4*)(Hs + tau * 100 + c0 + i * 4); hv[4 * i] = x[0]; hv[4 * i + 1] = x[1]; hv[4 * i + 2] = x[2]; hv[4 * i + 3] = x[3]; ss += x[0] * x[0] + x[1] * x[1] + x[2] * x[2] + x[3] * x[3]; }
        ss += __shfl_xor(ss, 1); ss += __shfl_xor(ss, 2);
        const float rstd = rsqrtf(ss * (1.0f / 96.0f) + EPS);
        const bf16_t* op = P + (size_t)(rowbase + tau) * PW + PC_O + h * 96 + c0; const float* ng = a.in[I_MNG] + l * 384 + h * 96 + c0;
        bf16_t* mp = MIX + (size_t)(rowbase + tau) * 1024 + 384 + h * 96 + c0;
#pragma unroll
        for (int i = 0; i < 3; ++i) {
            const u32x4 ow = *(const u32x4*)(op + i * 8); const unsigned oo[4] = {ow.x, ow.y, ow.z, ow.w}; unsigned r[4];
#pragma unroll
            for (int j = 0; j < 4; ++j) { const int c = i * 8 + 2 * j; r[j] = cvt_pk_bf16(sigmoidf_(__uint_as_float(oo[j] << 16)) * hv[c] * rstd * ng[c], sigmoidf_(__uint_as_float(oo[j] & 0xffff0000u)) * hv[c + 1] * rstd * ng[c + 1]); }
            *(u32x4*)(mp + i * 8) = (u32x4){r[0], r[1], r[2], r[3]};
        }
    }
}

template <int D> __device__ __forceinline__ void scan16(float& A, float& U) {
#define RG_STEP(o) { const float Ao = dppf<(D ? 0x100 : 0x110) | (o)>(1.0f, A), Uo = dppf<(D ? 0x100 : 0x110) | (o)>(0.0f, U); U = fmaf(A, Uo, U); A *= Ao; }
    RG_STEP(1) RG_STEP(2) RG_STEP(4) RG_STEP(8)
#undef RG_STEP
}
template <bool FINAL>
__device__ __forceinline__ void rg_unit(const Args& a, LAS unsigned char* lds, int l, int b, int hd, int cidx) {
    const int tid = opaque_tid(), wid = __builtin_amdgcn_readfirstlane(tid >> 6), lane = tid & 63, fr = lane & 15, fq = lane >> 4;
    LAS bf16_t* zi = (LAS bf16_t*)lds;
    LAS bf16_t* Wi = (LAS bf16_t*)(lds + 18432);
    LAS float* zf = (LAS float*)(lds + 55296);
    LAS float* cst = (LAS float*)(lds + 88064);
    LAS float* wagg = (LAS float*)(lds + 89600);
    LAS float* hin = (LAS float*)(lds + 97792);
    const bf16_t* P = (const bf16_t*)(a.ws + WS_P); bf16_t* MIX = (bf16_t*)(a.ws + WS_MIX);
    float* AGG = (float*)(a.ws + WS_RGAGG);
    const bool isctx = cidx >= 16; const int n = isctx ? cidx - 16 : cidx, nc = isctx ? 2 : 16, Tseg = isctx ? CTXL : SEQ, segbase = isctx ? NLAT + b * CTXL : b * SEQ, base = n * 128;
    const int c = lane, ch = hd * 64 + c;
    __syncthreads();
    { const bf16_t* wt = (const bf16_t*)(a.ws + WS_RGWT) + (size_t)((l * 2) * 6 + hd) * 8192;
#pragma unroll
      for (int i = 0; i < 4; ++i) { const int idx = tid + 512 * i, dd = idx >> 10, r = (idx >> 3) & 127, k8 = idx & 7; *(LAS u32x4*)(Wi + (dd * 128 + r) * 72 + k8 * 8) = *(const u32x4*)(wt + (size_t)dd * 6 * 8192 + r * 64 + k8 * 8); } }
    if (tid < 128) { const int dd = tid >> 6, cc = tid & 63;
        cst[(dd * 3 + 0) * 64 + cc] = -1.4426950408889634f * a.in[I_RGGB][((l * 2 + dd) * 2 + 0) * 384 + hd * 64 + cc]; cst[(dd * 3 + 1) * 64 + cc] = -1.4426950408889634f * a.in[I_RGGB][((l * 2 + dd) * 2 + 1) * 384 + hd * 64 + cc];
        cst[(dd * 3 + 2) * 64 + cc] = -8.0f * 1.4426950408889634f * log1pf(expf(-a.in[I_RGLAM][(l * 2 + dd) * 384 + hd * 64 + cc]));
        if (FINAL) {
            const int np = dd ? nc - 1 - n : n, step = isctx ? np : 2 + np; const float* ag = AGG + (size_t)((b * 6 + hd) * 2 + dd) * 18 * 128 + cc;
            float Av[17], Uv[17];
#pragma unroll
            for (int s2 = 0; s2 < 17; ++s2) { Av[s2] = 1.f; Uv[s2] = 0.f; if (s2 < step) { Av[s2] = ag[s2 * 128]; Uv[s2] = ag[s2 * 128 + 64]; } }
            float hv = 0.f;
#pragma unroll
            for (int s2 = 0; s2 < 17; ++s2) hv = Av[s2] * hv + Uv[s2];
            hin[dd * 64 + cc] = hv;
        } }
    {
        const float cw0 = a.in[I_RGCW][(l * 4 + 0) * 384 + ch], cw1 = a.in[I_RGCW][(l * 4 + 1) * 384 + ch], cw2 = a.in[I_RGCW][(l * 4 + 2) * 384 + ch], cw3 = a.in[I_RGCW][(l * 4 + 3) * 384 + ch], cbias = a.in[I_RGCB][l * 384 + ch];
        const int tl0 = wid * 16; const bf16_t* pp = P + (size_t)segbase * PW + PC_RX + ch;
#define RG_LD(pos) (((pos) >= 0 && (pos) < Tseg) ? bf2f(pp[(size_t)(pos) * PW]) : 0.f)
        float xv[19];
#pragma unroll
        for (int i = 0; i < 19; ++i) xv[i] = RG_LD(base + tl0 - 2 + i);
#pragma unroll
        for (int i = 0; i < 16; ++i) { const float z = cw0 * xv[i] + cw1 * xv[i + 1] + cw2 * xv[i + 2] + cw3 * xv[i + 3] + cbias; zf[(tl0 + i) * 64 + c] = z; zi[(tl0 + i) * 72 + c] = f2bf(z); }
#undef RG_LD
    }
    __syncthreads();
    const int tl = wid * 16 + fr;
    f32x4 ysum[4];
#pragma unroll
    for (int nb = 0; nb < 4; ++nb) ysum[nb] = (f32x4){0.f, 0.f, 0.f, 0.f};
    f32x4 Ad[2][4], Ud[2][4];
#pragma unroll
    for (int d = 0; d < 2; ++d) {
        f32x4 acc[8];
#pragma unroll
        for (int nb = 0; nb < 8; ++nb) acc[nb] = (f32x4){0.f, 0.f, 0.f, 0.f};
#pragma unroll
        for (int ks = 0; ks < 2; ++ks) {
            const bf16x8 bz = ldfrag(zi, 72, wid * 16, ks * 32, fr, fq);
#pragma unroll
            for (int nb = 0; nb < 8; ++nb) acc[nb] = MFMA(ldfrag(Wi + d * 128 * 72, 72, nb * 16, ks * 32, fr, fq), bz, acc[nb]);
        }
#pragma unroll
        for (int nb = 0; nb < 4; ++nb) {
            const int j0 = nb * 16 + fq * 4;
            const f32x4 z4 = *(const LAS f32x4*)(zf + tl * 64 + j0), br = *(const LAS f32x4*)(cst + (d * 3 + 0) * 64 + j0), bi4 = *(const LAS f32x4*)(cst + (d * 3 + 1) * 64 + j0), sp = *(const LAS f32x4*)(cst + (d * 3 + 2) * 64 + j0);
#pragma unroll
            for (int j = 0; j < 4; ++j) {
                const float rg = __builtin_amdgcn_rcpf(1.0f + __builtin_amdgcn_exp2f(fmaf(acc[nb][j], -1.4426950408889634f, br[j])));
                const float ig = __builtin_amdgcn_rcpf(1.0f + __builtin_amdgcn_exp2f(fmaf(acc[nb + 4][j], -1.4426950408889634f, bi4[j])));
                const float av = __builtin_amdgcn_exp2f(rg * sp[j]);
                Ad[d][nb][j] = av; Ud[d][nb][j] = __builtin_amdgcn_sqrtf(fmaxf(fmaf(-av, av, 1.0f), 0.f)) * (ig * z4[j]);
            }
        }
#pragma unroll
        for (int nb = 0; nb < 4; ++nb)
#pragma unroll
            for (int j = 0; j < 4; ++j) { float A = Ad[d][nb][j], U = Ud[d][nb][j]; if (d == 0) scan16<0>(A, U); else scan16<1>(A, U); Ad[d][nb][j] = A; Ud[d][nb][j] = U; }
        if (fr == (d ? 0 : 15)) {
#pragma unroll
            for (int nb = 0; nb < 4; ++nb) { *(LAS f32x4*)(wagg + ((d * 8 + wid) * 2 + 0) * 64 + nb * 16 + fq * 4) = Ad[d][nb]; *(LAS f32x4*)(wagg + ((d * 8 + wid) * 2 + 1) * 64 + nb * 16 + fq * 4) = Ud[d][nb]; }
        }
    }
    __syncthreads();
    {
        bf16_t* PF = (bf16_t*)(a.ws + WS_RGPF) + ((size_t)(segbase + base + tl) * 384 + hd * 64) * 4;
#pragma unroll
        for (int nb = 0; nb < 4; ++nb) {
            const int j0 = nb * 16 + fq * 4;
            f32x4 Ap[2], Up[2];
#pragma unroll
            for (int d = 0; d < 2; ++d) {
                f32x4 Aw = (f32x4){1.f, 1.f, 1.f, 1.f}, Uw = (f32x4){0.f, 0.f, 0.f, 0.f};
                for (int w2 = 0; w2 < 7; ++w2) { const int w = d ? 7 - w2 : w2; if (d ? (w > wid) : (w < wid)) { const f32x4 aw = *(const LAS f32x4*)(wagg + ((d * 8 + w) * 2 + 0) * 64 + j0), uw = *(const LAS f32x4*)(wagg + ((d * 8 + w) * 2 + 1) * 64 + j0); Uw = aw * Uw + uw; Aw = Aw * aw; } }
                Ap[d] = Aw * Ad[d][nb]; Up[d] = Ad[d][nb] * Uw + Ud[d][nb];
            }
            u32x4 w0, w1;
            w0.x = cvt_pk_bf16(Ap[0][0], Up[0][0]); w0.y = cvt_pk_bf16(Ap[1][0], Up[1][0]); w0.z = cvt_pk_bf16(Ap[0][1], Up[0][1]); w0.w = cvt_pk_bf16(Ap[1][1], Up[1][1]);
            w1.x = cvt_pk_bf16(Ap[0][2], Up[0][2]); w1.y = cvt_pk_bf16(Ap[1][2], Up[1][2]); w1.z = cvt_pk_bf16(Ap[0][3], Up[0][3]); w1.w = cvt_pk_bf16(Ap[1][3], Up[1][3]);
            *(u32x4*)(PF + j0 * 4) = w0; *(u32x4*)(PF + j0 * 4 + 8) = w1;
        }
        if (tid < 128) { const int dd = tid >> 6, cc = tid & 63; float A = 1.f, U = 0.f;
#pragma unroll
            for (int w2 = 0; w2 < 8; ++w2) { const int w = dd ? 7 - w2 : w2; const float aw = wagg[((dd * 8 + w) * 2 + 0) * 64 + cc], uw = wagg[((dd * 8 + w) * 2 + 1) * 64 + cc]; U = aw * U + uw; A *= aw; }
            const int np = dd ? nc - 1 - n : n, step = isctx ? np : 2 + np; float* ag = AGG + ((size_t)((b * 6 + hd) * 2 + dd) * 18 + step) * 128 + cc;
            ag[0] = A; ag[64] = U; }
    }
}

__device__ __forceinline__ void rgc_unit(const Args& a, LAS unsigned char* lds, int l, int b, int hd, int cidx) {
    const int tid = opaque_tid();
    LAS float* hin = (LAS float*)lds;
    const bf16_t* P = (const bf16_t*)(a.ws + WS_P); bf16_t* MIX = (bf16_t*)(a.ws + WS_MIX); const float* AGG = (const float*)(a.ws + WS_RGAGG);
    const bool isctx = cidx >= 16; const int n = isctx ? cidx - 16 : cidx, nc = isctx ? 2 : 16, rowbase = (isctx ? NLAT + b * CTXL : b * SEQ) + n * 128;
    __syncthreads();
    if (tid < 128) { const int dd = tid >> 6, cc = tid & 63;
        const int np = dd ? nc - 1 - n : n, step = isctx ? np : 2 + np; const float* ag = AGG + (size_t)((b * 6 + hd) * 2 + dd) * 18 * 128 + cc;
        float Av[17], Uv[17];
#pragma unroll
        for (int s2 = 0; s2 < 17; ++s2) { Av[s2] = 1.f; Uv[s2] = 0.f; if (s2 < step) { Av[s2] = ag[s2 * 128]; Uv[s2] = ag[s2 * 128 + 64]; } }
        float hv = 0.f;
#pragma unroll
        for (int s2 = 0; s2 < 17; ++s2) hv = Av[s2] * hv + Uv[s2];
        hin[dd * 64 + cc] = hv; }
    __syncthreads();
    const int c4 = (tid & 15) * 4;
    const f32x4 hf = *(const LAS f32x4*)(hin + c4), hb = *(const LAS f32x4*)(hin + 64 + c4);
#pragma unroll
    for (int i = 0; i < 4; ++i) {
        const size_t row = (size_t)rowbase + (tid >> 4) + 32 * i;
        const bf16_t* pf = (const bf16_t*)(a.ws + WS_RGPF) + (row * 384 + hd * 64 + c4) * 4;
        const u32x4 w0 = *(const u32x4*)pf, w1 = *(const u32x4*)(pf + 8);
        const u32x2 gw = *(const u32x2*)(P + row * PW + PC_RG + hd * 64 + c4);
        const unsigned ww[8] = {w0.x, w0.y, w0.z, w0.w, w1.x, w1.y, w1.z, w1.w};
        float y[4];
#pragma unroll
        for (int j = 0; j < 4; ++j) y[j] = __uint_as_float(ww[2 * j] << 16) * hf[j] + __uint_as_float(ww[2 * j] & 0xffff0000u) + __uint_as_float(ww[2 * j + 1] << 16) * hb[j] + __uint_as_float(ww[2 * j + 1] & 0xffff0000u);
        u32x2 o; o.x = cvt_pk_bf16(__uint_as_float(gw.x << 16) * y[0], __uint_as_float(gw.x & 0xffff0000u) * y[1]); o.y = cvt_pk_bf16(__uint_as_float(gw.y << 16) * y[2], __uint_as_float(gw.y & 0xffff0000u) * y[3]);
        *(u32x2*)(MIX + row * 1024 + hd * 64 + c4) = o;
    }
}

__device__ __forceinline__ void gmlp_unit(const Args& a, LAS unsigned char* lds, int l, int chunk) {
    const int tid = opaque_tid(), wid = __builtin_amdgcn_readfirstlane(tid >> 6), lane = tid & 63, fr = lane & 15, fq = lane >> 4;
    LAS bf16_t* vn = (LAS bf16_t*)lds;
    const bf16_t* P = (const bf16_t*)(a.ws + WS_P); bf16_t* MIX = (bf16_t*)(a.ws + WS_MIX);
    const int row0 = chunk * 128;
    __syncthreads();
    {
        const f32x4 g = *(const f32x4*)(a.in[I_CMNG] + l * 256 + lane * 4);
        u32x2 wv[16];
#pragma unroll
        for (int i = 0; i < 16; ++i) wv[i] = *(const u32x2*)(P + (size_t)(row0 + wid * 16 + i) * PW + PC_CV + lane * 4);
#pragma unroll
        for (int i = 0; i < 16; ++i) {
            const int s = wid * 16 + i;
            const u32x2 w = wv[i];
            const float v0 = __uint_as_float(w.x << 16), v1 = __uint_as_float(w.x & 0xffff0000u), v2 = __uint_as_float(w.y << 16), v3 = __uint_as_float(w.y & 0xffff0000u);
            const float ss = wave_sum(v0 * v0 + v1 * v1 + v2 * v2 + v3 * v3);
            const float rstd = rsqrtf(ss * (1.0f / 256.0f) + EPS);
            u32x2 o; o.x = cvt_pk_bf16(v0 * rstd * g[0], v1 * rstd * g[1]); o.y = cvt_pk_bf16(v2 * rstd * g[2], v3 * rstd * g[3]);
            *(LAS u32x2*)(vn + s * 264 + lane * 4) = o;
        }
    }
    __syncthreads();
    const int g = wid >> 1, th = wid & 1;
    const float* ws = a.in[I_CMW] + ((size_t)(l * 4 + g) * 128) * 128;
    f32x4 acc[4][4];
#pragma unroll
    for (int m = 0; m < 4; ++m)
#pragma unroll
        for (int n = 0; n < 4; ++n) acc[m][n] = (f32x4){0.f, 0.f, 0.f, 0.f};
#pragma unroll
    for (int ks = 0; ks < 4; ++ks) {
        bf16x8 bw[4];
#pragma unroll
        for (int m = 0; m < 4; ++m) {
            const float* wp = ws + (size_t)(th * 64 + m * 16 + fr) * 128 + ks * 32 + fq * 8;
            const f32x4 w0 = *(const f32x4*)wp, w1 = *(const f32x4*)(wp + 4);
            u32x4 pk; pk.x = cvt_pk_bf16(w0[0], w0[1]); pk.y = cvt_pk_bf16(w0[2], w0[3]); pk.z = cvt_pk_bf16(w1[0], w1[1]); pk.w = cvt_pk_bf16(w1[2], w1[3]);
            bw[m] = __builtin_bit_cast(bf16x8, pk);
        }
#pragma unroll
        for (int n = 0; n < 4; ++n) {
            const bf16x8 av = trfrag(vn, 264, ks * 32, g * 64 + n * 16, fr, fq);
#pragma unroll
            for (int m = 0; m < 4; ++m) acc[m][n] = MFMA(av, bw[m], acc[m][n]);
        }
    }
#pragma unroll
    for (int m = 0; m < 4; ++m) {
        const int t = th * 64 + m * 16 + fr; const float bsv = a.in[I_CMB][(l * 4 + g) * 128 + t];
#pragma unroll
        for (int n = 0; n < 4; ++n) {
            const int cc = g * 64 + n * 16 + fq * 4;
            const u32x2 uw = *(const u32x2*)(P + (size_t)(row0 + t) * PW + PC_CU + cc);
            const float u0 = __uint_as_float(uw.x << 16), u1 = __uint_as_float(uw.x & 0xffff0000u), u2 = __uint_as_float(uw.y << 16), u3 = __uint_as_float(uw.y & 0xffff0000u);
            u32x2 o; o.x = cvt_pk_bf16(u0 * (acc[m][n][0] + bsv), u1 * (acc[m][n][1] + bsv)); o.y = cvt_pk_bf16(u2 * (acc[m][n][2] + bsv), u3 * (acc[m][n][3] + bsv));
            *(u32x2*)(MIX + (size_t)(row0 + t) * 1024 + 768 + cc) = o;
        }
    }
}

#define MX_NEXT(head) ({ __syncthreads(); if (tid == 0) *qv = (int)atomicAdd(q + (head) * 64, 1u); __syncthreads(); *qv; })
__device__ __forceinline__ void phase_mxa(const Args& a, LAS unsigned char* lds, int l) {
    unsigned* q = (unsigned*)(a.ws + WS_CTL + CTL_QUEUE) + l * 8 * 64; LAS int* qv = (LAS int*)(lds + LDS_BARW - 16); const int tid = opaque_tid();
    const int nch = (l == 0) ? 18 : 18;
    for (;;) { const int u = MX_NEXT(0); if (u >= 128) break; ms_unit(a, lds, l, u >> 3, (u >> 1) & 3, u & 1); }
    for (;;) { const int u = MX_NEXT(1); if (u >= 16 * 6 * nch) break; rg_unit<false>(a, lds, l, u / (6 * nch), (u / nch) % 6, u % nch); }
    const int ngm = (l == 0 ? TOK : NLAT) / 128;
    for (;;) { const int u = MX_NEXT(2); if (u >= ngm) break; gmlp_unit(a, lds, l, u); }
}
__device__ __forceinline__ void phase_mxc(const Args& a, LAS unsigned char* lds, int l) {
    unsigned* q = (unsigned*)(a.ws + WS_CTL + CTL_QUEUE) + l * 8 * 64; LAS int* qv = (LAS int*)(lds + LDS_BARW - 16); const int tid = opaque_tid();
    const int nch = (l == 0) ? 18 : 16;
    for (;;) { const int u = MX_NEXT(3); if (u >= 16 * 4 * nch) break; mo_unit(a, lds, l, u / (4 * nch), (u / nch) & 3, u % nch); }
    for (;;) { const int u = MX_NEXT(4); if (u >= 16 * 6 * nch) break; rgc_unit(a, lds, l, u / (6 * nch), (u / nch) % 6, u % nch); }
}
#undef MX_NEXT

constexpr int N_PHASES = 22;
__global__ void __launch_bounds__(NTHREADS, 2) fwd_kernel(Args a) {
    extern __shared__ __attribute__((aligned(16))) unsigned char lds_raw[];
    LAS unsigned char* lds = (LAS unsigned char*)lds_raw;
    const int lo = a.ph_lo, hi = a.ph_hi;
    XcdBarrier bar; bar.bar = (unsigned*)(a.ws + WS_CTL); bar.x = 0; bar.st = (volatile LAS unsigned*)(lds + LDS_BARW);
    if (hi - lo > 1) {
        if (threadIdx.x == 0) { *(LAS u32x4*)(lds + LDS_BARW) = (u32x4){0u, 0u, 0u, 0u}; }
        __syncthreads();
        bar = xcd_barrier_post((unsigned*)(a.ws + WS_CTL), (volatile LAS unsigned*)(lds + LDS_BARW));
    }
#ifndef PHSEL
#define PHSEL 0xFFF
#endif
#define SELJ(j) (((PHSEL) >> (j)) & 1)
#define IN(k) (lo <= (k) && (k) < hi)
#ifndef PROBE_MASK
#define PROBE_MASK 0u
#endif
    unsigned long long t_ph = PROBE_MASK ? __builtin_amdgcn_s_memrealtime() : 0ull;
#define SEAM(k) do { if (IN(k) && IN((k) + 1)) xcd_barrier(bar); \
    if (PROBE_MASK) { if (((PROBE_MASK) >> (k)) & 1u) { const unsigned long long t1 = __builtin_amdgcn_s_memrealtime(); while (__builtin_amdgcn_s_memrealtime() < t1 + (t1 - t_ph)) __builtin_amdgcn_s_sleep(4); } \
        __syncthreads(); t_ph = __builtin_amdgcn_s_memrealtime(); } } while (0)
    if (SELJ(10) && IN(0)) { p0_mod(a, lds); p0_conv(a, lds); }
    SEAM(0);
    for (int l = 0; l < 2; ++l) {
        const int pb = 1 + 10 * l, T = (l == 0) ? TOK : NLAT;
        if (SELJ(0) && IN(pb + 0)) phase_n1(a, l);
        SEAM(pb + 0);
        if (SELJ(1) && IN(pb + 1)) phase_g1(a, lds, l);
        SEAM(pb + 1);
        if (SELJ(2) && IN(pb + 2)) phase_mxa(a, lds, l);
        SEAM(pb + 2);
        if (SELJ(3) && IN(pb + 3)) phase_mxc(a, lds, l);
        SEAM(pb + 3);
        if (SELJ(4) && IN(pb + 4)) phase_g2(a, lds, l, T);
        SEAM(pb + 4);
        if (SELJ(5) && IN(pb + 5)) phase_n2(a, l, T);
        SEAM(pb + 5);
        if (SELJ(6) && IN(pb + 6)) phase_rt(a, lds, l, T);
        SEAM(pb + 6);
        if (SELJ(7) && IN(pb + 7)) phase_tk(a, lds, l, T);
        SEAM(pb + 7);
        if (SELJ(8) && IN(pb + 8)) phase_e1(a, lds, l, T);
        SEAM(pb + 8);
        if (SELJ(9) && IN(pb + 9)) phase_e2(a, lds, l, T);
        SEAM(pb + 9);
    }
    if (SELJ(11) && IN(21)) phase_fin(a);
#undef IN
#undef SEAM
}

extern "C" void kernel_launch(void* const* d_in, const int* in_sizes, int n_in, void* d_out, int out_size, void* d_ws, size_t ws_size, hipStream_t stream) {
    static int grid = 0;
    if (grid == 0) {
        if (n_in != 29 || out_size != NLAT * D || ws_size < WS_END) { fprintf(stderr, "kernel_launch: unexpected shapes (n_in %d, out %d, ws %zu, need %zu)\n", n_in, out_size, ws_size, (size_t)WS_END); grid = -1; return; }
        int dev = 0, cus = 0, per_cu = 0;
        if (hipGetDevice(&dev) != hipSuccess || hipDeviceGetAttribute(&cus, hipDeviceAttributeMultiprocessorCount, dev) != hipSuccess) { grid = -1; return; }
        if (hipFuncSetAttribute((const void*)fwd_kernel, hipFuncAttributeMaxDynamicSharedMemorySize, LDS_BYTES) != hipSuccess) { fprintf(stderr, "kernel_launch: hipFuncSetAttribute failed\n"); grid = -1; return; }
        if (hipOccupancyMaxActiveBlocksPerMultiprocessor(&per_cu, (const void*)fwd_kernel, NTHREADS, LDS_BYTES) != hipSuccess || per_cu < 1) { fprintf(stderr, "kernel_launch: occupancy query says %d\n", per_cu); (void)hipGetLastError(); grid = -1; return; }
        grid = cus;
    }
    if (grid < 0) return;
    (void)hipMemsetAsync((char*)d_ws + WS_CTL, 0, CTL_BYTES, stream);
    Args a{};
    for (int i = 0; i < 29; ++i) a.in[i] = (const float*)d_in[i];
    a.out = (float*)d_out; a.ws = (unsigned char*)d_ws;
#if MK_PER_PHASE
    for (int p = 0; p < N_PHASES; ++p) { a.ph_lo = p; a.ph_hi = p + 1; hipLaunchKernelGGL(fwd_kernel, dim3(grid), dim3(NTHREADS), LDS_BYTES, stream, a); }
#else
    a.ph_lo = 0; a.ph_hi = N_PHASES;
    hipLaunchKernelGGL(fwd_kernel, dim3(grid), dim3(NTHREADS), LDS_BYTES, stream, a);
#endif
}
```
